# Optimizing an MI355X kernel written in HIP

```python
import jax, jax.numpy as jnp
from jax import lax
import numpy as np

D_MODEL = 1024
BATCH = 2
SEQ = 8192
DEPTH = 2

N_MIXERS = 2
N_HEADS = 16
HEAD_DIM = D_MODEL // N_HEADS
N_KV_GROUPS = 2
HEADS_PER_GROUP = N_HEADS // N_KV_GROUPS
KV_DIM = N_KV_GROUPS * HEAD_DIM
N_BRANCH = 3
CMP_STRIDE = 16
CMP_BLOCK = 2 * CMP_STRIDE
CMP_HIDDEN = 256
SEL_BLOCK = 64
SEL_TOPK = 16
WINDOW = 512
Q_BLOCK = 128
ROPE_THETA = 10000.0
IN_SIZES = (D_MODEL,) + (KV_DIM,) * 6 + (N_BRANCH * N_HEADS,)
IN_COLS = sum(IN_SIZES)
POOL_WINDOWS = (2, 4, 8, 16)
N_POOL_GROUPS = len(POOL_WINDOWS)
POOL_GROUP_DIM = D_MODEL // N_POOL_GROUPS
D_FF = 2816
CONV_WIDTH = 3
NORM_EPS = 1e-6
NEG_INF = -1e30
FORCE_BONUS = 1e4

kernel_name = 'hybrid_nsa_pool_convffn'


def rmsnorm(x, g):
    xf = x.astype(jnp.float32)
    y = xf * lax.rsqrt(jnp.mean(xf * xf, axis=-1, keepdims=True) + NORM_EPS)
    return (y * g.astype(jnp.float32)).astype(x.dtype)


def rope_tables(pos):
    inv = 1.0 / (ROPE_THETA ** (jnp.arange(0, HEAD_DIM, 2, dtype=jnp.float32) / HEAD_DIM))
    ang = pos.astype(jnp.float32)[:, None] * inv[None, :]
    return jnp.cos(ang), jnp.sin(ang)


def apply_rope(a, cos, sin):
    a1, a2 = jnp.split(a.astype(jnp.float32), 2, axis=-1)
    c, s = cos[:, None, :], sin[:, None, :]
    return jnp.concatenate([a1 * c - a2 * s, a1 * s + a2 * c], axis=-1).astype(a.dtype)


def masked_softmax(s, mask):
    s = jnp.where(mask, s.astype(jnp.float32), NEG_INF)
    return jax.nn.softmax(s, axis=-1) * jnp.any(mask, axis=-1, keepdims=True)


def compress_blocks(a, pos_emb, w1, b1, w2, b2):
    B, T, G, dh = a.shape
    c = a.reshape(B, T // CMP_STRIDE, CMP_STRIDE, G, dh)
    blocks = jnp.concatenate([c[:, :-1], c[:, 1:]], axis=2) + pos_emb[:, None, :]
    flat = blocks.transpose(0, 1, 3, 2, 4).reshape(B, T // CMP_STRIDE - 1, G, CMP_BLOCK * dh)
    return jax.nn.gelu(flat @ w1 + b1) @ w2 + b2


def cmp_sel_overlap(n_cmp, n_blk):
    j = np.arange(n_cmp)[:, None]
    s = np.arange(n_blk)[None, :]
    lo = np.maximum(j * CMP_STRIDE, s * SEL_BLOCK)
    hi = np.minimum(j * CMP_STRIDE + CMP_BLOCK, (s + 1) * SEL_BLOCK)
    return jnp.asarray(np.clip(hi - lo, 0, None) / CMP_BLOCK, dtype=jnp.float32)


def gather_blocks(blocks, sel):
    return jax.vmap(jax.vmap(lambda bl, idx: bl[idx]))(blocks, sel)


def nsa_mixer(h, w_in, ck_pos, ck_w1, ck_b1, ck_w2, ck_b2,
              cv_pos, cv_w1, cv_b1, cv_w2, cv_b2, w_out):
    B, T, _ = h.shape
    G, HG, dh = N_KV_GROUPS, HEADS_PER_GROUP, HEAD_DIM
    n_cmp = T // CMP_STRIDE - 1
    n_blk = T // SEL_BLOCK
    n_sel = min(SEL_TOPK, n_blk)
    n_chunks = T // Q_BLOCK
    scale = HEAD_DIM ** -0.5
    split_at = [int(v) for v in np.cumsum(IN_SIZES)[:-1]]
    q, k_c, v_c, k_s, v_s, k_w, v_w, g_logit = jnp.split(h @ w_in, split_at, axis=-1)
    q = q.reshape(B, T, N_HEADS, dh)
    k_c, v_c, k_s, v_s, k_w, v_w = [a.reshape(B, T, G, dh) for a in (k_c, v_c, k_s, v_s, k_w, v_w)]
    cos, sin = rope_tables(jnp.arange(T))
    q = apply_rope(q, cos, sin)
    k_s = apply_rope(k_s, cos, sin)
    k_w = apply_rope(k_w, cos, sin)
    kc = compress_blocks(k_c, ck_pos, ck_w1, ck_b1, ck_w2, ck_b2)
    vc = compress_blocks(v_c, cv_pos, cv_w1, cv_b1, cv_w2, cv_b2)
    cmp_end = jnp.arange(n_cmp) * CMP_STRIDE + (CMP_BLOCK - 1)
    ccos, csin = rope_tables(cmp_end)
    kc = apply_rope(kc, ccos, csin)
    qg = q.reshape(B, T, G, HG, dh).transpose(0, 2, 3, 1, 4)
    kc = kc.transpose(0, 2, 1, 3)
    vc = vc.transpose(0, 2, 1, 3)
    kb = k_s.transpose(0, 2, 1, 3).reshape(B, G, n_blk, SEL_BLOCK, dh)
    vb = v_s.transpose(0, 2, 1, 3).reshape(B, G, n_blk, SEL_BLOCK, dh)
    pad_w = ((0, 0), (0, 0), (WINDOW, 0), (0, 0))
    kw = jnp.pad(k_w.transpose(0, 2, 1, 3), pad_w)
    vw = jnp.pad(v_w.transpose(0, 2, 1, 3), pad_w)
    gates = jax.nn.sigmoid(g_logit).reshape(B, T, G, HG, N_BRANCH).transpose(0, 2, 3, 1, 4)
    overlap = cmp_sel_overlap(n_cmp, n_blk)
    blk_ids = jnp.arange(n_blk)
    win_off = jnp.arange(Q_BLOCK + WINDOW)
    sel_off = jnp.arange(SEL_BLOCK)

    def chunk(i):
        s0 = i * Q_BLOCK
        t = s0 + jnp.arange(Q_BLOCK)
        qb = lax.dynamic_slice_in_dim(qg, s0, Q_BLOCK, axis=3)
        m_c = cmp_end[None, :] <= t[:, None]
        p_c = masked_softmax(jnp.einsum('bghqd,bgnd->bghqn', qb, kc) * scale, m_c)
        o_c = jnp.einsum('bghqn,bgnd->bghqd', p_c.astype(vc.dtype), vc)
        imp = jnp.einsum('bghqn,ns->bgqs', p_c, overlap)
        cur = t // SEL_BLOCK
        forced = (blk_ids == 0) | (blk_ids == cur[:, None]) | (blk_ids == cur[:, None] - 1)
        score = jnp.where(blk_ids <= cur[:, None], imp + FORCE_BONUS * forced, NEG_INF)
        _, sel = lax.top_k(score, n_sel)
        kg = gather_blocks(kb, sel)
        vg = gather_blocks(vb, sel)
        tok = sel[..., None] * SEL_BLOCK + sel_off
        m_s = (tok <= t[:, None, None]).reshape(B, G, 1, Q_BLOCK, n_sel * SEL_BLOCK)
        s_s = jnp.einsum('bghqd,bgqnkd->bghqnk', qb, kg).reshape(B, G, HG, Q_BLOCK, n_sel * SEL_BLOCK)
        p_s = masked_softmax(s_s * scale, m_s).reshape(B, G, HG, Q_BLOCK, n_sel, SEL_BLOCK)
        o_s = jnp.einsum('bghqnk,bgqnkd->bghqd', p_s.astype(vg.dtype), vg)
        kwb = lax.dynamic_slice_in_dim(kw, s0, Q_BLOCK + WINDOW, axis=2)
        vwb = lax.dynamic_slice_in_dim(vw, s0, Q_BLOCK + WINDOW, axis=2)
        kpos = s0 - WINDOW + win_off
        m_w = (kpos[None, :] <= t[:, None]) & (kpos[None, :] > t[:, None] - WINDOW) & (kpos[None, :] >= 0)
        p_w = masked_softmax(jnp.einsum('bghqd,bgkd->bghqk', qb, kwb) * scale, m_w)
        o_w = jnp.einsum('bghqk,bgkd->bghqd', p_w.astype(vwb.dtype), vwb)
        gb = lax.dynamic_slice_in_dim(gates, s0, Q_BLOCK, axis=3)
        return gb[..., 0:1] * o_c + gb[..., 1:2] * o_s + gb[..., 2:3] * o_w

    o = lax.map(chunk, jnp.arange(n_chunks))
    o = o.transpose(1, 0, 4, 2, 3, 5).reshape(B, T, D_MODEL)
    return o @ w_out


def pool_mixer(h, pool_w, pool_b, pool_scale):
    B, T, _ = h.shape
    hf = h.astype(jnp.float32)
    csum = jnp.pad(jnp.cumsum(hf, axis=1), ((0, 0), (1, 0), (0, 0)))
    count_base = jnp.arange(1, T + 1, dtype=jnp.float32)[:, None]
    outs = []
    for g, w in enumerate(POOL_WINDOWS):
        sl = slice(g * POOL_GROUP_DIM, (g + 1) * POOL_GROUP_DIM)
        c = csum[..., sl]
        lag = jnp.pad(c, ((0, 0), (w - 1, 0), (0, 0)))[:, :T]
        count = jnp.minimum(count_base, float(w))
        outs.append((c[:, 1:] - lag) / count - hf[..., sl])
    pooled = jnp.stack(outs, axis=2)
    y = jnp.einsum('btgc,gcd->btgd', pooled, pool_w.astype(jnp.float32)) + pool_b
    return (y.reshape(B, T, D_MODEL) * pool_scale).astype(h.dtype)


def conv_ffn(h, w_up, conv_w, conv_b, w_down):
    u = h @ w_up
    T = u.shape[1]
    up = jnp.pad(u, ((0, 0), (CONV_WIDTH - 1, 0), (0, 0)))
    conv = sum(conv_w[k] * up[:, k:k + T] for k in range(CONV_WIDTH)) + conv_b
    gate, val = jnp.split(conv, 2, axis=-1)
    return (jax.nn.silu(gate) * val) @ w_down


def setup_inputs(seed: int = 0) -> dict:
    key = jax.random.key(seed)
    ks = iter(jax.random.split(key, 40))
    f32 = jnp.float32

    def w(shape, fan_in):
        return jax.random.normal(next(ks), shape, f32) * (fan_in ** -0.5)

    def gain(n):
        return 1.0 + 0.02 * jax.random.normal(next(ks), (n,), f32)

    def bias(shape):
        return 0.01 * jax.random.normal(next(ks), shape, f32)

    def ffn_params():
        return (gain(D_MODEL), w((D_MODEL, 2 * D_FF), D_MODEL),
                w((CONV_WIDTH, 2 * D_FF), CONV_WIDTH), bias((2 * D_FF,)),
                w((D_FF, D_MODEL), D_FF))

    x = jax.random.normal(next(ks), (BATCH, SEQ, D_MODEL), f32)
    norm_mix_0 = gain(D_MODEL)
    nsa_w_in = w((D_MODEL, IN_COLS), D_MODEL)
    cmp_k_pos = 0.02 * jax.random.normal(next(ks), (CMP_BLOCK, HEAD_DIM), f32)
    cmp_k_w1 = w((CMP_BLOCK * HEAD_DIM, CMP_HIDDEN), CMP_BLOCK * HEAD_DIM)
    cmp_k_b1 = bias((CMP_HIDDEN,))
    cmp_k_w2 = w((CMP_HIDDEN, HEAD_DIM), CMP_HIDDEN)
    cmp_k_b2 = bias((HEAD_DIM,))
    cmp_v_pos = 0.02 * jax.random.normal(next(ks), (CMP_BLOCK, HEAD_DIM), f32)
    cmp_v_w1 = w((CMP_BLOCK * HEAD_DIM, CMP_HIDDEN), CMP_BLOCK * HEAD_DIM)
    cmp_v_b1 = bias((CMP_HIDDEN,))
    cmp_v_w2 = w((CMP_HIDDEN, HEAD_DIM), CMP_HIDDEN)
    cmp_v_b2 = bias((HEAD_DIM,))
    nsa_w_out = w((D_MODEL, D_MODEL), D_MODEL)
    norm_ffn_0, ffn_up_0, ffn_conv_w_0, ffn_conv_b_0, ffn_down_0 = ffn_params()
    norm_mix_1 = gain(D_MODEL)
    pool_w = w((N_POOL_GROUPS, POOL_GROUP_DIM, POOL_GROUP_DIM), POOL_GROUP_DIM)
    pool_b = bias((N_POOL_GROUPS, POOL_GROUP_DIM))
    pool_scale = 1.0 + 0.1 * jax.random.normal(next(ks), (D_MODEL,), f32)
    norm_ffn_1, ffn_up_1, ffn_conv_w_1, ffn_conv_b_1, ffn_down_1 = ffn_params()
    norm_final = gain(D_MODEL)
    return {
        'x': x, 'norm_mix_0': norm_mix_0, 'nsa_w_in': nsa_w_in,
        'cmp_k_pos': cmp_k_pos, 'cmp_k_w1': cmp_k_w1, 'cmp_k_b1': cmp_k_b1,
        'cmp_k_w2': cmp_k_w2, 'cmp_k_b2': cmp_k_b2,
        'cmp_v_pos': cmp_v_pos, 'cmp_v_w1': cmp_v_w1, 'cmp_v_b1': cmp_v_b1,
        'cmp_v_w2': cmp_v_w2, 'cmp_v_b2': cmp_v_b2, 'nsa_w_out': nsa_w_out,
        'norm_ffn_0': norm_ffn_0, 'ffn_up_0': ffn_up_0, 'ffn_conv_w_0': ffn_conv_w_0,
        'ffn_conv_b_0': ffn_conv_b_0, 'ffn_down_0': ffn_down_0,
        'norm_mix_1': norm_mix_1, 'pool_w': pool_w, 'pool_b': pool_b, 'pool_scale': pool_scale,
        'norm_ffn_1': norm_ffn_1, 'ffn_up_1': ffn_up_1, 'ffn_conv_w_1': ffn_conv_w_1,
        'ffn_conv_b_1': ffn_conv_b_1, 'ffn_down_1': ffn_down_1, 'norm_final': norm_final,
    }


def reference(x, norm_mix_0, nsa_w_in, cmp_k_pos, cmp_k_w1, cmp_k_b1, cmp_k_w2, cmp_k_b2,
              cmp_v_pos, cmp_v_w1, cmp_v_b1, cmp_v_w2, cmp_v_b2, nsa_w_out,
              norm_ffn_0, ffn_up_0, ffn_conv_w_0, ffn_conv_b_0, ffn_down_0,
              norm_mix_1, pool_w, pool_b, pool_scale,
              norm_ffn_1, ffn_up_1, ffn_conv_w_1, ffn_conv_b_1, ffn_down_1, norm_final):
    mixers = [
        lambda h: nsa_mixer(h, nsa_w_in, cmp_k_pos, cmp_k_w1, cmp_k_b1, cmp_k_w2, cmp_k_b2,
                            cmp_v_pos, cmp_v_w1, cmp_v_b1, cmp_v_w2, cmp_v_b2, nsa_w_out),
        lambda h: pool_mixer(h, pool_w, pool_b, pool_scale),
    ]
    mix_norms = [norm_mix_0, norm_mix_1]
    ffns = [(norm_ffn_0, ffn_up_0, ffn_conv_w_0, ffn_conv_b_0, ffn_down_0),
            (norm_ffn_1, ffn_up_1, ffn_conv_w_1, ffn_conv_b_1, ffn_down_1)]
    for i in range(DEPTH):
        x = x + mixers[i % N_MIXERS](rmsnorm(x, mix_norms[i]))
        g, up, cw, cb, down = ffns[i]
        x = x + conv_ffn(rmsnorm(x, g), up, cw, cb, down)
    return rmsnorm(x, norm_final)
```

```cpp
#include <hip/hip_runtime.h>
#include <hip/hip_cooperative_groups.h>
#include <cstdio>
#include <cstdint>
namespace cg = cooperative_groups;

#define LAS __attribute__((address_space(3)))
typedef unsigned short bf16_t;
typedef short bf16x8 __attribute__((ext_vector_type(8)));
typedef short s16x4 __attribute__((ext_vector_type(4)));
typedef float f32x4 __attribute__((ext_vector_type(4)));
typedef unsigned u32x4 __attribute__((ext_vector_type(4)));
typedef unsigned u32x2 __attribute__((ext_vector_type(2)));

constexpr int T = 8192, D = 1024, M = 16384, FF = 2816, UP = 5632, NIN = 2048;
constexpr float EPS = 1e-6f;
constexpr float QSCALE = 0.125f * 1.4426950408889634f;
constexpr size_t MiB = 1u << 20;
constexpr size_t WS_ROPE = 1 * MiB;
constexpr size_t WS_SSP = 3 * MiB;
constexpr size_t WS_C1P = 4 * MiB;
constexpr size_t WS_RSTD = 4 * MiB + 256 * 1024;
constexpr size_t WS_HB = 5 * MiB;
constexpr size_t WS_FB = 8 * MiB;
constexpr size_t WS_GATE = 11 * MiB;
constexpr size_t WS_WIN = 16 * MiB, WS_WOUT = 20 * MiB, WS_WUP0 = 22 * MiB, WS_WUP1 = 33 * MiB, WS_WDN0 = 44 * MiB, WS_WDN1 = 50 * MiB;
constexpr size_t WS_WPOOL = 56 * MiB, WS_WC1K = 57 * MiB, WS_WC1V = 58 * MiB, WS_WC2K = 59 * MiB, WS_WC2V = 59 * MiB + 512 * 1024;
constexpr size_t WS_XB = 64 * MiB;
constexpr size_t WS_Q = 96 * MiB;
constexpr size_t WS_KC = 128 * MiB, WS_VC = 132 * MiB, WS_KS = 136 * MiB, WS_VST = 140 * MiB, WS_KW = 144 * MiB, WS_VWT = 148 * MiB;
constexpr size_t WS_KCC = 152 * MiB, WS_VCT = 153 * MiB, WS_HIDK = 154 * MiB, WS_HIDV = 155 * MiB;
constexpr size_t WS_O = 160 * MiB;
constexpr size_t WS_ACT = 96 * MiB;
constexpr size_t WS_POOLED = 192 * MiB;
constexpr int LDS_RING = 131072, LDS_BYTES = 155648;

__device__ __forceinline__ unsigned cvt_pk_bf16(float lo, float hi) { unsigned r; asm volatile("v_cvt_pk_bf16_f32 %0, %1, %2" : "=v"(r) : "v"(lo), "v"(hi)); return r; }
__device__ __forceinline__ float bf2f(unsigned short b) { return __uint_as_float((unsigned)b << 16); }
__device__ __forceinline__ float ex2(float x) { return __builtin_amdgcn_exp2f(x); }
__device__ __forceinline__ float rcp(float x) { return __builtin_amdgcn_rcpf(x); }
__device__ __forceinline__ float sigmoidf_(float x) { return rcp(1.0f + ex2(-1.4426950408889634f * x)); }
__device__ __forceinline__ int perm8(int a) { return (a & ~31) | (16 * ((a >> 2) & 1) + 4 * ((a >> 3) & 3) + (a & 3)); }
__device__ __forceinline__ int vperm(int kk) { return (kk & 32) | (((kk >> 2) & 3) << 3) | (((kk >> 4) & 1) << 2) | (kk & 3); }
__device__ __forceinline__ int swap45(int a) { return (a & ~48) | (((a >> 4) & 1) << 5) | (((a >> 5) & 1) << 4); }
template <int CTRL> __device__ __forceinline__ float dppf(float x) { return __builtin_bit_cast(float, __builtin_amdgcn_mov_dpp(__builtin_bit_cast(int, x), CTRL, 0xf, 0xf, true)); }
__device__ __forceinline__ float xrow16_max(float x) {
    auto s = __builtin_amdgcn_permlane16_swap(__float_as_uint(x), __float_as_uint(x), false, false); x = fmaxf(__uint_as_float(s[0]), __uint_as_float(s[1]));
    auto t = __builtin_amdgcn_permlane32_swap(__float_as_uint(x), __float_as_uint(x), false, false); return fmaxf(__uint_as_float(t[0]), __uint_as_float(t[1])); }
__device__ __forceinline__ float xrow16_sum(float x) {
    auto s = __builtin_amdgcn_permlane16_swap(__float_as_uint(x), __float_as_uint(x), false, false); x = __uint_as_float(s[0]) + __uint_as_float(s[1]);
    auto t = __builtin_amdgcn_permlane32_swap(__float_as_uint(x), __float_as_uint(x), false, false); return __uint_as_float(t[0]) + __uint_as_float(t[1]); }
__device__ __forceinline__ float sum8(float x) { x += dppf<0xB1>(x); x += dppf<0x4E>(x); x += dppf<0x141>(x); return x; }
#define LDS_WAIT() asm volatile("s_waitcnt lgkmcnt(0)" ::: "memory")
#define WG_BAR() do { asm volatile("s_waitcnt lgkmcnt(0)" ::: "memory"); __builtin_amdgcn_s_barrier(); asm volatile("" ::: "memory"); } while (0)

namespace pg8 {
constexpr int BM = 256, BK = 64, HALF = 128, HTB = HALF * BK * 2, NXCD = 8, WGM = 8;
__host__ __device__ __forceinline__ int lds_byte(int r, int c) { const int st = (r >> 4) * 2 + (c >> 5), rr = r & 15, cc = c & 31, ob = rr * 64 + cc * 2; return st * 1024 + (ob ^ (((ob >> 9) & 1) << 5)); }
__host__ __device__ __forceinline__ void stage_rc(int b, int& R, int& C) { const int st = b / 1024, sb = b % 1024, swz = sb ^ (((sb >> 9) & 1) << 5); R = (st >> 1) * 16 + swz / 64; C = (st & 1) * 32 + (swz % 64) / 2; }
struct Unit { int pm, pn; };
struct Gemm { const bf16_t* A; const bf16_t* Bt; int M, N, K, lda, apn; };
struct StaticOrder {
    int nM, nN, nwg, G, c;
    __device__ __forceinline__ void init(int M_, int N_, int G_, int c_) { nM = M_ / BM; nN = N_ / BM; nwg = nM * nN; G = G_; c = c_; }
    __device__ __forceinline__ bool next(int i, Unit& u) const {
        const long L = (long)i * G + c; if (L >= nwg) return false;
        int wgid = (int)L; { const int q = nwg / NXCD, r = nwg % NXCD, xcd = wgid % NXCD, off = wgid / NXCD; wgid = (xcd < r ? xcd * (q + 1) : r * (q + 1) + (xcd - r) * q) + off; }
        const int nig = WGM * nN, gid = wgid / nig, fm = gid * WGM, gsz = (nM - fm) < WGM ? (nM - fm) : WGM;
        u.pm = fm + ((wgid % nig) % gsz); u.pn = (wgid % nig) / gsz; return true;
    }
};
template <class Epi>
__device__ __forceinline__ void gemm_phase(LAS unsigned char* lds, LAS unsigned char* ldsx, const Gemm g, const StaticOrder& S, const Epi& E) {
    int tid = threadIdx.x; asm volatile("" : "+v"(tid));
    const int wid = __builtin_amdgcn_readfirstlane(tid >> 6), lane = tid & 63, wr = wid >> 2, wc = wid & 3, fr = lane & 15, fq = lane >> 4;
    const int K = g.K, nt = K / BK;
    unsigned voffA[2], voffB[2];
#pragma unroll
    for (int i = 0; i < 2; ++i) { int R, C; stage_rc(tid * 16 + i * 8192, R, C); voffA[i] = (unsigned)(R * g.lda + C) * 2u; voffB[i] = (unsigned)(R * K + C) * 2u; }
    const size_t kstep = (size_t)(BK * 2);
    const size_t hstepA = (size_t)HALF * g.lda * 2, tstepA = 2 * hstepA, hstepB = (size_t)HALF * K * 2, tstepB = 2 * hstepB;
    const unsigned ldsw = (unsigned)wid * 1024u;
    const int aoff = lds_byte(wr * 64 + fr, fq * 8), boff = lds_byte(wc * 32 + fr, fq * 8);
#define PG8_SA(b, h) (((b) * 2 + (h)) * HTB)
#define PG8_SB(b, h) ((4 + (b) * 2 + (h)) * HTB)
#define PG8_STAGE(bufoff, gbase, voff) do { _Pragma("unroll") for (int _i = 0; _i < 2; ++_i) \
        __builtin_amdgcn_global_load_lds((const unsigned*)((const char*)(gbase) + (voff)[_i]), (LAS unsigned*)(lds + (bufoff) + ldsw + _i * 8192), 16, 0, 0); } while (0)
#define PG8_LDA(dst, b, h) do { _Pragma("unroll") for (int m = 0; m < 4; ++m) _Pragma("unroll") for (int k = 0; k < 2; ++k) dst[m][k] = *(const LAS bf16x8*)(lds + PG8_SA(b, h) + aoff + m * 2048 + k * 1024); } while (0)
#define PG8_LDB(dst, b, h) do { _Pragma("unroll") for (int n = 0; n < 2; ++n) _Pragma("unroll") for (int k = 0; k < 2; ++k) dst[n][k] = *(const LAS bf16x8*)(lds + PG8_SB(b, h) + boff + n * 2048 + k * 1024); } while (0)
#define PG8_MMA(ai, bj, At, Bt) do { __builtin_amdgcn_s_setprio(1); _Pragma("unroll") for (int m = 0; m < 4; ++m) _Pragma("unroll") for (int n = 0; n < 2; ++n) _Pragma("unroll") for (int k = 0; k < 2; ++k) \
        acc[ai][bj][m][n] = __builtin_amdgcn_mfma_f32_16x16x32_bf16(Bt[n][k], At[m][k], acc[ai][bj][m][n], 0, 0, 0); __builtin_amdgcn_s_setprio(0); } while (0)
#define PG8_WAIT_V(n) asm volatile("s_waitcnt vmcnt(" #n ")" ::: "memory")
#define PG8_WAIT_L(n) asm volatile("s_waitcnt lgkmcnt(" #n ")" ::: "memory")
#define PG8_BAR __builtin_amdgcn_s_barrier()
#define PG8_SCHED __builtin_amdgcn_sched_barrier(0)
    Unit cur, nxt; int ui = 0;
    if (!S.next(0, cur)) return;
    f32x4 acc[2][2][4][2];
#pragma unroll
    for (int a = 0; a < 2; ++a)
#pragma unroll
        for (int b = 0; b < 2; ++b)
#pragma unroll
            for (int m = 0; m < 4; ++m)
#pragma unroll
                for (int n = 0; n < 2; ++n) acc[a][b][m][n] = (f32x4){0.f, 0.f, 0.f, 0.f};
    bf16x8 At[4][2], B0[2][2], B1[2][2];
    const char* cA = (const char*)g.A + (size_t)cur.pm * tstepA + (size_t)cur.pn * g.apn; const char* cB = (const char*)g.Bt + (size_t)cur.pn * tstepB;
    PG8_STAGE(PG8_SB(0, 0), cB, voffB); PG8_STAGE(PG8_SB(0, 1), cB + hstepB, voffB); PG8_STAGE(PG8_SA(0, 0), cA, voffA); PG8_STAGE(PG8_SA(0, 1), cA + hstepA, voffA);
    if (wr == 1) PG8_BAR;
    PG8_WAIT_V(2); PG8_BAR;
    PG8_STAGE(PG8_SB(1, 0), cB + kstep, voffB); PG8_STAGE(PG8_SA(1, 0), cA + kstep, voffA); PG8_STAGE(PG8_SB(1, 1), cB + hstepB + kstep, voffB);
    PG8_WAIT_V(6); PG8_BAR;
    for (;;) {
        const bool has_next = S.next(ui + 1, nxt);
        const char* nA = has_next ? (const char*)g.A + (size_t)nxt.pm * tstepA + (size_t)nxt.pn * g.apn : cA; const char* nB = has_next ? (const char*)g.Bt + (size_t)nxt.pn * tstepB : cB;
        for (int t = 0; t < nt; t += 2) {
            const bool last = (t == nt - 2);
            const char* a1 = cA + (size_t)(t + 1) * kstep;
            const char* a2 = last ? nA : cA + (size_t)(t + 2) * kstep; const char* b2 = last ? nB : cB + (size_t)(t + 2) * kstep;
            const char* a3 = a2 + kstep; const char* b3 = b2 + kstep;
            PG8_LDB(B0, 0, 0); PG8_LDB(B1, 0, 1); PG8_SCHED; PG8_LDA(At, 0, 0); PG8_STAGE(PG8_SA(1, 1), a1 + hstepA, voffA);
            PG8_WAIT_V(8); PG8_WAIT_L(0); PG8_BAR; PG8_MMA(0, 0, At, B0); PG8_MMA(0, 1, At, B1); PG8_BAR; PG8_SCHED;
            PG8_LDA(At, 0, 1); PG8_STAGE(PG8_SB(0, 0), b2, voffB); PG8_STAGE(PG8_SB(0, 1), b2 + hstepB, voffB); PG8_STAGE(PG8_SA(0, 0), a2, voffA);
            PG8_WAIT_V(8); PG8_WAIT_L(0); PG8_BAR; PG8_MMA(1, 0, At, B0); PG8_MMA(1, 1, At, B1); PG8_BAR; PG8_SCHED;
            PG8_LDB(B0, 1, 0); PG8_LDB(B1, 1, 1); PG8_SCHED; PG8_LDA(At, 1, 0); PG8_STAGE(PG8_SA(0, 1), a2 + hstepA, voffA);
            PG8_WAIT_V(8); PG8_WAIT_L(0); PG8_BAR; PG8_MMA(0, 0, At, B0); PG8_MMA(0, 1, At, B1); PG8_BAR; PG8_SCHED;
            PG8_LDA(At, 1, 1); PG8_STAGE(PG8_SB(1, 0), b3, voffB); PG8_STAGE(PG8_SB(1, 1), b3 + hstepB, voffB); PG8_STAGE(PG8_SA(1, 0), a3, voffA);
            PG8_WAIT_V(8); PG8_WAIT_L(0); PG8_BAR; PG8_MMA(1, 0, At, B0); PG8_MMA(1, 1, At, B1); PG8_BAR; PG8_SCHED;
        }
        if (wr == 0) PG8_BAR;
        E(acc, cur, wr, wc, fr, fq, ldsx, tid);
        if (!has_next) break;
#pragma unroll
        for (int a = 0; a < 2; ++a)
#pragma unroll
            for (int b = 0; b < 2; ++b)
#pragma unroll
                for (int m = 0; m < 4; ++m)
#pragma unroll
                    for (int n = 0; n < 2; ++n) acc[a][b][m][n] = (f32x4){0.f, 0.f, 0.f, 0.f};
        cur = nxt; cA = nA; cB = nB; ++ui;
        if (wr == 1) PG8_BAR;
    }
    PG8_WAIT_V(0);
    PG8_BAR;
#undef PG8_SA
#undef PG8_SB
#undef PG8_STAGE
#undef PG8_LDA
#undef PG8_LDB
#undef PG8_MMA
#undef PG8_WAIT_V
#undef PG8_WAIT_L
#undef PG8_BAR
#undef PG8_SCHED
}
}
using pg8::Unit;
typedef f32x4 Acc[2][2][4][2];

__device__ __forceinline__ float row_rstd(const float* ssp, int np, int row) {
    float s = 0.f; for (int i = 0; i < np; ++i) s += ssp[(size_t)i * M + row];
    return 1.0f / sqrtf(s * (1.0f / D) + EPS);
}

struct EpiIn {
    const float* rstdv; const float* cosT; const float* sinT;
    bf16_t *Q, *KC, *VC, *KS, *VST, *KW, *VWT; float* gates;
    __device__ __forceinline__ void operator()(Acc& acc, const Unit& u, int wr, int wc, int fr, int fq, LAS unsigned char*, int) const {
#pragma unroll
        for (int ai = 0; ai < 2; ++ai)
#pragma unroll
            for (int m = 0; m < 4; ++m) {
                const int row = u.pm * 256 + ai * 128 + wr * 64 + m * 16 + fr; const float rs = rstdv[row];
                const int t = row & (T - 1), b = row >> 13;
                const int d0 = 16 * (wc & 1) + 4 * fq;
                const f32x4 cs = *(const f32x4*)(cosT + t * 32 + d0), sn = *(const f32x4*)(sinT + t * 32 + d0);
#pragma unroll
                for (int bj = 0; bj < 2; ++bj) {
                    f32x4 a1 = acc[ai][bj][m][0] * rs, a2 = acc[ai][bj][m][1] * rs;
                    if (u.pn == 7) {
                        if (bj == 0) {
#pragma unroll
                            for (int n = 0; n < 2; ++n) { const int c0 = 32 * wc + 16 * n + 4 * fq; if (c0 < 48) { const f32x4 v = n ? a2 : a1; f32x4 o; o[0] = sigmoidf_(v[0]); o[1] = sigmoidf_(v[1]); o[2] = sigmoidf_(v[2]); o[3] = sigmoidf_(v[3]); *(f32x4*)(gates + (size_t)row * 48 + c0) = o; } }
                        }
                        continue;
                    }
                    const int hh = 2 * bj + (wc >> 1);
                    bool rope; if (u.pn < 4) rope = true; else rope = (u.pn >= 5) && (hh < 2);
                    f32x4 o1 = a1, o2 = a2;
                    if (rope) { o1 = a1 * cs - a2 * sn; o2 = a1 * sn + a2 * cs; }
                    if (u.pn < 4) {
                        o1 = o1 * QSCALE; o2 = o2 * QSCALE;
                        bf16_t* p = Q + (size_t)row * 1024 + (u.pn * 4 + hh) * 64 + d0;
                        u32x2 w1; w1.x = cvt_pk_bf16(o1[0], o1[1]); w1.y = cvt_pk_bf16(o1[2], o1[3]); *(u32x2*)p = w1;
                        u32x2 w2; w2.x = cvt_pk_bf16(o2[0], o2[1]); w2.y = cvt_pk_bf16(o2[2], o2[3]); *(u32x2*)(p + 32) = w2;
                    } else {
                        const int gg = hh & 1; const bool isv = hh >= 2;
                        if (!isv) {
                            bf16_t* base = (u.pn == 4) ? KC : (u.pn == 5) ? KS : KW;
                            bf16_t* p = base + ((size_t)(b * 2 + gg) * T + t) * 64 + d0;
                            u32x2 w1; w1.x = cvt_pk_bf16(o1[0], o1[1]); w1.y = cvt_pk_bf16(o1[2], o1[3]); *(u32x2*)p = w1;
                            u32x2 w2; w2.x = cvt_pk_bf16(o2[0], o2[1]); w2.y = cvt_pk_bf16(o2[2], o2[3]); *(u32x2*)(p + 32) = w2;
                        } else if (u.pn == 4) {
                            bf16_t* p = VC + ((size_t)(b * 2 + gg) * T + t) * 64 + d0;
                            u32x2 w1; w1.x = cvt_pk_bf16(o1[0], o1[1]); w1.y = cvt_pk_bf16(o1[2], o1[3]); *(u32x2*)p = w1;
                            u32x2 w2; w2.x = cvt_pk_bf16(o2[0], o2[1]); w2.y = cvt_pk_bf16(o2[2], o2[3]); *(u32x2*)(p + 32) = w2;
                        } else {
                            bf16_t* base = (u.pn == 5) ? VST : VWT;
                            bf16_t* p = base + ((size_t)(b * 2 + gg) * 128 + (t >> 6)) * 4096 + vperm(t & 63);
#pragma unroll
                            for (int j = 0; j < 4; ++j) { p[(d0 + j) * 64] = (bf16_t)(cvt_pk_bf16(o1[j], 0.f) & 0xffff); p[(d0 + 32 + j) * 64] = (bf16_t)(cvt_pk_bf16(o2[j], 0.f) & 0xffff); }
                        }
                    }
                }
                asm volatile("" ::: "memory"); __builtin_amdgcn_sched_barrier(0);
            }
    }
};

struct EpiC1 {
    bf16_t* hid;
    __device__ __forceinline__ void operator()(Acc& acc, const Unit& u, int wr, int wc, int fr, int fq, LAS unsigned char* ldsx, int) const {
        const LAS float* c1 = (const LAS float*)ldsx;
#pragma unroll
        for (int bj = 0; bj < 2; ++bj) {
            const int c0 = 128 * bj + 32 * wc + 8 * fq;
            const f32x4 bA = *(const LAS f32x4*)(c1 + c0), bB = *(const LAS f32x4*)(c1 + c0 + 4);
#pragma unroll
            for (int ai = 0; ai < 2; ++ai)
#pragma unroll
                for (int m = 0; m < 4; ++m) {
                    const int row = u.pm * 256 + ai * 128 + wr * 64 + m * 16 + fr;
                    float v[8];
#pragma unroll
                    for (int e = 0; e < 8; ++e) { const float x = acc[ai][bj][m][e >> 2][e & 3] + ((e >> 2) ? bB[e & 3] : bA[e & 3]); const float y = 0.7978845608028654f * (x + 0.044715f * x * x * x); v[e] = x * sigmoidf_(2.0f * y); }
                    u32x4 w; w.x = cvt_pk_bf16(v[0], v[1]); w.y = cvt_pk_bf16(v[2], v[3]); w.z = cvt_pk_bf16(v[4], v[5]); w.w = cvt_pk_bf16(v[6], v[7]);
                    *(u32x4*)(hid + (size_t)row * 256 + c0) = w;
                    asm volatile("" ::: "memory"); __builtin_amdgcn_sched_barrier(0);
                }
        }
    }
};
struct EpiC2 {
    const float* b2; const float* cosT; const float* sinT; bf16_t* out; int isv;
    __device__ __forceinline__ void operator()(Acc& acc, const Unit& u, int wr, int wc, int fr, int fq, LAS unsigned char*, int) const {
        if (wc >= 2) return;
        const int d0 = 16 * (wc & 1) + 4 * fq;
        const f32x4 bA = *(const f32x4*)(b2 + d0), bB = *(const f32x4*)(b2 + d0 + 32);
#pragma unroll
        for (int ai = 0; ai < 2; ++ai)
#pragma unroll
            for (int m = 0; m < 4; ++m) {
                const int row = u.pm * 256 + ai * 128 + wr * 64 + m * 16 + fr; const int j = row & 511;
                f32x4 a1 = acc[ai][0][m][0] + bA, a2 = acc[ai][0][m][1] + bB;
                if (j == 511) { a1 = (f32x4){0.f, 0.f, 0.f, 0.f}; a2 = a1; }
                if (!isv) {
                    const int pos = (j == 511) ? 0 : 16 * j + 31;
                    const f32x4 cs = *(const f32x4*)(cosT + pos * 32 + d0), sn = *(const f32x4*)(sinT + pos * 32 + d0);
                    const f32x4 o1 = a1 * cs - a2 * sn, o2 = a1 * sn + a2 * cs;
                    bf16_t* p = out + (size_t)row * 64 + d0;
                    u32x2 w1; w1.x = cvt_pk_bf16(o1[0], o1[1]); w1.y = cvt_pk_bf16(o1[2], o1[3]); *(u32x2*)p = w1;
                    u32x2 w2; w2.x = cvt_pk_bf16(o2[0], o2[1]); w2.y = cvt_pk_bf16(o2[2], o2[3]); *(u32x2*)(p + 32) = w2;
                } else {
                    bf16_t* p = out + (size_t)(row >> 6) * 4096 + vperm(row & 63);
#pragma unroll
                    for (int e = 0; e < 4; ++e) { p[(d0 + e) * 64] = (bf16_t)(cvt_pk_bf16(a1[e], 0.f) & 0xffff); p[(d0 + 32 + e) * 64] = (bf16_t)(cvt_pk_bf16(a2[e], 0.f) & 0xffff); }
                }
                asm volatile("" ::: "memory"); __builtin_amdgcn_sched_barrier(0);
            }
    }
};

struct EpiRes {
    const float* xold; float* xnew; bf16_t* xb; float* ssp; const float* pb; const float* ps;
    __device__ __forceinline__ void operator()(Acc& acc, const Unit& u, int wr, int wc, int fr, int fq, LAS unsigned char* ldsx, int tid) const {
#pragma unroll
        for (int ai = 0; ai < 2; ++ai)
#pragma unroll
            for (int m = 0; m < 4; ++m) {
                const int row = u.pm * 256 + ai * 128 + wr * 64 + m * 16 + fr; float ss = 0.f;
#pragma unroll
                for (int bj = 0; bj < 2; ++bj) {
                    const int col = u.pn * 256 + 128 * bj + 32 * wc + 8 * fq; const size_t off = (size_t)row * D + col;
                    f32x4 a0 = acc[ai][bj][m][0], a1 = acc[ai][bj][m][1];
                    if (pb) { a0 = (a0 + *(const f32x4*)(pb + col)) * *(const f32x4*)(ps + col); a1 = (a1 + *(const f32x4*)(pb + col + 4)) * *(const f32x4*)(ps + col + 4); }
                    const f32x4 x0 = *(const f32x4*)(xold + off) + a0, x1 = *(const f32x4*)(xold + off + 4) + a1;
                    *(f32x4*)(xnew + off) = x0; *(f32x4*)(xnew + off + 4) = x1;
                    u32x4 w; w.x = cvt_pk_bf16(x0[0], x0[1]); w.y = cvt_pk_bf16(x0[2], x0[3]); w.z = cvt_pk_bf16(x1[0], x1[1]); w.w = cvt_pk_bf16(x1[2], x1[3]);
                    *(u32x4*)(xb + off) = w;
                    ss += (x0[0] * x0[0] + x0[1] * x0[1]) + (x0[2] * x0[2] + x0[3] * x0[3]) + (x1[0] * x1[0] + x1[1] * x1[1]) + (x1[2] * x1[2] + x1[3] * x1[3]);
                    asm volatile("" ::: "memory"); __builtin_amdgcn_sched_barrier(0);
                }
                ss = xrow16_sum(ss);
                if (fq == 0) ((LAS float*)ldsx)[wc * 256 + ai * 128 + wr * 64 + m * 16 + fr] = ss;
            }
        WG_BAR();
        if (tid < 256) { const LAS float* rd = (const LAS float*)ldsx; ssp[(size_t)u.pn * M + u.pm * 256 + tid] = (rd[tid] + rd[256 + tid]) + (rd[512 + tid] + rd[768 + tid]); }
        WG_BAR();
    }
};

struct EpiFinal {
    float* x; const float* gain; float* ssx; unsigned* cnt;
    __device__ __forceinline__ void operator()(Acc& acc, const Unit& u, int wr, int wc, int fr, int fq, LAS unsigned char* ldsx, int tid) const {
        LAS float* red = (LAS float*)ldsx; LAS float* rsl = (LAS float*)(ldsx + 4096);
#pragma unroll
        for (int ai = 0; ai < 2; ++ai)
#pragma unroll
            for (int m = 0; m < 4; ++m) {
                const int row = u.pm * 256 + ai * 128 + wr * 64 + m * 16 + fr; float ss = 0.f;
#pragma unroll
                for (int bj = 0; bj < 2; ++bj) {
                    const int col = u.pn * 256 + 128 * bj + 32 * wc + 8 * fq; const size_t off = (size_t)row * D + col;
                    const f32x4 x0 = *(const f32x4*)(x + off) + acc[ai][bj][m][0], x1 = *(const f32x4*)(x + off + 4) + acc[ai][bj][m][1];
                    acc[ai][bj][m][0] = x0; acc[ai][bj][m][1] = x1;
                    ss += (x0[0] * x0[0] + x0[1] * x0[1]) + (x0[2] * x0[2] + x0[3] * x0[3]) + (x1[0] * x1[0] + x1[1] * x1[1]) + (x1[2] * x1[2] + x1[3] * x1[3]);
                    asm volatile("" ::: "memory"); __builtin_amdgcn_sched_barrier(0);
                }
                ss = xrow16_sum(ss);
                if (fq == 0) red[wc * 256 + ai * 128 + wr * 64 + m * 16 + fr] = ss;
            }
        WG_BAR();
        if (tid < 256) __hip_atomic_store(ssx + (size_t)u.pn * M + u.pm * 256 + tid, (red[tid] + red[256 + tid]) + (red[512 + tid] + red[768 + tid]), __ATOMIC_RELAXED, __HIP_MEMORY_SCOPE_AGENT);
        asm volatile("s_waitcnt vmcnt(0)" ::: "memory");
        WG_BAR();
        if (tid == 0) {
            unsigned* c = cnt + 64 * u.pm;
            __hip_atomic_fetch_add(c, 1u, __ATOMIC_RELAXED, __HIP_MEMORY_SCOPE_AGENT);
            unsigned spins = 0;
            while (__hip_atomic_load(c, __ATOMIC_RELAXED, __HIP_MEMORY_SCOPE_AGENT) < 4u) { __builtin_amdgcn_s_sleep(2); if (++spins > (1u << 22)) break; }
            __builtin_amdgcn_fence(__ATOMIC_ACQUIRE, "agent");
            asm volatile("s_waitcnt vmcnt(0)" ::: "memory");
        }
        WG_BAR();
        if (tid < 256) {
            const float* p = ssx + u.pm * 256 + tid;
            const float sq = (__hip_atomic_load(p, __ATOMIC_RELAXED, __HIP_MEMORY_SCOPE_AGENT) + __hip_atomic_load(p + M, __ATOMIC_RELAXED, __HIP_MEMORY_SCOPE_AGENT)) +
                             (__hip_atomic_load(p + 2 * M, __ATOMIC_RELAXED, __HIP_MEMORY_SCOPE_AGENT) + __hip_atomic_load(p + 3 * M, __ATOMIC_RELAXED, __HIP_MEMORY_SCOPE_AGENT));
            rsl[tid] = 1.0f / sqrtf(sq * (1.0f / D) + EPS);
        }
        WG_BAR();
#pragma unroll
        for (int ai = 0; ai < 2; ++ai)
#pragma unroll
            for (int m = 0; m < 4; ++m) {
                const int rl = ai * 128 + wr * 64 + m * 16 + fr; const float rs = rsl[rl]; const int row = u.pm * 256 + rl;
#pragma unroll
                for (int bj = 0; bj < 2; ++bj) {
                    const int col = u.pn * 256 + 128 * bj + 32 * wc + 8 * fq; const size_t off = (size_t)row * D + col;
                    *(f32x4*)(x + off) = acc[ai][bj][m][0] * rs * *(const f32x4*)(gain + col); *(f32x4*)(x + off + 4) = acc[ai][bj][m][1] * rs * *(const f32x4*)(gain + col + 4);
                }
                asm volatile("" ::: "memory"); __builtin_amdgcn_sched_barrier(0);
            }
    }
};

struct EpiUp {
    const float* ssp; const float* cw; const float* cb; bf16_t* act; float* HB; float* FB;
    __device__ __forceinline__ void operator()(Acc& acc, const Unit& u, int wr, int wc, int fr, int fq, LAS unsigned char* ldsx, int tid) const {
        LAS float* Hl = (LAS float*)ldsx;
        LAS float* rsl = (LAS float*)(ldsx + 10240);
        const int lane = tid & 63;
        if (tid < 256) { const int row = u.pm * 256 + tid; const float sq = (ssp[row] + ssp[M + row]) + (ssp[2 * M + row] + ssp[3 * M + row]); rsl[tid] = 1.0f / sqrtf(sq * (1.0f / D) + EPS); }
        WG_BAR();
#pragma unroll
        for (int ai = 0; ai < 2; ++ai)
#pragma unroll
            for (int m = 0; m < 4; ++m) {
                const float rs = rsl[ai * 128 + wr * 64 + m * 16 + fr];
#pragma unroll
                for (int bj = 0; bj < 2; ++bj) { acc[ai][bj][m][0] *= rs; acc[ai][bj][m][1] *= rs; }
                asm volatile("" ::: "memory"); __builtin_amdgcn_sched_barrier(0);
            }
        if (tid < 128) *(LAS f32x4*)(Hl + tid * 4) = (f32x4){0.f, 0.f, 0.f, 0.f};
#pragma unroll
        for (int ai = 0; ai < 2; ++ai) {
            const int k = 2 * ai + wr;
#pragma unroll
            for (int bj = 0; bj < 2; ++bj)
#pragma unroll
                for (int n = 0; n < 2; ++n) {
                    const int tc = 128 * bj + 32 * wc + 8 * fq + 4 * n; const int uc = bj * FF + u.pn * 128 + 32 * wc + 8 * fq + 4 * n;
                    if (fr >= 14) { *(LAS f32x4*)(Hl + ((k + 1) * 2 + (fr - 14)) * 256 + tc) = acc[ai][bj][3][n]; if (k == 3) *(f32x4*)(HB + ((size_t)u.pm * 2 + (fr - 14)) * UP + uc) = acc[ai][bj][3][n]; }
                    if (k == 0 && fr < 2) *(f32x4*)(FB + ((size_t)u.pm * 2 + fr) * UP + uc) = acc[0][bj][0][n];
                }
        }
        WG_BAR();
#pragma unroll
        for (int ai = 0; ai < 2; ++ai) {
            const int k = 2 * ai + wr;
#pragma unroll
            for (int n = 0; n < 2; ++n) {
                const int tc = 32 * wc + 8 * fq + 4 * n; const int ucg = u.pn * 128 + tc;
                f32x4 cg[4];
#pragma unroll
                for (int bj = 0; bj < 2; ++bj) {
                    const int uc = bj * FF + ucg;
                    const f32x4 w0 = *(const f32x4*)(cw + uc), w1 = *(const f32x4*)(cw + UP + uc), w2 = *(const f32x4*)(cw + 2 * UP + uc), bb = *(const f32x4*)(cb + uc);
                    const f32x4 h0 = *(const LAS f32x4*)(Hl + (k * 2 + 0) * 256 + 128 * bj + tc), h1 = *(const LAS f32x4*)(Hl + (k * 2 + 1) * 256 + 128 * bj + tc);
#pragma unroll
                    for (int m = 0; m < 4; ++m) {
                        const f32x4 V = acc[ai][bj][m][n]; f32x4 p1, p2;
#pragma unroll
                        for (int e = 0; e < 4; ++e) {
                            const float r1 = dppf<0x121>(V[e]), r2 = dppf<0x122>(V[e]); float x1, x2;
                            if (m > 0) { x1 = dppf<0x121>(acc[ai][bj][m > 0 ? m - 1 : 0][n][e]); x2 = dppf<0x122>(acc[ai][bj][m > 0 ? m - 1 : 0][n][e]); }
                            else { x1 = h1[e]; x2 = (fr == 0) ? h0[e] : h1[e]; }
                            p1[e] = (fr == 0) ? x1 : r1; p2[e] = (fr < 2) ? x2 : r2;
                        }
                        const f32x4 cv = bb + w0 * p2 + w1 * p1 + w2 * V;
                        __builtin_amdgcn_sched_barrier(0);
                        if (bj == 0) cg[m] = cv;
                        else {
                            const int row = u.pm * 256 + ai * 128 + wr * 64 + m * 16 + fr;
                            float o[4];
#pragma unroll
                            for (int e = 0; e < 4; ++e) { const float gt = cg[m][e]; o[e] = gt * sigmoidf_(gt) * cv[e]; }
                            u32x2 w; w.x = cvt_pk_bf16(o[0], o[1]); w.y = cvt_pk_bf16(o[2], o[3]);
                            *(u32x2*)(act + (size_t)row * FF + ucg) = w;
                        }
                    }
                    asm volatile("" ::: "memory"); __builtin_amdgcn_sched_barrier(0);
                }
            }
        }
        WG_BAR();
    }
};

namespace att {
constexpr int SLOT_B = 16384, NSLOT = 6;
constexpr int OFF_K = 0, OFF_IMP = NSLOT * SLOT_B, IMPW = 132, OFF_SEL = OFF_IMP + 64 * IMPW * 4, OFF_UNI = OFF_SEL + 1024, OFF_LIST = OFF_UNI + 64, OFF_N = OFF_LIST + 132 * 4, OFF_CODE = OFF_N + 48, CODEW = 144;
static_assert(OFF_CODE + 8 * CODEW <= LDS_BYTES - 16 && 8 * SLOT_B <= OFF_SEL, "attention LDS map");
struct Ctx {
    const bf16_t *Q, *KCC, *VCT, *KS, *VST, *KW, *VWT; const float* gates; bf16_t* O;
};
__device__ __forceinline__ bf16x8 mk8(s16x4 a, s16x4 b) { return (bf16x8){a[0], a[1], a[2], a[3], b[0], b[1], b[2], b[3]}; }

template <int MODE>
__device__ __forceinline__ void branch(LAS unsigned char* lds, const bf16_t* Kg, const bf16_t* Vg, int ktile_elems, int nt, int c, int w, int lane, int tid,
                                       const bf16x8 (&qf)[4][2], float (&mrow)[4], float (&lrow)[4], f32x4 (&O)[4][4]) {
    const int fr = lane & 15, fq = lane >> 4;
    const LAS int* list = (const LAS int*)(lds + OFF_LIST);
    LAS float* impL = (LAS float*)(lds + OFF_IMP);
    const LAS unsigned char* codeL = (const LAS unsigned char*)(lds + OFF_CODE) + w * CODEW;
    constexpr int TPS = (MODE >= 2) ? 4 : 3;
#define ATT_DMA(ti, slot) do { const int ti_ = (ti); const int s_ = list[ti_]; LAS unsigned char* d_ = lds + OFF_K + (slot) * SLOT_B + w * 1024; \
        int t2_ = tid; asm volatile("" : "+v"(t2_)); const int lr = t2_ >> 3, lq = t2_ & 7; const int goff = lr * 64 + ((lq ^ ((lr >> 1) & 7)) * 8); \
        __builtin_amdgcn_global_load_lds((const unsigned*)(Kg + (size_t)s_ * ktile_elems + goff), (LAS unsigned*)d_, 16, 0, 0); \
        if (MODE != 0) __builtin_amdgcn_global_load_lds((const unsigned*)(Vg + (size_t)s_ * 4096 + goff), (LAS unsigned*)(d_ + 8192), 16, 0, 0); } while (0)
    asm volatile("s_waitcnt vmcnt(0)" ::: "memory");
#pragma unroll
    for (int ti = 0; ti < TPS; ++ti) if (ti < nt) ATT_DMA(ti, ti);
    const int nst = (nt + TPS - 1) / TPS;
    for (int j = 0; j < nst; ++j) {
        asm volatile("s_waitcnt vmcnt(0)" ::: "memory");
        WG_BAR();
#pragma unroll
        for (int hh = 0; hh < TPS; ++hh) if (TPS * (j + 1) + hh < nt) ATT_DMA(TPS * (j + 1) + hh, ((j + 1) & 1) * TPS + hh);
#pragma unroll 1
        for (int h = 0; h < TPS; ++h) {
        const int i = TPS * j + h; if (i >= nt) break;
        const int s = list[i];
        unsigned code = 0xffu; if (MODE == 2) code = (unsigned)__builtin_amdgcn_readfirstlane((int)codeL[i]);
        const LAS unsigned char* Kb = lds + OFF_K + ((j & 1) * TPS + h) * SLOT_B;
        const LAS unsigned char* Vb = Kb;
        int l2_ = lane; asm volatile("" : "+v"(l2_)); const int fr2 = l2_ & 15, fq2 = l2_ >> 4, swz = (fr2 >> 1) & 7;
        const int kb0 = fr2 * 128 + ((fq2 ^ swz) * 16), kb1 = kb0 ^ 64;
#pragma unroll
        for (int p = 0; p < 4; ++p) {
            const int ttA = 8 * w + 2 * p;
            const unsigned mA = (code >> (2 * p)) & 1u, mB = (code >> (2 * p + 1)) & 1u;
            if ((mA | mB) != 0u) {
            const int tt = ttA + (fr >> 3);
            float cinit;
            if (MODE == 1) cinit = lrow[p];
            else { const float mref = (mrow[p] < -1e29f) ? 0.f : mrow[p]; const bool colact = (MODE != 2) || (((fr >> 3) ? mB : mA) != 0u); cinit = colact ? -mref : -1e30f; }
            f32x4 sa[4];
#pragma unroll
            for (int mt = 0; mt < 4; ++mt) {
                sa[mt] = (f32x4){cinit, cinit, cinit, cinit};
#pragma unroll
                for (int ks = 0; ks < 2; ++ks) { const bf16x8 kf = *(const LAS bf16x8*)(Kb + (ks ? kb1 : kb0) + mt * 2048); sa[mt] = __builtin_amdgcn_mfma_f32_16x16x32_bf16(kf, qf[p][ks], sa[mt], 0, 0, 0); }
            }
            bool needmask;
            if (MODE <= 1) needmask = (((64 * c + ttA - 31) >> 4) - 64 * s) < 63;
            else if (MODE == 2) needmask = (s == c);
            else needmask = (s == c) || (c >= 8 && s == c - 8);
            if (needmask) {
                int hi, lov = -1;
                if (MODE <= 1) { const int t = 64 * c + tt; hi = ((t - 31) >> 4) - 64 * s; }
                else if (MODE == 2) hi = tt;
                else { hi = (s == c) ? tt : 63; lov = (c >= 8 && s == c - 8) ? tt : -1; }
#pragma unroll
                for (int mt = 0; mt < 4; ++mt)
#pragma unroll
                    for (int j = 0; j < 4; ++j) { const int kk = 16 * mt + 4 * fq + j; sa[mt][j] = (kk <= hi && kk > lov) ? sa[mt][j] : -1e30f; }
            }
            if (MODE != 1) {
                float mx = fmaxf(fmaxf(sa[0][0], sa[0][1]), sa[0][2]);
                mx = fmaxf(fmaxf(mx, sa[0][3]), sa[1][0]); mx = fmaxf(fmaxf(mx, sa[1][1]), sa[1][2]); mx = fmaxf(fmaxf(mx, sa[1][3]), sa[2][0]);
                mx = fmaxf(fmaxf(mx, sa[2][1]), sa[2][2]); mx = fmaxf(fmaxf(mx, sa[2][3]), sa[3][0]); mx = fmaxf(fmaxf(mx, sa[3][1]), sa[3][2]); mx = fmaxf(mx, sa[3][3]);
                mx = xrow16_max(mx);
                const bool uninit = mrow[p] < -1e29f;
                const bool resc = (mx > 8.0f) || (uninit && mx > -1e29f);
                if (__any(resc)) {
                    const float delta = resc ? mx : 0.f;
                    const float alpha = (resc && !uninit) ? ex2(-delta) : 1.0f;
#pragma unroll
                    for (int mt = 0; mt < 4; ++mt) sa[mt] = sa[mt] - delta;
                    lrow[p] *= alpha;
                    if (MODE >= 2) {
#pragma unroll
                        for (int d = 0; d < 4; ++d) O[p][d] *= alpha;
                    }
                    if (resc) mrow[p] = (uninit ? 0.f : mrow[p]) + delta;
                }
            }
            f32x4 pv[4];
#pragma unroll
            for (int mt = 0; mt < 4; ++mt)
#pragma unroll
                for (int j = 0; j < 4; ++j) pv[mt][j] = ex2(sa[mt][j]);
            if (MODE != 1) { const f32x4 t4 = (pv[0] + pv[1]) + (pv[2] + pv[3]); lrow[p] += (t4[0] + t4[1]) + (t4[2] + t4[3]); }
            if (MODE >= 1) {
                bf16x8 pf[2];
#pragma unroll
                for (int k2 = 0; k2 < 2; ++k2) {
                    u32x4 wv; wv.x = cvt_pk_bf16(pv[2 * k2][0], pv[2 * k2][1]); wv.y = cvt_pk_bf16(pv[2 * k2][2], pv[2 * k2][3]); wv.z = cvt_pk_bf16(pv[2 * k2 + 1][0], pv[2 * k2 + 1][1]); wv.w = cvt_pk_bf16(pv[2 * k2 + 1][2], pv[2 * k2 + 1][3]);
                    pf[k2] = __builtin_bit_cast(bf16x8, wv);
                }
#pragma unroll
                for (int d = 0; d < 4; ++d)
#pragma unroll
                    for (int k2 = 0; k2 < 2; ++k2) {
                        const bf16x8 vf = *(const LAS bf16x8*)(Vb + 8192 + (k2 ? kb1 : kb0) + d * 2048);
                        O[p][d] = __builtin_amdgcn_mfma_f32_16x16x32_bf16(vf, pf[k2], O[p][d], 0, 0, 0);
                    }
            }
            if (MODE == 1) {
#pragma unroll
                for (int mt = 0; mt < 4; ++mt) {
                    float a = pv[mt][0] + pv[mt][1] + pv[mt][2] + 0.5f * pv[mt][3], bn = 0.5f * pv[mt][3];
                    a = sum8(a); bn = sum8(bn);
                    const int sb = 16 * s + 4 * mt + fq;
                    if ((fr & 7) == 0) { (void)__hip_atomic_fetch_add(impL + tt * IMPW + sb, a, __ATOMIC_RELAXED, __HIP_MEMORY_SCOPE_WORKGROUP); (void)__hip_atomic_fetch_add(impL + tt * IMPW + sb + 1, bn, __ATOMIC_RELAXED, __HIP_MEMORY_SCOPE_WORKGROUP); }
                }
            }
            }
            __builtin_amdgcn_sched_barrier(0);
        }
        }
    }
    WG_BAR();
#undef ATT_DMA
}

__device__ __forceinline__ void unit(LAS unsigned char* lds, const Ctx& X, int b, int g, int c, int tid_in) {
    int tid = tid_in; asm volatile("" : "+v"(tid));
    const int lane = tid & 63, w = __builtin_amdgcn_readfirstlane(tid >> 6), fr = lane & 15, fq = lane >> 4;
    LAS int* list = (LAS int*)(lds + OFF_LIST);
    LAS unsigned* selm = (LAS unsigned*)(lds + OFF_SEL);
    LAS unsigned* uni = (LAS unsigned*)(lds + OFF_UNI);
    LAS float* impL = (LAS float*)(lds + OFF_IMP);
    LAS int* nl = (LAS int*)(lds + OFF_N);
    const int bg = b * 2 + g; const size_t rowbase = (size_t)b * T + 64 * c;
    bf16x8 qf[4][2];
#pragma unroll
    for (int p = 0; p < 4; ++p) { const bf16_t* qp = X.Q + (rowbase + 8 * w + 2 * p + (fr >> 3)) * 1024 + (8 * g + (fr & 7)) * 64 + 8 * fq;
#pragma unroll
        for (int ks = 0; ks < 2; ++ks) qf[p][ks] = *(const bf16x8*)(qp + 32 * ks); }
    for (int i = lane; i < 8 * IMPW; i += 64) impL[(8 * w) * IMPW + i] = 0.f;
    const int ncmp = (4 * c + 3 + 63) >> 6;
    if (tid < 8) list[tid] = tid;
    float mrow[4], lrow[4]; f32x4 O[4][4];
#pragma unroll
    for (int p = 0; p < 4; ++p) { mrow[p] = -1e30f; lrow[p] = 0.f;
#pragma unroll
        for (int d = 0; d < 4; ++d) { O[p][d] = (f32x4){0.f, 0.f, 0.f, 0.f}; } }
    WG_BAR();
    const bf16_t* kcc = X.KCC + (size_t)bg * 512 * 64; const bf16_t* vct = X.VCT + (size_t)bg * 8 * 4096;
    branch<0>(lds, kcc, vct, 4096, ncmp, c, w, lane, tid, qf, mrow, lrow, O);
#pragma unroll
    for (int p = 0; p < 4; ++p) { float l = xrow16_sum(lrow[p]); lrow[p] = (l > 0.f) ? (-mrow[p] - __builtin_amdgcn_logf(l)) : -1e30f; }
    branch<1>(lds, kcc, vct, 4096, ncmp, c, w, lane, tid, qf, mrow, lrow, O);
#define ATT_GATE(br, scale_expr) do { _Pragma("unroll") for (int p = 0; p < 4; ++p) { \
        const size_t grow = rowbase + 8 * w + 2 * p + (fr >> 3); \
        const float gt = X.gates[grow * 48 + (8 * g + (fr & 7)) * 3 + (br)]; const float sc = gt * (scale_expr); \
        _Pragma("unroll") for (int d = 0; d < 4; ++d) { \
            u32x2* optr = (u32x2*)(X.O + grow * 1024 + (8 * g + (fr & 7)) * 64 + 4 * fq + 16 * d); u32x2 ot = (u32x2){0u, 0u}; if ((br) > 0) ot = *optr; \
            float o0 = __uint_as_float(ot.x << 16), o1 = __uint_as_float(ot.x & 0xffff0000u), o2 = __uint_as_float(ot.y << 16), o3 = __uint_as_float(ot.y & 0xffff0000u); \
            o0 += sc * O[p][d][0]; o1 += sc * O[p][d][1]; o2 += sc * O[p][d][2]; o3 += sc * O[p][d][3]; \
            ot.x = cvt_pk_bf16(o0, o1); ot.y = cvt_pk_bf16(o2, o3); O[p][d] = (f32x4){0.f, 0.f, 0.f, 0.f}; \
            *optr = ot; } \
        mrow[p] = -1e30f; lrow[p] = 0.f; } } while (0)
    ATT_GATE(0, 1.0f);
    LDS_WAIT();
    for (int q8 = 0; q8 < 8; ++q8) {
        const int tt = 8 * w + q8;
        unsigned long long blo, bhi;
        if (c + 1 <= 16) { blo = (1ull << (c + 1)) - 1ull; bhi = 0ull; }
        else {
            const int s1 = lane, s2 = lane + 64;
            const bool c1 = (s1 >= 1 && s1 <= c - 2), c2 = (s2 >= 1 && s2 <= c - 2);
            const float v1 = c1 ? impL[tt * IMPW + s1] : -1.f, v2 = c2 ? impL[tt * IMPW + s2] : -1.f;
            int r1 = 0, r2 = 0;
            const int nq = (c - 2) / 4 + 1;
#pragma unroll 2
            for (int q = 0; q < nq; ++q) {
                const f32x4 x4 = *(const LAS f32x4*)(impL + tt * IMPW + 4 * q);
#pragma unroll
                for (int e = 0; e < 4; ++e) { const int sp = 4 * q + e; const float x = (sp >= 1 && sp <= c - 2) ? x4[e] : -2.f;
                    r1 += (x > v1 || (x == v1 && sp < s1)) ? 1 : 0; r2 += (x > v2 || (x == v2 && sp < s2)) ? 1 : 0; }
            }
            const bool f1 = (s1 == 0 || s1 == c || s1 == c - 1), f2 = (s2 == c || s2 == c - 1);
            blo = __ballot((c1 && r1 < 13) || f1); bhi = __ballot((c2 && r2 < 13) || f2);
        }
        if (lane == 0) { selm[tt * 4 + 0] = (unsigned)blo; selm[tt * 4 + 1] = (unsigned)(blo >> 32); selm[tt * 4 + 2] = (unsigned)bhi; selm[tt * 4 + 3] = (unsigned)(bhi >> 32); }
    }
    WG_BAR();
    if (tid < 4) { unsigned o = 0; for (int i = 0; i < 64; ++i) o |= selm[i * 4 + tid]; uni[tid] = o; }
    WG_BAR();
    if (tid == 0) { int n = 0; for (int s = 0; s <= c; ++s) if ((uni[s >> 5] >> (s & 31)) & 1u) list[n++] = s; nl[0] = n; }
    WG_BAR();
    const int nsel = nl[0];
    { LAS unsigned char* cw_ = (LAS unsigned char*)(lds + OFF_CODE) + w * CODEW;
      for (int i = lane; i < nsel; i += 64) { const int s_ = list[i]; unsigned cd = 0;
#pragma unroll
          for (int q8 = 0; q8 < 8; ++q8) cd |= ((selm[(8 * w + q8) * 4 + (s_ >> 5)] >> (s_ & 31)) & 1u) << q8;
          cw_[i] = (unsigned char)cd; }
      LDS_WAIT(); }
    branch<2>(lds, X.KS + (size_t)bg * T * 64, X.VST + (size_t)bg * 128 * 4096, 4096, nsel, c, w, lane, tid, qf, mrow, lrow, O);
#pragma unroll
    for (int p = 0; p < 4; ++p) { float l = xrow16_sum(lrow[p]); lrow[p] = (l > 0.f) ? 1.0f / l : 0.f; }
    { float rl[4] = {lrow[0], lrow[1], lrow[2], lrow[3]}; ATT_GATE(1, rl[p]); }
    const int w0 = (c >= 8) ? c - 8 : 0, nwin = c - w0 + 1;
    if (tid < nwin) list[tid] = w0 + tid;
    WG_BAR();
    branch<3>(lds, X.KW + (size_t)bg * T * 64, X.VWT + (size_t)bg * 128 * 4096, 4096, nwin, c, w, lane, tid, qf, mrow, lrow, O);
#pragma unroll
    for (int p = 0; p < 4; ++p) { float l = xrow16_sum(lrow[p]); lrow[p] = (l > 0.f) ? 1.0f / l : 0.f; }
    { float rl[4] = {lrow[0], lrow[1], lrow[2], lrow[3]}; ATT_GATE(2, rl[p]); }
#undef ATT_GATE
    WG_BAR();
}
}

__device__ __forceinline__ unsigned f2bf(float f) { unsigned u = __builtin_bit_cast(unsigned, f); return (u + 0x7fffu + ((u >> 16) & 1u)) >> 16; }
__device__ __forceinline__ unsigned pk2(float lo, float hi) { return f2bf(lo) | (f2bf(hi) << 16); }
template <int MAP>
__device__ __forceinline__ int rowmap(int a) {
    if (MAP == 0) return perm8(a);
    if (MAP == 1) return a < 1792 ? ((a & ~63) | swap45(a & 63)) : a;
    if (MAP == 2) { if (a < FF) return 256 * (a >> 7) + perm8(a & 127); const int a2 = a - FF; return 256 * (a2 >> 7) + 128 + perm8(a2 & 127); }
    return swap45(a);
}
template <int MAP>
__device__ __forceinline__ void transpose_item(const float* W, int K, int N, bf16_t* WT, int row_off, const float* gain, LAS float* scr, int item, int lane) {
    const int nblk = (N + 31) / 32, kb = item / nblk, nb = item % nblk, k0 = 64 * kb, n0 = 32 * nb;
#pragma unroll
    for (int i = 0; i < 32; ++i) { const int kk = 2 * i + (lane >> 5); const int col = n0 + (lane & 31); float v = (col < N) ? W[(size_t)(k0 + kk) * N + col] : 0.f; if (gain) v *= gain[k0 + kk]; scr[kk * 33 + (lane & 31)] = v; }
    LDS_WAIT();
    const int cc = lane & 7;
#pragma unroll
    for (int j = 0; j < 4; ++j) { const int n = (lane >> 3) + 8 * j; const LAS float* s = scr + (8 * cc) * 33 + n;
        u32x4 o; o.x = pk2(s[0 * 33], s[1 * 33]); o.y = pk2(s[2 * 33], s[3 * 33]); o.z = pk2(s[4 * 33], s[5 * 33]); o.w = pk2(s[6 * 33], s[7 * 33]);
        if (n0 + n < N) *(u32x4*)(WT + (size_t)(row_off + rowmap<MAP>(n0 + n)) * K + k0 + 8 * cc) = o; }
    LDS_WAIT();
}

#define XB_TMO      128
#define XB_XCNT(j)  (256  + 64 * (j))
#define XB_XSUB(j)  (1280 + 64 * (j))
#define XB_XGEN(j)  (2304 + 64 * (j))
#define XB_TOP      3328
#define XB_TOPGEN   3392
#define XCD_BAR_WORDS 3456
#define XB_SPIN_CAP (1u << 18)
__device__ __forceinline__ unsigned xb_ld(unsigned* p)              { return __hip_atomic_load(p, __ATOMIC_RELAXED, __HIP_MEMORY_SCOPE_AGENT); }
__device__ __forceinline__ unsigned xb_add(unsigned* p, unsigned v) { return __hip_atomic_fetch_add(p, v, __ATOMIC_RELAXED, __HIP_MEMORY_SCOPE_AGENT); }
__device__ __forceinline__ unsigned xb_xcc_id() { return (unsigned)__builtin_amdgcn_s_getreg((3 << 11) | 20) & 0xFu; }
#define XB_SPIN(cond, bar) do { unsigned _sp = 0; while (cond) { __builtin_amdgcn_s_sleep(1); \
    if ((++_sp & 255u) == 0u) { if (xb_ld(&(bar)[XB_TMO])) break; if (_sp > XB_SPIN_CAP) { atomicAdd(&(bar)[XB_TMO], 1u); break; } } } } while (0)
struct XcdBarrier { unsigned* bar; unsigned x; volatile LAS unsigned* st; };
__device__ __forceinline__ XcdBarrier xcd_barrier_post(unsigned* bar, volatile LAS unsigned* st) {
    XcdBarrier b; b.bar = bar; b.x = xb_xcc_id(); b.st = st;
    if (threadIdx.x == 0) (void)xb_add(&bar[XB_XCNT(b.x)], 1u);
    return b;
}
__device__ __forceinline__ void xcd_barrier_complete(unsigned* bar, unsigned x, unsigned& nloc, unsigned& nx) {
    const unsigned G = gridDim.x * gridDim.y * gridDim.z;
    unsigned sum, cnt, mine, sp = 0u;
    for (;;) {
        sum = 0u; cnt = 0u; mine = 0u;
#pragma unroll
        for (unsigned j = 0; j < 16; ++j) { const unsigned c = xb_ld(&bar[XB_XCNT(j)]); sum += c; cnt += (c > 0u) ? 1u : 0u; mine = (j == x) ? c : mine; }
        if (sum == G) break;
        __builtin_amdgcn_s_sleep(1);
        if ((++sp & 255u) == 0u) { if (xb_ld(&bar[XB_TMO])) break; if (sp > XB_SPIN_CAP) { atomicAdd(&bar[XB_TMO], 1u); break; } }
    }
    nloc = mine > 0u ? mine : 1u; nx = cnt > 0u ? cnt : 1u;
}
__device__ __forceinline__ void xcd_barrier(const XcdBarrier& b) {
    asm volatile("s_waitcnt vmcnt(0)" ::: "memory");
    __syncthreads();
    if (threadIdx.x == 0) {
        unsigned* bar = b.bar;
        __builtin_amdgcn_s_waitcnt(0);
        unsigned nloc = b.st[0], nx = b.st[1];
        if (nloc == 0u) { xcd_barrier_complete(bar, b.x, nloc, nx); b.st[0] = nloc; b.st[1] = nx; }
        const unsigned old = xb_add(&bar[XB_XSUB(b.x)], 1u);
        const unsigned gen = old / nloc;
        if (old + 1u == (gen + 1u) * nloc) {
            __builtin_amdgcn_fence(__ATOMIC_RELEASE, "agent");
            asm volatile("s_waitcnt vmcnt(0)" ::: "memory");
            const unsigned og = xb_add(&bar[XB_TOP], 1u);
            const unsigned tg = og / nx;
            if (og + 1u == (tg + 1u) * nx) xb_add(&bar[XB_TOPGEN], 1u);
            else XB_SPIN(xb_ld(&bar[XB_TOPGEN]) == tg, bar);
            __builtin_amdgcn_fence(__ATOMIC_ACQUIRE, "agent");
            xb_add(&bar[XB_XGEN(b.x)], 1u);
            asm volatile("s_waitcnt vmcnt(0)" ::: "memory");
        } else {
            XB_SPIN(xb_ld(&bar[XB_XGEN(b.x)]) == gen, bar);
            __builtin_amdgcn_fence(__ATOMIC_ACQUIRE, "agent");
            asm volatile("s_waitcnt vmcnt(0)" ::: "memory");
        }
    }
    __syncthreads();
}

struct Args { const float* in[29]; float* out; unsigned char* ws; float inv[32]; int ph_lo, ph_hi; };

__global__ void __launch_bounds__(512) mk_fwd(Args a) {
    extern __shared__ __attribute__((aligned(16))) unsigned char lds_raw[];
    LAS unsigned char* lds = (LAS unsigned char*)lds_raw;
    LAS unsigned char* ldsx = lds + LDS_RING;
    cg::grid_group grid = cg::this_grid();
    if (threadIdx.x < 2) ((volatile LAS unsigned*)(lds + LDS_BYTES - 16))[threadIdx.x] = 0u;
    __syncthreads();
    if (a.ph_hi == 0x7fff) grid.sync();
    const XcdBarrier xbar = xcd_barrier_post((unsigned*)a.ws, (volatile LAS unsigned*)(lds + LDS_BYTES - 16));
    const int tid = threadIdx.x, lane = tid & 63, wave = __builtin_amdgcn_readfirstlane(tid >> 6);
    const int G = gridDim.x, bx = blockIdx.x;
    unsigned char* ws = a.ws;
    float* cosT = (float*)(ws + WS_ROPE); float* sinT = cosT + T * 32;
    float* ssp = (float*)(ws + WS_SSP); float* c1p = (float*)(ws + WS_C1P); float* rstdv = (float*)(ws + WS_RSTD);
    float* HB = (float*)(ws + WS_HB); float* FB = (float*)(ws + WS_FB); float* gates = (float*)(ws + WS_GATE);
    bf16_t* Wt_in = (bf16_t*)(ws + WS_WIN); bf16_t* Wt_out = (bf16_t*)(ws + WS_WOUT);
    bf16_t* Wt_pool = (bf16_t*)(ws + WS_WPOOL); bf16_t* Wt_c1[2] = {(bf16_t*)(ws + WS_WC1K), (bf16_t*)(ws + WS_WC1V)}; bf16_t* Wt_c2[2] = {(bf16_t*)(ws + WS_WC2K), (bf16_t*)(ws + WS_WC2V)};
    bf16_t* XB = (bf16_t*)(ws + WS_XB); bf16_t* Qb = (bf16_t*)(ws + WS_Q);
    bf16_t* KC = (bf16_t*)(ws + WS_KC); bf16_t* VC = (bf16_t*)(ws + WS_VC); bf16_t* KS = (bf16_t*)(ws + WS_KS); bf16_t* VST = (bf16_t*)(ws + WS_VST); bf16_t* KW = (bf16_t*)(ws + WS_KW); bf16_t* VWT = (bf16_t*)(ws + WS_VWT);
    bf16_t* KCC = (bf16_t*)(ws + WS_KCC); bf16_t* VCT = (bf16_t*)(ws + WS_VCT); bf16_t* HID[2] = {(bf16_t*)(ws + WS_HIDK), (bf16_t*)(ws + WS_HIDV)};
    bf16_t* Ob = (bf16_t*)(ws + WS_O); bf16_t* ACT = (bf16_t*)(ws + WS_ACT); bf16_t* POOLED = (bf16_t*)(ws + WS_POOLED);
    float* out = a.out;
    const int lo = a.ph_lo, hi = a.ph_hi;
#define IN(k) (lo <= (k) && (k) < hi)
#define SEAM(k) do { if (IN(k) && IN((k) + 1)) xcd_barrier(xbar); } while (0)

    if (IN(0)) {
        LAS float* scr = (LAS float*)(lds + wave * 16384);
        const int gw = bx * 8 + wave, NGW = G * 8;
        constexpr int I_IN = 16 * 58, I_OUT = 16 * 32, I_UP = 16 * 176, I_DN = 44 * 32, I_PL = 4 * 8, I_C1 = 32 * 8, I_C2 = 4 * 2;
        constexpr int NIT = I_IN + I_OUT + 2 * I_UP + 2 * I_DN + 4 * I_PL + 2 * I_C1 + 2 * I_C2;
        for (int it = gw; it < NIT; it += NGW) {
            int r = it;
            if (r < I_IN) { transpose_item<1>(a.in[2], D, 1840, Wt_in, 0, a.in[1], scr, r, lane); continue; } r -= I_IN;
            if (r < I_OUT) { transpose_item<0>(a.in[13], D, D, Wt_out, 0, nullptr, scr, r, lane); continue; } r -= I_OUT;
            if (r < I_UP) { transpose_item<2>(a.in[15], D, UP, (bf16_t*)(ws + WS_WUP0), 0, a.in[14], scr, r, lane); continue; } r -= I_UP;
            if (r < I_UP) { transpose_item<2>(a.in[24], D, UP, (bf16_t*)(ws + WS_WUP1), 0, a.in[23], scr, r, lane); continue; } r -= I_UP;
            if (r < I_DN) { transpose_item<0>(a.in[18], FF, D, (bf16_t*)(ws + WS_WDN0), 0, nullptr, scr, r, lane); continue; } r -= I_DN;
            if (r < I_DN) { transpose_item<0>(a.in[27], FF, D, (bf16_t*)(ws + WS_WDN1), 0, nullptr, scr, r, lane); continue; } r -= I_DN;
            if (r < 4 * I_PL) { const int gi = r / I_PL; transpose_item<0>(a.in[20] + (size_t)gi * 65536, 256, 256, Wt_pool, gi * 256, nullptr, scr, r % I_PL, lane); continue; } r -= 4 * I_PL;
            if (r < I_C1) { transpose_item<0>(a.in[4], 2048, 256, Wt_c1[0], 0, nullptr, scr, r, lane); continue; } r -= I_C1;
            if (r < I_C1) { transpose_item<0>(a.in[9], 2048, 256, Wt_c1[1], 0, nullptr, scr, r, lane); continue; } r -= I_C1;
            if (r < I_C2) { transpose_item<3>(a.in[6], 256, 64, Wt_c2[0], 0, nullptr, scr, r, lane); continue; } r -= I_C2;
            transpose_item<3>(a.in[11], 256, 64, Wt_c2[1], 0, nullptr, scr, r, lane);
        }
        for (int m = gw; m < M; m += 2 * NGW) {
            const int m2 = m + NGW;
            const f32x4* xr = (const f32x4*)(a.in[0] + (size_t)m * D) + lane; const f32x4* xr2 = (const f32x4*)(a.in[0] + (size_t)m2 * D) + lane;
            f32x4 v[4], w[4];
#pragma unroll
            for (int j = 0; j < 4; ++j) { v[j] = xr[64 * j]; w[j] = (m2 < M) ? xr2[64 * j] : (f32x4){0.f, 0.f, 0.f, 0.f}; }
            unsigned long long* o8 = (unsigned long long*)(XB + (size_t)m * D) + lane; unsigned long long* o82 = (unsigned long long*)(XB + (size_t)m2 * D) + lane; float s1 = 0.f, s2 = 0.f;
#pragma unroll
            for (int j = 0; j < 4; ++j) {
                s1 += (v[j][0] * v[j][0] + v[j][1] * v[j][1]) + (v[j][2] * v[j][2] + v[j][3] * v[j][3]); o8[64 * j] = (unsigned long long)pk2(v[j][0], v[j][1]) | ((unsigned long long)pk2(v[j][2], v[j][3]) << 32);
                s2 += (w[j][0] * w[j][0] + w[j][1] * w[j][1]) + (w[j][2] * w[j][2] + w[j][3] * w[j][3]); if (m2 < M) o82[64 * j] = (unsigned long long)pk2(w[j][0], w[j][1]) | ((unsigned long long)pk2(w[j][2], w[j][3]) << 32);
            }
#pragma unroll
            for (int o = 1; o < 64; o <<= 1) { s1 += __shfl_xor(s1, o); s2 += __shfl_xor(s2, o); }
            if (lane == 0) { rstdv[m] = 1.0f / sqrtf(s1 * (1.0f / D) + EPS); if (m2 < M) rstdv[m2] = 1.0f / sqrtf(s2 * (1.0f / D) + EPS); }
        }
        for (int i = bx * 512 + tid; i < T * 32; i += G * 512) {
            const int t = i >> 5, f = i & 31; const float ang = (float)t * a.inv[f];
            double x = (double)ang * 0.15915494309189535; x -= __builtin_rint(x); const float xf = (float)x;
            cosT[i] = __builtin_amdgcn_cosf(xf); sinT[i] = __builtin_amdgcn_sinf(xf);
        }
        for (int it = NGW - 1 - gw; it < 256; it += NGW) {
            const int kv = it >> 7, chunk = (it >> 2) & 31, nb = it & 3; const float* pos = a.in[kv ? 8 : 3]; const float* w1 = a.in[kv ? 9 : 4];
            float s = 0.f;
#pragma unroll 32
            for (int r = 0; r < 64; ++r) { const int rr = chunk * 64 + r; s += pos[rr] * w1[(size_t)rr * 256 + nb * 64 + lane]; }
            c1p[(kv * 32 + chunk) * 256 + nb * 64 + lane] = s;
        }
        asm volatile("s_waitcnt vmcnt(0) lgkmcnt(0)" ::: "memory"); __syncthreads();
    }
    SEAM(0);
    if (IN(1)) {
        pg8::Gemm g{XB, Wt_in, M, NIN, D, D, 0}; pg8::StaticOrder S; S.init(M, NIN, G, bx);
        EpiIn E{rstdv, cosT, sinT, Qb, KC, VC, KS, VST, KW, VWT, gates};
        pg8::gemm_phase(lds, ldsx, g, S, E);
    }
    SEAM(1);
    if (IN(2)) {
        const int tid = threadIdx.x, lane = tid & 63, w = __builtin_amdgcn_readfirstlane(tid >> 6), fr = lane & 15, fq = lane >> 4;
        LAS float* c1s = (LAS float*)lds;
        LAS unsigned char* hidL = lds + 4096;
        for (int i = tid; i < 512; i += 512) { const int kv = i >> 8, n = i & 255; const float* b1 = a.in[kv ? 10 : 5]; float sv = b1[n]; for (int q = 0; q < 32; ++q) sv += c1p[(kv * 32 + q) * 256 + n]; c1s[i] = sv; }
        __syncthreads();
        for (int u = bx; u < 256; u += G) {
            const int kv = u >> 7, r0 = (u & 127) * 16;
            const bf16_t* Ap = (kv ? VC : KC) + (size_t)(r0 + fr) * 1024 + 8 * fq;
            const bf16_t* Bp = Wt_c1[kv] + (size_t)(32 * w + fr) * 2048 + 8 * fq;
            f32x4 h0 = (f32x4){0.f, 0.f, 0.f, 0.f}, h1 = h0;
#pragma unroll 1
            for (int k0 = 0; k0 < 2048; k0 += 256) {
                bf16x8 af[8], b0[8], b1f[8];
#pragma unroll
                for (int q = 0; q < 8; ++q) { af[q] = *(const bf16x8*)(Ap + k0 + 32 * q); b0[q] = *(const bf16x8*)(Bp + k0 + 32 * q); b1f[q] = *(const bf16x8*)(Bp + 16 * 2048 + k0 + 32 * q); }
#pragma unroll
                for (int q = 0; q < 8; ++q) { h0 = __builtin_amdgcn_mfma_f32_16x16x32_bf16(b0[q], af[q], h0, 0, 0, 0); h1 = __builtin_amdgcn_mfma_f32_16x16x32_bf16(b1f[q], af[q], h1, 0, 0, 0); }
            }
            { const int c0 = 32 * w + 8 * fq; float v[8];
#pragma unroll
              for (int e = 0; e < 8; ++e) { const float x = ((e >> 2) ? h1[e & 3] : h0[e & 3]) + c1s[kv * 256 + c0 + e]; const float y = 0.7978845608028654f * (x + 0.044715f * x * x * x); v[e] = x * sigmoidf_(2.0f * y); }
              u32x4 wv; wv.x = cvt_pk_bf16(v[0], v[1]); wv.y = cvt_pk_bf16(v[2], v[3]); wv.z = cvt_pk_bf16(v[4], v[5]); wv.w = cvt_pk_bf16(v[6], v[7]);
              *(LAS u32x4*)(hidL + fr * 528 + c0 * 2) = wv; }
            __syncthreads();
            if (w < 2) {
                const bf16_t* W2 = Wt_c2[kv] + (size_t)(32 * w + fr) * 256 + 8 * fq;
                f32x4 oA = (f32x4){0.f, 0.f, 0.f, 0.f}, oB = oA;
#pragma unroll
                for (int q = 0; q < 8; ++q) {
                    const bf16x8 hf = *(const LAS bf16x8*)(hidL + fr * 528 + (32 * q + 8 * fq) * 2);
                    const bf16x8 wa = *(const bf16x8*)(W2 + 32 * q), wb = *(const bf16x8*)(W2 + 16 * 256 + 32 * q);
                    oA = __builtin_amdgcn_mfma_f32_16x16x32_bf16(wa, hf, oA, 0, 0, 0); oB = __builtin_amdgcn_mfma_f32_16x16x32_bf16(wb, hf, oB, 0, 0, 0);
                }
                const float* b2 = a.in[kv ? 12 : 7]; const int d0 = 16 * w + 4 * fq; const int row = r0 + fr, j = row & 511;
                f32x4 a1 = oA + *(const f32x4*)(b2 + d0), a2 = oB + *(const f32x4*)(b2 + d0 + 32);
                if (j == 511) { a1 = (f32x4){0.f, 0.f, 0.f, 0.f}; a2 = a1; }
                if (!kv) {
                    const int pos = (j == 511) ? 0 : 16 * j + 31;
                    const f32x4 cs = *(const f32x4*)(cosT + pos * 32 + d0), sn = *(const f32x4*)(sinT + pos * 32 + d0);
                    const f32x4 o1 = a1 * cs - a2 * sn, o2 = a1 * sn + a2 * cs;
                    bf16_t* p = KCC + (size_t)row * 64 + d0;
                    u32x2 w1; w1.x = cvt_pk_bf16(o1[0], o1[1]); w1.y = cvt_pk_bf16(o1[2], o1[3]); *(u32x2*)p = w1;
                    u32x2 w2; w2.x = cvt_pk_bf16(o2[0], o2[1]); w2.y = cvt_pk_bf16(o2[2], o2[3]); *(u32x2*)(p + 32) = w2;
                } else {
                    bf16_t* p = VCT + (size_t)(row >> 6) * 4096 + vperm(row & 63);
#pragma unroll
                    for (int e = 0; e < 4; ++e) { p[(d0 + e) * 64] = (bf16_t)(cvt_pk_bf16(a1[e], 0.f) & 0xffff); p[(d0 + 32 + e) * 64] = (bf16_t)(cvt_pk_bf16(a2[e], 0.f) & 0xffff); }
                }
            }
            __syncthreads();
        }
    }
    if (IN(2) && IN(4)) xcd_barrier(xbar);
    if (IN(4)) {
        att::Ctx X{Qb, KCC, VCT, KS, VST, KW, VWT, gates, Ob};
        for (int k = bx; k < 256; k += G) {
            for (int rep = 0; rep < 2; ++rep) { const int uu = rep ? 511 - k : k; const int c = 127 - (uu >> 2), bgi = uu & 3; att::unit(lds, X, bgi >> 1, bgi & 1, c, tid); }
        }
    }
    SEAM(4);
    if (IN(5)) {
        pg8::Gemm g{Ob, Wt_out, M, D, D, D, 0}; pg8::StaticOrder S; S.init(M, D, G, bx);
        EpiRes E{a.in[0], out, XB, ssp, nullptr, nullptr};
        pg8::gemm_phase(lds, ldsx, g, S, E);
    }
    SEAM(5);
#pragma unroll
    for (int L = 0; L < 2; ++L) {
        const int pb = 6 + 5 * L;
        const float* cw = a.in[L ? 25 : 16]; const float* cb = a.in[L ? 26 : 17];
        if (IN(pb)) {
            pg8::Gemm g{XB, (const bf16_t*)(ws + (L ? WS_WUP1 : WS_WUP0)), M, UP, D, D, 0}; pg8::StaticOrder S; S.init(M, UP, G, bx);
            EpiUp E{ssp, cw, cb, ACT, HB, FB};
            pg8::gemm_phase(lds, ldsx, g, S, E);
        }
        if (IN(pb) && IN(pb + 2)) xcd_barrier(xbar);
        if (IN(pb + 2)) {
            pg8::Gemm g{ACT, (const bf16_t*)(ws + (L ? WS_WDN1 : WS_WDN0)), M, D, FF, FF, 0}; pg8::StaticOrder S; S.init(M, D, G, bx);
            {
                int tf = threadIdx.x; asm volatile("" : "+v"(tf));
                pg8::Unit fu;
                for (int ui = 0; S.next(ui, fu); ++ui) {
                    const int pm = fu.pm; const bool hasp = (pm & 31) != 0;
                    const float* h = HB + (size_t)(hasp ? pm - 1 : pm) * 2 * UP; const float* f = FB + (size_t)pm * 2 * UP;
                    float hv[6][4], fv[6][4], wv[6][8];
#pragma unroll
                    for (int it = 0; it < 6; ++it) { const int cidx = tf + 512 * it; const int cc = cidx < FF ? cidx : FF - 1;
                        hv[it][0] = h[cc]; hv[it][1] = h[UP + cc]; hv[it][2] = h[FF + cc]; hv[it][3] = h[UP + FF + cc];
                        fv[it][0] = f[cc]; fv[it][1] = f[UP + cc]; fv[it][2] = f[FF + cc]; fv[it][3] = f[UP + FF + cc];
                        wv[it][0] = cw[cc]; wv[it][1] = cw[UP + cc]; wv[it][2] = cw[2 * UP + cc]; wv[it][3] = cb[cc];
                        wv[it][4] = cw[FF + cc]; wv[it][5] = cw[UP + FF + cc]; wv[it][6] = cw[2 * UP + FF + cc]; wv[it][7] = cb[FF + cc]; }
#pragma unroll
                    for (int it = 0; it < 6; ++it) { const int cidx = tf + 512 * it;
                        const float hg0 = hasp ? hv[it][0] : 0.f, hg1 = hasp ? hv[it][1] : 0.f, hv0 = hasp ? hv[it][2] : 0.f, hv1 = hasp ? hv[it][3] : 0.f;
                        const float fg0 = fv[it][0], fg1 = fv[it][1], fv0 = fv[it][2], fv1 = fv[it][3];
                        const float g0 = wv[it][3] + wv[it][0] * hg0 + wv[it][1] * hg1 + wv[it][2] * fg0;
                        const float g1 = wv[it][3] + wv[it][0] * hg1 + wv[it][1] * fg0 + wv[it][2] * fg1;
                        const float v0 = wv[it][7] + wv[it][4] * hv0 + wv[it][5] * hv1 + wv[it][6] * fv0;
                        const float v1 = wv[it][7] + wv[it][4] * hv1 + wv[it][5] * fv0 + wv[it][6] * fv1;
                        if (cidx < FF) { ACT[(size_t)(pm * 256) * FF + cidx] = (bf16_t)f2bf(g0 * sigmoidf_(g0) * v0); ACT[(size_t)(pm * 256 + 1) * FF + cidx] = (bf16_t)f2bf(g1 * sigmoidf_(g1) * v1); } }
                }
                asm volatile("s_waitcnt vmcnt(0)" ::: "memory"); __syncthreads();
            }
            if (L == 1 && G == 256) { EpiFinal E{out, a.in[28], (float*)(ws + WS_SSP + 512 * 1024), (unsigned*)(ws + 16384)}; pg8::gemm_phase(lds, ldsx, g, S, E); }
            else { EpiRes E{out, out, XB, ssp, nullptr, nullptr}; pg8::gemm_phase(lds, ldsx, g, S, E); }
        }
        if (!(L == 1 && G == 256)) SEAM(pb + 2);
        if (L == 0) {
            if (IN(9)) {
                LAS float* rsd = (LAS float*)lds;
                const float* gn = a.in[19];
                int tid = threadIdx.x; asm volatile("" : "+v"(tid));
                const int q = tid & 255, strip = tid >> 8, c4 = q * 4, wsz = 2 << (c4 >> 8), t0 = strip * 32;
                const f32x4 gv = *(const f32x4*)(gn + c4);
                for (int tile = bx; tile < 256; tile += G) {
                    const int r0 = tile * 64; const int tb = r0 & (T - 1);
                    __syncthreads();
                    if (tid < 80) { const int rr = r0 - 16 + tid; rsd[tid] = (tb - 16 + tid >= 0) ? row_rstd(ssp, 4, rr) : 0.f; }
                    __syncthreads();
                    const float* xb0 = out + (size_t)r0 * D + c4;
#define POOL_H(tl) (*(const f32x4*)(xb0 + (ptrdiff_t)(tl) * D) * rsd[16 + (tl)])
                    f32x4 sw = (f32x4){0.f, 0.f, 0.f, 0.f};
                    for (int i = 1; i <= wsz; ++i) { const int tl = t0 - i; if (tb + tl >= 0) sw += POOL_H(tl); }
#pragma unroll 4
                    for (int tl = t0; tl < t0 + 32; ++tl) {
                        const f32x4 hv = POOL_H(tl); sw += hv;
                        const int td = tl - wsz; if (tb + td >= 0) sw -= POOL_H(td);
                        const int t = tb + tl; const int cnt = (t + 1 < wsz) ? t + 1 : wsz;
                        const f32x4 pvv = (sw * (1.0f / (float)cnt) - hv) * gv;
                        u32x2 wv; wv.x = cvt_pk_bf16(pvv[0], pvv[1]); wv.y = cvt_pk_bf16(pvv[2], pvv[3]);
                        *(u32x2*)(POOLED + (size_t)(r0 + tl) * D + c4) = wv;
                    }
#undef POOL_H
                }
                __syncthreads();
            }
            SEAM(9);
            if (IN(10)) {
                pg8::Gemm g{POOLED, Wt_pool, M, D, 256, D, 512}; pg8::StaticOrder S; S.init(M, D, G, bx);
                EpiRes E{out, out, XB, ssp, a.in[21], a.in[22]};
                pg8::gemm_phase(lds, ldsx, g, S, E);
            }
            SEAM(10);
        }
    }
    if (IN(14) && G != 256) {
        int t14 = threadIdx.x; asm volatile("" : "+v"(t14)); const int lane = t14 & 63, wave = __builtin_amdgcn_readfirstlane(t14 >> 6);
        const int gw = bx * 8 + wave, NGW = G * 8; const float* gn = a.in[28];
        for (int m = gw; m < M; m += NGW) {
            const float rs = row_rstd(ssp, 4, m); f32x4* xr = (f32x4*)(out + (size_t)m * D) + lane; const f32x4* gr = (const f32x4*)gn + lane;
#pragma unroll
            for (int j = 0; j < 4; ++j) xr[64 * j] = xr[64 * j] * rs * gr[64 * j];
        }
    }
#undef IN
#undef SEAM
}

extern "C" void kernel_launch(void* const* d_in, const int* in_sizes, int n_in, void* d_out, int out_size, void* d_ws, size_t ws_size, hipStream_t stream) {
    static int grid = 0;
    if (grid == 0) {
        int dev = 0, cus = 0, per_cu = 0;
        hipGetDevice(&dev); hipDeviceGetAttribute(&cus, hipDeviceAttributeMultiprocessorCount, dev);
        hipFuncSetAttribute((const void*)mk_fwd, hipFuncAttributeMaxDynamicSharedMemorySize, LDS_BYTES);
        hipOccupancyMaxActiveBlocksPerMultiprocessor(&per_cu, (const void*)mk_fwd, 512, LDS_BYTES);
        if (per_cu < 1) per_cu = 1;
        grid = cus * per_cu; if (grid > 256) grid = 256;
        (void)hipGetLastError();
    }
    Args a{};
    for (int i = 0; i < 29; ++i) a.in[i] = (const float*)d_in[i];
    a.out = (float*)d_out; a.ws = (unsigned char*)d_ws;
    for (int i = 0; i < 32; ++i) a.inv[i] = 1.0f / powf(10000.0f, (float)(2 * i) / 64.0f);
    a.ph_lo = 0; a.ph_hi = 15;
    hipMemsetAsync(d_ws, 0, 65536, stream);
    void* args[] = {&a};
    hipError_t e = hipLaunchCooperativeKernel((const void*)mk_fwd, dim3(grid), dim3(512), args, LDS_BYTES, stream);
    if (e != hipSuccess) fprintf(stderr, "cooperative launch failed: %s (grid %d)\n", hipGetErrorString(e), grid);
}
```

```cpp
#include <hip/hip_runtime.h>
#include <hip/hip_cooperative_groups.h>
#include <cstdio>
#include <cstdint>
namespace cg = cooperative_groups;

#define LAS __attribute__((address_space(3)))
typedef unsigned short bf16_t;
typedef short bf16x8 __attribute__((ext_vector_type(8)));
typedef short s16x4 __attribute__((ext_vector_type(4)));
typedef float f32x4 __attribute__((ext_vector_type(4)));
typedef unsigned u32x4 __attribute__((ext_vector_type(4)));
typedef unsigned u32x2 __attribute__((ext_vector_type(2)));

constexpr int T = 8192, D = 1024, M = 16384, FF = 2816, UP = 5632, NIN = 2048;
constexpr float EPS = 1e-6f;
constexpr float QSCALE = 0.125f * 1.4426950408889634f;
constexpr size_t MiB = 1u << 20;
constexpr size_t WS_ROPE = 1 * MiB;
constexpr size_t WS_SSP = 3 * MiB;
constexpr size_t WS_C1P = 4 * MiB;
constexpr size_t WS_RSTD = 4 * MiB + 256 * 1024;
constexpr size_t WS_HB = 5 * MiB;
constexpr size_t WS_FB = 8 * MiB;
constexpr size_t WS_GATE = 11 * MiB;
constexpr size_t WS_WIN = 16 * MiB, WS_WOUT = 20 * MiB, WS_WUP0 = 22 * MiB, WS_WUP1 = 33 * MiB, WS_WDN0 = 44 * MiB, WS_WDN1 = 50 * MiB;
constexpr size_t WS_WPOOL = 56 * MiB, WS_WC1K = 57 * MiB, WS_WC1V = 58 * MiB, WS_WC2K = 59 * MiB, WS_WC2V = 59 * MiB + 512 * 1024;
constexpr size_t WS_XB = 64 * MiB;
constexpr size_t WS_Q = 96 * MiB;
constexpr size_t WS_KC = 128 * MiB, WS_VC = 132 * MiB, WS_KS = 136 * MiB, WS_VST = 140 * MiB, WS_KW = 144 * MiB, WS_VWT = 148 * MiB;
constexpr size_t WS_KCC = 152 * MiB, WS_VCT = 153 * MiB, WS_HIDK = 154 * MiB, WS_HIDV = 155 * MiB;
constexpr size_t WS_O = 160 * MiB;
constexpr size_t WS_ACT = 96 * MiB;
constexpr size_t WS_POOLED = 192 * MiB;
constexpr int LDS_RING = 131072, LDS_BYTES = 155648;

__device__ __forceinline__ unsigned cvt_pk_bf16(float lo, float hi) { unsigned r; asm volatile("v_cvt_pk_bf16_f32 %0, %1, %2" : "=v"(r) : "v"(lo), "v"(hi)); return r; }
__device__ __forceinline__ float bf2f(unsigned short b) { return __uint_as_float((unsigned)b << 16); }
__device__ __forceinline__ float ex2(float x) { return __builtin_amdgcn_exp2f(x); }
__device__ __forceinline__ float rcp(float x) { return __builtin_amdgcn_rcpf(x); }
__device__ __forceinline__ float sigmoidf_(float x) { return rcp(1.0f + ex2(-1.4426950408889634f * x)); }
__device__ __forceinline__ int perm8(int a) { return (a & ~31) | (16 * ((a >> 2) & 1) + 4 * ((a >> 3) & 3) + (a & 3)); }
__device__ __forceinline__ int vperm(int kk) { return (kk & 32) | (((kk >> 2) & 3) << 3) | (((kk >> 4) & 1) << 2) | (kk & 3); }
__device__ __forceinline__ int swap45(int a) { return (a & ~48) | (((a >> 4) & 1) << 5) | (((a >> 5) & 1) << 4); }
template <int CTRL> __device__ __forceinline__ float dppf(float x) { return __builtin_bit_cast(float, __builtin_amdgcn_mov_dpp(__builtin_bit_cast(int, x), CTRL, 0xf, 0xf, true)); }
__device__ __forceinline__ float xrow16_max(float x) {
    auto s = __builtin_amdgcn_permlane16_swap(__float_as_uint(x), __float_as_uint(x), false, false); x = fmaxf(__uint_as_float(s[0]), __uint_as_float(s[1]));
    auto t = __builtin_amdgcn_permlane32_swap(__float_as_uint(x), __float_as_uint(x), false, false); return fmaxf(__uint_as_float(t[0]), __uint_as_float(t[1])); }
__device__ __forceinline__ float xrow16_sum(float x) {
    auto s = __builtin_amdgcn_permlane16_swap(__float_as_uint(x), __float_as_uint(x), false, false); x = __uint_as_float(s[0]) + __uint_as_float(s[1]);
    auto t = __builtin_amdgcn_permlane32_swap(__float_as_uint(x), __float_as_uint(x), false, false); return __uint_as_float(t[0]) + __uint_as_float(t[1]); }
__device__ __forceinline__ float sum8(float x) { x += dppf<0xB1>(x); x += dppf<0x4E>(x); x += dppf<0x141>(x); return x; }
#define LDS_WAIT() asm volatile("s_waitcnt lgkmcnt(0)" ::: "memory")
#define WG_BAR() do { asm volatile("s_waitcnt lgkmcnt(0)" ::: "memory"); __builtin_amdgcn_s_barrier(); asm volatile("" ::: "memory"); } while (0)

namespace pg8 {
constexpr int BM = 256, BK = 64, HALF = 128, HTB = HALF * BK * 2, NXCD = 8, WGM = 8;
__host__ __device__ __forceinline__ int lds_byte(int r, int c) { const int st = (r >> 4) * 2 + (c >> 5), rr = r & 15, cc = c & 31, ob = rr * 64 + cc * 2; return st * 1024 + (ob ^ (((ob >> 9) & 1) << 5)); }
__host__ __device__ __forceinline__ void stage_rc(int b, int& R, int& C) { const int st = b / 1024, sb = b % 1024, swz = sb ^ (((sb >> 9) & 1) << 5); R = (st >> 1) * 16 + swz / 64; C = (st & 1) * 32 + (swz % 64) / 2; }
struct Unit { int pm, pn; };
struct Gemm { const bf16_t* A; const bf16_t* Bt; int M, N, K, lda, apn; };
struct StaticOrder {
    int nM, nN, nwg, G, c;
    __device__ void init(int M_, int N_, int G_, int c_) { nM = M_ / BM; nN = N_ / BM; nwg = nM * nN; G = G_; c = c_; }
    __device__ bool next(int i, Unit& u) const {
        const long L = (long)i * G + c; if (L >= nwg) return false;
        int wgid = (int)L; { const int q = nwg / NXCD, r = nwg % NXCD, xcd = wgid % NXCD, off = wgid / NXCD; wgid = (xcd < r ? xcd * (q + 1) : r * (q + 1) + (xcd - r) * q) + off; }
        const int nig = WGM * nN, gid = wgid / nig, fm = gid * WGM, gsz = (nM - fm) < WGM ? (nM - fm) : WGM;
        u.pm = fm + ((wgid % nig) % gsz); u.pn = (wgid % nig) / gsz; return true;
    }
};
template <class Epi>
__device__ __forceinline__ void gemm_phase(LAS unsigned char* lds, LAS unsigned char* ldsx, const Gemm g, const StaticOrder& S, const Epi& E) {
    int tid = threadIdx.x; asm volatile("" : "+v"(tid));
    const int wid = __builtin_amdgcn_readfirstlane(tid >> 6), lane = tid & 63, wr = wid >> 2, wc = wid & 3, fr = lane & 15, fq = lane >> 4;
    const int K = g.K, nt = K / BK;
    unsigned voffA[2], voffB[2];
#pragma unroll
    for (int i = 0; i < 2; ++i) { int R, C; stage_rc(tid * 16 + i * 8192, R, C); voffA[i] = (unsigned)(R * g.lda + C) * 2u; voffB[i] = (unsigned)(R * K + C) * 2u; }
    const size_t kstep = (size_t)(BK * 2);
    const size_t hstepA = (size_t)HALF * g.lda * 2, tstepA = 2 * hstepA, hstepB = (size_t)HALF * K * 2, tstepB = 2 * hstepB;
    const unsigned ldsw = (unsigned)wid * 1024u;
    const int aoff = lds_byte(wr * 64 + fr, fq * 8), boff = lds_byte(wc * 32 + fr, fq * 8);
#define PG8_SA(b, h) (((b) * 2 + (h)) * HTB)
#define PG8_SB(b, h) ((4 + (b) * 2 + (h)) * HTB)
#define PG8_STAGE(bufoff, gbase, voff) do { _Pragma("unroll") for (int _i = 0; _i < 2; ++_i) \
        __builtin_amdgcn_global_load_lds((const unsigned*)((const char*)(gbase) + (voff)[_i]), (LAS unsigned*)(lds + (bufoff) + ldsw + _i * 8192), 16, 0, 0); } while (0)
#define PG8_LDA(dst, b, h) do { _Pragma("unroll") for (int m = 0; m < 4; ++m) _Pragma("unroll") for (int k = 0; k < 2; ++k) dst[m][k] = *(const LAS bf16x8*)(lds + PG8_SA(b, h) + aoff + m * 2048 + k * 1024); } while (0)
#define PG8_LDB(dst, b, h) do { _Pragma("unroll") for (int n = 0; n < 2; ++n) _Pragma("unroll") for (int k = 0; k < 2; ++k) dst[n][k] = *(const LAS bf16x8*)(lds + PG8_SB(b, h) + boff + n * 2048 + k * 1024); } while (0)
#define PG8_MMA(ai, bj, At, Bt) do { __builtin_amdgcn_s_setprio(1); _Pragma("unroll") for (int m = 0; m < 4; ++m) _Pragma("unroll") for (int n = 0; n < 2; ++n) _Pragma("unroll") for (int k = 0; k < 2; ++k) \
        acc[ai][bj][m][n] = __builtin_amdgcn_mfma_f32_16x16x32_bf16(Bt[n][k], At[m][k], acc[ai][bj][m][n], 0, 0, 0); __builtin_amdgcn_s_setprio(0); } while (0)
#define PG8_WAIT_V(n) asm volatile("s_waitcnt vmcnt(" #n ")" ::: "memory")
#define PG8_WAIT_L(n) asm volatile("s_waitcnt lgkmcnt(" #n ")" ::: "memory")
#define PG8_BAR __builtin_amdgcn_s_barrier()
#define PG8_SCHED __builtin_amdgcn_sched_barrier(0)
    Unit cur, nxt; int ui = 0;
    if (!S.next(0, cur)) return;
    f32x4 acc[2][2][4][2];
#pragma unroll
    for (int a = 0; a < 2; ++a)
#pragma unroll
        for (int b = 0; b < 2; ++b)
#pragma unroll
            for (int m = 0; m < 4; ++m)
#pragma unroll
                for (int n = 0; n < 2; ++n) acc[a][b][m][n] = (f32x4){0.f, 0.f, 0.f, 0.f};
    bf16x8 At[4][2], B0[2][2], B1[2][2];
    const char* cA = (const char*)g.A + (size_t)cur.pm * tstepA + (size_t)cur.pn * g.apn; const char* cB = (const char*)g.Bt + (size_t)cur.pn * tstepB;
    PG8_STAGE(PG8_SB(0, 0), cB, voffB); PG8_STAGE(PG8_SB(0, 1), cB + hstepB, voffB); PG8_STAGE(PG8_SA(0, 0), cA, voffA); PG8_STAGE(PG8_SA(0, 1), cA + hstepA, voffA);
    if (wr == 1) PG8_BAR;
    PG8_WAIT_V(2); PG8_BAR;
    PG8_STAGE(PG8_SB(1, 0), cB + kstep, voffB); PG8_STAGE(PG8_SA(1, 0), cA + kstep, voffA); PG8_STAGE(PG8_SB(1, 1), cB + hstepB + kstep, voffB);
    PG8_WAIT_V(6); PG8_BAR;
    for (;;) {
        const bool has_next = S.next(ui + 1, nxt);
        const char* nA = has_next ? (const char*)g.A + (size_t)nxt.pm * tstepA + (size_t)nxt.pn * g.apn : cA; const char* nB = has_next ? (const char*)g.Bt + (size_t)nxt.pn * tstepB : cB;
        for (int t = 0; t < nt; t += 2) {
            const bool last = (t == nt - 2);
            const char* a1 = cA + (size_t)(t + 1) * kstep;
            const char* a2 = last ? nA : cA + (size_t)(t + 2) * kstep; const char* b2 = last ? nB : cB + (size_t)(t + 2) * kstep;
            const char* a3 = a2 + kstep; const char* b3 = b2 + kstep;
            PG8_LDB(B0, 0, 0); PG8_LDB(B1, 0, 1); PG8_SCHED; PG8_LDA(At, 0, 0); PG8_STAGE(PG8_SA(1, 1), a1 + hstepA, voffA);
            PG8_WAIT_V(8); PG8_WAIT_L(0); PG8_BAR; PG8_MMA(0, 0, At, B0); PG8_MMA(0, 1, At, B1); PG8_BAR; PG8_SCHED;
            PG8_LDA(At, 0, 1); PG8_STAGE(PG8_SB(0, 0), b2, voffB); PG8_STAGE(PG8_SB(0, 1), b2 + hstepB, voffB); PG8_STAGE(PG8_SA(0, 0), a2, voffA);
            PG8_WAIT_V(8); PG8_WAIT_L(0); PG8_BAR; PG8_MMA(1, 0, At, B0); PG8_MMA(1, 1, At, B1); PG8_BAR; PG8_SCHED;
            PG8_LDB(B0, 1, 0); PG8_LDB(B1, 1, 1); PG8_SCHED; PG8_LDA(At, 1, 0); PG8_STAGE(PG8_SA(0, 1), a2 + hstepA, voffA);
            PG8_WAIT_V(8); PG8_WAIT_L(0); PG8_BAR; PG8_MMA(0, 0, At, B0); PG8_MMA(0, 1, At, B1); PG8_BAR; PG8_SCHED;
            PG8_LDA(At, 1, 1); PG8_STAGE(PG8_SB(1, 0), b3, voffB); PG8_STAGE(PG8_SB(1, 1), b3 + hstepB, voffB); PG8_STAGE(PG8_SA(1, 0), a3, voffA);
            PG8_WAIT_V(8); PG8_WAIT_L(0); PG8_BAR; PG8_MMA(1, 0, At, B0); PG8_MMA(1, 1, At, B1); PG8_BAR; PG8_SCHED;
        }
        if (wr == 0) PG8_BAR;
        { int t2 = threadIdx.x; asm volatile("" : "+v"(t2));
          E(acc, cur, wr, wc, t2 & 15, (t2 & 63) >> 4, ldsx, t2); }
        if (!has_next) break;
#pragma unroll
        for (int a = 0; a < 2; ++a)
#pragma unroll
            for (int b = 0; b < 2; ++b)
#pragma unroll
                for (int m = 0; m < 4; ++m)
#pragma unroll
                    for (int n = 0; n < 2; ++n) acc[a][b][m][n] = (f32x4){0.f, 0.f, 0.f, 0.f};
        cur = nxt; cA = nA; cB = nB; ++ui;
        if (wr == 1) PG8_BAR;
    }
    PG8_WAIT_V(0);
    PG8_BAR;
#undef PG8_SA
#undef PG8_SB
#undef PG8_STAGE
#undef PG8_LDA
#undef PG8_LDB
#undef PG8_MMA
#undef PG8_WAIT_V
#undef PG8_WAIT_L
#undef PG8_BAR
#undef PG8_SCHED
}
}
using pg8::Unit;
typedef f32x4 Acc[2][2][4][2];

__device__ __forceinline__ float row_rstd(const float* ssp, int np, int row) {
    float s = 0.f; for (int i = 0; i < np; ++i) s += ssp[(size_t)i * M + row];
    return 1.0f / sqrtf(s * (1.0f / D) + EPS);
}

struct EpiIn {
    const float* rstdv; const float* cosT; const float* sinT;
    bf16_t *Q, *KC, *VC, *KS, *VST, *KW, *VWT; float* gates;
    __device__ __forceinline__ void operator()(Acc& acc, const Unit& u, int wr, int wc, int fr, int fq, LAS unsigned char*, int) const {
#pragma unroll
        for (int ai = 0; ai < 2; ++ai)
#pragma unroll
            for (int m = 0; m < 4; ++m) {
                const int row = u.pm * 256 + ai * 128 + wr * 64 + m * 16 + fr; const float rs = rstdv[row];
                const int t = row & (T - 1), b = row >> 13;
                const int d0 = 16 * (wc & 1) + 4 * fq;
                const f32x4 cs = *(const f32x4*)(cosT + t * 32 + d0), sn = *(const f32x4*)(sinT + t * 32 + d0);
#pragma unroll
                for (int bj = 0; bj < 2; ++bj) {
                    f32x4 a1 = acc[ai][bj][m][0] * rs, a2 = acc[ai][bj][m][1] * rs;
                    if (u.pn == 7) {
                        if (bj == 0) {
#pragma unroll
                            for (int n = 0; n < 2; ++n) { const int c0 = 32 * wc + 16 * n + 4 * fq; if (c0 < 48) { const f32x4 v = n ? a2 : a1; f32x4 o; o[0] = sigmoidf_(v[0]); o[1] = sigmoidf_(v[1]); o[2] = sigmoidf_(v[2]); o[3] = sigmoidf_(v[3]); *(f32x4*)(gates + (size_t)row * 48 + c0) = o; } }
                        }
                        continue;
                    }
                    const int hh = 2 * bj + (wc >> 1);
                    bool rope; if (u.pn < 4) rope = true; else rope = (u.pn >= 5) && (hh < 2);
                    f32x4 o1 = a1, o2 = a2;
                    if (rope) { o1 = a1 * cs - a2 * sn; o2 = a1 * sn + a2 * cs; }
                    if (u.pn < 4) {
                        o1 = o1 * QSCALE; o2 = o2 * QSCALE;
                        bf16_t* p = Q + (size_t)row * 1024 + (u.pn * 4 + hh) * 64 + d0;
                        u32x2 w1; w1.x = cvt_pk_bf16(o1[0], o1[1]); w1.y = cvt_pk_bf16(o1[2], o1[3]); *(u32x2*)p = w1;
                        u32x2 w2; w2.x = cvt_pk_bf16(o2[0], o2[1]); w2.y = cvt_pk_bf16(o2[2], o2[3]); *(u32x2*)(p + 32) = w2;
                    } else {
                        const int gg = hh & 1; const bool isv = hh >= 2;
                        if (!isv) {
                            bf16_t* base = (u.pn == 4) ? KC : (u.pn == 5) ? KS : KW;
                            bf16_t* p = base + ((size_t)(b * 2 + gg) * T + t) * 64 + d0;
                            u32x2 w1; w1.x = cvt_pk_bf16(o1[0], o1[1]); w1.y = cvt_pk_bf16(o1[2], o1[3]); *(u32x2*)p = w1;
                            u32x2 w2; w2.x = cvt_pk_bf16(o2[0], o2[1]); w2.y = cvt_pk_bf16(o2[2], o2[3]); *(u32x2*)(p + 32) = w2;
                        } else if (u.pn == 4) {
                            bf16_t* p = VC + ((size_t)(b * 2 + gg) * T + t) * 64 + d0;
                            u32x2 w1; w1.x = cvt_pk_bf16(o1[0], o1[1]); w1.y = cvt_pk_bf16(o1[2], o1[3]); *(u32x2*)p = w1;
                            u32x2 w2; w2.x = cvt_pk_bf16(o2[0], o2[1]); w2.y = cvt_pk_bf16(o2[2], o2[3]); *(u32x2*)(p + 32) = w2;
                        } else {
                            bf16_t* base = (u.pn == 5) ? VST : VWT;
                            bf16_t* p = base + ((size_t)(b * 2 + gg) * 128 + (t >> 6)) * 4096 + vperm(t & 63);
#pragma unroll
                            for (int j = 0; j < 4; ++j) { p[(d0 + j) * 64] = (bf16_t)(cvt_pk_bf16(o1[j], 0.f) & 0xffff); p[(d0 + 32 + j) * 64] = (bf16_t)(cvt_pk_bf16(o2[j], 0.f) & 0xffff); }
                        }
                    }
                }
                asm volatile("" ::: "memory"); __builtin_amdgcn_sched_barrier(0);
            }
    }
};

struct EpiC1 {
    bf16_t* hid;
    __device__ __forceinline__ void operator()(Acc& acc, const Unit& u, int wr, int wc, int fr, int fq, LAS unsigned char* ldsx, int) const {
        const LAS float* c1 = (const LAS float*)ldsx;
#pragma unroll
        for (int bj = 0; bj < 2; ++bj) {
            const int c0 = 128 * bj + 32 * wc + 8 * fq;
            const f32x4 bA = *(const LAS f32x4*)(c1 + c0), bB = *(const LAS f32x4*)(c1 + c0 + 4);
#pragma unroll
            for (int ai = 0; ai < 2; ++ai)
#pragma unroll
                for (int m = 0; m < 4; ++m) {
                    const int row = u.pm * 256 + ai * 128 + wr * 64 + m * 16 + fr;
                    float v[8];
#pragma unroll
                    for (int e = 0; e < 8; ++e) { const float x = acc[ai][bj][m][e >> 2][e & 3] + ((e >> 2) ? bB[e & 3] : bA[e & 3]); const float y = 0.7978845608028654f * (x + 0.044715f * x * x * x); v[e] = x * sigmoidf_(2.0f * y); }
                    u32x4 w; w.x = cvt_pk_bf16(v[0], v[1]); w.y = cvt_pk_bf16(v[2], v[3]); w.z = cvt_pk_bf16(v[4], v[5]); w.w = cvt_pk_bf16(v[6], v[7]);
                    *(u32x4*)(hid + (size_t)row * 256 + c0) = w;
                    asm volatile("" ::: "memory"); __builtin_amdgcn_sched_barrier(0);
                }
        }
    }
};
struct EpiC2 {
    const float* b2; const float* cosT; const float* sinT; bf16_t* out; int isv;
    __device__ __forceinline__ void operator()(Acc& acc, const Unit& u, int wr, int wc, int fr, int fq, LAS unsigned char*, int) const {
        if (wc >= 2) return;
        const int d0 = 16 * (wc & 1) + 4 * fq;
        const f32x4 bA = *(const f32x4*)(b2 + d0), bB = *(const f32x4*)(b2 + d0 + 32);
#pragma unroll
        for (int ai = 0; ai < 2; ++ai)
#pragma unroll
            for (int m = 0; m < 4; ++m) {
                const int row = u.pm * 256 + ai * 128 + wr * 64 + m * 16 + fr; const int j = row & 511;
                f32x4 a1 = acc[ai][0][m][0] + bA, a2 = acc[ai][0][m][1] + bB;
                if (j == 511) { a1 = (f32x4){0.f, 0.f, 0.f, 0.f}; a2 = a1; }
                if (!isv) {
                    const int pos = (j == 511) ? 0 : 16 * j + 31;
                    const f32x4 cs = *(const f32x4*)(cosT + pos * 32 + d0), sn = *(const f32x4*)(sinT + pos * 32 + d0);
                    const f32x4 o1 = a1 * cs - a2 * sn, o2 = a1 * sn + a2 * cs;
                    bf16_t* p = out + (size_t)row * 64 + d0;
                    u32x2 w1; w1.x = cvt_pk_bf16(o1[0], o1[1]); w1.y = cvt_pk_bf16(o1[2], o1[3]); *(u32x2*)p = w1;
                    u32x2 w2; w2.x = cvt_pk_bf16(o2[0], o2[1]); w2.y = cvt_pk_bf16(o2[2], o2[3]); *(u32x2*)(p + 32) = w2;
                } else {
                    bf16_t* p = out + (size_t)(row >> 6) * 4096 + vperm(row & 63);
#pragma unroll
                    for (int e = 0; e < 4; ++e) { p[(d0 + e) * 64] = (bf16_t)(cvt_pk_bf16(a1[e], 0.f) & 0xffff); p[(d0 + 32 + e) * 64] = (bf16_t)(cvt_pk_bf16(a2[e], 0.f) & 0xffff); }
                }
                asm volatile("" ::: "memory"); __builtin_amdgcn_sched_barrier(0);
            }
    }
};

struct EpiRes {
    const float* xold; float* xnew; bf16_t* xb; float* ssp; const float* pb; const float* ps;
    __device__ __forceinline__ void operator()(Acc& acc, const Unit& u, int wr, int wc, int fr, int fq, LAS unsigned char* ldsx, int tid) const {
#pragma unroll
        for (int ai = 0; ai < 2; ++ai)
#pragma unroll
            for (int m = 0; m < 4; ++m) {
                const int row = u.pm * 256 + ai * 128 + wr * 64 + m * 16 + fr; float ss = 0.f;
#pragma unroll
                for (int bj = 0; bj < 2; ++bj) {
                    const int col = u.pn * 256 + 128 * bj + 32 * wc + 8 * fq; const size_t off = (size_t)row * D + col;
                    f32x4 a0 = acc[ai][bj][m][0], a1 = acc[ai][bj][m][1];
                    if (pb) { a0 = (a0 + *(const f32x4*)(pb + col)) * *(const f32x4*)(ps + col); a1 = (a1 + *(const f32x4*)(pb + col + 4)) * *(const f32x4*)(ps + col + 4); }
                    const f32x4 x0 = *(const f32x4*)(xold + off) + a0, x1 = *(const f32x4*)(xold + off + 4) + a1;
                    *(f32x4*)(xnew + off) = x0; *(f32x4*)(xnew + off + 4) = x1;
                    u32x4 w; w.x = cvt_pk_bf16(x0[0], x0[1]); w.y = cvt_pk_bf16(x0[2], x0[3]); w.z = cvt_pk_bf16(x1[0], x1[1]); w.w = cvt_pk_bf16(x1[2], x1[3]);
                    *(u32x4*)(xb + off) = w;
                    ss += (x0[0] * x0[0] + x0[1] * x0[1]) + (x0[2] * x0[2] + x0[3] * x0[3]) + (x1[0] * x1[0] + x1[1] * x1[1]) + (x1[2] * x1[2] + x1[3] * x1[3]);
                    asm volatile("" ::: "memory"); __builtin_amdgcn_sched_barrier(0);
                }
                ss = xrow16_sum(ss);
                if (fq == 0) ((LAS float*)ldsx)[wc * 256 + ai * 128 + wr * 64 + m * 16 + fr] = ss;
            }
        WG_BAR();
        if (tid < 256) { const LAS float* rd = (const LAS float*)ldsx; ssp[(size_t)u.pn * M + u.pm * 256 + tid] = (rd[tid] + rd[256 + tid]) + (rd[512 + tid] + rd[768 + tid]); }
        WG_BAR();
    }
};

struct EpiFinal {
    float* x; const float* gain; float* ssx; unsigned* cnt;
    __device__ __forceinline__ void operator()(Acc& acc, const Unit& u, int wr, int wc, int fr, int fq, LAS unsigned char* ldsx, int tid) const {
        LAS float* red = (LAS float*)ldsx; LAS float* rsl = (LAS float*)(ldsx + 4096);
#pragma unroll
        for (int ai = 0; ai < 2; ++ai)
#pragma unroll
            for (int m = 0; m < 4; ++m) {
                const int row = u.pm * 256 + ai * 128 + wr * 64 + m * 16 + fr; float ss = 0.f;
#pragma unroll
                for (int bj = 0; bj < 2; ++bj) {
                    const int col = u.pn * 256 + 128 * bj + 32 * wc + 8 * fq; const size_t off = (size_t)row * D + col;
                    const f32x4 x0 = *(const f32x4*)(x + off) + acc[ai][bj][m][0], x1 = *(const f32x4*)(x + off + 4) + acc[ai][bj][m][1];
                    acc[ai][bj][m][0] = x0; acc[ai][bj][m][1] = x1;
                    ss += (x0[0] * x0[0] + x0[1] * x0[1]) + (x0[2] * x0[2] + x0[3] * x0[3]) + (x1[0] * x1[0] + x1[1] * x1[1]) + (x1[2] * x1[2] + x1[3] * x1[3]);
                    asm volatile("" ::: "memory"); __builtin_amdgcn_sched_barrier(0);
                }
                ss = xrow16_sum(ss);
                if (fq == 0) red[wc * 256 + ai * 128 + wr * 64 + m * 16 + fr] = ss;
            }
        WG_BAR();
        if (tid < 256) __hip_atomic_store(ssx + (size_t)u.pn * M + u.pm * 256 + tid, (red[tid] + red[256 + tid]) + (red[512 + tid] + red[768 + tid]), __ATOMIC_RELAXED, __HIP_MEMORY_SCOPE_AGENT);
        asm volatile("s_waitcnt vmcnt(0)" ::: "memory");
        WG_BAR();
        if (tid == 0) {
            unsigned* c = cnt + 64 * u.pm;
            __hip_atomic_fetch_add(c, 1u, __ATOMIC_RELAXED, __HIP_MEMORY_SCOPE_AGENT);
            unsigned spins = 0;
            while (__hip_atomic_load(c, __ATOMIC_RELAXED, __HIP_MEMORY_SCOPE_AGENT) < 4u) { __builtin_amdgcn_s_sleep(2); if (++spins > (1u << 22)) break; }
            __builtin_amdgcn_fence(__ATOMIC_ACQUIRE, "agent");
            asm volatile("s_waitcnt vmcnt(0)" ::: "memory");
        }
        WG_BAR();
        if (tid < 256) {
            const float* p = ssx + u.pm * 256 + tid;
            const float sq = (__hip_atomic_load(p, __ATOMIC_RELAXED, __HIP_MEMORY_SCOPE_AGENT) + __hip_atomic_load(p + M, __ATOMIC_RELAXED, __HIP_MEMORY_SCOPE_AGENT)) +
                             (__hip_atomic_load(p + 2 * M, __ATOMIC_RELAXED, __HIP_MEMORY_SCOPE_AGENT) + __hip_atomic_load(p + 3 * M, __ATOMIC_RELAXED, __HIP_MEMORY_SCOPE_AGENT));
            rsl[tid] = 1.0f / sqrtf(sq * (1.0f / D) + EPS);
        }
        WG_BAR();
#pragma unroll
        for (int ai = 0; ai < 2; ++ai)
#pragma unroll
            for (int m = 0; m < 4; ++m) {
                const int rl = ai * 128 + wr * 64 + m * 16 + fr; const float rs = rsl[rl]; const int row = u.pm * 256 + rl;
#pragma unroll
                for (int bj = 0; bj < 2; ++bj) {
                    const int col = u.pn * 256 + 128 * bj + 32 * wc + 8 * fq; const size_t off = (size_t)row * D + col;
                    *(f32x4*)(x + off) = acc[ai][bj][m][0] * rs * *(const f32x4*)(gain + col); *(f32x4*)(x + off + 4) = acc[ai][bj][m][1] * rs * *(const f32x4*)(gain + col + 4);
                }
                asm volatile("" ::: "memory"); __builtin_amdgcn_sched_barrier(0);
            }
    }
};

struct EpiUp {
    const float* ssp; const float* cw; const float* cb; bf16_t* act; float* HB; float* FB;
    __device__ __forceinline__ void operator()(Acc& acc, const Unit& u, int wr, int wc, int fr, int fq, LAS unsigned char* ldsx, int tid) const {
        LAS float* Hl = (LAS float*)ldsx;
        LAS float* rsl = (LAS float*)(ldsx + 10240);
        const int lane = tid & 63;
        if (tid < 256) { const int row = u.pm * 256 + tid; const float sq = (ssp[row] + ssp[M + row]) + (ssp[2 * M + row] + ssp[3 * M + row]); rsl[tid] = 1.0f / sqrtf(sq * (1.0f / D) + EPS); }
        WG_BAR();
#pragma unroll
        for (int ai = 0; ai < 2; ++ai)
#pragma unroll
            for (int m = 0; m < 4; ++m) {
                const float rs = rsl[ai * 128 + wr * 64 + m * 16 + fr];
#pragma unroll
                for (int bj = 0; bj < 2; ++bj) { acc[ai][bj][m][0] *= rs; acc[ai][bj][m][1] *= rs; }
                asm volatile("" ::: "memory"); __builtin_amdgcn_sched_barrier(0);
            }
        if (tid < 128) *(LAS f32x4*)(Hl + tid * 4) = (f32x4){0.f, 0.f, 0.f, 0.f};
#pragma unroll
        for (int ai = 0; ai < 2; ++ai) {
            const int k = 2 * ai + wr;
#pragma unroll
            for (int bj = 0; bj < 2; ++bj)
#pragma unroll
                for (int n = 0; n < 2; ++n) {
                    const int tc = 128 * bj + 32 * wc + 8 * fq + 4 * n; const int uc = bj * FF + u.pn * 128 + 32 * wc + 8 * fq + 4 * n;
                    if (fr >= 14) { *(LAS f32x4*)(Hl + ((k + 1) * 2 + (fr - 14)) * 256 + tc) = acc[ai][bj][3][n]; if (k == 3) *(f32x4*)(HB + ((size_t)u.pm * 2 + (fr - 14)) * UP + uc) = acc[ai][bj][3][n]; }
                    if (k == 0 && fr < 2) *(f32x4*)(FB + ((size_t)u.pm * 2 + fr) * UP + uc) = acc[0][bj][0][n];
                }
        }
        WG_BAR();
#pragma unroll
        for (int ai = 0; ai < 2; ++ai) {
            const int k = 2 * ai + wr;
#pragma unroll
            for (int n = 0; n < 2; ++n) {
                const int tc = 32 * wc + 8 * fq + 4 * n; const int ucg = u.pn * 128 + tc;
                f32x4 cg[4];
#pragma unroll
                for (int bj = 0; bj < 2; ++bj) {
                    const int uc = bj * FF + ucg;
                    const f32x4 w0 = *(const f32x4*)(cw + uc), w1 = *(const f32x4*)(cw + UP + uc), w2 = *(const f32x4*)(cw + 2 * UP + uc), bb = *(const f32x4*)(cb + uc);
                    const f32x4 h0 = *(const LAS f32x4*)(Hl + (k * 2 + 0) * 256 + 128 * bj + tc), h1 = *(const LAS f32x4*)(Hl + (k * 2 + 1) * 256 + 128 * bj + tc);
#pragma unroll
                    for (int m = 0; m < 4; ++m) {
                        const f32x4 V = acc[ai][bj][m][n]; f32x4 p1, p2;
#pragma unroll
                        for (int e = 0; e < 4; ++e) {
                            const float r1 = dppf<0x121>(V[e]), r2 = dppf<0x122>(V[e]); float x1, x2;
                            if (m > 0) { x1 = dppf<0x121>(acc[ai][bj][m > 0 ? m - 1 : 0][n][e]); x2 = dppf<0x122>(acc[ai][bj][m > 0 ? m - 1 : 0][n][e]); }
                            else { x1 = h1[e]; x2 = (fr == 0) ? h0[e] : h1[e]; }
                            p1[e] = (fr == 0) ? x1 : r1; p2[e] = (fr < 2) ? x2 : r2;
                        }
                        const f32x4 cv = bb + w0 * p2 + w1 * p1 + w2 * V;
                        __builtin_amdgcn_sched_barrier(0);
                        if (bj == 0) cg[m] = cv;
                        else {
                            const int row = u.pm * 256 + ai * 128 + wr * 64 + m * 16 + fr;
                            float o[4];
#pragma unroll
                            for (int e = 0; e < 4; ++e) { const float gt = cg[m][e]; o[e] = gt * sigmoidf_(gt) * cv[e]; }
                            u32x2 w; w.x = cvt_pk_bf16(o[0], o[1]); w.y = cvt_pk_bf16(o[2], o[3]);
                            *(u32x2*)(act + (size_t)row * FF + ucg) = w;
                        }
                    }
                    asm volatile("" ::: "memory"); __builtin_amdgcn_sched_barrier(0);
                }
            }
        }
        WG_BAR();
    }
};

namespace att {
constexpr int SLOT_B = 16384, NSLOT = 6;
constexpr int OFF_K = 0, OFF_IMP = NSLOT * SLOT_B, IMPW = 132, OFF_SEL = OFF_IMP + 64 * IMPW * 4, OFF_UNI = OFF_SEL + 1024, OFF_LIST = OFF_UNI + 64, OFF_N = OFF_LIST + 132 * 4, OFF_CODE = OFF_N + 48, CODEW = 144;
static_assert(OFF_CODE + 8 * CODEW <= LDS_BYTES - 16 && 8 * SLOT_B <= OFF_SEL, "attention LDS map");
struct Ctx {
    const bf16_t *Q, *KCC, *VCT, *KS, *VST, *KW, *VWT; const float* gates; bf16_t* O;
};
__device__ __forceinline__ bf16x8 mk8(s16x4 a, s16x4 b) { return (bf16x8){a[0], a[1], a[2], a[3], b[0], b[1], b[2], b[3]}; }

template <int MODE>
__device__ __forceinline__ void branch(LAS unsigned char* lds, const bf16_t* Kg, const bf16_t* Vg, int ktile_elems, int nt, int c, int w, int lane, int tid,
                                       const bf16x8 (&qf)[4][2], float (&mrow)[4], float (&lrow)[4], f32x4 (&O)[4][4]) {
    const int fr = lane & 15, fq = lane >> 4;
    const LAS int* list = (const LAS int*)(lds + OFF_LIST);
    LAS float* impL = (LAS float*)(lds + OFF_IMP);
    const LAS unsigned char* codeL = (const LAS unsigned char*)(lds + OFF_CODE) + w * CODEW;
    constexpr int TPS = (MODE >= 2) ? 4 : 3;
#define ATT_DMA(ti, slot) do { const int ti_ = (ti); const int s_ = list[ti_]; LAS unsigned char* d_ = lds + OFF_K + (slot) * SLOT_B + w * 1024; \
        int t2_ = tid; asm volatile("" : "+v"(t2_)); const int lr = t2_ >> 3, lq = t2_ & 7; const int goff = lr * 64 + ((lq ^ ((lr >> 1) & 7)) * 8); \
        __builtin_amdgcn_global_load_lds((const unsigned*)(Kg + (size_t)s_ * ktile_elems + goff), (LAS unsigned*)d_, 16, 0, 0); \
        if (MODE != 0) __builtin_amdgcn_global_load_lds((const unsigned*)(Vg + (size_t)s_ * 4096 + goff), (LAS unsigned*)(d_ + 8192), 16, 0, 0); } while (0)
    asm volatile("s_waitcnt vmcnt(0)" ::: "memory");
#pragma unroll
    for (int ti = 0; ti < TPS; ++ti) if (ti < nt) ATT_DMA(ti, ti);
    const int nst = (nt + TPS - 1) / TPS;
    for (int j = 0; j < nst; ++j) {
        asm volatile("s_waitcnt vmcnt(0)" ::: "memory");
        WG_BAR();
#pragma unroll
        for (int hh = 0; hh < TPS; ++hh) if (TPS * (j + 1) + hh < nt) ATT_DMA(TPS * (j + 1) + hh, ((j + 1) & 1) * TPS + hh);
#pragma unroll 1
        for (int h = 0; h < TPS; ++h) {
        const int i = TPS * j + h; if (i >= nt) break;
        const int s = list[i];
        unsigned code = 0xffu; if (MODE == 2) code = (unsigned)__builtin_amdgcn_readfirstlane((int)codeL[i]);
        const LAS unsigned char* Kb = lds + OFF_K + ((j & 1) * TPS + h) * SLOT_B;
        const LAS unsigned char* Vb = Kb;
        int l2_ = lane; asm volatile("" : "+v"(l2_)); const int fr2 = l2_ & 15, fq2 = l2_ >> 4, swz = (fr2 >> 1) & 7;
        const int kb0 = fr2 * 128 + ((fq2 ^ swz) * 16), kb1 = kb0 ^ 64;
        if (MODE != 2) {
            f32x4 sa[4][4];
#pragma unroll
            for (int p = 0; p < 4; ++p) {
                const float cinit = (MODE == 1) ? lrow[p] : -((mrow[p] < -1e29f) ? 0.f : mrow[p]);
#pragma unroll
                for (int mt = 0; mt < 4; ++mt) sa[p][mt] = (f32x4){cinit, cinit, cinit, cinit};
            }
#pragma unroll
            for (int mt = 0; mt < 4; ++mt)
#pragma unroll
                for (int ks = 0; ks < 2; ++ks) {
                    const bf16x8 kf = *(const LAS bf16x8*)(Kb + (ks ? kb1 : kb0) + mt * 2048);
#pragma unroll
                    for (int p = 0; p < 4; ++p) sa[p][mt] = __builtin_amdgcn_mfma_f32_16x16x32_bf16(kf, qf[p][ks], sa[p][mt], 0, 0, 0);
                }
            bf16x8 pf[4][2];
#pragma unroll
            for (int p = 0; p < 4; ++p) {
                const int ttA = 8 * w + 2 * p, tt = ttA + (fr >> 3);
                bool needmask;
                if (MODE <= 1) needmask = (((64 * c + ttA - 31) >> 4) - 64 * s) < 63;
                else needmask = (s == c) || (c >= 8 && s == c - 8);
                if (needmask) {
                    int hi, lov = -1;
                    if (MODE <= 1) { const int t = 64 * c + tt; hi = ((t - 31) >> 4) - 64 * s; }
                    else { hi = (s == c) ? tt : 63; lov = (c >= 8 && s == c - 8) ? tt : -1; }
#pragma unroll
                    for (int mt = 0; mt < 4; ++mt)
#pragma unroll
                        for (int j = 0; j < 4; ++j) { const int kk = 16 * mt + 4 * fq + j; sa[p][mt][j] = (kk <= hi && kk > lov) ? sa[p][mt][j] : -1e30f; }
                }
                if (MODE != 1) {
                    float mx = fmaxf(fmaxf(sa[p][0][0], sa[p][0][1]), sa[p][0][2]);
                    mx = fmaxf(fmaxf(mx, sa[p][0][3]), sa[p][1][0]); mx = fmaxf(fmaxf(mx, sa[p][1][1]), sa[p][1][2]); mx = fmaxf(fmaxf(mx, sa[p][1][3]), sa[p][2][0]);
                    mx = fmaxf(fmaxf(mx, sa[p][2][1]), sa[p][2][2]); mx = fmaxf(fmaxf(mx, sa[p][2][3]), sa[p][3][0]); mx = fmaxf(fmaxf(mx, sa[p][3][1]), sa[p][3][2]); mx = fmaxf(mx, sa[p][3][3]);
                    mx = xrow16_max(mx);
                    const bool uninit = mrow[p] < -1e29f;
                    const bool resc = (mx > 8.0f) || (uninit && mx > -1e29f);
                    if (__any(resc)) {
                        const float delta = resc ? mx : 0.f;
                        const float alpha = (resc && !uninit) ? ex2(-delta) : 1.0f;
#pragma unroll
                        for (int mt = 0; mt < 4; ++mt) sa[p][mt] = sa[p][mt] - delta;
                        lrow[p] *= alpha;
                        if (MODE >= 2) {
#pragma unroll
                            for (int d = 0; d < 4; ++d) O[p][d] *= alpha;
                        }
                        if (resc) mrow[p] = (uninit ? 0.f : mrow[p]) + delta;
                    }
                }
#pragma unroll
                for (int mt = 0; mt < 4; ++mt)
#pragma unroll
                    for (int j = 0; j < 4; ++j) sa[p][mt][j] = ex2(sa[p][mt][j]);
                if (MODE != 1) { const f32x4 t4 = (sa[p][0] + sa[p][1]) + (sa[p][2] + sa[p][3]); lrow[p] += (t4[0] + t4[1]) + (t4[2] + t4[3]); }
                if (MODE >= 1) {
#pragma unroll
                    for (int k2 = 0; k2 < 2; ++k2) {
                        u32x4 wv; wv.x = cvt_pk_bf16(sa[p][2 * k2][0], sa[p][2 * k2][1]); wv.y = cvt_pk_bf16(sa[p][2 * k2][2], sa[p][2 * k2][3]); wv.z = cvt_pk_bf16(sa[p][2 * k2 + 1][0], sa[p][2 * k2 + 1][1]); wv.w = cvt_pk_bf16(sa[p][2 * k2 + 1][2], sa[p][2 * k2 + 1][3]);
                        pf[p][k2] = __builtin_bit_cast(bf16x8, wv);
                    }
                }
                if (MODE == 1) {
#pragma unroll
                    for (int mt = 0; mt < 4; ++mt) {
                        float a = sa[p][mt][0] + sa[p][mt][1] + sa[p][mt][2] + 0.5f * sa[p][mt][3], bn = 0.5f * sa[p][mt][3];
                        a = sum8(a); bn = sum8(bn);
                        const int sb = 16 * s + 4 * mt + fq;
                        if ((fr & 7) == 0) { (void)__hip_atomic_fetch_add(impL + tt * IMPW + sb, a, __ATOMIC_RELAXED, __HIP_MEMORY_SCOPE_WORKGROUP); (void)__hip_atomic_fetch_add(impL + tt * IMPW + sb + 1, bn, __ATOMIC_RELAXED, __HIP_MEMORY_SCOPE_WORKGROUP); }
                    }
                }
            }
            if (MODE >= 1) {
#pragma unroll
                for (int d = 0; d < 4; ++d)
#pragma unroll
                    for (int k2 = 0; k2 < 2; ++k2) {
                        const bf16x8 vf = *(const LAS bf16x8*)(Vb + 8192 + (k2 ? kb1 : kb0) + d * 2048);
#pragma unroll
                        for (int p = 0; p < 4; ++p) O[p][d] = __builtin_amdgcn_mfma_f32_16x16x32_bf16(vf, pf[p][k2], O[p][d], 0, 0, 0);
                    }
            }
            __builtin_amdgcn_sched_barrier(0);
        } else {
#pragma unroll
        for (int p = 0; p < 4; ++p) {
            const int ttA = 8 * w + 2 * p;
            const unsigned mA = (code >> (2 * p)) & 1u, mB = (code >> (2 * p + 1)) & 1u;
            if ((mA | mB) != 0u) {
            const int tt = ttA + (fr >> 3);
            float cinit;
            if (MODE == 1) cinit = lrow[p];
            else { const float mref = (mrow[p] < -1e29f) ? 0.f : mrow[p]; const bool colact = (MODE != 2) || (((fr >> 3) ? mB : mA) != 0u); cinit = colact ? -mref : -1e30f; }
            f32x4 sa[4];
#pragma unroll
            for (int mt = 0; mt < 4; ++mt) {
                sa[mt] = (f32x4){cinit, cinit, cinit, cinit};
#pragma unroll
                for (int ks = 0; ks < 2; ++ks) { const bf16x8 kf = *(const LAS bf16x8*)(Kb + (ks ? kb1 : kb0) + mt * 2048); sa[mt] = __builtin_amdgcn_mfma_f32_16x16x32_bf16(kf, qf[p][ks], sa[mt], 0, 0, 0); }
            }
            bool needmask;
            if (MODE <= 1) needmask = (((64 * c + ttA - 31) >> 4) - 64 * s) < 63;
            else if (MODE == 2) needmask = (s == c);
            else needmask = (s == c) || (c >= 8 && s == c - 8);
            if (needmask) {
                int hi, lov = -1;
                if (MODE <= 1) { const int t = 64 * c + tt; hi = ((t - 31) >> 4) - 64 * s; }
                else if (MODE == 2) hi = tt;
                else { hi = (s == c) ? tt : 63; lov = (c >= 8 && s == c - 8) ? tt : -1; }
#pragma unroll
                for (int mt = 0; mt < 4; ++mt)
#pragma unroll
                    for (int j = 0; j < 4; ++j) { const int kk = 16 * mt + 4 * fq + j; sa[mt][j] = (kk <= hi && kk > lov) ? sa[mt][j] : -1e30f; }
            }
            if (MODE != 1) {
                float mx = fmaxf(fmaxf(sa[0][0], sa[0][1]), sa[0][2]);
                mx = fmaxf(fmaxf(mx, sa[0][3]), sa[1][0]); mx = fmaxf(fmaxf(mx, sa[1][1]), sa[1][2]); mx = fmaxf(fmaxf(mx, sa[1][3]), sa[2][0]);
                mx = fmaxf(fmaxf(mx, sa[2][1]), sa[2][2]); mx = fmaxf(fmaxf(mx, sa[2][3]), sa[3][0]); mx = fmaxf(fmaxf(mx, sa[3][1]), sa[3][2]); mx = fmaxf(mx, sa[3][3]);
                mx = xrow16_max(mx);
                const bool uninit = mrow[p] < -1e29f;
                const bool resc = (mx > 8.0f) || (uninit && mx > -1e29f);
                if (__any(resc)) {
                    const float delta = resc ? mx : 0.f;
                    const float alpha = (resc && !uninit) ? ex2(-delta) : 1.0f;
#pragma unroll
                    for (int mt = 0; mt < 4; ++mt) sa[mt] = sa[mt] - delta;
                    lrow[p] *= alpha;
                    if (MODE >= 2) {
#pragma unroll
                        for (int d = 0; d < 4; ++d) O[p][d] *= alpha;
                    }
                    if (resc) mrow[p] = (uninit ? 0.f : mrow[p]) + delta;
                }
            }
            f32x4 pv[4];
#pragma unroll
            for (int mt = 0; mt < 4; ++mt)
#pragma unroll
                for (int j = 0; j < 4; ++j) pv[mt][j] = ex2(sa[mt][j]);
            if (MODE != 1) { const f32x4 t4 = (pv[0] + pv[1]) + (pv[2] + pv[3]); lrow[p] += (t4[0] + t4[1]) + (t4[2] + t4[3]); }
            if (MODE >= 1) {
                bf16x8 pf[2];
#pragma unroll
                for (int k2 = 0; k2 < 2; ++k2) {
                    u32x4 wv; wv.x = cvt_pk_bf16(pv[2 * k2][0], pv[2 * k2][1]); wv.y = cvt_pk_bf16(pv[2 * k2][2], pv[2 * k2][3]); wv.z = cvt_pk_bf16(pv[2 * k2 + 1][0], pv[2 * k2 + 1][1]); wv.w = cvt_pk_bf16(pv[2 * k2 + 1][2], pv[2 * k2 + 1][3]);
                    pf[k2] = __builtin_bit_cast(bf16x8, wv);
                }
#pragma unroll
                for (int d = 0; d < 4; ++d)
#pragma unroll
                    for (int k2 = 0; k2 < 2; ++k2) {
                        const bf16x8 vf = *(const LAS bf16x8*)(Vb + 8192 + (k2 ? kb1 : kb0) + d * 2048);
                        O[p][d] = __builtin_amdgcn_mfma_f32_16x16x32_bf16(vf, pf[k2], O[p][d], 0, 0, 0);
                    }
            }
            if (MODE == 1) {
#pragma unroll
                for (int mt = 0; mt < 4; ++mt) {
                    float a = pv[mt][0] + pv[mt][1] + pv[mt][2] + 0.5f * pv[mt][3], bn = 0.5f * pv[mt][3];
                    a = sum8(a); bn = sum8(bn);
                    const int sb = 16 * s + 4 * mt + fq;
                    if ((fr & 7) == 0) { (void)__hip_atomic_fetch_add(impL + tt * IMPW + sb, a, __ATOMIC_RELAXED, __HIP_MEMORY_SCOPE_WORKGROUP); (void)__hip_atomic_fetch_add(impL + tt * IMPW + sb + 1, bn, __ATOMIC_RELAXED, __HIP_MEMORY_SCOPE_WORKGROUP); }
                }
            }
            }
            __builtin_amdgcn_sched_barrier(0);
        }
        }
        }
    }
    WG_BAR();
#undef ATT_DMA
}

__device__ __forceinline__ void unit(LAS unsigned char* lds, const Ctx& X, int b, int g, int c, int tid_in) {
    int tid = tid_in; asm volatile("" : "+v"(tid));
    const int lane = tid & 63, w = __builtin_amdgcn_readfirstlane(tid >> 6), fr = lane & 15, fq = lane >> 4;
    LAS int* list = (LAS int*)(lds + OFF_LIST);
    LAS unsigned* selm = (LAS unsigned*)(lds + OFF_SEL);
    LAS unsigned* uni = (LAS unsigned*)(lds + OFF_UNI);
    LAS float* impL = (LAS float*)(lds + OFF_IMP);
    LAS int* nl = (LAS int*)(lds + OFF_N);
    const int bg = b * 2 + g; const size_t rowbase = (size_t)b * T + 64 * c;
    bf16x8 qf[4][2];
#pragma unroll
    for (int p = 0; p < 4; ++p) { const bf16_t* qp = X.Q + (rowbase + 8 * w + 2 * p + (fr >> 3)) * 1024 + (8 * g + (fr & 7)) * 64 + 8 * fq;
#pragma unroll
        for (int ks = 0; ks < 2; ++ks) qf[p][ks] = *(const bf16x8*)(qp + 32 * ks); }
    for (int i = lane; i < 8 * IMPW; i += 64) impL[(8 * w) * IMPW + i] = 0.f;
    const int ncmp = (4 * c + 3 + 63) >> 6;
    if (tid < 8) list[tid] = tid;
    float mrow[4], lrow[4]; f32x4 O[4][4];
#pragma unroll
    for (int p = 0; p < 4; ++p) { mrow[p] = -1e30f; lrow[p] = 0.f;
#pragma unroll
        for (int d = 0; d < 4; ++d) { O[p][d] = (f32x4){0.f, 0.f, 0.f, 0.f}; } }
    WG_BAR();
    const bf16_t* kcc = X.KCC + (size_t)bg * 512 * 64; const bf16_t* vct = X.VCT + (size_t)bg * 8 * 4096;
    branch<0>(lds, kcc, vct, 4096, ncmp, c, w, lane, tid, qf, mrow, lrow, O);
#pragma unroll
    for (int p = 0; p < 4; ++p) { float l = xrow16_sum(lrow[p]); lrow[p] = (l > 0.f) ? (-mrow[p] - __builtin_amdgcn_logf(l)) : -1e30f; }
    branch<1>(lds, kcc, vct, 4096, ncmp, c, w, lane, tid, qf, mrow, lrow, O);
#define ATT_GATE(br, scale_expr) do { _Pragma("unroll") for (int p = 0; p < 4; ++p) { \
        const size_t grow = rowbase + 8 * w + 2 * p + (fr >> 3); \
        const float gt = X.gates[grow * 48 + (8 * g + (fr & 7)) * 3 + (br)]; const float sc = gt * (scale_expr); \
        _Pragma("unroll") for (int d = 0; d < 4; ++d) { \
            u32x2* optr = (u32x2*)(X.O + grow * 1024 + (8 * g + (fr & 7)) * 64 + 4 * fq + 16 * d); u32x2 ot = (u32x2){0u, 0u}; if ((br) > 0) ot = *optr; \
            float o0 = __uint_as_float(ot.x << 16), o1 = __uint_as_float(ot.x & 0xffff0000u), o2 = __uint_as_float(ot.y << 16), o3 = __uint_as_float(ot.y & 0xffff0000u); \
            o0 += sc * O[p][d][0]; o1 += sc * O[p][d][1]; o2 += sc * O[p][d][2]; o3 += sc * O[p][d][3]; \
            ot.x = cvt_pk_bf16(o0, o1); ot.y = cvt_pk_bf16(o2, o3); O[p][d] = (f32x4){0.f, 0.f, 0.f, 0.f}; \
            *optr = ot; } \
        mrow[p] = -1e30f; lrow[p] = 0.f; } } while (0)
    ATT_GATE(0, 1.0f);
    LDS_WAIT();
    for (int q8 = 0; q8 < 8; ++q8) {
        const int tt = 8 * w + q8;
        unsigned long long blo, bhi;
        if (c + 1 <= 16) { blo = (1ull << (c + 1)) - 1ull; bhi = 0ull; }
        else {
            const int s1 = lane, s2 = lane + 64;
            const bool c1 = (s1 >= 1 && s1 <= c - 2), c2 = (s2 >= 1 && s2 <= c - 2);
            const float v1 = c1 ? impL[tt * IMPW + s1] : -1.f, v2 = c2 ? impL[tt * IMPW + s2] : -1.f;
            int r1 = 0, r2 = 0;
            const int nq = (c - 2) / 4 + 1;
#pragma unroll 2
            for (int q = 0; q < nq; ++q) {
                const f32x4 x4 = *(const LAS f32x4*)(impL + tt * IMPW + 4 * q);
#pragma unroll
                for (int e = 0; e < 4; ++e) { const int sp = 4 * q + e; const float x = (sp >= 1 && sp <= c - 2) ? x4[e] : -2.f;
                    r1 += (x > v1 || (x == v1 && sp < s1)) ? 1 : 0; r2 += (x > v2 || (x == v2 && sp < s2)) ? 1 : 0; }
            }
            const bool f1 = (s1 == 0 || s1 == c || s1 == c - 1), f2 = (s2 == c || s2 == c - 1);
            blo = __ballot((c1 && r1 < 13) || f1); bhi = __ballot((c2 && r2 < 13) || f2);
        }
        if (lane == 0) { selm[tt * 4 + 0] = (unsigned)blo; selm[tt * 4 + 1] = (unsigned)(blo >> 32); selm[tt * 4 + 2] = (unsigned)bhi; selm[tt * 4 + 3] = (unsigned)(bhi >> 32); }
    }
    WG_BAR();
    if (tid < 4) { unsigned o = 0; for (int i = 0; i < 64; ++i) o |= selm[i * 4 + tid]; uni[tid] = o; }
    WG_BAR();
    if (tid == 0) { int n = 0; for (int s = 0; s <= c; ++s) if ((uni[s >> 5] >> (s & 31)) & 1u) list[n++] = s; nl[0] = n; }
    WG_BAR();
    const int nsel = nl[0];
    { LAS unsigned char* cw_ = (LAS unsigned char*)(lds + OFF_CODE) + w * CODEW;
      for (int i = lane; i < nsel; i += 64) { const int s_ = list[i]; unsigned cd = 0;
#pragma unroll
          for (int q8 = 0; q8 < 8; ++q8) cd |= ((selm[(8 * w + q8) * 4 + (s_ >> 5)] >> (s_ & 31)) & 1u) << q8;
          cw_[i] = (unsigned char)cd; }
      LDS_WAIT(); }
    branch<2>(lds, X.KS + (size_t)bg * T * 64, X.VST + (size_t)bg * 128 * 4096, 4096, nsel, c, w, lane, tid, qf, mrow, lrow, O);
#pragma unroll
    for (int p = 0; p < 4; ++p) { float l = xrow16_sum(lrow[p]); lrow[p] = (l > 0.f) ? 1.0f / l : 0.f; }
    { float rl[4] = {lrow[0], lrow[1], lrow[2], lrow[3]}; ATT_GATE(1, rl[p]); }
    const int w0 = (c >= 8) ? c - 8 : 0, nwin = c - w0 + 1;
    if (tid < nwin) list[tid] = w0 + tid;
    WG_BAR();
    branch<3>(lds, X.KW + (size_t)bg * T * 64, X.VWT + (size_t)bg * 128 * 4096, 4096, nwin, c, w, lane, tid, qf, mrow, lrow, O);
#pragma unroll
    for (int p = 0; p < 4; ++p) { float l = xrow16_sum(lrow[p]); lrow[p] = (l > 0.f) ? 1.0f / l : 0.f; }
    { float rl[4] = {lrow[0], lrow[1], lrow[2], lrow[3]}; ATT_GATE(2, rl[p]); }
#undef ATT_GATE
    WG_BAR();
}
}

__device__ __forceinline__ unsigned f2bf(float f) { unsigned u = __builtin_bit_cast(unsigned, f); return (u + 0x7fffu + ((u >> 16) & 1u)) >> 16; }
__device__ __forceinline__ unsigned pk2(float lo, float hi) { return f2bf(lo) | (f2bf(hi) << 16); }
template <int MAP>
__device__ __forceinline__ int rowmap(int a) {
    if (MAP == 0) return perm8(a);
    if (MAP == 1) return a < 1792 ? ((a & ~63) | swap45(a & 63)) : a;
    if (MAP == 2) { if (a < FF) return 256 * (a >> 7) + perm8(a & 127); const int a2 = a - FF; return 256 * (a2 >> 7) + 128 + perm8(a2 & 127); }
    return swap45(a);
}
template <int MAP>
__device__ __forceinline__ void transpose_item(const float* W, int K, int N, bf16_t* WT, int row_off, const float* gain, LAS float* scr, int item, int lane) {
    const int nblk = (N + 31) / 32, kb = item / nblk, nb = item % nblk, k0 = 64 * kb, n0 = 32 * nb;
#pragma unroll
    for (int i = 0; i < 32; ++i) { const int kk = 2 * i + (lane >> 5); const int col = n0 + (lane & 31); float v = (col < N) ? W[(size_t)(k0 + kk) * N + col] : 0.f; if (gain) v *= gain[k0 + kk]; scr[kk * 33 + (lane & 31)] = v; }
    LDS_WAIT();
    const int cc = lane & 7;
#pragma unroll
    for (int j = 0; j < 4; ++j) { const int n = (lane >> 3) + 8 * j; const LAS float* s = scr + (8 * cc) * 33 + n;
        u32x4 o; o.x = pk2(s[0 * 33], s[1 * 33]); o.y = pk2(s[2 * 33], s[3 * 33]); o.z = pk2(s[4 * 33], s[5 * 33]); o.w = pk2(s[6 * 33], s[7 * 33]);
        if (n0 + n < N) *(u32x4*)(WT + (size_t)(row_off + rowmap<MAP>(n0 + n)) * K + k0 + 8 * cc) = o; }
    LDS_WAIT();
}

#define XB_TMO      128
#define XB_XCNT(j)  (256  + 64 * (j))
#define XB_XSUB(j)  (1280 + 64 * (j))
#define XB_XGEN(j)  (2304 + 64 * (j))
#define XB_TOP      3328
#define XB_TOPGEN   3392
#define XCD_BAR_WORDS 3456
#define XB_SPIN_CAP (1u << 18)
__device__ __forceinline__ unsigned xb_ld(unsigned* p)              { return __hip_atomic_load(p, __ATOMIC_RELAXED, __HIP_MEMORY_SCOPE_AGENT); }
__device__ __forceinline__ unsigned xb_add(unsigned* p, unsigned v) { return __hip_atomic_fetch_add(p, v, __ATOMIC_RELAXED, __HIP_MEMORY_SCOPE_AGENT); }
__device__ __forceinline__ unsigned xb_xcc_id() { return (unsigned)__builtin_amdgcn_s_getreg((3 << 11) | 20) & 0xFu; }
#define XB_SPIN(cond, bar) do { unsigned _sp = 0; while (cond) { __builtin_amdgcn_s_sleep(1); \
    if ((++_sp & 255u) == 0u) { if (xb_ld(&(bar)[XB_TMO])) break; if (_sp > XB_SPIN_CAP) { atomicAdd(&(bar)[XB_TMO], 1u); break; } } } } while (0)
struct XcdBarrier { unsigned* bar; unsigned x; volatile LAS unsigned* st; };
__device__ __forceinline__ XcdBarrier xcd_barrier_post(unsigned* bar, volatile LAS unsigned* st) {
    XcdBarrier b; b.bar = bar; b.x = xb_xcc_id(); b.st = st;
    if (threadIdx.x == 0) (void)xb_add(&bar[XB_XCNT(b.x)], 1u);
    return b;
}
__device__ __forceinline__ void xcd_barrier_complete(unsigned* bar, unsigned x, unsigned& nloc, unsigned& nx) {
    const unsigned G = gridDim.x * gridDim.y * gridDim.z;
    unsigned sum, cnt, mine, sp = 0u;
    for (;;) {
        sum = 0u; cnt = 0u; mine = 0u;
#pragma unroll
        for (unsigned j = 0; j < 16; ++j) { const unsigned c = xb_ld(&bar[XB_XCNT(j)]); sum += c; cnt += (c > 0u) ? 1u : 0u; mine = (j == x) ? c : mine; }
        if (sum == G) break;
        __builtin_amdgcn_s_sleep(1);
        if ((++sp & 255u) == 0u) { if (xb_ld(&bar[XB_TMO])) break; if (sp > XB_SPIN_CAP) { atomicAdd(&bar[XB_TMO], 1u); break; } }
    }
    nloc = mine > 0u ? mine : 1u; nx = cnt > 0u ? cnt : 1u;
}
__device__ __forceinline__ void xcd_barrier(const XcdBarrier& b) {
    asm volatile("s_waitcnt vmcnt(0)" ::: "memory");
    __syncthreads();
    if (threadIdx.x == 0) {
        unsigned* bar = b.bar;
        __builtin_amdgcn_s_waitcnt(0);
        unsigned nloc = b.st[0], nx = b.st[1];
        if (nloc == 0u) { xcd_barrier_complete(bar, b.x, nloc, nx); b.st[0] = nloc; b.st[1] = nx; }
        const unsigned old = xb_add(&bar[XB_XSUB(b.x)], 1u);
        const unsigned gen = old / nloc;
        if (old + 1u == (gen + 1u) * nloc) {
            __builtin_amdgcn_fence(__ATOMIC_RELEASE, "agent");
            asm volatile("s_waitcnt vmcnt(0)" ::: "memory");
            const unsigned og = xb_add(&bar[XB_TOP], 1u);
            const unsigned tg = og / nx;
            if (og + 1u == (tg + 1u) * nx) xb_add(&bar[XB_TOPGEN], 1u);
            else XB_SPIN(xb_ld(&bar[XB_TOPGEN]) == tg, bar);
            __builtin_amdgcn_fence(__ATOMIC_ACQUIRE, "agent");
            xb_add(&bar[XB_XGEN(b.x)], 1u);
            asm volatile("s_waitcnt vmcnt(0)" ::: "memory");
        } else {
            XB_SPIN(xb_ld(&bar[XB_XGEN(b.x)]) == gen, bar);
            __builtin_amdgcn_fence(__ATOMIC_ACQUIRE, "agent");
            asm volatile("s_waitcnt vmcnt(0)" ::: "memory");
        }
    }
    __syncthreads();
}

struct Args { const float* in[29]; float* out; unsigned char* ws; float inv[32]; int ph_lo, ph_hi; };

constexpr int DI_UP = 16 * 176, DI_DN = 44 * 32, DI_PL = 4 * 8, N_DEFER = 2 * DI_UP + 2 * DI_DN + 4 * DI_PL;
__device__ __forceinline__ void ffn_weight_item(const Args& a, unsigned char* ws, LAS float* scr, int r, int lane) {
    if (r < DI_UP) { transpose_item<2>(a.in[15], D, UP, (bf16_t*)(ws + WS_WUP0), 0, a.in[14], scr, r, lane); return; } r -= DI_UP;
    if (r < DI_UP) { transpose_item<2>(a.in[24], D, UP, (bf16_t*)(ws + WS_WUP1), 0, a.in[23], scr, r, lane); return; } r -= DI_UP;
    if (r < DI_DN) { transpose_item<0>(a.in[18], FF, D, (bf16_t*)(ws + WS_WDN0), 0, nullptr, scr, r, lane); return; } r -= DI_DN;
    if (r < DI_DN) { transpose_item<0>(a.in[27], FF, D, (bf16_t*)(ws + WS_WDN1), 0, nullptr, scr, r, lane); return; } r -= DI_DN;
    const int gi = r / DI_PL; transpose_item<0>(a.in[20] + (size_t)gi * 65536, 256, 256, (bf16_t*)(ws + WS_WPOOL), gi * 256, nullptr, scr, r % DI_PL, lane);
}

__global__ void __launch_bounds__(512) mk_fwd(Args a) {
    extern __shared__ __attribute__((aligned(16))) unsigned char lds_raw[];
    LAS unsigned char* lds = (LAS unsigned char*)lds_raw;
    LAS unsigned char* ldsx = lds + LDS_RING;
    cg::grid_group grid = cg::this_grid();
    if (threadIdx.x < 2) ((volatile LAS unsigned*)(lds + LDS_BYTES - 16))[threadIdx.x] = 0u;
    __syncthreads();
    if (a.ph_hi == 0x7fff) grid.sync();
    const XcdBarrier xbar = xcd_barrier_post((unsigned*)a.ws, (volatile LAS unsigned*)(lds + LDS_BYTES - 16));
    const int tid = threadIdx.x, lane = tid & 63, wave = __builtin_amdgcn_readfirstlane(tid >> 6);
    const int G = gridDim.x, bx = blockIdx.x;
    unsigned char* ws = a.ws;
#define cosT ((float*)(ws + WS_ROPE))
#define sinT ((float*)(ws + WS_ROPE) + T * 32)
#define ssp ((float*)(ws + WS_SSP))
#define c1p ((float*)(ws + WS_C1P))
#define rstdv ((float*)(ws + WS_RSTD))
#define HB ((float*)(ws + WS_HB))
#define FB ((float*)(ws + WS_FB))
#define gates ((float*)(ws + WS_GATE))
#define Wt_in ((bf16_t*)(ws + WS_WIN))
#define Wt_out ((bf16_t*)(ws + WS_WOUT))
#define Wt_pool ((bf16_t*)(ws + WS_WPOOL))
#define Wt_c1 (kv ? (bf16_t*)(ws + WS_WC1V) : (bf16_t*)(ws + WS_WC1K))
#define Wt_c2 (kv ? (bf16_t*)(ws + WS_WC2V) : (bf16_t*)(ws + WS_WC2K))
#define XB ((bf16_t*)(ws + WS_XB))
#define Qb ((bf16_t*)(ws + WS_Q))
#define KC ((bf16_t*)(ws + WS_KC))
#define VC ((bf16_t*)(ws + WS_VC))
#define KS ((bf16_t*)(ws + WS_KS))
#define VST ((bf16_t*)(ws + WS_VST))
#define KW ((bf16_t*)(ws + WS_KW))
#define VWT ((bf16_t*)(ws + WS_VWT))
#define KCC ((bf16_t*)(ws + WS_KCC))
#define VCT ((bf16_t*)(ws + WS_VCT))
#define Ob ((bf16_t*)(ws + WS_O))
#define ACT ((bf16_t*)(ws + WS_ACT))
#define POOLED ((bf16_t*)(ws + WS_POOLED))
    float* out = a.out;
    const int lo = a.ph_lo, hi = a.ph_hi;
    const bool defer = (G == 256);
#define IN(k) (lo <= (k) && (k) < hi)
#define SEAM(k) do { if (IN(k) && IN((k) + 1)) xcd_barrier(xbar); } while (0)

    if (IN(0)) {
        LAS float* scr = (LAS float*)(lds + wave * 16384);
        const int gw = bx * 8 + wave, NGW = G * 8;
        constexpr int I_IN = 16 * 58, I_OUT = 16 * 32, I_C1 = 32 * 8, I_C2 = 4 * 2;
        constexpr int NA = I_IN + I_OUT + 2 * I_C1 + 2 * I_C2;
        const int NIT = NA + (defer ? 0 : N_DEFER);
        for (int it = gw; it < NIT; it += NGW) {
            int r = it;
            if (r < I_IN) { transpose_item<1>(a.in[2], D, 1840, Wt_in, 0, a.in[1], scr, r, lane); continue; } r -= I_IN;
            if (r < I_OUT) { transpose_item<0>(a.in[13], D, D, Wt_out, 0, nullptr, scr, r, lane); continue; } r -= I_OUT;
            if (r < I_C1) { transpose_item<0>(a.in[4], 2048, 256, (bf16_t*)(ws + WS_WC1K), 0, nullptr, scr, r, lane); continue; } r -= I_C1;
            if (r < I_C1) { transpose_item<0>(a.in[9], 2048, 256, (bf16_t*)(ws + WS_WC1V), 0, nullptr, scr, r, lane); continue; } r -= I_C1;
            if (r < I_C2) { transpose_item<3>(a.in[6], 256, 64, (bf16_t*)(ws + WS_WC2K), 0, nullptr, scr, r, lane); continue; } r -= I_C2;
            if (r < I_C2) { transpose_item<3>(a.in[11], 256, 64, (bf16_t*)(ws + WS_WC2V), 0, nullptr, scr, r, lane); continue; } r -= I_C2;
            ffn_weight_item(a, ws, scr, r, lane);
        }
        for (int m = gw; m < M; m += 2 * NGW) {
            const int m2 = m + NGW;
            const f32x4* xr = (const f32x4*)(a.in[0] + (size_t)m * D) + lane; const f32x4* xr2 = (const f32x4*)(a.in[0] + (size_t)m2 * D) + lane;
            f32x4 v[4], w[4];
#pragma unroll
            for (int j = 0; j < 4; ++j) { v[j] = xr[64 * j]; w[j] = (m2 < M) ? xr2[64 * j] : (f32x4){0.f, 0.f, 0.f, 0.f}; }
            unsigned long long* o8 = (unsigned long long*)(XB + (size_t)m * D) + lane; unsigned long long* o82 = (unsigned long long*)(XB + (size_t)m2 * D) + lane; float s1 = 0.f, s2 = 0.f;
#pragma unroll
            for (int j = 0; j < 4; ++j) {
                s1 += (v[j][0] * v[j][0] + v[j][1] * v[j][1]) + (v[j][2] * v[j][2] + v[j][3] * v[j][3]); o8[64 * j] = (unsigned long long)pk2(v[j][0], v[j][1]) | ((unsigned long long)pk2(v[j][2], v[j][3]) << 32);
                s2 += (w[j][0] * w[j][0] + w[j][1] * w[j][1]) + (w[j][2] * w[j][2] + w[j][3] * w[j][3]); if (m2 < M) o82[64 * j] = (unsigned long long)pk2(w[j][0], w[j][1]) | ((unsigned long long)pk2(w[j][2], w[j][3]) << 32);
            }
#pragma unroll
            for (int o = 1; o < 64; o <<= 1) { s1 += __shfl_xor(s1, o); s2 += __shfl_xor(s2, o); }
            if (lane == 0) { rstdv[m] = 1.0f / sqrtf(s1 * (1.0f / D) + EPS); if (m2 < M) rstdv[m2] = 1.0f / sqrtf(s2 * (1.0f / D) + EPS); }
        }
        for (int i = bx * 512 + tid; i < T * 32; i += G * 512) {
            const int t = i >> 5, f = i & 31; const float ang = (float)t * a.inv[f];
            double x = (double)ang * 0.15915494309189535; x -= __builtin_rint(x); const float xf = (float)x;
            cosT[i] = __builtin_amdgcn_cosf(xf); sinT[i] = __builtin_amdgcn_sinf(xf);
        }
        for (int it = NGW - 1 - gw; it < 256; it += NGW) {
            const int kv = it >> 7, chunk = (it >> 2) & 31, nb = it & 3; const float* pos = a.in[kv ? 8 : 3]; const float* w1 = a.in[kv ? 9 : 4];
            float s = 0.f;
#pragma unroll 32
            for (int r = 0; r < 64; ++r) { const int rr = chunk * 64 + r; s += pos[rr] * w1[(size_t)rr * 256 + nb * 64 + lane]; }
            c1p[(kv * 32 + chunk) * 256 + nb * 64 + lane] = s;
        }
        asm volatile("s_waitcnt vmcnt(0) lgkmcnt(0)" ::: "memory"); __syncthreads();
    }
    SEAM(0);
    if (IN(1)) {
        pg8::Gemm g{XB, Wt_in, M, NIN, D, D, 0}; pg8::StaticOrder S; S.init(M, NIN, G, bx);
        EpiIn E{rstdv, cosT, sinT, Qb, KC, VC, KS, VST, KW, VWT, gates};
        pg8::gemm_phase(lds, ldsx, g, S, E);
    }
    SEAM(1);
    if (IN(2)) {
        const int tid = threadIdx.x, lane = tid & 63, w = __builtin_amdgcn_readfirstlane(tid >> 6), fr = lane & 15, fq = lane >> 4;
        LAS float* c1s = (LAS float*)lds;
        LAS unsigned char* hidL = lds + 4096;
        for (int i = tid; i < 512; i += 512) { const int kv = i >> 8, n = i & 255; const float* b1 = a.in[kv ? 10 : 5]; float sv = b1[n]; for (int q = 0; q < 32; ++q) sv += c1p[(kv * 32 + q) * 256 + n]; c1s[i] = sv; }
        __syncthreads();
        for (int u = bx; u < 256; u += G) {
            const int kv = u >> 7, r0 = (u & 127) * 16;
            const bf16_t* Ap = (kv ? VC : KC) + (size_t)(r0 + fr) * 1024 + 8 * fq;
            const bf16_t* Bp = Wt_c1 + (size_t)(32 * w + fr) * 2048 + 8 * fq;
            f32x4 h0 = (f32x4){0.f, 0.f, 0.f, 0.f}, h1 = h0;
#pragma unroll 1
            for (int k0 = 0; k0 < 2048; k0 += 256) {
                bf16x8 af[8], b0[8], b1f[8];
#pragma unroll
                for (int q = 0; q < 8; ++q) { af[q] = *(const bf16x8*)(Ap + k0 + 32 * q); b0[q] = *(const bf16x8*)(Bp + k0 + 32 * q); b1f[q] = *(const bf16x8*)(Bp + 16 * 2048 + k0 + 32 * q); }
#pragma unroll
                for (int q = 0; q < 8; ++q) { h0 = __builtin_amdgcn_mfma_f32_16x16x32_bf16(b0[q], af[q], h0, 0, 0, 0); h1 = __builtin_amdgcn_mfma_f32_16x16x32_bf16(b1f[q], af[q], h1, 0, 0, 0); }
            }
            { const int c0 = 32 * w + 8 * fq; float v[8];
#pragma unroll
              for (int e = 0; e < 8; ++e) { const float x = ((e >> 2) ? h1[e & 3] : h0[e & 3]) + c1s[kv * 256 + c0 + e]; const float y = 0.7978845608028654f * (x + 0.044715f * x * x * x); v[e] = x * sigmoidf_(2.0f * y); }
              u32x4 wv; wv.x = cvt_pk_bf16(v[0], v[1]); wv.y = cvt_pk_bf16(v[2], v[3]); wv.z = cvt_pk_bf16(v[4], v[5]); wv.w = cvt_pk_bf16(v[6], v[7]);
              *(LAS u32x4*)(hidL + fr * 528 + c0 * 2) = wv; }
            __syncthreads();
            if (w < 2) {
                const bf16_t* W2 = Wt_c2 + (size_t)(32 * w + fr) * 256 + 8 * fq;
                f32x4 oA = (f32x4){0.f, 0.f, 0.f, 0.f}, oB = oA;
#pragma unroll
                for (int q = 0; q < 8; ++q) {
                    const bf16x8 hf = *(const LAS bf16x8*)(hidL + fr * 528 + (32 * q + 8 * fq) * 2);
                    const bf16x8 wa = *(const bf16x8*)(W2 + 32 * q), wb = *(const bf16x8*)(W2 + 16 * 256 + 32 * q);
                    oA = __builtin_amdgcn_mfma_f32_16x16x32_bf16(wa, hf, oA, 0, 0, 0); oB = __builtin_amdgcn_mfma_f32_16x16x32_bf16(wb, hf, oB, 0, 0, 0);
                }
                const float* b2 = a.in[kv ? 12 : 7]; const int d0 = 16 * w + 4 * fq; const int row = r0 + fr, j = row & 511;
                f32x4 a1 = oA + *(const f32x4*)(b2 + d0), a2 = oB + *(const f32x4*)(b2 + d0 + 32);
                if (j == 511) { a1 = (f32x4){0.f, 0.f, 0.f, 0.f}; a2 = a1; }
                if (!kv) {
                    const int pos = (j == 511) ? 0 : 16 * j + 31;
                    const f32x4 cs = *(const f32x4*)(cosT + pos * 32 + d0), sn = *(const f32x4*)(sinT + pos * 32 + d0);
                    const f32x4 o1 = a1 * cs - a2 * sn, o2 = a1 * sn + a2 * cs;
                    bf16_t* p = KCC + (size_t)row * 64 + d0;
                    u32x2 w1; w1.x = cvt_pk_bf16(o1[0], o1[1]); w1.y = cvt_pk_bf16(o1[2], o1[3]); *(u32x2*)p = w1;
                    u32x2 w2; w2.x = cvt_pk_bf16(o2[0], o2[1]); w2.y = cvt_pk_bf16(o2[2], o2[3]); *(u32x2*)(p + 32) = w2;
                } else {
                    bf16_t* p = VCT + (size_t)(row >> 6) * 4096 + vperm(row & 63);
#pragma unroll
                    for (int e = 0; e < 4; ++e) { p[(d0 + e) * 64] = (bf16_t)(cvt_pk_bf16(a1[e], 0.f) & 0xffff); p[(d0 + 32 + e) * 64] = (bf16_t)(cvt_pk_bf16(a2[e], 0.f) & 0xffff); }
                }
            }
            __syncthreads();
        }
    }
    if (IN(2) && IN(4)) xcd_barrier(xbar);
    if (IN(4)) {
        att::Ctx X{Qb, KCC, VCT, KS, VST, KW, VWT, gates, Ob};
        for (int k = bx; k < 256; k += G) {
            for (int rep = 0; rep < 2; ++rep) { const int uu = rep ? 511 - k : k; const int c = 127 - (uu >> 2), bgi = uu & 3; att::unit(lds, X, bgi >> 1, bgi & 1, c, tid); }
        }
        if (defer && bx < 128) {
            int td = threadIdx.x; asm volatile("" : "+v"(td)); const int dl = td & 63, dw = __builtin_amdgcn_readfirstlane(td >> 6);
            LAS float* scr = (LAS float*)(lds + dw * 16384);
            for (int it = bx * 8 + dw; it < N_DEFER; it += 1024) ffn_weight_item(a, ws, scr, it, dl);
        }
    }
    SEAM(4);
    if (IN(5)) {
        pg8::Gemm g{Ob, Wt_out, M, D, D, D, 0}; pg8::StaticOrder S; S.init(M, D, G, bx);
        EpiRes E{a.in[0], out, XB, ssp, nullptr, nullptr};
        pg8::gemm_phase(lds, ldsx, g, S, E);
    }
    SEAM(5);
#pragma unroll
    for (int L = 0; L < 2; ++L) {
        const int pb = 6 + 5 * L;
        const float* cw = a.in[L ? 25 : 16]; const float* cb = a.in[L ? 26 : 17];
        if (IN(pb)) {
            pg8::Gemm g{XB, (const bf16_t*)(ws + (L ? WS_WUP1 : WS_WUP0)), M, UP, D, D, 0}; pg8::StaticOrder S; S.init(M, UP, G, bx);
            EpiUp E{ssp, cw, cb, ACT, HB, FB};
            pg8::gemm_phase(lds, ldsx, g, S, E);
        }
        SEAM(pb);
        if (IN(pb + 1)) {
            for (int i = bx * 512 + tid; i < 64 * FF; i += G * 512) {
                const int pm = i / FF, cidx = i % FF;
                float hg0 = 0.f, hg1 = 0.f, hv0 = 0.f, hv1 = 0.f;
                if (pm & 31) { const float* h = HB + (size_t)(pm - 1) * 2 * UP; hg0 = h[cidx]; hg1 = h[UP + cidx]; hv0 = h[FF + cidx]; hv1 = h[UP + FF + cidx]; }
                const float* f = FB + (size_t)pm * 2 * UP; const float fg0 = f[cidx], fg1 = f[UP + cidx], fv0 = f[FF + cidx], fv1 = f[UP + FF + cidx];
                const float g0 = cb[cidx] + cw[cidx] * hg0 + cw[UP + cidx] * hg1 + cw[2 * UP + cidx] * fg0;
                const float g1 = cb[cidx] + cw[cidx] * hg1 + cw[UP + cidx] * fg0 + cw[2 * UP + cidx] * fg1;
                const float v0 = cb[FF + cidx] + cw[FF + cidx] * hv0 + cw[UP + FF + cidx] * hv1 + cw[2 * UP + FF + cidx] * fv0;
                const float v1 = cb[FF + cidx] + cw[FF + cidx] * hv1 + cw[UP + FF + cidx] * fv0 + cw[2 * UP + FF + cidx] * fv1;
                ACT[(size_t)(pm * 256) * FF + cidx] = (bf16_t)f2bf(g0 * sigmoidf_(g0) * v0);
                ACT[(size_t)(pm * 256 + 1) * FF + cidx] = (bf16_t)f2bf(g1 * sigmoidf_(g1) * v1);
            }
        }
        SEAM(pb + 1);
        if (IN(pb + 2)) {
            pg8::Gemm g{ACT, (const bf16_t*)(ws + (L ? WS_WDN1 : WS_WDN0)), M, D, FF, FF, 0}; pg8::StaticOrder S; S.init(M, D, G, bx);
            if (L == 1 && G == 256) { EpiFinal E{out, a.in[28], (float*)(ws + WS_SSP + 512 * 1024), (unsigned*)(ws + 16384)}; pg8::gemm_phase(lds, ldsx, g, S, E); }
            else { EpiRes E{out, out, XB, ssp, nullptr, nullptr}; pg8::gemm_phase(lds, ldsx, g, S, E); }
        }
        if (!(L == 1 && G == 256)) SEAM(pb + 2);
        if (L == 0) {
            if (IN(9)) {
                LAS float* rsd = (LAS float*)lds;
                const float* gn = a.in[19];
                int tid = threadIdx.x; asm volatile("" : "+v"(tid));
                const int q = tid & 255, strip = tid >> 8, c4 = q * 4, wsz = 2 << (c4 >> 8), t0 = strip * 32;
                const f32x4 gv = *(const f32x4*)(gn + c4);
                for (int tile = bx; tile < 256; tile += G) {
                    const int r0 = tile * 64; const int tb = r0 & (T - 1);
                    __syncthreads();
                    if (tid < 80) { const int rr = r0 - 16 + tid; rsd[tid] = (tb - 16 + tid >= 0) ? row_rstd(ssp, 4, rr) : 0.f; }
                    __syncthreads();
                    const float* xb0 = out + (size_t)r0 * D + c4;
#define POOL_H(tl) (*(const f32x4*)(xb0 + (ptrdiff_t)(tl) * D) * rsd[16 + (tl)])
                    f32x4 sw = (f32x4){0.f, 0.f, 0.f, 0.f};
                    for (int i = 1; i <= wsz; ++i) { const int tl = t0 - i; if (tb + tl >= 0) sw += POOL_H(tl); }
#pragma unroll 4
                    for (int tl = t0; tl < t0 + 32; ++tl) {
                        const f32x4 hv = POOL_H(tl); sw += hv;
                        const int td = tl - wsz; if (tb + td >= 0) sw -= POOL_H(td);
                        const int t = tb + tl; const int cnt = (t + 1 < wsz) ? t + 1 : wsz;
                        const f32x4 pvv = (sw * (1.0f / (float)cnt) - hv) * gv;
                        u32x2 wv; wv.x = cvt_pk_bf16(pvv[0], pvv[1]); wv.y = cvt_pk_bf16(pvv[2], pvv[3]);
                        *(u32x2*)(POOLED + (size_t)(r0 + tl) * D + c4) = wv;
                    }
#undef POOL_H
                }
                __syncthreads();
            }
            SEAM(9);
            if (IN(10)) {
                pg8::Gemm g{POOLED, Wt_pool, M, D, 256, D, 512}; pg8::StaticOrder S; S.init(M, D, G, bx);
                EpiRes E{out, out, XB, ssp, a.in[21], a.in[22]};
                pg8::gemm_phase(lds, ldsx, g, S, E);
            }
            SEAM(10);
        }
    }
    if (IN(14) && G != 256) {
        int t14 = threadIdx.x; asm volatile("" : "+v"(t14)); const int lane = t14 & 63, wave = __builtin_amdgcn_readfirstlane(t14 >> 6);
        const int gw = bx * 8 + wave, NGW = G * 8; const float* gn = a.in[28];
        for (int m = gw; m < M; m += NGW) {
            const float rs = row_rstd(ssp, 4, m); f32x4* xr = (f32x4*)(out + (size_t)m * D) + lane; const f32x4* gr = (const f32x4*)gn + lane;
#pragma unroll
            for (int j = 0; j < 4; ++j) xr[64 * j] = xr[64 * j] * rs * gr[64 * j];
        }
    }
#undef IN
#undef SEAM
#undef cosT
#undef sinT
#undef ssp
#undef c1p
#undef rstdv
#undef HB
#undef FB
#undef gates
#undef Wt_in
#undef Wt_out
#undef Wt_pool
#undef Wt_c1
#undef Wt_c2
#undef XB
#undef Qb
#undef KC
#undef VC
#undef KS
#undef VST
#undef KW
#undef VWT
#undef KCC
#undef VCT
#undef Ob
#undef ACT
#undef POOLED
}

extern "C" void kernel_launch(void* const* d_in, const int* in_sizes, int n_in, void* d_out, int out_size, void* d_ws, size_t ws_size, hipStream_t stream) {
    static int grid = 0;
    if (grid == 0) {
        int dev = 0, cus = 0, per_cu = 0;
        hipGetDevice(&dev); hipDeviceGetAttribute(&cus, hipDeviceAttributeMultiprocessorCount, dev);
        hipFuncSetAttribute((const void*)mk_fwd, hipFuncAttributeMaxDynamicSharedMemorySize, LDS_BYTES);
        hipOccupancyMaxActiveBlocksPerMultiprocessor(&per_cu, (const void*)mk_fwd, 512, LDS_BYTES);
        if (per_cu < 1) per_cu = 1;
        grid = cus * per_cu; if (grid > 256) grid = 256;
        (void)hipGetLastError();
    }
    Args a{};
    for (int i = 0; i < 29; ++i) a.in[i] = (const float*)d_in[i];
    a.out = (float*)d_out; a.ws = (unsigned char*)d_ws;
    for (int i = 0; i < 32; ++i) a.inv[i] = 1.0f / powf(10000.0f, (float)(2 * i) / 64.0f);
    a.ph_lo = 0; a.ph_hi = 15;
    hipMemsetAsync(d_ws, 0, 65536, stream);
    void* args[] = {&a};
    hipError_t e = hipLaunchCooperativeKernel((const void*)mk_fwd, dim3(grid), dim3(512), args, LDS_BYTES, stream);
    if (e != hipSuccess) fprintf(stderr, "cooperative launch failed: %s (grid %d)\n", hipGetErrorString(e), grid);
}
```

```cpp
#include <hip/hip_runtime.h>
#include <hip/hip_cooperative_groups.h>
#include <cstdio>
#include <cstdint>
namespace cg = cooperative_groups;

#define LAS __attribute__((address_space(3)))
typedef unsigned short bf16_t;
typedef short bf16x8 __attribute__((ext_vector_type(8)));
typedef short s16x4 __attribute__((ext_vector_type(4)));
typedef float f32x4 __attribute__((ext_vector_type(4)));
typedef unsigned u32x4 __attribute__((ext_vector_type(4)));
typedef unsigned u32x2 __attribute__((ext_vector_type(2)));

constexpr int T = 8192, D = 1024, M = 16384, FF = 2816, UP = 5632, NIN = 2048;
constexpr float EPS = 1e-6f;
constexpr float QSCALE = 0.125f * 1.4426950408889634f;
constexpr size_t MiB = 1u << 20;
constexpr size_t WS_ROPE = 1 * MiB;
constexpr size_t WS_SSP = 3 * MiB;
constexpr size_t WS_C1P = 4 * MiB;
constexpr size_t WS_RSTD = 4 * MiB + 256 * 1024;
constexpr size_t WS_HB = 5 * MiB;
constexpr size_t WS_FB = 8 * MiB;
constexpr size_t WS_GATE = 11 * MiB;
constexpr size_t WS_WIN = 16 * MiB, WS_WOUT = 20 * MiB, WS_WUP0 = 22 * MiB, WS_WUP1 = 33 * MiB, WS_WDN0 = 44 * MiB, WS_WDN1 = 50 * MiB;
constexpr size_t WS_WPOOL = 56 * MiB, WS_WC1K = 57 * MiB, WS_WC1V = 58 * MiB, WS_WC2K = 59 * MiB, WS_WC2V = 59 * MiB + 512 * 1024;
constexpr size_t WS_XB = 64 * MiB;
constexpr size_t WS_Q = 96 * MiB;
constexpr size_t WS_KC = 128 * MiB, WS_VC = 132 * MiB, WS_KS = 136 * MiB, WS_VST = 140 * MiB, WS_KW = 144 * MiB, WS_VWT = 148 * MiB;
constexpr size_t WS_KCC = 152 * MiB, WS_VCT = 153 * MiB, WS_HIDK = 154 * MiB, WS_HIDV = 155 * MiB;
constexpr size_t WS_O = 160 * MiB;
constexpr size_t WS_ACT = 96 * MiB;
constexpr size_t WS_POOLED = 192 * MiB;
constexpr int LDS_RING = 131072, LDS_BYTES = 155648;

__device__ __forceinline__ unsigned cvt_pk_bf16(float lo, float hi) { unsigned r; asm volatile("v_cvt_pk_bf16_f32 %0, %1, %2" : "=v"(r) : "v"(lo), "v"(hi)); return r; }
__device__ __forceinline__ float bf2f(unsigned short b) { return __uint_as_float((unsigned)b << 16); }
__device__ __forceinline__ float ex2(float x) { return __builtin_amdgcn_exp2f(x); }
__device__ __forceinline__ float rcp(float x) { return __builtin_amdgcn_rcpf(x); }
__device__ __forceinline__ float sigmoidf_(float x) { return rcp(1.0f + ex2(-1.4426950408889634f * x)); }
__device__ __forceinline__ int perm8(int a) { return (a & ~31) | (16 * ((a >> 2) & 1) + 4 * ((a >> 3) & 3) + (a & 3)); }
__device__ __forceinline__ int vperm(int kk) { return (kk & 32) | (((kk >> 2) & 3) << 3) | (((kk >> 4) & 1) << 2) | (kk & 3); }
__device__ __forceinline__ int swap45(int a) { return (a & ~48) | (((a >> 4) & 1) << 5) | (((a >> 5) & 1) << 4); }
template <int CTRL> __device__ __forceinline__ float dppf(float x) { return __builtin_bit_cast(float, __builtin_amdgcn_mov_dpp(__builtin_bit_cast(int, x), CTRL, 0xf, 0xf, true)); }
__device__ __forceinline__ float xrow16_max(float x) {
    auto s = __builtin_amdgcn_permlane16_swap(__float_as_uint(x), __float_as_uint(x), false, false); x = fmaxf(__uint_as_float(s[0]), __uint_as_float(s[1]));
    auto t = __builtin_amdgcn_permlane32_swap(__float_as_uint(x), __float_as_uint(x), false, false); return fmaxf(__uint_as_float(t[0]), __uint_as_float(t[1])); }
__device__ __forceinline__ float xrow16_sum(float x) {
    auto s = __builtin_amdgcn_permlane16_swap(__float_as_uint(x), __float_as_uint(x), false, false); x = __uint_as_float(s[0]) + __uint_as_float(s[1]);
    auto t = __builtin_amdgcn_permlane32_swap(__float_as_uint(x), __float_as_uint(x), false, false); return __uint_as_float(t[0]) + __uint_as_float(t[1]); }
__device__ __forceinline__ float sum8(float x) { x += dppf<0xB1>(x); x += dppf<0x4E>(x); x += dppf<0x141>(x); return x; }
#define LDS_WAIT() asm volatile("s_waitcnt lgkmcnt(0)" ::: "memory")
#define WG_BAR() do { asm volatile("s_waitcnt lgkmcnt(0)" ::: "memory"); __builtin_amdgcn_s_barrier(); asm volatile("" ::: "memory"); } while (0)

namespace pg8 {
constexpr int BM = 256, BK = 64, HALF = 128, HTB = HALF * BK * 2, NXCD = 8, WGM = 8;
__host__ __device__ __forceinline__ int lds_byte(int r, int c) { const int st = (r >> 4) * 2 + (c >> 5), rr = r & 15, cc = c & 31, ob = rr * 64 + cc * 2; return st * 1024 + (ob ^ (((ob >> 9) & 1) << 5)); }
__host__ __device__ __forceinline__ void stage_rc(int b, int& R, int& C) { const int st = b / 1024, sb = b % 1024, swz = sb ^ (((sb >> 9) & 1) << 5); R = (st >> 1) * 16 + swz / 64; C = (st & 1) * 32 + (swz % 64) / 2; }
struct Unit { int pm, pn; };
struct Gemm { const bf16_t* A; const bf16_t* Bt; int M, N, K, lda, apn; };
struct StaticOrder {
    int nM, nN, nwg, G, c;
    __device__ void init(int M_, int N_, int G_, int c_) { nM = M_ / BM; nN = N_ / BM; nwg = nM * nN; G = G_; c = c_; }
    __device__ bool next(int i, Unit& u) const {
        const long L = (long)i * G + c; if (L >= nwg) return false;
        int wgid = (int)L; { const int q = nwg / NXCD, r = nwg % NXCD, xcd = wgid % NXCD, off = wgid / NXCD; wgid = (xcd < r ? xcd * (q + 1) : r * (q + 1) + (xcd - r) * q) + off; }
        const int nig = WGM * nN, gid = wgid / nig, fm = gid * WGM, gsz = (nM - fm) < WGM ? (nM - fm) : WGM;
        u.pm = fm + ((wgid % nig) % gsz); u.pn = (wgid % nig) / gsz; return true;
    }
};
template <class Epi>
__device__ __forceinline__ void gemm_phase(LAS unsigned char* lds, LAS unsigned char* ldsx, const Gemm g, const StaticOrder& S, const Epi& E) {
    int tid = threadIdx.x; asm volatile("" : "+v"(tid));
    const int wid = __builtin_amdgcn_readfirstlane(tid >> 6), lane = tid & 63, wr = wid >> 2, wc = wid & 3, fr = lane & 15, fq = lane >> 4;
    const int K = g.K, nt = K / BK;
    unsigned voffA[2], voffB[2];
#pragma unroll
    for (int i = 0; i < 2; ++i) { int R, C; stage_rc(tid * 16 + i * 8192, R, C); voffA[i] = (unsigned)(R * g.lda + C) * 2u; voffB[i] = (unsigned)(R * K + C) * 2u; }
    const size_t kstep = (size_t)(BK * 2);
    const size_t hstepA = (size_t)HALF * g.lda * 2, tstepA = 2 * hstepA, hstepB = (size_t)HALF * K * 2, tstepB = 2 * hstepB;
    const unsigned ldsw = (unsigned)wid * 1024u;
    const int aoff = lds_byte(wr * 64 + fr, fq * 8), boff = lds_byte(wc * 32 + fr, fq * 8);
#define PG8_SA(b, h) (((b) * 2 + (h)) * HTB)
#define PG8_SB(b, h) ((4 + (b) * 2 + (h)) * HTB)
#define PG8_STAGE(bufoff, gbase, voff) do { _Pragma("unroll") for (int _i = 0; _i < 2; ++_i) \
        __builtin_amdgcn_global_load_lds((const unsigned*)((const char*)(gbase) + (voff)[_i]), (LAS unsigned*)(lds + (bufoff) + ldsw + _i * 8192), 16, 0, 0); } while (0)
#define PG8_LDA(dst, b, h) do { _Pragma("unroll") for (int m = 0; m < 4; ++m) _Pragma("unroll") for (int k = 0; k < 2; ++k) dst[m][k] = *(const LAS bf16x8*)(lds + PG8_SA(b, h) + aoff + m * 2048 + k * 1024); } while (0)
#define PG8_LDB(dst, b, h) do { _Pragma("unroll") for (int n = 0; n < 2; ++n) _Pragma("unroll") for (int k = 0; k < 2; ++k) dst[n][k] = *(const LAS bf16x8*)(lds + PG8_SB(b, h) + boff + n * 2048 + k * 1024); } while (0)
#define PG8_MMA(ai, bj, At, Bt) do { __builtin_amdgcn_s_setprio(1); _Pragma("unroll") for (int m = 0; m < 4; ++m) _Pragma("unroll") for (int n = 0; n < 2; ++n) _Pragma("unroll") for (int k = 0; k < 2; ++k) \
        acc[ai][bj][m][n] = __builtin_amdgcn_mfma_f32_16x16x32_bf16(Bt[n][k], At[m][k], acc[ai][bj][m][n], 0, 0, 0); __builtin_amdgcn_s_setprio(0); } while (0)
#define PG8_WAIT_V(n) asm volatile("s_waitcnt vmcnt(" #n ")" ::: "memory")
#define PG8_WAIT_L(n) asm volatile("s_waitcnt lgkmcnt(" #n ")" ::: "memory")
#define PG8_BAR __builtin_amdgcn_s_barrier()
#define PG8_SCHED __builtin_amdgcn_sched_barrier(0)
    Unit cur, nxt; int ui = 0;
    if (!S.next(0, cur)) return;
    f32x4 acc[2][2][4][2];
#pragma unroll
    for (int a = 0; a < 2; ++a)
#pragma unroll
        for (int b = 0; b < 2; ++b)
#pragma unroll
            for (int m = 0; m < 4; ++m)
#pragma unroll
                for (int n = 0; n < 2; ++n) acc[a][b][m][n] = (f32x4){0.f, 0.f, 0.f, 0.f};
    bf16x8 At[4][2], B0[2][2], B1[2][2];
    const char* cA = (const char*)g.A + (size_t)cur.pm * tstepA + (size_t)cur.pn * g.apn; const char* cB = (const char*)g.Bt + (size_t)cur.pn * tstepB;
    PG8_STAGE(PG8_SB(0, 0), cB, voffB); PG8_STAGE(PG8_SB(0, 1), cB + hstepB, voffB); PG8_STAGE(PG8_SA(0, 0), cA, voffA); PG8_STAGE(PG8_SA(0, 1), cA + hstepA, voffA);
    if (wr == 1) PG8_BAR;
    PG8_WAIT_V(2); PG8_BAR;
    PG8_STAGE(PG8_SB(1, 0), cB + kstep, voffB); PG8_STAGE(PG8_SA(1, 0), cA + kstep, voffA); PG8_STAGE(PG8_SB(1, 1), cB + hstepB + kstep, voffB);
    PG8_WAIT_V(6); PG8_BAR;
    for (;;) {
        const bool has_next = S.next(ui + 1, nxt);
        const char* nA = has_next ? (const char*)g.A + (size_t)nxt.pm * tstepA + (size_t)nxt.pn * g.apn : cA; const char* nB = has_next ? (const char*)g.Bt + (size_t)nxt.pn * tstepB : cB;
        for (int t = 0; t < nt; t += 2) {
            const bool last = (t == nt - 2);
            const char* a1 = cA + (size_t)(t + 1) * kstep;
            const char* a2 = last ? nA : cA + (size_t)(t + 2) * kstep; const char* b2 = last ? nB : cB + (size_t)(t + 2) * kstep;
            const char* a3 = a2 + kstep; const char* b3 = b2 + kstep;
            PG8_LDB(B0, 0, 0); PG8_LDB(B1, 0, 1); PG8_SCHED; PG8_LDA(At, 0, 0); PG8_STAGE(PG8_SA(1, 1), a1 + hstepA, voffA);
            PG8_WAIT_V(8); PG8_WAIT_L(0); PG8_BAR; PG8_MMA(0, 0, At, B0); PG8_MMA(0, 1, At, B1); PG8_BAR; PG8_SCHED;
            PG8_LDA(At, 0, 1); PG8_STAGE(PG8_SB(0, 0), b2, voffB); PG8_STAGE(PG8_SB(0, 1), b2 + hstepB, voffB); PG8_STAGE(PG8_SA(0, 0), a2, voffA);
            PG8_WAIT_V(8); PG8_WAIT_L(0); PG8_BAR; PG8_MMA(1, 0, At, B0); PG8_MMA(1, 1, At, B1); PG8_BAR; PG8_SCHED;
            PG8_LDB(B0, 1, 0); PG8_LDB(B1, 1, 1); PG8_SCHED; PG8_LDA(At, 1, 0); PG8_STAGE(PG8_SA(0, 1), a2 + hstepA, voffA);
            PG8_WAIT_V(8); PG8_WAIT_L(0); PG8_BAR; PG8_MMA(0, 0, At, B0); PG8_MMA(0, 1, At, B1); PG8_BAR; PG8_SCHED;
            PG8_LDA(At, 1, 1); PG8_STAGE(PG8_SB(1, 0), b3, voffB); PG8_STAGE(PG8_SB(1, 1), b3 + hstepB, voffB); PG8_STAGE(PG8_SA(1, 0), a3, voffA);
            PG8_WAIT_V(8); PG8_WAIT_L(0); PG8_BAR; PG8_MMA(1, 0, At, B0); PG8_MMA(1, 1, At, B1); PG8_BAR; PG8_SCHED;
        }
        if (wr == 0) PG8_BAR;
        { int t2 = threadIdx.x; asm volatile("" : "+v"(t2));
          E(acc, cur, wr, wc, t2 & 15, (t2 & 63) >> 4, ldsx, t2); }
        if (!has_next) break;
#pragma unroll
        for (int a = 0; a < 2; ++a)
#pragma unroll
            for (int b = 0; b < 2; ++b)
#pragma unroll
                for (int m = 0; m < 4; ++m)
#pragma unroll
                    for (int n = 0; n < 2; ++n) acc[a][b][m][n] = (f32x4){0.f, 0.f, 0.f, 0.f};
        cur = nxt; cA = nA; cB = nB; ++ui;
        if (wr == 1) PG8_BAR;
    }
    PG8_WAIT_V(0);
    PG8_BAR;
#undef PG8_SA
#undef PG8_SB
#undef PG8_STAGE
#undef PG8_LDA
#undef PG8_LDB
#undef PG8_MMA
#undef PG8_WAIT_V
#undef PG8_WAIT_L
#undef PG8_BAR
#undef PG8_SCHED
}
}
using pg8::Unit;
typedef f32x4 Acc[2][2][4][2];

__device__ __forceinline__ float row_rstd(const float* ssp, int np, int row) {
    float s = 0.f; for (int i = 0; i < np; ++i) s += ssp[(size_t)i * M + row];
    return 1.0f / sqrtf(s * (1.0f / D) + EPS);
}

struct EpiIn {
    const float* rstdv; const float* cosT; const float* sinT;
    bf16_t *Q, *KC, *VC, *KS, *VST, *KW, *VWT; float* gates;
    __device__ __forceinline__ void operator()(Acc& acc, const Unit& u, int wr, int wc, int fr, int fq, LAS unsigned char*, int) const {
#pragma unroll
        for (int ai = 0; ai < 2; ++ai)
#pragma unroll
            for (int m = 0; m < 4; ++m) {
                const int row = u.pm * 256 + ai * 128 + wr * 64 + m * 16 + fr; const float rs = rstdv[row];
                const int t = row & (T - 1), b = row >> 13;
                const int d0 = 16 * (wc & 1) + 4 * fq;
                const f32x4 cs = *(const f32x4*)(cosT + t * 32 + d0), sn = *(const f32x4*)(sinT + t * 32 + d0);
#pragma unroll
                for (int bj = 0; bj < 2; ++bj) {
                    f32x4 a1 = acc[ai][bj][m][0] * rs, a2 = acc[ai][bj][m][1] * rs;
                    if (u.pn == 7) {
                        if (bj == 0) {
#pragma unroll
                            for (int n = 0; n < 2; ++n) { const int c0 = 32 * wc + 16 * n + 4 * fq; if (c0 < 48) { const f32x4 v = n ? a2 : a1; f32x4 o; o[0] = sigmoidf_(v[0]); o[1] = sigmoidf_(v[1]); o[2] = sigmoidf_(v[2]); o[3] = sigmoidf_(v[3]); *(f32x4*)(gates + (size_t)row * 48 + c0) = o; } }
                        }
                        continue;
                    }
                    const int hh = 2 * bj + (wc >> 1);
                    bool rope; if (u.pn < 4) rope = true; else rope = (u.pn >= 5) && (hh < 2);
                    f32x4 o1 = a1, o2 = a2;
                    if (rope) { o1 = a1 * cs - a2 * sn; o2 = a1 * sn + a2 * cs; }
                    if (u.pn < 4) {
                        o1 = o1 * QSCALE; o2 = o2 * QSCALE;
                        bf16_t* p = Q + (size_t)row * 1024 + (u.pn * 4 + hh) * 64 + d0;
                        u32x2 w1; w1.x = cvt_pk_bf16(o1[0], o1[1]); w1.y = cvt_pk_bf16(o1[2], o1[3]); *(u32x2*)p = w1;
                        u32x2 w2; w2.x = cvt_pk_bf16(o2[0], o2[1]); w2.y = cvt_pk_bf16(o2[2], o2[3]); *(u32x2*)(p + 32) = w2;
                    } else {
                        const int gg = hh & 1; const bool isv = hh >= 2;
                        if (!isv) {
                            bf16_t* base = (u.pn == 4) ? KC : (u.pn == 5) ? KS : KW;
                            bf16_t* p = base + ((size_t)(b * 2 + gg) * T + t) * 64 + d0;
                            u32x2 w1; w1.x = cvt_pk_bf16(o1[0], o1[1]); w1.y = cvt_pk_bf16(o1[2], o1[3]); *(u32x2*)p = w1;
                            u32x2 w2; w2.x = cvt_pk_bf16(o2[0], o2[1]); w2.y = cvt_pk_bf16(o2[2], o2[3]); *(u32x2*)(p + 32) = w2;
                        } else if (u.pn == 4) {
                            bf16_t* p = VC + ((size_t)(b * 2 + gg) * T + t) * 64 + d0;
                            u32x2 w1; w1.x = cvt_pk_bf16(o1[0], o1[1]); w1.y = cvt_pk_bf16(o1[2], o1[3]); *(u32x2*)p = w1;
                            u32x2 w2; w2.x = cvt_pk_bf16(o2[0], o2[1]); w2.y = cvt_pk_bf16(o2[2], o2[3]); *(u32x2*)(p + 32) = w2;
                        } else {
                            bf16_t* base = (u.pn == 5) ? VST : VWT;
                            bf16_t* p = base + ((size_t)(b * 2 + gg) * 128 + (t >> 6)) * 4096 + vperm(t & 63);
#pragma unroll
                            for (int j = 0; j < 4; ++j) { p[(d0 + j) * 64] = (bf16_t)(cvt_pk_bf16(o1[j], 0.f) & 0xffff); p[(d0 + 32 + j) * 64] = (bf16_t)(cvt_pk_bf16(o2[j], 0.f) & 0xffff); }
                        }
                    }
                }
                asm volatile("" ::: "memory"); __builtin_amdgcn_sched_barrier(0);
            }
    }
};

struct EpiC1 {
    bf16_t* hid;
    __device__ __forceinline__ void operator()(Acc& acc, const Unit& u, int wr, int wc, int fr, int fq, LAS unsigned char* ldsx, int) const {
        const LAS float* c1 = (const LAS float*)ldsx;
#pragma unroll
        for (int bj = 0; bj < 2; ++bj) {
            const int c0 = 128 * bj + 32 * wc + 8 * fq;
            const f32x4 bA = *(const LAS f32x4*)(c1 + c0), bB = *(const LAS f32x4*)(c1 + c0 + 4);
#pragma unroll
            for (int ai = 0; ai < 2; ++ai)
#pragma unroll
                for (int m = 0; m < 4; ++m) {
                    const int row = u.pm * 256 + ai * 128 + wr * 64 + m * 16 + fr;
                    float v[8];
#pragma unroll
                    for (int e = 0; e < 8; ++e) { const float x = acc[ai][bj][m][e >> 2][e & 3] + ((e >> 2) ? bB[e & 3] : bA[e & 3]); const float y = 0.7978845608028654f * (x + 0.044715f * x * x * x); v[e] = x * sigmoidf_(2.0f * y); }
                    u32x4 w; w.x = cvt_pk_bf16(v[0], v[1]); w.y = cvt_pk_bf16(v[2], v[3]); w.z = cvt_pk_bf16(v[4], v[5]); w.w = cvt_pk_bf16(v[6], v[7]);
                    *(u32x4*)(hid + (size_t)row * 256 + c0) = w;
                    asm volatile("" ::: "memory"); __builtin_amdgcn_sched_barrier(0);
                }
        }
    }
};
struct EpiC2 {
    const float* b2; const float* cosT; const float* sinT; bf16_t* out; int isv;
    __device__ __forceinline__ void operator()(Acc& acc, const Unit& u, int wr, int wc, int fr, int fq, LAS unsigned char*, int) const {
        if (wc >= 2) return;
        const int d0 = 16 * (wc & 1) + 4 * fq;
        const f32x4 bA = *(const f32x4*)(b2 + d0), bB = *(const f32x4*)(b2 + d0 + 32);
#pragma unroll
        for (int ai = 0; ai < 2; ++ai)
#pragma unroll
            for (int m = 0; m < 4; ++m) {
                const int row = u.pm * 256 + ai * 128 + wr * 64 + m * 16 + fr; const int j = row & 511;
                f32x4 a1 = acc[ai][0][m][0] + bA, a2 = acc[ai][0][m][1] + bB;
                if (j == 511) { a1 = (f32x4){0.f, 0.f, 0.f, 0.f}; a2 = a1; }
                if (!isv) {
                    const int pos = (j == 511) ? 0 : 16 * j + 31;
                    const f32x4 cs = *(const f32x4*)(cosT + pos * 32 + d0), sn = *(const f32x4*)(sinT + pos * 32 + d0);
                    const f32x4 o1 = a1 * cs - a2 * sn, o2 = a1 * sn + a2 * cs;
                    bf16_t* p = out + (size_t)row * 64 + d0;
                    u32x2 w1; w1.x = cvt_pk_bf16(o1[0], o1[1]); w1.y = cvt_pk_bf16(o1[2], o1[3]); *(u32x2*)p = w1;
                    u32x2 w2; w2.x = cvt_pk_bf16(o2[0], o2[1]); w2.y = cvt_pk_bf16(o2[2], o2[3]); *(u32x2*)(p + 32) = w2;
                } else {
                    bf16_t* p = out + (size_t)(row >> 6) * 4096 + vperm(row & 63);
#pragma unroll
                    for (int e = 0; e < 4; ++e) { p[(d0 + e) * 64] = (bf16_t)(cvt_pk_bf16(a1[e], 0.f) & 0xffff); p[(d0 + 32 + e) * 64] = (bf16_t)(cvt_pk_bf16(a2[e], 0.f) & 0xffff); }
                }
                asm volatile("" ::: "memory"); __builtin_amdgcn_sched_barrier(0);
            }
    }
};

struct EpiRes {
    const float* xold; float* xnew; bf16_t* xb; float* ssp; const float* pb; const float* ps;
    __device__ __forceinline__ void operator()(Acc& acc, const Unit& u, int wr, int wc, int fr, int fq, LAS unsigned char* ldsx, int tid) const {
#pragma unroll
        for (int ai = 0; ai < 2; ++ai)
#pragma unroll
            for (int m = 0; m < 4; ++m) {
                const int row = u.pm * 256 + ai * 128 + wr * 64 + m * 16 + fr; float ss = 0.f;
#pragma unroll
                for (int bj = 0; bj < 2; ++bj) {
                    const int col = u.pn * 256 + 128 * bj + 32 * wc + 8 * fq; const size_t off = (size_t)row * D + col;
                    f32x4 a0 = acc[ai][bj][m][0], a1 = acc[ai][bj][m][1];
                    if (pb) { a0 = (a0 + *(const f32x4*)(pb + col)) * *(const f32x4*)(ps + col); a1 = (a1 + *(const f32x4*)(pb + col + 4)) * *(const f32x4*)(ps + col + 4); }
                    const f32x4 x0 = *(const f32x4*)(xold + off) + a0, x1 = *(const f32x4*)(xold + off + 4) + a1;
                    *(f32x4*)(xnew + off) = x0; *(f32x4*)(xnew + off + 4) = x1;
                    u32x4 w; w.x = cvt_pk_bf16(x0[0], x0[1]); w.y = cvt_pk_bf16(x0[2], x0[3]); w.z = cvt_pk_bf16(x1[0], x1[1]); w.w = cvt_pk_bf16(x1[2], x1[3]);
                    *(u32x4*)(xb + off) = w;
                    ss += (x0[0] * x0[0] + x0[1] * x0[1]) + (x0[2] * x0[2] + x0[3] * x0[3]) + (x1[0] * x1[0] + x1[1] * x1[1]) + (x1[2] * x1[2] + x1[3] * x1[3]);
                    asm volatile("" ::: "memory"); __builtin_amdgcn_sched_barrier(0);
                }
                ss = xrow16_sum(ss);
                if (fq == 0) ((LAS float*)ldsx)[wc * 256 + ai * 128 + wr * 64 + m * 16 + fr] = ss;
            }
        WG_BAR();
        if (tid < 256) { const LAS float* rd = (const LAS float*)ldsx; ssp[(size_t)u.pn * M + u.pm * 256 + tid] = (rd[tid] + rd[256 + tid]) + (rd[512 + tid] + rd[768 + tid]); }
        WG_BAR();
    }
};

struct EpiFinal {
    float* x; const float* gain; float* ssx; unsigned* cnt;
    __device__ __forceinline__ void operator()(Acc& acc, const Unit& u, int wr, int wc, int fr, int fq, LAS unsigned char* ldsx, int tid) const {
        LAS float* red = (LAS float*)ldsx; LAS float* rsl = (LAS float*)(ldsx + 4096);
#pragma unroll
        for (int ai = 0; ai < 2; ++ai)
#pragma unroll
            for (int m = 0; m < 4; ++m) {
                const int row = u.pm * 256 + ai * 128 + wr * 64 + m * 16 + fr; float ss = 0.f;
#pragma unroll
                for (int bj = 0; bj < 2; ++bj) {
                    const int col = u.pn * 256 + 128 * bj + 32 * wc + 8 * fq; const size_t off = (size_t)row * D + col;
                    const f32x4 x0 = *(const f32x4*)(x + off) + acc[ai][bj][m][0], x1 = *(const f32x4*)(x + off + 4) + acc[ai][bj][m][1];
                    acc[ai][bj][m][0] = x0; acc[ai][bj][m][1] = x1;
                    ss += (x0[0] * x0[0] + x0[1] * x0[1]) + (x0[2] * x0[2] + x0[3] * x0[3]) + (x1[0] * x1[0] + x1[1] * x1[1]) + (x1[2] * x1[2] + x1[3] * x1[3]);
                    asm volatile("" ::: "memory"); __builtin_amdgcn_sched_barrier(0);
                }
                ss = xrow16_sum(ss);
                if (fq == 0) red[wc * 256 + ai * 128 + wr * 64 + m * 16 + fr] = ss;
            }
        WG_BAR();
        if (tid < 256) __hip_atomic_store(ssx + (size_t)u.pn * M + u.pm * 256 + tid, (red[tid] + red[256 + tid]) + (red[512 + tid] + red[768 + tid]), __ATOMIC_RELAXED, __HIP_MEMORY_SCOPE_AGENT);
        asm volatile("s_waitcnt vmcnt(0)" ::: "memory");
        WG_BAR();
        if (tid == 0) {
            unsigned* c = cnt + 64 * u.pm;
            __hip_atomic_fetch_add(c, 1u, __ATOMIC_RELAXED, __HIP_MEMORY_SCOPE_AGENT);
            unsigned spins = 0;
            while (__hip_atomic_load(c, __ATOMIC_RELAXED, __HIP_MEMORY_SCOPE_AGENT) < 4u) { __builtin_amdgcn_s_sleep(2); if (++spins > (1u << 22)) break; }
            __builtin_amdgcn_fence(__ATOMIC_ACQUIRE, "agent");
            asm volatile("s_waitcnt vmcnt(0)" ::: "memory");
        }
        WG_BAR();
        if (tid < 256) {
            const float* p = ssx + u.pm * 256 + tid;
            const float sq = (__hip_atomic_load(p, __ATOMIC_RELAXED, __HIP_MEMORY_SCOPE_AGENT) + __hip_atomic_load(p + M, __ATOMIC_RELAXED, __HIP_MEMORY_SCOPE_AGENT)) +
                             (__hip_atomic_load(p + 2 * M, __ATOMIC_RELAXED, __HIP_MEMORY_SCOPE_AGENT) + __hip_atomic_load(p + 3 * M, __ATOMIC_RELAXED, __HIP_MEMORY_SCOPE_AGENT));
            rsl[tid] = 1.0f / sqrtf(sq * (1.0f / D) + EPS);
        }
        WG_BAR();
#pragma unroll
        for (int ai = 0; ai < 2; ++ai)
#pragma unroll
            for (int m = 0; m < 4; ++m) {
                const int rl = ai * 128 + wr * 64 + m * 16 + fr; const float rs = rsl[rl]; const int row = u.pm * 256 + rl;
#pragma unroll
                for (int bj = 0; bj < 2; ++bj) {
                    const int col = u.pn * 256 + 128 * bj + 32 * wc + 8 * fq; const size_t off = (size_t)row * D + col;
                    *(f32x4*)(x + off) = acc[ai][bj][m][0] * rs * *(const f32x4*)(gain + col); *(f32x4*)(x + off + 4) = acc[ai][bj][m][1] * rs * *(const f32x4*)(gain + col + 4);
                }
                asm volatile("" ::: "memory"); __builtin_amdgcn_sched_barrier(0);
            }
    }
};

struct EpiUp {
    const float* ssp; const float* cw; const float* cb; bf16_t* act; float* HB; float* FB;
    __device__ __forceinline__ void operator()(Acc& acc, const Unit& u, int wr, int wc, int fr, int fq, LAS unsigned char* ldsx, int tid) const {
        LAS float* Hl = (LAS float*)ldsx;
        LAS float* rsl = (LAS float*)(ldsx + 10240);
        const int lane = tid & 63;
        if (tid < 256) { const int row = u.pm * 256 + tid; const float sq = (ssp[row] + ssp[M + row]) + (ssp[2 * M + row] + ssp[3 * M + row]); rsl[tid] = 1.0f / sqrtf(sq * (1.0f / D) + EPS); }
        WG_BAR();
#pragma unroll
        for (int ai = 0; ai < 2; ++ai)
#pragma unroll
            for (int m = 0; m < 4; ++m) {
                const float rs = rsl[ai * 128 + wr * 64 + m * 16 + fr];
#pragma unroll
                for (int bj = 0; bj < 2; ++bj) { acc[ai][bj][m][0] *= rs; acc[ai][bj][m][1] *= rs; }
                asm volatile("" ::: "memory"); __builtin_amdgcn_sched_barrier(0);
            }
        if (tid < 128) *(LAS f32x4*)(Hl + tid * 4) = (f32x4){0.f, 0.f, 0.f, 0.f};
#pragma unroll
        for (int ai = 0; ai < 2; ++ai) {
            const int k = 2 * ai + wr;
#pragma unroll
            for (int bj = 0; bj < 2; ++bj)
#pragma unroll
                for (int n = 0; n < 2; ++n) {
                    const int tc = 128 * bj + 32 * wc + 8 * fq + 4 * n; const int uc = bj * FF + u.pn * 128 + 32 * wc + 8 * fq + 4 * n;
                    if (fr >= 14) { *(LAS f32x4*)(Hl + ((k + 1) * 2 + (fr - 14)) * 256 + tc) = acc[ai][bj][3][n]; if (k == 3) *(f32x4*)(HB + ((size_t)u.pm * 2 + (fr - 14)) * UP + uc) = acc[ai][bj][3][n]; }
                    if (k == 0 && fr < 2) *(f32x4*)(FB + ((size_t)u.pm * 2 + fr) * UP + uc) = acc[0][bj][0][n];
                }
        }
        WG_BAR();
#pragma unroll
        for (int ai = 0; ai < 2; ++ai) {
            const int k = 2 * ai + wr;
#pragma unroll
            for (int n = 0; n < 2; ++n) {
                const int tc = 32 * wc + 8 * fq + 4 * n; const int ucg = u.pn * 128 + tc;
                f32x4 cg[4];
#pragma unroll
                for (int bj = 0; bj < 2; ++bj) {
                    const int uc = bj * FF + ucg;
                    const f32x4 w0 = *(const f32x4*)(cw + uc), w1 = *(const f32x4*)(cw + UP + uc), w2 = *(const f32x4*)(cw + 2 * UP + uc), bb = *(const f32x4*)(cb + uc);
                    const f32x4 h0 = *(const LAS f32x4*)(Hl + (k * 2 + 0) * 256 + 128 * bj + tc), h1 = *(const LAS f32x4*)(Hl + (k * 2 + 1) * 256 + 128 * bj + tc);
#pragma unroll
                    for (int m = 0; m < 4; ++m) {
                        const f32x4 V = acc[ai][bj][m][n]; f32x4 p1, p2;
#pragma unroll
                        for (int e = 0; e < 4; ++e) {
                            const float r1 = dppf<0x121>(V[e]), r2 = dppf<0x122>(V[e]); float x1, x2;
                            if (m > 0) { x1 = dppf<0x121>(acc[ai][bj][m > 0 ? m - 1 : 0][n][e]); x2 = dppf<0x122>(acc[ai][bj][m > 0 ? m - 1 : 0][n][e]); }
                            else { x1 = h1[e]; x2 = (fr == 0) ? h0[e] : h1[e]; }
                            p1[e] = (fr == 0) ? x1 : r1; p2[e] = (fr < 2) ? x2 : r2;
                        }
                        const f32x4 cv = bb + w0 * p2 + w1 * p1 + w2 * V;
                        __builtin_amdgcn_sched_barrier(0);
                        if (bj == 0) cg[m] = cv;
                        else {
                            const int row = u.pm * 256 + ai * 128 + wr * 64 + m * 16 + fr;
                            float o[4];
#pragma unroll
                            for (int e = 0; e < 4; ++e) { const float gt = cg[m][e]; o[e] = gt * sigmoidf_(gt) * cv[e]; }
                            u32x2 w; w.x = cvt_pk_bf16(o[0], o[1]); w.y = cvt_pk_bf16(o[2], o[3]);
                            *(u32x2*)(act + (size_t)row * FF + ucg) = w;
                        }
                    }
                    asm volatile("" ::: "memory"); __builtin_amdgcn_sched_barrier(0);
                }
            }
        }
        WG_BAR();
    }
};

namespace att {
constexpr int SLOT_B = 16384, NSLOT = 6;
constexpr int OFF_K = 0, OFF_IMP = NSLOT * SLOT_B, IMPW = 132, OFF_SEL = OFF_IMP + 64 * IMPW * 4, OFF_UNI = OFF_SEL + 1024, OFF_LIST = OFF_UNI + 64, OFF_N = OFF_LIST + 132 * 4, OFF_CODE = OFF_N + 48, CODEW = 144;
static_assert(OFF_CODE + 8 * CODEW <= LDS_BYTES - 16 && 8 * SLOT_B <= OFF_SEL, "attention LDS map");
struct Ctx {
    const bf16_t *Q, *KCC, *VCT, *KS, *VST, *KW, *VWT; const float* gates; bf16_t* O;
};
__device__ __forceinline__ bf16x8 mk8(s16x4 a, s16x4 b) { return (bf16x8){a[0], a[1], a[2], a[3], b[0], b[1], b[2], b[3]}; }

template <int MODE>
__device__ __forceinline__ void branch(LAS unsigned char* lds, const bf16_t* Kg, const bf16_t* Vg, int ktile_elems, int nt, int c, int w, int lane, int tid,
                                       const bf16x8 (&qf)[4][2], float (&mrow)[4], float (&lrow)[4], f32x4 (&O)[4][4]) {
    const int fr = lane & 15, fq = lane >> 4;
    const LAS int* list = (const LAS int*)(lds + OFF_LIST);
    LAS float* impL = (LAS float*)(lds + OFF_IMP);
    const LAS unsigned char* codeL = (const LAS unsigned char*)(lds + OFF_CODE) + w * CODEW;
    constexpr int TPS = (MODE >= 2) ? 4 : 3;
#define ATT_DMA(ti, slot) do { const int ti_ = (ti); const int s_ = list[ti_]; LAS unsigned char* d_ = lds + OFF_K + (slot) * SLOT_B + w * 1024; \
        int t2_ = tid; asm volatile("" : "+v"(t2_)); const int lr = t2_ >> 3, lq = t2_ & 7; const int goff = lr * 64 + ((lq ^ ((lr >> 1) & 7)) * 8); \
        __builtin_amdgcn_global_load_lds((const unsigned*)(Kg + (size_t)s_ * ktile_elems + goff), (LAS unsigned*)d_, 16, 0, 0); \
        if (MODE != 0) __builtin_amdgcn_global_load_lds((const unsigned*)(Vg + (size_t)s_ * 4096 + goff), (LAS unsigned*)(d_ + 8192), 16, 0, 0); } while (0)
    asm volatile("s_waitcnt vmcnt(0)" ::: "memory");
#pragma unroll
    for (int ti = 0; ti < TPS; ++ti) if (ti < nt) ATT_DMA(ti, ti);
    const int nst = (nt + TPS - 1) / TPS;
    for (int j = 0; j < nst; ++j) {
        asm volatile("s_waitcnt vmcnt(0)" ::: "memory");
        WG_BAR();
#pragma unroll
        for (int hh = 0; hh < TPS; ++hh) if (TPS * (j + 1) + hh < nt) ATT_DMA(TPS * (j + 1) + hh, ((j + 1) & 1) * TPS + hh);
#pragma unroll 1
        for (int h = 0; h < TPS; ++h) {
        const int i = TPS * j + h; if (i >= nt) break;
        const int s = list[i];
        unsigned code = 0xffu; if (MODE == 2) code = (unsigned)__builtin_amdgcn_readfirstlane((int)codeL[i]);
        const LAS unsigned char* Kb = lds + OFF_K + ((j & 1) * TPS + h) * SLOT_B;
        const LAS unsigned char* Vb = Kb;
        int l2_ = lane; asm volatile("" : "+v"(l2_)); const int fr2 = l2_ & 15, fq2 = l2_ >> 4, swz = (fr2 >> 1) & 7;
        const int kb0 = fr2 * 128 + ((fq2 ^ swz) * 16), kb1 = kb0 ^ 64;
        if (MODE != 2) {
            f32x4 sa[4][4];
#pragma unroll
            for (int p = 0; p < 4; ++p) {
                const float cinit = (MODE == 1) ? lrow[p] : -((mrow[p] < -1e29f) ? 0.f : mrow[p]);
#pragma unroll
                for (int mt = 0; mt < 4; ++mt) sa[p][mt] = (f32x4){cinit, cinit, cinit, cinit};
            }
#pragma unroll
            for (int mt = 0; mt < 4; ++mt)
#pragma unroll
                for (int ks = 0; ks < 2; ++ks) {
                    const bf16x8 kf = *(const LAS bf16x8*)(Kb + (ks ? kb1 : kb0) + mt * 2048);
#pragma unroll
                    for (int p = 0; p < 4; ++p) sa[p][mt] = __builtin_amdgcn_mfma_f32_16x16x32_bf16(kf, qf[p][ks], sa[p][mt], 0, 0, 0);
                }
            bf16x8 pf[4][2];
#pragma unroll
            for (int p = 0; p < 4; ++p) {
                const int ttA = 8 * w + 2 * p, tt = ttA + (fr >> 3);
                bool needmask;
                if (MODE <= 1) needmask = (((64 * c + ttA - 31) >> 4) - 64 * s) < 63;
                else needmask = (s == c) || (c >= 8 && s == c - 8);
                if (needmask) {
                    int hi, lov = -1;
                    if (MODE <= 1) { const int t = 64 * c + tt; hi = ((t - 31) >> 4) - 64 * s; }
                    else { hi = (s == c) ? tt : 63; lov = (c >= 8 && s == c - 8) ? tt : -1; }
#pragma unroll
                    for (int mt = 0; mt < 4; ++mt)
#pragma unroll
                        for (int j = 0; j < 4; ++j) { const int kk = 16 * mt + 4 * fq + j; sa[p][mt][j] = (kk <= hi && kk > lov) ? sa[p][mt][j] : -1e30f; }
                }
                if (MODE != 1) {
                    float mx = fmaxf(fmaxf(sa[p][0][0], sa[p][0][1]), sa[p][0][2]);
                    mx = fmaxf(fmaxf(mx, sa[p][0][3]), sa[p][1][0]); mx = fmaxf(fmaxf(mx, sa[p][1][1]), sa[p][1][2]); mx = fmaxf(fmaxf(mx, sa[p][1][3]), sa[p][2][0]);
                    mx = fmaxf(fmaxf(mx, sa[p][2][1]), sa[p][2][2]); mx = fmaxf(fmaxf(mx, sa[p][2][3]), sa[p][3][0]); mx = fmaxf(fmaxf(mx, sa[p][3][1]), sa[p][3][2]); mx = fmaxf(mx, sa[p][3][3]);
                    mx = xrow16_max(mx);
                    const bool uninit = mrow[p] < -1e29f;
                    const bool resc = (mx > 8.0f) || (uninit && mx > -1e29f);
                    if (__any(resc)) {
                        const float delta = resc ? mx : 0.f;
                        const float alpha = (resc && !uninit) ? ex2(-delta) : 1.0f;
#pragma unroll
                        for (int mt = 0; mt < 4; ++mt) sa[p][mt] = sa[p][mt] - delta;
                        lrow[p] *= alpha;
                        if (MODE >= 2) {
#pragma unroll
                            for (int d = 0; d < 4; ++d) O[p][d] *= alpha;
                        }
                        if (resc) mrow[p] = (uninit ? 0.f : mrow[p]) + delta;
                    }
                }
#pragma unroll
                for (int mt = 0; mt < 4; ++mt)
#pragma unroll
                    for (int j = 0; j < 4; ++j) sa[p][mt][j] = ex2(sa[p][mt][j]);
                if (MODE != 1) { const f32x4 t4 = (sa[p][0] + sa[p][1]) + (sa[p][2] + sa[p][3]); lrow[p] += (t4[0] + t4[1]) + (t4[2] + t4[3]); }
                if (MODE >= 1) {
#pragma unroll
                    for (int k2 = 0; k2 < 2; ++k2) {
                        u32x4 wv; wv.x = cvt_pk_bf16(sa[p][2 * k2][0], sa[p][2 * k2][1]); wv.y = cvt_pk_bf16(sa[p][2 * k2][2], sa[p][2 * k2][3]); wv.z = cvt_pk_bf16(sa[p][2 * k2 + 1][0], sa[p][2 * k2 + 1][1]); wv.w = cvt_pk_bf16(sa[p][2 * k2 + 1][2], sa[p][2 * k2 + 1][3]);
                        pf[p][k2] = __builtin_bit_cast(bf16x8, wv);
                    }
                }
                if (MODE == 1) {
#pragma unroll
                    for (int mt = 0; mt < 4; ++mt) {
                        float a = sa[p][mt][0] + sa[p][mt][1] + sa[p][mt][2] + 0.5f * sa[p][mt][3], bn = 0.5f * sa[p][mt][3];
                        a = sum8(a); bn = sum8(bn);
                        const int sb = 16 * s + 4 * mt + fq;
                        if ((fr & 7) == 0) { (void)__hip_atomic_fetch_add(impL + tt * IMPW + sb, a, __ATOMIC_RELAXED, __HIP_MEMORY_SCOPE_WORKGROUP); (void)__hip_atomic_fetch_add(impL + tt * IMPW + sb + 1, bn, __ATOMIC_RELAXED, __HIP_MEMORY_SCOPE_WORKGROUP); }
                    }
                }
            }
            if (MODE >= 1) {
#pragma unroll
                for (int d = 0; d < 4; ++d)
#pragma unroll
                    for (int k2 = 0; k2 < 2; ++k2) {
                        const bf16x8 vf = *(const LAS bf16x8*)(Vb + 8192 + (k2 ? kb1 : kb0) + d * 2048);
#pragma unroll
                        for (int p = 0; p < 4; ++p) O[p][d] = __builtin_amdgcn_mfma_f32_16x16x32_bf16(vf, pf[p][k2], O[p][d], 0, 0, 0);
                    }
            }
            __builtin_amdgcn_sched_barrier(0);
        } else {
#pragma unroll
        for (int p = 0; p < 4; ++p) {
            const int ttA = 8 * w + 2 * p;
            const unsigned mA = (code >> (2 * p)) & 1u, mB = (code >> (2 * p + 1)) & 1u;
            if ((mA | mB) != 0u) {
            const int tt = ttA + (fr >> 3);
            float cinit;
            if (MODE == 1) cinit = lrow[p];
            else { const float mref = (mrow[p] < -1e29f) ? 0.f : mrow[p]; const bool colact = (MODE != 2) || (((fr >> 3) ? mB : mA) != 0u); cinit = colact ? -mref : -1e30f; }
            f32x4 sa[4];
#pragma unroll
            for (int mt = 0; mt < 4; ++mt) {
                sa[mt] = (f32x4){cinit, cinit, cinit, cinit};
#pragma unroll
                for (int ks = 0; ks < 2; ++ks) { const bf16x8 kf = *(const LAS bf16x8*)(Kb + (ks ? kb1 : kb0) + mt * 2048); sa[mt] = __builtin_amdgcn_mfma_f32_16x16x32_bf16(kf, qf[p][ks], sa[mt], 0, 0, 0); }
            }
            bool needmask;
            if (MODE <= 1) needmask = (((64 * c + ttA - 31) >> 4) - 64 * s) < 63;
            else if (MODE == 2) needmask = (s == c);
            else needmask = (s == c) || (c >= 8 && s == c - 8);
            if (needmask) {
                int hi, lov = -1;
                if (MODE <= 1) { const int t = 64 * c + tt; hi = ((t - 31) >> 4) - 64 * s; }
                else if (MODE == 2) hi = tt;
                else { hi = (s == c) ? tt : 63; lov = (c >= 8 && s == c - 8) ? tt : -1; }
#pragma unroll
                for (int mt = 0; mt < 4; ++mt)
#pragma unroll
                    for (int j = 0; j < 4; ++j) { const int kk = 16 * mt + 4 * fq + j; sa[mt][j] = (kk <= hi && kk > lov) ? sa[mt][j] : -1e30f; }
            }
            if (MODE != 1) {
                float mx = fmaxf(fmaxf(sa[0][0], sa[0][1]), sa[0][2]);
                mx = fmaxf(fmaxf(mx, sa[0][3]), sa[1][0]); mx = fmaxf(fmaxf(mx, sa[1][1]), sa[1][2]); mx = fmaxf(fmaxf(mx, sa[1][3]), sa[2][0]);
                mx = fmaxf(fmaxf(mx, sa[2][1]), sa[2][2]); mx = fmaxf(fmaxf(mx, sa[2][3]), sa[3][0]); mx = fmaxf(fmaxf(mx, sa[3][1]), sa[3][2]); mx = fmaxf(mx, sa[3][3]);
                mx = xrow16_max(mx);
                const bool uninit = mrow[p] < -1e29f;
                const bool resc = (mx > 8.0f) || (uninit && mx > -1e29f);
                if (__any(resc)) {
                    const float delta = resc ? mx : 0.f;
                    const float alpha = (resc && !uninit) ? ex2(-delta) : 1.0f;
#pragma unroll
                    for (int mt = 0; mt < 4; ++mt) sa[mt] = sa[mt] - delta;
                    lrow[p] *= alpha;
                    if (MODE >= 2) {
#pragma unroll
                        for (int d = 0; d < 4; ++d) O[p][d] *= alpha;
                    }
                    if (resc) mrow[p] = (uninit ? 0.f : mrow[p]) + delta;
                }
            }
            f32x4 pv[4];
#pragma unroll
            for (int mt = 0; mt < 4; ++mt)
#pragma unroll
                for (int j = 0; j < 4; ++j) pv[mt][j] = ex2(sa[mt][j]);
            if (MODE != 1) { const f32x4 t4 = (pv[0] + pv[1]) + (pv[2] + pv[3]); lrow[p] += (t4[0] + t4[1]) + (t4[2] + t4[3]); }
            if (MODE >= 1) {
                bf16x8 pf[2];
#pragma unroll
                for (int k2 = 0; k2 < 2; ++k2) {
                    u32x4 wv; wv.x = cvt_pk_bf16(pv[2 * k2][0], pv[2 * k2][1]); wv.y = cvt_pk_bf16(pv[2 * k2][2], pv[2 * k2][3]); wv.z = cvt_pk_bf16(pv[2 * k2 + 1][0], pv[2 * k2 + 1][1]); wv.w = cvt_pk_bf16(pv[2 * k2 + 1][2], pv[2 * k2 + 1][3]);
                    pf[k2] = __builtin_bit_cast(bf16x8, wv);
                }
#pragma unroll
                for (int d = 0; d < 4; ++d)
#pragma unroll
                    for (int k2 = 0; k2 < 2; ++k2) {
                        const bf16x8 vf = *(const LAS bf16x8*)(Vb + 8192 + (k2 ? kb1 : kb0) + d * 2048);
                        O[p][d] = __builtin_amdgcn_mfma_f32_16x16x32_bf16(vf, pf[k2], O[p][d], 0, 0, 0);
                    }
            }
            if (MODE == 1) {
#pragma unroll
                for (int mt = 0; mt < 4; ++mt) {
                    float a = pv[mt][0] + pv[mt][1] + pv[mt][2] + 0.5f * pv[mt][3], bn = 0.5f * pv[mt][3];
                    a = sum8(a); bn = sum8(bn);
                    const int sb = 16 * s + 4 * mt + fq;
                    if ((fr & 7) == 0) { (void)__hip_atomic_fetch_add(impL + tt * IMPW + sb, a, __ATOMIC_RELAXED, __HIP_MEMORY_SCOPE_WORKGROUP); (void)__hip_atomic_fetch_add(impL + tt * IMPW + sb + 1, bn, __ATOMIC_RELAXED, __HIP_MEMORY_SCOPE_WORKGROUP); }
                }
            }
            }
            __builtin_amdgcn_sched_barrier(0);
        }
        }
        }
    }
    WG_BAR();
#undef ATT_DMA
}

__device__ __forceinline__ void unit(LAS unsigned char* lds, const Ctx& X, int b, int g, int c, int tid_in) {
    int tid = tid_in; asm volatile("" : "+v"(tid));
    const int lane = tid & 63, w = __builtin_amdgcn_readfirstlane(tid >> 6), fr = lane & 15, fq = lane >> 4;
    LAS int* list = (LAS int*)(lds + OFF_LIST);
    LAS unsigned* selm = (LAS unsigned*)(lds + OFF_SEL);
    LAS unsigned* uni = (LAS unsigned*)(lds + OFF_UNI);
    LAS float* impL = (LAS float*)(lds + OFF_IMP);
    LAS int* nl = (LAS int*)(lds + OFF_N);
    const int bg = b * 2 + g; const size_t rowbase = (size_t)b * T + 64 * c;
    bf16x8 qf[4][2];
#pragma unroll
    for (int p = 0; p < 4; ++p) { const bf16_t* qp = X.Q + (rowbase + 8 * w + 2 * p + (fr >> 3)) * 1024 + (8 * g + (fr & 7)) * 64 + 8 * fq;
#pragma unroll
        for (int ks = 0; ks < 2; ++ks) qf[p][ks] = *(const bf16x8*)(qp + 32 * ks); }
    for (int i = lane; i < 8 * IMPW; i += 64) impL[(8 * w) * IMPW + i] = 0.f;
    const int ncmp = (4 * c + 3 + 63) >> 6;
    if (tid < 8) list[tid] = tid;
    float mrow[4], lrow[4]; f32x4 O[4][4];
#pragma unroll
    for (int p = 0; p < 4; ++p) { mrow[p] = -1e30f; lrow[p] = 0.f;
#pragma unroll
        for (int d = 0; d < 4; ++d) { O[p][d] = (f32x4){0.f, 0.f, 0.f, 0.f}; } }
    WG_BAR();
    const bf16_t* kcc = X.KCC + (size_t)bg * 512 * 64; const bf16_t* vct = X.VCT + (size_t)bg * 8 * 4096;
    branch<0>(lds, kcc, vct, 4096, ncmp, c, w, lane, tid, qf, mrow, lrow, O);
#pragma unroll
    for (int p = 0; p < 4; ++p) { float l = xrow16_sum(lrow[p]); lrow[p] = (l > 0.f) ? (-mrow[p] - __builtin_amdgcn_logf(l)) : -1e30f; }
    branch<1>(lds, kcc, vct, 4096, ncmp, c, w, lane, tid, qf, mrow, lrow, O);
#define ATT_GATE(br, scale_expr) do { _Pragma("unroll") for (int p = 0; p < 4; ++p) { \
        const size_t grow = rowbase + 8 * w + 2 * p + (fr >> 3); \
        const float gt = X.gates[grow * 48 + (8 * g + (fr & 7)) * 3 + (br)]; const float sc = gt * (scale_expr); \
        _Pragma("unroll") for (int d = 0; d < 4; ++d) { \
            u32x2* optr = (u32x2*)(X.O + grow * 1024 + (8 * g + (fr & 7)) * 64 + 4 * fq + 16 * d); u32x2 ot = (u32x2){0u, 0u}; if ((br) > 0) ot = *optr; \
            float o0 = __uint_as_float(ot.x << 16), o1 = __uint_as_float(ot.x & 0xffff0000u), o2 = __uint_as_float(ot.y << 16), o3 = __uint_as_float(ot.y & 0xffff0000u); \
            o0 += sc * O[p][d][0]; o1 += sc * O[p][d][1]; o2 += sc * O[p][d][2]; o3 += sc * O[p][d][3]; \
            ot.x = cvt_pk_bf16(o0, o1); ot.y = cvt_pk_bf16(o2, o3); O[p][d] = (f32x4){0.f, 0.f, 0.f, 0.f}; \
            *optr = ot; } \
        mrow[p] = -1e30f; lrow[p] = 0.f; } } while (0)
    ATT_GATE(0, 1.0f);
    LDS_WAIT();
    for (int q8 = 0; q8 < 8; ++q8) {
        const int tt = 8 * w + q8;
        unsigned long long blo, bhi;
        if (c + 1 <= 16) { blo = (1ull << (c + 1)) - 1ull; bhi = 0ull; }
        else {
            const int s1 = lane, s2 = lane + 64;
            const bool c1 = (s1 >= 1 && s1 <= c - 2), c2 = (s2 >= 1 && s2 <= c - 2);
            const float v1 = c1 ? impL[tt * IMPW + s1] : -1.f, v2 = c2 ? impL[tt * IMPW + s2] : -1.f;
            int r1 = 0, r2 = 0;
            const int nq = (c - 2) / 4 + 1;
#pragma unroll 2
            for (int q = 0; q < nq; ++q) {
                const f32x4 x4 = *(const LAS f32x4*)(impL + tt * IMPW + 4 * q);
#pragma unroll
                for (int e = 0; e < 4; ++e) { const int sp = 4 * q + e; const float x = (sp >= 1 && sp <= c - 2) ? x4[e] : -2.f;
                    r1 += (x > v1 || (x == v1 && sp < s1)) ? 1 : 0; r2 += (x > v2 || (x == v2 && sp < s2)) ? 1 : 0; }
            }
            const bool f1 = (s1 == 0 || s1 == c || s1 == c - 1), f2 = (s2 == c || s2 == c - 1);
            blo = __ballot((c1 && r1 < 13) || f1); bhi = __ballot((c2 && r2 < 13) || f2);
        }
        if (lane == 0) { selm[tt * 4 + 0] = (unsigned)blo; selm[tt * 4 + 1] = (unsigned)(blo >> 32); selm[tt * 4 + 2] = (unsigned)bhi; selm[tt * 4 + 3] = (unsigned)(bhi >> 32); }
    }
    WG_BAR();
    if (tid < 4) { unsigned o = 0; for (int i = 0; i < 64; ++i) o |= selm[i * 4 + tid]; uni[tid] = o; }
    WG_BAR();
    if (tid == 0) { int n = 0; for (int s = 0; s <= c; ++s) if ((uni[s >> 5] >> (s & 31)) & 1u) list[n++] = s; nl[0] = n; }
    WG_BAR();
    const int nsel = nl[0];
    { LAS unsigned char* cw_ = (LAS unsigned char*)(lds + OFF_CODE) + w * CODEW;
      for (int i = lane; i < nsel; i += 64) { const int s_ = list[i]; unsigned cd = 0;
#pragma unroll
          for (int q8 = 0; q8 < 8; ++q8) cd |= ((selm[(8 * w + q8) * 4 + (s_ >> 5)] >> (s_ & 31)) & 1u) << q8;
          cw_[i] = (unsigned char)cd; }
      LDS_WAIT(); }
    branch<2>(lds, X.KS + (size_t)bg * T * 64, X.VST + (size_t)bg * 128 * 4096, 4096, nsel, c, w, lane, tid, qf, mrow, lrow, O);
#pragma unroll
    for (int p = 0; p < 4; ++p) { float l = xrow16_sum(lrow[p]); lrow[p] = (l > 0.f) ? 1.0f / l : 0.f; }
    { float rl[4] = {lrow[0], lrow[1], lrow[2], lrow[3]}; ATT_GATE(1, rl[p]); }
    const int w0 = (c >= 8) ? c - 8 : 0, nwin = c - w0 + 1;
    if (tid < nwin) list[tid] = w0 + tid;
    WG_BAR();
    branch<3>(lds, X.KW + (size_t)bg * T * 64, X.VWT + (size_t)bg * 128 * 4096, 4096, nwin, c, w, lane, tid, qf, mrow, lrow, O);
#pragma unroll
    for (int p = 0; p < 4; ++p) { float l = xrow16_sum(lrow[p]); lrow[p] = (l > 0.f) ? 1.0f / l : 0.f; }
    { float rl[4] = {lrow[0], lrow[1], lrow[2], lrow[3]}; ATT_GATE(2, rl[p]); }
#undef ATT_GATE
    WG_BAR();
}
}

__device__ __forceinline__ unsigned f2bf(float f) { unsigned u = __builtin_bit_cast(unsigned, f); return (u + 0x7fffu + ((u >> 16) & 1u)) >> 16; }
__device__ __forceinline__ unsigned pk2(float lo, float hi) { return f2bf(lo) | (f2bf(hi) << 16); }
template <int MAP>
__device__ __forceinline__ int rowmap(int a) {
    if (MAP == 0) return perm8(a);
    if (MAP == 1) return a < 1792 ? ((a & ~63) | swap45(a & 63)) : a;
    if (MAP == 2) { if (a < FF) return 256 * (a >> 7) + perm8(a & 127); const int a2 = a - FF; return 256 * (a2 >> 7) + 128 + perm8(a2 & 127); }
    return swap45(a);
}
template <int MAP>
__device__ __forceinline__ void transpose_item(const float* W, int K, int N, bf16_t* WT, int row_off, const float* gain, LAS float* scr, int item, int lane) {
    const int nblk = (N + 31) / 32, kb = item / nblk, nb = item % nblk, k0 = 64 * kb, n0 = 32 * nb;
#pragma unroll
    for (int i = 0; i < 32; ++i) { const int kk = 2 * i + (lane >> 5); const int col = n0 + (lane & 31); float v = (col < N) ? W[(size_t)(k0 + kk) * N + col] : 0.f; if (gain) v *= gain[k0 + kk]; scr[kk * 33 + (lane & 31)] = v; }
    LDS_WAIT();
    const int cc = lane & 7;
#pragma unroll
    for (int j = 0; j < 4; ++j) { const int n = (lane >> 3) + 8 * j; const LAS float* s = scr + (8 * cc) * 33 + n;
        u32x4 o; o.x = pk2(s[0 * 33], s[1 * 33]); o.y = pk2(s[2 * 33], s[3 * 33]); o.z = pk2(s[4 * 33], s[5 * 33]); o.w = pk2(s[6 * 33], s[7 * 33]);
        if (n0 + n < N) *(u32x4*)(WT + (size_t)(row_off + rowmap<MAP>(n0 + n)) * K + k0 + 8 * cc) = o; }
    LDS_WAIT();
}

#define XB_TMO      128
#define XB_XCNT(j)  (256  + 64 * (j))
#define XB_XSUB(j)  (1280 + 64 * (j))
#define XB_XGEN(j)  (2304 + 64 * (j))
#define XB_TOP      3328
#define XB_TOPGEN   3392
#define XCD_BAR_WORDS 3456
#define XB_SPIN_CAP (1u << 18)
__device__ __forceinline__ unsigned xb_ld(unsigned* p)              { return __hip_atomic_load(p, __ATOMIC_RELAXED, __HIP_MEMORY_SCOPE_AGENT); }
__device__ __forceinline__ unsigned xb_add(unsigned* p, unsigned v) { return __hip_atomic_fetch_add(p, v, __ATOMIC_RELAXED, __HIP_MEMORY_SCOPE_AGENT); }
__device__ __forceinline__ unsigned xb_xcc_id() { return (unsigned)__builtin_amdgcn_s_getreg((3 << 11) | 20) & 0xFu; }
#define XB_SPIN(cond, bar) do { unsigned _sp = 0; while (cond) { __builtin_amdgcn_s_sleep(1); \
    if ((++_sp & 255u) == 0u) { if (xb_ld(&(bar)[XB_TMO])) break; if (_sp > XB_SPIN_CAP) { atomicAdd(&(bar)[XB_TMO], 1u); break; } } } } while (0)
struct XcdBarrier { unsigned* bar; unsigned x; volatile LAS unsigned* st; };
__device__ __forceinline__ XcdBarrier xcd_barrier_post(unsigned* bar, volatile LAS unsigned* st) {
    XcdBarrier b; b.bar = bar; b.x = xb_xcc_id(); b.st = st;
    if (threadIdx.x == 0) (void)xb_add(&bar[XB_XCNT(b.x)], 1u);
    return b;
}
__device__ __forceinline__ void xcd_barrier_complete(unsigned* bar, unsigned x, unsigned& nloc, unsigned& nx) {
    const unsigned G = gridDim.x * gridDim.y * gridDim.z;
    unsigned sum, cnt, mine, sp = 0u;
    for (;;) {
        sum = 0u; cnt = 0u; mine = 0u;
#pragma unroll
        for (unsigned j = 0; j < 16; ++j) { const unsigned c = xb_ld(&bar[XB_XCNT(j)]); sum += c; cnt += (c > 0u) ? 1u : 0u; mine = (j == x) ? c : mine; }
        if (sum == G) break;
        __builtin_amdgcn_s_sleep(1);
        if ((++sp & 255u) == 0u) { if (xb_ld(&bar[XB_TMO])) break; if (sp > XB_SPIN_CAP) { atomicAdd(&bar[XB_TMO], 1u); break; } }
    }
    nloc = mine > 0u ? mine : 1u; nx = cnt > 0u ? cnt : 1u;
}
__device__ __forceinline__ void xcd_barrier(const XcdBarrier& b) {
    asm volatile("s_waitcnt vmcnt(0)" ::: "memory");
    __syncthreads();
    if (threadIdx.x == 0) {
        unsigned* bar = b.bar;
        __builtin_amdgcn_s_waitcnt(0);
        unsigned nloc = b.st[0], nx = b.st[1];
        if (nloc == 0u) { xcd_barrier_complete(bar, b.x, nloc, nx); b.st[0] = nloc; b.st[1] = nx; }
        const unsigned old = xb_add(&bar[XB_XSUB(b.x)], 1u);
        const unsigned gen = old / nloc;
        if (old + 1u == (gen + 1u) * nloc) {
            __builtin_amdgcn_fence(__ATOMIC_RELEASE, "agent");
            asm volatile("s_waitcnt vmcnt(0)" ::: "memory");
            const unsigned og = xb_add(&bar[XB_TOP], 1u);
            const unsigned tg = og / nx;
            if (og + 1u == (tg + 1u) * nx) xb_add(&bar[XB_TOPGEN], 1u);
            else XB_SPIN(xb_ld(&bar[XB_TOPGEN]) == tg, bar);
            __builtin_amdgcn_fence(__ATOMIC_ACQUIRE, "agent");
            xb_add(&bar[XB_XGEN(b.x)], 1u);
            asm volatile("s_waitcnt vmcnt(0)" ::: "memory");
        } else {
            XB_SPIN(xb_ld(&bar[XB_XGEN(b.x)]) == gen, bar);
            __builtin_amdgcn_fence(__ATOMIC_ACQUIRE, "agent");
            asm volatile("s_waitcnt vmcnt(0)" ::: "memory");
        }
    }
    __syncthreads();
}

struct Args { const float* in[29]; float* out; unsigned char* ws; float inv[32]; int ph_lo, ph_hi; };

constexpr int DI_UP = 16 * 176, DI_DN = 44 * 32, DI_PL = 4 * 8, N_DEFER = 2 * DI_UP + 2 * DI_DN + 4 * DI_PL;
__device__ __forceinline__ void ffn_weight_item(const Args& a, unsigned char* ws, LAS float* scr, int r, int lane) {
    if (r < DI_UP) { transpose_item<2>(a.in[15], D, UP, (bf16_t*)(ws + WS_WUP0), 0, a.in[14], scr, r, lane); return; } r -= DI_UP;
    if (r < DI_UP) { transpose_item<2>(a.in[24], D, UP, (bf16_t*)(ws + WS_WUP1), 0, a.in[23], scr, r, lane); return; } r -= DI_UP;
    if (r < DI_DN) { transpose_item<0>(a.in[18], FF, D, (bf16_t*)(ws + WS_WDN0), 0, nullptr, scr, r, lane); return; } r -= DI_DN;
    if (r < DI_DN) { transpose_item<0>(a.in[27], FF, D, (bf16_t*)(ws + WS_WDN1), 0, nullptr, scr, r, lane); return; } r -= DI_DN;
    const int gi = r / DI_PL; transpose_item<0>(a.in[20] + (size_t)gi * 65536, 256, 256, (bf16_t*)(ws + WS_WPOOL), gi * 256, nullptr, scr, r % DI_PL, lane);
}

__global__ void __launch_bounds__(512) mk_fwd(Args a) {
    extern __shared__ __attribute__((aligned(16))) unsigned char lds_raw[];
    LAS unsigned char* lds = (LAS unsigned char*)lds_raw;
    LAS unsigned char* ldsx = lds + LDS_RING;
    cg::grid_group grid = cg::this_grid();
    if (threadIdx.x < 2) ((volatile LAS unsigned*)(lds + LDS_BYTES - 16))[threadIdx.x] = 0u;
    __syncthreads();
    if (a.ph_hi == 0x7fff) grid.sync();
    const XcdBarrier xbar = xcd_barrier_post((unsigned*)a.ws, (volatile LAS unsigned*)(lds + LDS_BYTES - 16));
    const int tid = threadIdx.x, lane = tid & 63, wave = __builtin_amdgcn_readfirstlane(tid >> 6);
    const int G = gridDim.x, bx = blockIdx.x;
    unsigned char* ws = a.ws;
#define cosT ((float*)(ws + WS_ROPE))
#define sinT ((float*)(ws + WS_ROPE) + T * 32)
#define ssp ((float*)(ws + WS_SSP))
#define c1p ((float*)(ws + WS_C1P))
#define rstdv ((float*)(ws + WS_RSTD))
#define HB ((float*)(ws + WS_HB))
#define FB ((float*)(ws + WS_FB))
#define gates ((float*)(ws + WS_GATE))
#define Wt_in ((bf16_t*)(ws + WS_WIN))
#define Wt_out ((bf16_t*)(ws + WS_WOUT))
#define Wt_pool ((bf16_t*)(ws + WS_WPOOL))
#define Wt_c1 (kv ? (bf16_t*)(ws + WS_WC1V) : (bf16_t*)(ws + WS_WC1K))
#define Wt_c2 (kv ? (bf16_t*)(ws + WS_WC2V) : (bf16_t*)(ws + WS_WC2K))
#define XB ((bf16_t*)(ws + WS_XB))
#define Qb ((bf16_t*)(ws + WS_Q))
#define KC ((bf16_t*)(ws + WS_KC))
#define VC ((bf16_t*)(ws + WS_VC))
#define KS ((bf16_t*)(ws + WS_KS))
#define VST ((bf16_t*)(ws + WS_VST))
#define KW ((bf16_t*)(ws + WS_KW))
#define VWT ((bf16_t*)(ws + WS_VWT))
#define KCC ((bf16_t*)(ws + WS_KCC))
#define VCT ((bf16_t*)(ws + WS_VCT))
#define Ob ((bf16_t*)(ws + WS_O))
#define ACT ((bf16_t*)(ws + WS_ACT))
#define POOLED ((bf16_t*)(ws + WS_POOLED))
    float* out = a.out;
    const int lo = a.ph_lo, hi = a.ph_hi;
    const bool defer = (G == 256);
#define IN(k) (lo <= (k) && (k) < hi)
#define SEAM(k) do { if (IN(k) && IN((k) + 1)) xcd_barrier(xbar); } while (0)

    if (IN(0)) {
        LAS float* scr = (LAS float*)(lds + wave * 16384);
        const int gw = bx * 8 + wave, NGW = G * 8;
        constexpr int I_IN = 16 * 58, I_OUT = 16 * 32, I_C1 = 32 * 8, I_C2 = 4 * 2;
        constexpr int NA = I_IN + I_OUT + 2 * I_C1 + 2 * I_C2;
        const int NIT = NA + (defer ? 0 : N_DEFER);
        for (int it = gw; it < NIT; it += NGW) {
            int r = it;
            if (r < I_IN) { transpose_item<1>(a.in[2], D, 1840, Wt_in, 0, a.in[1], scr, r, lane); continue; } r -= I_IN;
            if (r < I_OUT) { transpose_item<0>(a.in[13], D, D, Wt_out, 0, nullptr, scr, r, lane); continue; } r -= I_OUT;
            if (r < I_C1) { transpose_item<0>(a.in[4], 2048, 256, (bf16_t*)(ws + WS_WC1K), 0, nullptr, scr, r, lane); continue; } r -= I_C1;
            if (r < I_C1) { transpose_item<0>(a.in[9], 2048, 256, (bf16_t*)(ws + WS_WC1V), 0, nullptr, scr, r, lane); continue; } r -= I_C1;
            if (r < I_C2) { transpose_item<3>(a.in[6], 256, 64, (bf16_t*)(ws + WS_WC2K), 0, nullptr, scr, r, lane); continue; } r -= I_C2;
            if (r < I_C2) { transpose_item<3>(a.in[11], 256, 64, (bf16_t*)(ws + WS_WC2V), 0, nullptr, scr, r, lane); continue; } r -= I_C2;
            ffn_weight_item(a, ws, scr, r, lane);
        }
        for (int m = gw; m < M; m += 2 * NGW) {
            const int m2 = m + NGW;
            const f32x4* xr = (const f32x4*)(a.in[0] + (size_t)m * D) + lane; const f32x4* xr2 = (const f32x4*)(a.in[0] + (size_t)m2 * D) + lane;
            f32x4 v[4], w[4];
#pragma unroll
            for (int j = 0; j < 4; ++j) { v[j] = xr[64 * j]; w[j] = (m2 < M) ? xr2[64 * j] : (f32x4){0.f, 0.f, 0.f, 0.f}; }
            unsigned long long* o8 = (unsigned long long*)(XB + (size_t)m * D) + lane; unsigned long long* o82 = (unsigned long long*)(XB + (size_t)m2 * D) + lane; float s1 = 0.f, s2 = 0.f;
#pragma unroll
            for (int j = 0; j < 4; ++j) {
                s1 += (v[j][0] * v[j][0] + v[j][1] * v[j][1]) + (v[j][2] * v[j][2] + v[j][3] * v[j][3]); o8[64 * j] = (unsigned long long)pk2(v[j][0], v[j][1]) | ((unsigned long long)pk2(v[j][2], v[j][3]) << 32);
                s2 += (w[j][0] * w[j][0] + w[j][1] * w[j][1]) + (w[j][2] * w[j][2] + w[j][3] * w[j][3]); if (m2 < M) o82[64 * j] = (unsigned long long)pk2(w[j][0], w[j][1]) | ((unsigned long long)pk2(w[j][2], w[j][3]) << 32);
            }
#pragma unroll
            for (int o = 1; o < 64; o <<= 1) { s1 += __shfl_xor(s1, o); s2 += __shfl_xor(s2, o); }
            if (lane == 0) { rstdv[m] = 1.0f / sqrtf(s1 * (1.0f / D) + EPS); if (m2 < M) rstdv[m2] = 1.0f / sqrtf(s2 * (1.0f / D) + EPS); }
        }
        for (int i = bx * 512 + tid; i < T * 32; i += G * 512) {
            const int t = i >> 5, f = i & 31; const float ang = (float)t * a.inv[f];
            double x = (double)ang * 0.15915494309189535; x -= __builtin_rint(x); const float xf = (float)x;
            cosT[i] = __builtin_amdgcn_cosf(xf); sinT[i] = __builtin_amdgcn_sinf(xf);
        }
        for (int it = NGW - 1 - gw; it < 256; it += NGW) {
            const int kv = it >> 7, chunk = (it >> 2) & 31, nb = it & 3; const float* pos = a.in[kv ? 8 : 3]; const float* w1 = a.in[kv ? 9 : 4];
            float s = 0.f;
#pragma unroll 32
            for (int r = 0; r < 64; ++r) { const int rr = chunk * 64 + r; s += pos[rr] * w1[(size_t)rr * 256 + nb * 64 + lane]; }
            c1p[(kv * 32 + chunk) * 256 + nb * 64 + lane] = s;
        }
        asm volatile("s_waitcnt vmcnt(0) lgkmcnt(0)" ::: "memory"); __syncthreads();
    }
    SEAM(0);
    if (IN(1)) {
        pg8::Gemm g{XB, Wt_in, M, NIN, D, D, 0}; pg8::StaticOrder S; S.init(M, NIN, G, bx);
        EpiIn E{rstdv, cosT, sinT, Qb, KC, VC, KS, VST, KW, VWT, gates};
        pg8::gemm_phase(lds, ldsx, g, S, E);
    }
    SEAM(1);
    if (IN(2)) {
        const int tid = threadIdx.x, lane = tid & 63, w = __builtin_amdgcn_readfirstlane(tid >> 6), fr = lane & 15, fq = lane >> 4;
        LAS float* c1s = (LAS float*)lds;
        LAS unsigned char* hidL = lds + 4096;
        for (int i = tid; i < 512; i += 512) { const int kv = i >> 8, n = i & 255; const float* b1 = a.in[kv ? 10 : 5]; float sv = b1[n]; for (int q = 0; q < 32; ++q) sv += c1p[(kv * 32 + q) * 256 + n]; c1s[i] = sv; }
        __syncthreads();
        for (int u = bx; u < 256; u += G) {
            const int kv = u >> 7, r0 = (u & 127) * 16;
            const bf16_t* Ap = (kv ? VC : KC) + (size_t)(r0 + fr) * 1024 + 8 * fq;
            const bf16_t* Bp = Wt_c1 + (size_t)(32 * w + fr) * 2048 + 8 * fq;
            f32x4 h0 = (f32x4){0.f, 0.f, 0.f, 0.f}, h1 = h0;
#pragma unroll 1
            for (int k0 = 0; k0 < 2048; k0 += 256) {
                bf16x8 af[8], b0[8], b1f[8];
#pragma unroll
                for (int q = 0; q < 8; ++q) { af[q] = *(const bf16x8*)(Ap + k0 + 32 * q); b0[q] = *(const bf16x8*)(Bp + k0 + 32 * q); b1f[q] = *(const bf16x8*)(Bp + 16 * 2048 + k0 + 32 * q); }
#pragma unroll
                for (int q = 0; q < 8; ++q) { h0 = __builtin_amdgcn_mfma_f32_16x16x32_bf16(b0[q], af[q], h0, 0, 0, 0); h1 = __builtin_amdgcn_mfma_f32_16x16x32_bf16(b1f[q], af[q], h1, 0, 0, 0); }
            }
            { const int c0 = 32 * w + 8 * fq; float v[8];
#pragma unroll
              for (int e = 0; e < 8; ++e) { const float x = ((e >> 2) ? h1[e & 3] : h0[e & 3]) + c1s[kv * 256 + c0 + e]; const float y = 0.7978845608028654f * (x + 0.044715f * x * x * x); v[e] = x * sigmoidf_(2.0f * y); }
              u32x4 wv; wv.x = cvt_pk_bf16(v[0], v[1]); wv.y = cvt_pk_bf16(v[2], v[3]); wv.z = cvt_pk_bf16(v[4], v[5]); wv.w = cvt_pk_bf16(v[6], v[7]);
              *(LAS u32x4*)(hidL + fr * 528 + c0 * 2) = wv; }
            __syncthreads();
            if (w < 2) {
                const bf16_t* W2 = Wt_c2 + (size_t)(32 * w + fr) * 256 + 8 * fq;
                f32x4 oA = (f32x4){0.f, 0.f, 0.f, 0.f}, oB = oA;
#pragma unroll
                for (int q = 0; q < 8; ++q) {
                    const bf16x8 hf = *(const LAS bf16x8*)(hidL + fr * 528 + (32 * q + 8 * fq) * 2);
                    const bf16x8 wa = *(const bf16x8*)(W2 + 32 * q), wb = *(const bf16x8*)(W2 + 16 * 256 + 32 * q);
                    oA = __builtin_amdgcn_mfma_f32_16x16x32_bf16(wa, hf, oA, 0, 0, 0); oB = __builtin_amdgcn_mfma_f32_16x16x32_bf16(wb, hf, oB, 0, 0, 0);
                }
                const float* b2 = a.in[kv ? 12 : 7]; const int d0 = 16 * w + 4 * fq; const int row = r0 + fr, j = row & 511;
                f32x4 a1 = oA + *(const f32x4*)(b2 + d0), a2 = oB + *(const f32x4*)(b2 + d0 + 32);
                if (j == 511) { a1 = (f32x4){0.f, 0.f, 0.f, 0.f}; a2 = a1; }
                if (!kv) {
                    const int pos = (j == 511) ? 0 : 16 * j + 31;
                    const f32x4 cs = *(const f32x4*)(cosT + pos * 32 + d0), sn = *(const f32x4*)(sinT + pos * 32 + d0);
                    const f32x4 o1 = a1 * cs - a2 * sn, o2 = a1 * sn + a2 * cs;
                    bf16_t* p = KCC + (size_t)row * 64 + d0;
                    u32x2 w1; w1.x = cvt_pk_bf16(o1[0], o1[1]); w1.y = cvt_pk_bf16(o1[2], o1[3]); *(u32x2*)p = w1;
                    u32x2 w2; w2.x = cvt_pk_bf16(o2[0], o2[1]); w2.y = cvt_pk_bf16(o2[2], o2[3]); *(u32x2*)(p + 32) = w2;
                } else {
                    bf16_t* p = VCT + (size_t)(row >> 6) * 4096 + vperm(row & 63);
#pragma unroll
                    for (int e = 0; e < 4; ++e) { p[(d0 + e) * 64] = (bf16_t)(cvt_pk_bf16(a1[e], 0.f) & 0xffff); p[(d0 + 32 + e) * 64] = (bf16_t)(cvt_pk_bf16(a2[e], 0.f) & 0xffff); }
                }
            }
            __syncthreads();
        }
    }
    if (IN(2) && IN(4)) xcd_barrier(xbar);
    if (IN(4)) {
        att::Ctx X{Qb, KCC, VCT, KS, VST, KW, VWT, gates, Ob};
        for (int k = bx; k < 256; k += G) {
            for (int rep = 0; rep < 2; ++rep) { const int uu = rep ? 511 - k : k; const int c = 127 - (uu >> 2), bgi = uu & 3; att::unit(lds, X, bgi >> 1, bgi & 1, c, tid); }
        }
        if (defer) {
            int td = threadIdx.x; asm volatile("" : "+v"(td)); const int dl = td & 63, dw = __builtin_amdgcn_readfirstlane(td >> 6);
            LAS float* scr = (LAS float*)(lds + dw * 16384);
            for (int it = bx * 8 + dw; it < N_DEFER; it += 2048) ffn_weight_item(a, ws, scr, it, dl);
        }
    }
    SEAM(4);
    if (IN(5)) {
        pg8::Gemm g{Ob, Wt_out, M, D, D, D, 0}; pg8::StaticOrder S; S.init(M, D, G, bx);
        EpiRes E{a.in[0], out, XB, ssp, nullptr, nullptr};
        pg8::gemm_phase(lds, ldsx, g, S, E);
    }
    SEAM(5);
#pragma unroll
    for (int L = 0; L < 2; ++L) {
        const int pb = 6 + 5 * L;
        const float* cw = a.in[L ? 25 : 16]; const float* cb = a.in[L ? 26 : 17];
        if (IN(pb)) {
            pg8::Gemm g{XB, (const bf16_t*)(ws + (L ? WS_WUP1 : WS_WUP0)), M, UP, D, D, 0}; pg8::StaticOrder S; S.init(M, UP, G, bx);
            EpiUp E{ssp, cw, cb, ACT, HB, FB};
            pg8::gemm_phase(lds, ldsx, g, S, E);
        }
        SEAM(pb);
        if (IN(pb + 1)) {
            for (int i = bx * 512 + tid; i < 64 * FF; i += G * 512) {
                const int pm = i / FF, cidx = i % FF;
                float hg0 = 0.f, hg1 = 0.f, hv0 = 0.f, hv1 = 0.f;
                if (pm & 31) { const float* h = HB + (size_t)(pm - 1) * 2 * UP; hg0 = h[cidx]; hg1 = h[UP + cidx]; hv0 = h[FF + cidx]; hv1 = h[UP + FF + cidx]; }
                const float* f = FB + (size_t)pm * 2 * UP; const float fg0 = f[cidx], fg1 = f[UP + cidx], fv0 = f[FF + cidx], fv1 = f[UP + FF + cidx];
                const float g0 = cb[cidx] + cw[cidx] * hg0 + cw[UP + cidx] * hg1 + cw[2 * UP + cidx] * fg0;
                const float g1 = cb[cidx] + cw[cidx] * hg1 + cw[UP + cidx] * fg0 + cw[2 * UP + cidx] * fg1;
                const float v0 = cb[FF + cidx] + cw[FF + cidx] * hv0 + cw[UP + FF + cidx] * hv1 + cw[2 * UP + FF + cidx] * fv0;
                const float v1 = cb[FF + cidx] + cw[FF + cidx] * hv1 + cw[UP + FF + cidx] * fv0 + cw[2 * UP + FF + cidx] * fv1;
                ACT[(size_t)(pm * 256) * FF + cidx] = (bf16_t)f2bf(g0 * sigmoidf_(g0) * v0);
                ACT[(size_t)(pm * 256 + 1) * FF + cidx] = (bf16_t)f2bf(g1 * sigmoidf_(g1) * v1);
            }
        }
        SEAM(pb + 1);
        if (IN(pb + 2)) {
            pg8::Gemm g{ACT, (const bf16_t*)(ws + (L ? WS_WDN1 : WS_WDN0)), M, D, FF, FF, 0}; pg8::StaticOrder S; S.init(M, D, G, bx);
            if (L == 1 && G == 256) { EpiFinal E{out, a.in[28], (float*)(ws + WS_SSP + 512 * 1024), (unsigned*)(ws + 16384)}; pg8::gemm_phase(lds, ldsx, g, S, E); }
            else { EpiRes E{out, out, XB, ssp, nullptr, nullptr}; pg8::gemm_phase(lds, ldsx, g, S, E); }
        }
        if (!(L == 1 && G == 256)) SEAM(pb + 2);
        if (L == 0) {
            if (IN(9)) {
                LAS float* rsd = (LAS float*)lds;
                const float* gn = a.in[19];
                int tid = threadIdx.x; asm volatile("" : "+v"(tid));
                const int q = tid & 255, strip = tid >> 8, c4 = q * 4, wsz = 2 << (c4 >> 8), t0 = strip * 32;
                const f32x4 gv = *(const f32x4*)(gn + c4);
                for (int tile = bx; tile < 256; tile += G) {
                    const int r0 = tile * 64; const int tb = r0 & (T - 1);
                    __syncthreads();
                    if (tid < 80) { const int rr = r0 - 16 + tid; rsd[tid] = (tb - 16 + tid >= 0) ? row_rstd(ssp, 4, rr) : 0.f; }
                    __syncthreads();
                    const float* xb0 = out + (size_t)r0 * D + c4;
#define POOL_H(tl) (*(const f32x4*)(xb0 + (ptrdiff_t)(tl) * D) * rsd[16 + (tl)])
                    f32x4 sw = (f32x4){0.f, 0.f, 0.f, 0.f};
                    for (int i = 1; i <= wsz; ++i) { const int tl = t0 - i; if (tb + tl >= 0) sw += POOL_H(tl); }
#pragma unroll 4
                    for (int tl = t0; tl < t0 + 32; ++tl) {
                        const f32x4 hv = POOL_H(tl); sw += hv;
                        const int td = tl - wsz; if (tb + td >= 0) sw -= POOL_H(td);
                        const int t = tb + tl; const int cnt = (t + 1 < wsz) ? t + 1 : wsz;
                        const f32x4 pvv = (sw * (1.0f / (float)cnt) - hv) * gv;
                        u32x2 wv; wv.x = cvt_pk_bf16(pvv[0], pvv[1]); wv.y = cvt_pk_bf16(pvv[2], pvv[3]);
                        *(u32x2*)(POOLED + (size_t)(r0 + tl) * D + c4) = wv;
                    }
#undef POOL_H
                }
                __syncthreads();
            }
            SEAM(9);
            if (IN(10)) {
                pg8::Gemm g{POOLED, Wt_pool, M, D, 256, D, 512}; pg8::StaticOrder S; S.init(M, D, G, bx);
                EpiRes E{out, out, XB, ssp, a.in[21], a.in[22]};
                pg8::gemm_phase(lds, ldsx, g, S, E);
            }
            SEAM(10);
        }
    }
    if (IN(14) && G != 256) {
        int t14 = threadIdx.x; asm volatile("" : "+v"(t14)); const int lane = t14 & 63, wave = __builtin_amdgcn_readfirstlane(t14 >> 6);
        const int gw = bx * 8 + wave, NGW = G * 8; const float* gn = a.in[28];
        for (int m = gw; m < M; m += NGW) {
            const float rs = row_rstd(ssp, 4, m); f32x4* xr = (f32x4*)(out + (size_t)m * D) + lane; const f32x4* gr = (const f32x4*)gn + lane;
#pragma unroll
            for (int j = 0; j < 4; ++j) xr[64 * j] = xr[64 * j] * rs * gr[64 * j];
        }
    }
#undef IN
#undef SEAM
#undef cosT
#undef sinT
#undef ssp
#undef c1p
#undef rstdv
#undef HB
#undef FB
#undef gates
#undef Wt_in
#undef Wt_out
#undef Wt_pool
#undef Wt_c1
#undef Wt_c2
#undef XB
#undef Qb
#undef KC
#undef VC
#undef KS
#undef VST
#undef KW
#undef VWT
#undef KCC
#undef VCT
#undef Ob
#undef ACT
#undef POOLED
}

extern "C" void kernel_launch(void* const* d_in, const int* in_sizes, int n_in, void* d_out, int out_size, void* d_ws, size_t ws_size, hipStream_t stream) {
    static int grid = 0;
    if (grid == 0) {
        int dev = 0, cus = 0, per_cu = 0;
        hipGetDevice(&dev); hipDeviceGetAttribute(&cus, hipDeviceAttributeMultiprocessorCount, dev);
        hipFuncSetAttribute((const void*)mk_fwd, hipFuncAttributeMaxDynamicSharedMemorySize, LDS_BYTES);
        hipOccupancyMaxActiveBlocksPerMultiprocessor(&per_cu, (const void*)mk_fwd, 512, LDS_BYTES);
        if (per_cu < 1) per_cu = 1;
        grid = cus * per_cu; if (grid > 256) grid = 256;
        (void)hipGetLastError();
    }
    Args a{};
    for (int i = 0; i < 29; ++i) a.in[i] = (const float*)d_in[i];
    a.out = (float*)d_out; a.ws = (unsigned char*)d_ws;
    for (int i = 0; i < 32; ++i) a.inv[i] = 1.0f / powf(10000.0f, (float)(2 * i) / 64.0f);
    a.ph_lo = 0; a.ph_hi = 15;
    hipMemsetAsync(d_ws, 0, 65536, stream);
    void* args[] = {&a};
    hipError_t e = hipLaunchCooperativeKernel((const void*)mk_fwd, dim3(grid), dim3(512), args, LDS_BYTES, stream);
    if (e != hipSuccess) fprintf(stderr, "cooperative launch failed: %s (grid %d)\n", hipGetErrorString(e), grid);
}
```

```cpp
#include <hip/hip_runtime.h>
#include <hip/hip_cooperative_groups.h>
#include <cstdio>
#include <cstdint>
namespace cg = cooperative_groups;

#define LAS __attribute__((address_space(3)))
typedef unsigned short bf16_t;
typedef short bf16x8 __attribute__((ext_vector_type(8)));
typedef short s16x4 __attribute__((ext_vector_type(4)));
typedef float f32x4 __attribute__((ext_vector_type(4)));
typedef unsigned u32x4 __attribute__((ext_vector_type(4)));
typedef unsigned u32x2 __attribute__((ext_vector_type(2)));

constexpr int T = 8192, D = 1024, M = 16384, FF = 2816, UP = 5632, NIN = 2048;
constexpr float EPS = 1e-6f;
constexpr float QSCALE = 0.125f * 1.4426950408889634f;
constexpr size_t MiB = 1u << 20;
constexpr size_t WS_ROPE = 1 * MiB;
constexpr size_t WS_SSP = 3 * MiB;
constexpr size_t WS_C1P = 4 * MiB;
constexpr size_t WS_RSTD = 4 * MiB + 256 * 1024;
constexpr size_t WS_HB = 5 * MiB;
constexpr size_t WS_FB = 8 * MiB;
constexpr size_t WS_GATE = 11 * MiB;
constexpr size_t WS_WIN = 16 * MiB, WS_WOUT = 20 * MiB, WS_WUP0 = 22 * MiB, WS_WUP1 = 33 * MiB, WS_WDN0 = 44 * MiB, WS_WDN1 = 50 * MiB;
constexpr size_t WS_WPOOL = 56 * MiB, WS_WC1K = 57 * MiB, WS_WC1V = 58 * MiB, WS_WC2K = 59 * MiB, WS_WC2V = 59 * MiB + 512 * 1024;
constexpr size_t WS_XB = 64 * MiB;
constexpr size_t WS_Q = 96 * MiB;
constexpr size_t WS_KC = 128 * MiB, WS_VC = 132 * MiB, WS_KS = 136 * MiB, WS_VST = 140 * MiB, WS_KW = 144 * MiB, WS_VWT = 148 * MiB;
constexpr size_t WS_KCC = 152 * MiB, WS_VCT = 153 * MiB, WS_HIDK = 154 * MiB, WS_HIDV = 155 * MiB;
constexpr size_t WS_O = 160 * MiB;
constexpr size_t WS_ACT = 96 * MiB;
constexpr size_t WS_POOLED = 192 * MiB;
constexpr int LDS_RING = 131072, LDS_BYTES = 155648;

__device__ __forceinline__ unsigned cvt_pk_bf16(float lo, float hi) { unsigned r; asm volatile("v_cvt_pk_bf16_f32 %0, %1, %2" : "=v"(r) : "v"(lo), "v"(hi)); return r; }
__device__ __forceinline__ float bf2f(unsigned short b) { return __uint_as_float((unsigned)b << 16); }
__device__ __forceinline__ float ex2(float x) { return __builtin_amdgcn_exp2f(x); }
__device__ __forceinline__ float rcp(float x) { return __builtin_amdgcn_rcpf(x); }
__device__ __forceinline__ float sigmoidf_(float x) { return rcp(1.0f + ex2(-1.4426950408889634f * x)); }
__device__ __forceinline__ int perm8(int a) { return (a & ~31) | (16 * ((a >> 2) & 1) + 4 * ((a >> 3) & 3) + (a & 3)); }
__device__ __forceinline__ int vperm(int kk) { return (kk & 32) | (((kk >> 2) & 3) << 3) | (((kk >> 4) & 1) << 2) | (kk & 3); }
__device__ __forceinline__ int swap45(int a) { return (a & ~48) | (((a >> 4) & 1) << 5) | (((a >> 5) & 1) << 4); }
template <int CTRL> __device__ __forceinline__ float dppf(float x) { return __builtin_bit_cast(float, __builtin_amdgcn_mov_dpp(__builtin_bit_cast(int, x), CTRL, 0xf, 0xf, true)); }
__device__ __forceinline__ float xrow16_max(float x) {
    auto s = __builtin_amdgcn_permlane16_swap(__float_as_uint(x), __float_as_uint(x), false, false); x = fmaxf(__uint_as_float(s[0]), __uint_as_float(s[1]));
    auto t = __builtin_amdgcn_permlane32_swap(__float_as_uint(x), __float_as_uint(x), false, false); return fmaxf(__uint_as_float(t[0]), __uint_as_float(t[1])); }
__device__ __forceinline__ float xrow16_sum(float x) {
    auto s = __builtin_amdgcn_permlane16_swap(__float_as_uint(x), __float_as_uint(x), false, false); x = __uint_as_float(s[0]) + __uint_as_float(s[1]);
    auto t = __builtin_amdgcn_permlane32_swap(__float_as_uint(x), __float_as_uint(x), false, false); return __uint_as_float(t[0]) + __uint_as_float(t[1]); }
__device__ __forceinline__ float sum8(float x) { x += dppf<0xB1>(x); x += dppf<0x4E>(x); x += dppf<0x141>(x); return x; }
#define LDS_WAIT() asm volatile("s_waitcnt lgkmcnt(0)" ::: "memory")
#define WG_BAR() do { asm volatile("s_waitcnt lgkmcnt(0)" ::: "memory"); __builtin_amdgcn_s_barrier(); asm volatile("" ::: "memory"); } while (0)

namespace pg8 {
constexpr int BM = 256, BK = 64, HALF = 128, HTB = HALF * BK * 2, NXCD = 8, WGM = 8;
__host__ __device__ __forceinline__ int lds_byte(int r, int c) { const int st = (r >> 4) * 2 + (c >> 5), rr = r & 15, cc = c & 31, ob = rr * 64 + cc * 2; return st * 1024 + (ob ^ (((ob >> 9) & 1) << 5)); }
__host__ __device__ __forceinline__ void stage_rc(int b, int& R, int& C) { const int st = b / 1024, sb = b % 1024, swz = sb ^ (((sb >> 9) & 1) << 5); R = (st >> 1) * 16 + swz / 64; C = (st & 1) * 32 + (swz % 64) / 2; }
struct Unit { int pm, pn; };
struct Gemm { const bf16_t* A; const bf16_t* Bt; int M, N, K, lda, apn; };
struct StaticOrder {
    int nM, nN, nwg, G, c;
    __device__ void init(int M_, int N_, int G_, int c_) { nM = M_ / BM; nN = N_ / BM; nwg = nM * nN; G = G_; c = c_; }
    __device__ bool next(int i, Unit& u) const {
        const long L = (long)i * G + c; if (L >= nwg) return false;
        int wgid = (int)L; { const int q = nwg / NXCD, r = nwg % NXCD, xcd = wgid % NXCD, off = wgid / NXCD; wgid = (xcd < r ? xcd * (q + 1) : r * (q + 1) + (xcd - r) * q) + off; }
        const int nig = WGM * nN, gid = wgid / nig, fm = gid * WGM, gsz = (nM - fm) < WGM ? (nM - fm) : WGM;
        u.pm = fm + ((wgid % nig) % gsz); u.pn = (wgid % nig) / gsz; return true;
    }
};
template <class Epi>
__device__ __forceinline__ void gemm_phase(LAS unsigned char* lds, LAS unsigned char* ldsx, const Gemm g, const StaticOrder& S, const Epi& E) {
    int tid = threadIdx.x; asm volatile("" : "+v"(tid));
    const int wid = __builtin_amdgcn_readfirstlane(tid >> 6), lane = tid & 63, wr = wid >> 2, wc = wid & 3, fr = lane & 15, fq = lane >> 4;
    const int K = g.K, nt = K / BK;
    unsigned voffA[2], voffB[2];
#pragma unroll
    for (int i = 0; i < 2; ++i) { int R, C; stage_rc(tid * 16 + i * 8192, R, C); voffA[i] = (unsigned)(R * g.lda + C) * 2u; voffB[i] = (unsigned)(R * K + C) * 2u; }
    const size_t kstep = (size_t)(BK * 2);
    const size_t hstepA = (size_t)HALF * g.lda * 2, tstepA = 2 * hstepA, hstepB = (size_t)HALF * K * 2, tstepB = 2 * hstepB;
    const unsigned ldsw = (unsigned)wid * 1024u;
    const int aoff = lds_byte(wr * 64 + fr, fq * 8), boff = lds_byte(wc * 32 + fr, fq * 8);
#define PG8_SA(b, h) (((b) * 2 + (h)) * HTB)
#define PG8_SB(b, h) ((4 + (b) * 2 + (h)) * HTB)
#define PG8_STAGE(bufoff, gbase, voff) do { _Pragma("unroll") for (int _i = 0; _i < 2; ++_i) \
        __builtin_amdgcn_global_load_lds((const unsigned*)((const char*)(gbase) + (voff)[_i]), (LAS unsigned*)(lds + (bufoff) + ldsw + _i * 8192), 16, 0, 0); } while (0)
#define PG8_LDA(dst, b, h) do { _Pragma("unroll") for (int m = 0; m < 4; ++m) _Pragma("unroll") for (int k = 0; k < 2; ++k) dst[m][k] = *(const LAS bf16x8*)(lds + PG8_SA(b, h) + aoff + m * 2048 + k * 1024); } while (0)
#define PG8_LDB(dst, b, h) do { _Pragma("unroll") for (int n = 0; n < 2; ++n) _Pragma("unroll") for (int k = 0; k < 2; ++k) dst[n][k] = *(const LAS bf16x8*)(lds + PG8_SB(b, h) + boff + n * 2048 + k * 1024); } while (0)
#define PG8_MMA(ai, bj, At, Bt) do { __builtin_amdgcn_s_setprio(1); _Pragma("unroll") for (int m = 0; m < 4; ++m) _Pragma("unroll") for (int n = 0; n < 2; ++n) _Pragma("unroll") for (int k = 0; k < 2; ++k) \
        acc[ai][bj][m][n] = __builtin_amdgcn_mfma_f32_16x16x32_bf16(Bt[n][k], At[m][k], acc[ai][bj][m][n], 0, 0, 0); __builtin_amdgcn_s_setprio(0); } while (0)
#define PG8_WAIT_V(n) asm volatile("s_waitcnt vmcnt(" #n ")" ::: "memory")
#define PG8_WAIT_L(n) asm volatile("s_waitcnt lgkmcnt(" #n ")" ::: "memory")
#define PG8_BAR __builtin_amdgcn_s_barrier()
#define PG8_SCHED __builtin_amdgcn_sched_barrier(0)
    Unit cur, nxt; int ui = 0;
    if (!S.next(0, cur)) return;
    f32x4 acc[2][2][4][2];
#pragma unroll
    for (int a = 0; a < 2; ++a)
#pragma unroll
        for (int b = 0; b < 2; ++b)
#pragma unroll
            for (int m = 0; m < 4; ++m)
#pragma unroll
                for (int n = 0; n < 2; ++n) acc[a][b][m][n] = (f32x4){0.f, 0.f, 0.f, 0.f};
    bf16x8 At[4][2], B0[2][2], B1[2][2];
    const char* cA = (const char*)g.A + (size_t)cur.pm * tstepA + (size_t)cur.pn * g.apn; const char* cB = (const char*)g.Bt + (size_t)cur.pn * tstepB;
    PG8_STAGE(PG8_SB(0, 0), cB, voffB); PG8_STAGE(PG8_SB(0, 1), cB + hstepB, voffB); PG8_STAGE(PG8_SA(0, 0), cA, voffA); PG8_STAGE(PG8_SA(0, 1), cA + hstepA, voffA);
    if (wr == 1) PG8_BAR;
    PG8_WAIT_V(2); PG8_BAR;
    PG8_STAGE(PG8_SB(1, 0), cB + kstep, voffB); PG8_STAGE(PG8_SA(1, 0), cA + kstep, voffA); PG8_STAGE(PG8_SB(1, 1), cB + hstepB + kstep, voffB);
    PG8_WAIT_V(6); PG8_BAR;
    for (;;) {
        const bool has_next = S.next(ui + 1, nxt);
        const char* nA = has_next ? (const char*)g.A + (size_t)nxt.pm * tstepA + (size_t)nxt.pn * g.apn : cA; const char* nB = has_next ? (const char*)g.Bt + (size_t)nxt.pn * tstepB : cB;
        for (int t = 0; t < nt; t += 2) {
            const bool last = (t == nt - 2);
            const char* a1 = cA + (size_t)(t + 1) * kstep;
            const char* a2 = last ? nA : cA + (size_t)(t + 2) * kstep; const char* b2 = last ? nB : cB + (size_t)(t + 2) * kstep;
            const char* a3 = a2 + kstep; const char* b3 = b2 + kstep;
            PG8_LDB(B0, 0, 0); PG8_LDB(B1, 0, 1); PG8_SCHED; PG8_LDA(At, 0, 0); PG8_STAGE(PG8_SA(1, 1), a1 + hstepA, voffA);
            PG8_WAIT_V(8); PG8_WAIT_L(0); PG8_BAR; PG8_MMA(0, 0, At, B0); PG8_MMA(0, 1, At, B1); PG8_BAR; PG8_SCHED;
            PG8_LDA(At, 0, 1); PG8_STAGE(PG8_SB(0, 0), b2, voffB); PG8_STAGE(PG8_SB(0, 1), b2 + hstepB, voffB); PG8_STAGE(PG8_SA(0, 0), a2, voffA);
            PG8_WAIT_V(8); PG8_WAIT_L(0); PG8_BAR; PG8_MMA(1, 0, At, B0); PG8_MMA(1, 1, At, B1); PG8_BAR; PG8_SCHED;
            PG8_LDB(B0, 1, 0); PG8_LDB(B1, 1, 1); PG8_SCHED; PG8_LDA(At, 1, 0); PG8_STAGE(PG8_SA(0, 1), a2 + hstepA, voffA);
            PG8_WAIT_V(8); PG8_WAIT_L(0); PG8_BAR; PG8_MMA(0, 0, At, B0); PG8_MMA(0, 1, At, B1); PG8_BAR; PG8_SCHED;
            PG8_LDA(At, 1, 1); PG8_STAGE(PG8_SB(1, 0), b3, voffB); PG8_STAGE(PG8_SB(1, 1), b3 + hstepB, voffB); PG8_STAGE(PG8_SA(1, 0), a3, voffA);
            PG8_WAIT_V(8); PG8_WAIT_L(0); PG8_BAR; PG8_MMA(1, 0, At, B0); PG8_MMA(1, 1, At, B1); PG8_BAR; PG8_SCHED;
        }
        if (wr == 0) PG8_BAR;
        { int t2 = threadIdx.x; asm volatile("" : "+v"(t2));
          E(acc, cur, wr, wc, t2 & 15, (t2 & 63) >> 4, ldsx, t2); }
        if (!has_next) break;
#pragma unroll
        for (int a = 0; a < 2; ++a)
#pragma unroll
            for (int b = 0; b < 2; ++b)
#pragma unroll
                for (int m = 0; m < 4; ++m)
#pragma unroll
                    for (int n = 0; n < 2; ++n) acc[a][b][m][n] = (f32x4){0.f, 0.f, 0.f, 0.f};
        cur = nxt; cA = nA; cB = nB; ++ui;
        if (wr == 1) PG8_BAR;
    }
    PG8_WAIT_V(0);
    PG8_BAR;
#undef PG8_SA
#undef PG8_SB
#undef PG8_STAGE
#undef PG8_LDA
#undef PG8_LDB
#undef PG8_MMA
#undef PG8_WAIT_V
#undef PG8_WAIT_L
#undef PG8_BAR
#undef PG8_SCHED
}
}
using pg8::Unit;
typedef f32x4 Acc[2][2][4][2];

__device__ __forceinline__ float row_rstd(const float* ssp, int np, int row) {
    float s = 0.f; for (int i = 0; i < np; ++i) s += ssp[(size_t)i * M + row];
    return 1.0f / sqrtf(s * (1.0f / D) + EPS);
}

struct EpiIn {
    const float* rstdv; const float* cosT; const float* sinT;
    bf16_t *Q, *KC, *VC, *KS, *VST, *KW, *VWT; float* gates;
    __device__ __forceinline__ void operator()(Acc& acc, const Unit& u, int wr, int wc, int fr, int fq, LAS unsigned char*, int) const {
#pragma unroll
        for (int ai = 0; ai < 2; ++ai)
#pragma unroll
            for (int m = 0; m < 4; ++m) {
                const int row = u.pm * 256 + ai * 128 + wr * 64 + m * 16 + fr; const float rs = rstdv[row];
                const int t = row & (T - 1), b = row >> 13;
                const int d0 = 16 * (wc & 1) + 4 * fq;
                const f32x4 cs = *(const f32x4*)(cosT + t * 32 + d0), sn = *(const f32x4*)(sinT + t * 32 + d0);
#pragma unroll
                for (int bj = 0; bj < 2; ++bj) {
                    f32x4 a1 = acc[ai][bj][m][0] * rs, a2 = acc[ai][bj][m][1] * rs;
                    if (u.pn == 7) {
                        if (bj == 0) {
#pragma unroll
                            for (int n = 0; n < 2; ++n) { const int c0 = 32 * wc + 16 * n + 4 * fq; if (c0 < 48) { const f32x4 v = n ? a2 : a1; f32x4 o; o[0] = sigmoidf_(v[0]); o[1] = sigmoidf_(v[1]); o[2] = sigmoidf_(v[2]); o[3] = sigmoidf_(v[3]); *(f32x4*)(gates + (size_t)row * 48 + c0) = o; } }
                        }
                        continue;
                    }
                    const int hh = 2 * bj + (wc >> 1);
                    bool rope; if (u.pn < 4) rope = true; else rope = (u.pn >= 5) && (hh < 2);
                    f32x4 o1 = a1, o2 = a2;
                    if (rope) { o1 = a1 * cs - a2 * sn; o2 = a1 * sn + a2 * cs; }
                    if (u.pn < 4) {
                        o1 = o1 * QSCALE; o2 = o2 * QSCALE;
                        bf16_t* p = Q + (size_t)row * 1024 + (u.pn * 4 + hh) * 64 + d0;
                        u32x2 w1; w1.x = cvt_pk_bf16(o1[0], o1[1]); w1.y = cvt_pk_bf16(o1[2], o1[3]); *(u32x2*)p = w1;
                        u32x2 w2; w2.x = cvt_pk_bf16(o2[0], o2[1]); w2.y = cvt_pk_bf16(o2[2], o2[3]); *(u32x2*)(p + 32) = w2;
                    } else {
                        const int gg = hh & 1; const bool isv = hh >= 2;
                        if (!isv) {
                            bf16_t* base = (u.pn == 4) ? KC : (u.pn == 5) ? KS : KW;
                            bf16_t* p = base + ((size_t)(b * 2 + gg) * T + t) * 64 + d0;
                            u32x2 w1; w1.x = cvt_pk_bf16(o1[0], o1[1]); w1.y = cvt_pk_bf16(o1[2], o1[3]); *(u32x2*)p = w1;
                            u32x2 w2; w2.x = cvt_pk_bf16(o2[0], o2[1]); w2.y = cvt_pk_bf16(o2[2], o2[3]); *(u32x2*)(p + 32) = w2;
                        } else if (u.pn == 4) {
                            bf16_t* p = VC + ((size_t)(b * 2 + gg) * T + t) * 64 + d0;
                            u32x2 w1; w1.x = cvt_pk_bf16(o1[0], o1[1]); w1.y = cvt_pk_bf16(o1[2], o1[3]); *(u32x2*)p = w1;
                            u32x2 w2; w2.x = cvt_pk_bf16(o2[0], o2[1]); w2.y = cvt_pk_bf16(o2[2], o2[3]); *(u32x2*)(p + 32) = w2;
                        } else {
                            bf16_t* base = (u.pn == 5) ? VST : VWT;
                            bf16_t* p = base + ((size_t)(b * 2 + gg) * 128 + (t >> 6)) * 4096 + vperm(t & 63);
#pragma unroll
                            for (int j = 0; j < 4; ++j) { p[(d0 + j) * 64] = (bf16_t)(cvt_pk_bf16(o1[j], 0.f) & 0xffff); p[(d0 + 32 + j) * 64] = (bf16_t)(cvt_pk_bf16(o2[j], 0.f) & 0xffff); }
                        }
                    }
                }
                asm volatile("" ::: "memory"); __builtin_amdgcn_sched_barrier(0);
            }
    }
};

struct EpiC1 {
    bf16_t* hid;
    __device__ __forceinline__ void operator()(Acc& acc, const Unit& u, int wr, int wc, int fr, int fq, LAS unsigned char* ldsx, int) const {
        const LAS float* c1 = (const LAS float*)ldsx;
#pragma unroll
        for (int bj = 0; bj < 2; ++bj) {
            const int c0 = 128 * bj + 32 * wc + 8 * fq;
            const f32x4 bA = *(const LAS f32x4*)(c1 + c0), bB = *(const LAS f32x4*)(c1 + c0 + 4);
#pragma unroll
            for (int ai = 0; ai < 2; ++ai)
#pragma unroll
                for (int m = 0; m < 4; ++m) {
                    const int row = u.pm * 256 + ai * 128 + wr * 64 + m * 16 + fr;
                    float v[8];
#pragma unroll
                    for (int e = 0; e < 8; ++e) { const float x = acc[ai][bj][m][e >> 2][e & 3] + ((e >> 2) ? bB[e & 3] : bA[e & 3]); const float y = 0.7978845608028654f * (x + 0.044715f * x * x * x); v[e] = x * sigmoidf_(2.0f * y); }
                    u32x4 w; w.x = cvt_pk_bf16(v[0], v[1]); w.y = cvt_pk_bf16(v[2], v[3]); w.z = cvt_pk_bf16(v[4], v[5]); w.w = cvt_pk_bf16(v[6], v[7]);
                    *(u32x4*)(hid + (size_t)row * 256 + c0) = w;
                    asm volatile("" ::: "memory"); __builtin_amdgcn_sched_barrier(0);
                }
        }
    }
};
struct EpiC2 {
    const float* b2; const float* cosT; const float* sinT; bf16_t* out; int isv;
    __device__ __forceinline__ void operator()(Acc& acc, const Unit& u, int wr, int wc, int fr, int fq, LAS unsigned char*, int) const {
        if (wc >= 2) return;
        const int d0 = 16 * (wc & 1) + 4 * fq;
        const f32x4 bA = *(const f32x4*)(b2 + d0), bB = *(const f32x4*)(b2 + d0 + 32);
#pragma unroll
        for (int ai = 0; ai < 2; ++ai)
#pragma unroll
            for (int m = 0; m < 4; ++m) {
                const int row = u.pm * 256 + ai * 128 + wr * 64 + m * 16 + fr; const int j = row & 511;
                f32x4 a1 = acc[ai][0][m][0] + bA, a2 = acc[ai][0][m][1] + bB;
                if (j == 511) { a1 = (f32x4){0.f, 0.f, 0.f, 0.f}; a2 = a1; }
                if (!isv) {
                    const int pos = (j == 511) ? 0 : 16 * j + 31;
                    const f32x4 cs = *(const f32x4*)(cosT + pos * 32 + d0), sn = *(const f32x4*)(sinT + pos * 32 + d0);
                    const f32x4 o1 = a1 * cs - a2 * sn, o2 = a1 * sn + a2 * cs;
                    bf16_t* p = out + (size_t)row * 64 + d0;
                    u32x2 w1; w1.x = cvt_pk_bf16(o1[0], o1[1]); w1.y = cvt_pk_bf16(o1[2], o1[3]); *(u32x2*)p = w1;
                    u32x2 w2; w2.x = cvt_pk_bf16(o2[0], o2[1]); w2.y = cvt_pk_bf16(o2[2], o2[3]); *(u32x2*)(p + 32) = w2;
                } else {
                    bf16_t* p = out + (size_t)(row >> 6) * 4096 + vperm(row & 63);
#pragma unroll
                    for (int e = 0; e < 4; ++e) { p[(d0 + e) * 64] = (bf16_t)(cvt_pk_bf16(a1[e], 0.f) & 0xffff); p[(d0 + 32 + e) * 64] = (bf16_t)(cvt_pk_bf16(a2[e], 0.f) & 0xffff); }
                }
                asm volatile("" ::: "memory"); __builtin_amdgcn_sched_barrier(0);
            }
    }
};

struct EpiRes {
    const float* xold; float* xnew; bf16_t* xb; float* ssp; const float* pb; const float* ps;
    __device__ __forceinline__ void operator()(Acc& acc, const Unit& u, int wr, int wc, int fr, int fq, LAS unsigned char* ldsx, int tid) const {
#pragma unroll
        for (int ai = 0; ai < 2; ++ai)
#pragma unroll
            for (int m = 0; m < 4; ++m) {
                const int row = u.pm * 256 + ai * 128 + wr * 64 + m * 16 + fr; float ss = 0.f;
#pragma unroll
                for (int bj = 0; bj < 2; ++bj) {
                    const int col = u.pn * 256 + 128 * bj + 32 * wc + 8 * fq; const size_t off = (size_t)row * D + col;
                    f32x4 a0 = acc[ai][bj][m][0], a1 = acc[ai][bj][m][1];
                    if (pb) { a0 = (a0 + *(const f32x4*)(pb + col)) * *(const f32x4*)(ps + col); a1 = (a1 + *(const f32x4*)(pb + col + 4)) * *(const f32x4*)(ps + col + 4); }
                    const f32x4 x0 = *(const f32x4*)(xold + off) + a0, x1 = *(const f32x4*)(xold + off + 4) + a1;
                    *(f32x4*)(xnew + off) = x0; *(f32x4*)(xnew + off + 4) = x1;
                    u32x4 w; w.x = cvt_pk_bf16(x0[0], x0[1]); w.y = cvt_pk_bf16(x0[2], x0[3]); w.z = cvt_pk_bf16(x1[0], x1[1]); w.w = cvt_pk_bf16(x1[2], x1[3]);
                    *(u32x4*)(xb + off) = w;
                    ss += (x0[0] * x0[0] + x0[1] * x0[1]) + (x0[2] * x0[2] + x0[3] * x0[3]) + (x1[0] * x1[0] + x1[1] * x1[1]) + (x1[2] * x1[2] + x1[3] * x1[3]);
                    asm volatile("" ::: "memory"); __builtin_amdgcn_sched_barrier(0);
                }
                ss = xrow16_sum(ss);
                if (fq == 0) ((LAS float*)ldsx)[wc * 256 + ai * 128 + wr * 64 + m * 16 + fr] = ss;
            }
        WG_BAR();
        if (tid < 256) { const LAS float* rd = (const LAS float*)ldsx; ssp[(size_t)u.pn * M + u.pm * 256 + tid] = (rd[tid] + rd[256 + tid]) + (rd[512 + tid] + rd[768 + tid]); }
        WG_BAR();
    }
};

struct EpiFinal {
    float* x; const float* gain; float* ssx; unsigned* cnt;
    __device__ __forceinline__ void operator()(Acc& acc, const Unit& u, int wr, int wc, int fr, int fq, LAS unsigned char* ldsx, int tid) const {
        LAS float* red = (LAS float*)ldsx; LAS float* rsl = (LAS float*)(ldsx + 4096);
#pragma unroll
        for (int ai = 0; ai < 2; ++ai)
#pragma unroll
            for (int m = 0; m < 4; ++m) {
                const int row = u.pm * 256 + ai * 128 + wr * 64 + m * 16 + fr; float ss = 0.f;
#pragma unroll
                for (int bj = 0; bj < 2; ++bj) {
                    const int col = u.pn * 256 + 128 * bj + 32 * wc + 8 * fq; const size_t off = (size_t)row * D + col;
                    const f32x4 x0 = *(const f32x4*)(x + off) + acc[ai][bj][m][0], x1 = *(const f32x4*)(x + off + 4) + acc[ai][bj][m][1];
                    acc[ai][bj][m][0] = x0; acc[ai][bj][m][1] = x1;
                    ss += (x0[0] * x0[0] + x0[1] * x0[1]) + (x0[2] * x0[2] + x0[3] * x0[3]) + (x1[0] * x1[0] + x1[1] * x1[1]) + (x1[2] * x1[2] + x1[3] * x1[3]);
                    asm volatile("" ::: "memory"); __builtin_amdgcn_sched_barrier(0);
                }
                ss = xrow16_sum(ss);
                if (fq == 0) red[wc * 256 + ai * 128 + wr * 64 + m * 16 + fr] = ss;
            }
        WG_BAR();
        if (tid < 256) __hip_atomic_store(ssx + (size_t)u.pn * M + u.pm * 256 + tid, (red[tid] + red[256 + tid]) + (red[512 + tid] + red[768 + tid]), __ATOMIC_RELAXED, __HIP_MEMORY_SCOPE_AGENT);
        asm volatile("s_waitcnt vmcnt(0)" ::: "memory");
        WG_BAR();
        if (tid == 0) {
            unsigned* c = cnt + 64 * u.pm;
            __hip_atomic_fetch_add(c, 1u, __ATOMIC_RELAXED, __HIP_MEMORY_SCOPE_AGENT);
            unsigned spins = 0;
            while (__hip_atomic_load(c, __ATOMIC_RELAXED, __HIP_MEMORY_SCOPE_AGENT) < 4u) { __builtin_amdgcn_s_sleep(2); if (++spins > (1u << 22)) break; }
            __builtin_amdgcn_fence(__ATOMIC_ACQUIRE, "agent");
            asm volatile("s_waitcnt vmcnt(0)" ::: "memory");
        }
        WG_BAR();
        if (tid < 256) {
            const float* p = ssx + u.pm * 256 + tid;
            const float sq = (__hip_atomic_load(p, __ATOMIC_RELAXED, __HIP_MEMORY_SCOPE_AGENT) + __hip_atomic_load(p + M, __ATOMIC_RELAXED, __HIP_MEMORY_SCOPE_AGENT)) +
                             (__hip_atomic_load(p + 2 * M, __ATOMIC_RELAXED, __HIP_MEMORY_SCOPE_AGENT) + __hip_atomic_load(p + 3 * M, __ATOMIC_RELAXED, __HIP_MEMORY_SCOPE_AGENT));
            rsl[tid] = 1.0f / sqrtf(sq * (1.0f / D) + EPS);
        }
        WG_BAR();
#pragma unroll
        for (int ai = 0; ai < 2; ++ai)
#pragma unroll
            for (int m = 0; m < 4; ++m) {
                const int rl = ai * 128 + wr * 64 + m * 16 + fr; const float rs = rsl[rl]; const int row = u.pm * 256 + rl;
#pragma unroll
                for (int bj = 0; bj < 2; ++bj) {
                    const int col = u.pn * 256 + 128 * bj + 32 * wc + 8 * fq; const size_t off = (size_t)row * D + col;
                    *(f32x4*)(x + off) = acc[ai][bj][m][0] * rs * *(const f32x4*)(gain + col); *(f32x4*)(x + off + 4) = acc[ai][bj][m][1] * rs * *(const f32x4*)(gain + col + 4);
                }
                asm volatile("" ::: "memory"); __builtin_amdgcn_sched_barrier(0);
            }
    }
};

struct EpiUp {
    const float* ssp; const float* cw; const float* cb; bf16_t* act; float* HB; float* FB;
    __device__ __forceinline__ void operator()(Acc& acc, const Unit& u, int wr, int wc, int fr, int fq, LAS unsigned char* ldsx, int tid) const {
        LAS float* Hl = (LAS float*)ldsx;
        LAS float* rsl = (LAS float*)(ldsx + 10240);
        const int lane = tid & 63;
        if (tid < 256) { const int row = u.pm * 256 + tid; const float sq = (ssp[row] + ssp[M + row]) + (ssp[2 * M + row] + ssp[3 * M + row]); rsl[tid] = 1.0f / sqrtf(sq * (1.0f / D) + EPS); }
        WG_BAR();
#pragma unroll
        for (int ai = 0; ai < 2; ++ai)
#pragma unroll
            for (int m = 0; m < 4; ++m) {
                const float rs = rsl[ai * 128 + wr * 64 + m * 16 + fr];
#pragma unroll
                for (int bj = 0; bj < 2; ++bj) { acc[ai][bj][m][0] *= rs; acc[ai][bj][m][1] *= rs; }
                asm volatile("" ::: "memory"); __builtin_amdgcn_sched_barrier(0);
            }
        if (tid < 128) *(LAS f32x4*)(Hl + tid * 4) = (f32x4){0.f, 0.f, 0.f, 0.f};
#pragma unroll
        for (int ai = 0; ai < 2; ++ai) {
            const int k = 2 * ai + wr;
#pragma unroll
            for (int bj = 0; bj < 2; ++bj)
#pragma unroll
                for (int n = 0; n < 2; ++n) {
                    const int tc = 128 * bj + 32 * wc + 8 * fq + 4 * n; const int uc = bj * FF + u.pn * 128 + 32 * wc + 8 * fq + 4 * n;
                    if (fr >= 14) { *(LAS f32x4*)(Hl + ((k + 1) * 2 + (fr - 14)) * 256 + tc) = acc[ai][bj][3][n]; if (k == 3) *(f32x4*)(HB + ((size_t)u.pm * 2 + (fr - 14)) * UP + uc) = acc[ai][bj][3][n]; }
                    if (k == 0 && fr < 2) *(f32x4*)(FB + ((size_t)u.pm * 2 + fr) * UP + uc) = acc[0][bj][0][n];
                }
        }
        WG_BAR();
#pragma unroll
        for (int ai = 0; ai < 2; ++ai) {
            const int k = 2 * ai + wr;
#pragma unroll
            for (int n = 0; n < 2; ++n) {
                const int tc = 32 * wc + 8 * fq + 4 * n; const int ucg = u.pn * 128 + tc;
                f32x4 cg[4];
#pragma unroll
                for (int bj = 0; bj < 2; ++bj) {
                    const int uc = bj * FF + ucg;
                    const f32x4 w0 = *(const f32x4*)(cw + uc), w1 = *(const f32x4*)(cw + UP + uc), w2 = *(const f32x4*)(cw + 2 * UP + uc), bb = *(const f32x4*)(cb + uc);
                    const f32x4 h0 = *(const LAS f32x4*)(Hl + (k * 2 + 0) * 256 + 128 * bj + tc), h1 = *(const LAS f32x4*)(Hl + (k * 2 + 1) * 256 + 128 * bj + tc);
#pragma unroll
                    for (int m = 0; m < 4; ++m) {
                        const f32x4 V = acc[ai][bj][m][n]; f32x4 p1, p2;
#pragma unroll
                        for (int e = 0; e < 4; ++e) {
                            const float r1 = dppf<0x121>(V[e]), r2 = dppf<0x122>(V[e]); float x1, x2;
                            if (m > 0) { x1 = dppf<0x121>(acc[ai][bj][m > 0 ? m - 1 : 0][n][e]); x2 = dppf<0x122>(acc[ai][bj][m > 0 ? m - 1 : 0][n][e]); }
                            else { x1 = h1[e]; x2 = (fr == 0) ? h0[e] : h1[e]; }
                            p1[e] = (fr == 0) ? x1 : r1; p2[e] = (fr < 2) ? x2 : r2;
                        }
                        const f32x4 cv = bb + w0 * p2 + w1 * p1 + w2 * V;
                        __builtin_amdgcn_sched_barrier(0);
                        if (bj == 0) cg[m] = cv;
                        else {
                            const int row = u.pm * 256 + ai * 128 + wr * 64 + m * 16 + fr;
                            float o[4];
#pragma unroll
                            for (int e = 0; e < 4; ++e) { const float gt = cg[m][e]; o[e] = gt * sigmoidf_(gt) * cv[e]; }
                            u32x2 w; w.x = cvt_pk_bf16(o[0], o[1]); w.y = cvt_pk_bf16(o[2], o[3]);
                            *(u32x2*)(act + (size_t)row * FF + ucg) = w;
                        }
                    }
                    asm volatile("" ::: "memory"); __builtin_amdgcn_sched_barrier(0);
                }
            }
        }
        WG_BAR();
    }
};

namespace att {
constexpr int SLOT_B = 16384, NSLOT = 6;
constexpr int OFF_K = 0, OFF_IMP = NSLOT * SLOT_B, IMPW = 132, OFF_SEL = OFF_IMP + 64 * IMPW * 4, OFF_UNI = OFF_SEL + 1024, OFF_LIST = OFF_UNI + 64, OFF_N = OFF_LIST + 132 * 4, OFF_CODE = OFF_N + 48, CODEW = 144;
static_assert(OFF_CODE + 8 * CODEW <= LDS_BYTES - 16 && 8 * SLOT_B <= OFF_SEL, "attention LDS map");
struct Ctx {
    const bf16_t *Q, *KCC, *VCT, *KS, *VST, *KW, *VWT; const float* gates; bf16_t* O;
};
__device__ __forceinline__ bf16x8 mk8(s16x4 a, s16x4 b) { return (bf16x8){a[0], a[1], a[2], a[3], b[0], b[1], b[2], b[3]}; }

template <int MODE>
__device__ __forceinline__ void branch(LAS unsigned char* lds, const bf16_t* Kg, const bf16_t* Vg, int ktile_elems, int nt, int c, int w, int lane, int tid,
                                       const bf16x8 (&qf)[4][2], float (&mrow)[4], float (&lrow)[4], f32x4 (&O)[4][4]) {
    const int fr = lane & 15, fq = lane >> 4;
    const LAS int* list = (const LAS int*)(lds + OFF_LIST);
    LAS float* impL = (LAS float*)(lds + OFF_IMP);
    const LAS unsigned char* codeL = (const LAS unsigned char*)(lds + OFF_CODE) + w * CODEW;
    constexpr int TPS = (MODE >= 2) ? 4 : 3;
#define ATT_DMA(ti, slot) do { const int ti_ = (ti); const int s_ = list[ti_]; LAS unsigned char* d_ = lds + OFF_K + (slot) * SLOT_B + w * 1024; \
        int t2_ = tid; asm volatile("" : "+v"(t2_)); const int lr = t2_ >> 3, lq = t2_ & 7; const int goff = lr * 64 + ((lq ^ ((lr >> 1) & 7)) * 8); \
        __builtin_amdgcn_global_load_lds((const unsigned*)(Kg + (size_t)s_ * ktile_elems + goff), (LAS unsigned*)d_, 16, 0, 0); \
        if (MODE != 0) __builtin_amdgcn_global_load_lds((const unsigned*)(Vg + (size_t)s_ * 4096 + goff), (LAS unsigned*)(d_ + 8192), 16, 0, 0); } while (0)
    asm volatile("s_waitcnt vmcnt(0)" ::: "memory");
#pragma unroll
    for (int ti = 0; ti < TPS; ++ti) if (ti < nt) ATT_DMA(ti, ti);
    const int nst = (nt + TPS - 1) / TPS;
    for (int j = 0; j < nst; ++j) {
        asm volatile("s_waitcnt vmcnt(0)" ::: "memory");
        WG_BAR();
#pragma unroll
        for (int hh = 0; hh < TPS; ++hh) if (TPS * (j + 1) + hh < nt) ATT_DMA(TPS * (j + 1) + hh, ((j + 1) & 1) * TPS + hh);
        int sl0 = 0, sl1 = 0, sl2 = 0, sl3 = 0; unsigned codes4 = 0xffffffffu;
        if (TPS == 4) {
            const u32x4 l4 = *(const LAS u32x4*)(list + TPS * j);
            sl0 = __builtin_amdgcn_readfirstlane((int)l4.x); sl1 = __builtin_amdgcn_readfirstlane((int)l4.y); sl2 = __builtin_amdgcn_readfirstlane((int)l4.z); sl3 = __builtin_amdgcn_readfirstlane((int)l4.w);
            if (MODE == 2) codes4 = (unsigned)__builtin_amdgcn_readfirstlane((int)*(const LAS unsigned*)(codeL + TPS * j));
        }
#pragma unroll 1
        for (int h = 0; h < TPS; ++h) {
        const int i = TPS * j + h; if (i >= nt) break;
        const int s = (TPS == 4) ? (h == 0 ? sl0 : h == 1 ? sl1 : h == 2 ? sl2 : sl3) : list[i];
        unsigned code = 0xffu; if (MODE == 2) code = (codes4 >> (8 * h)) & 0xffu;
        const LAS unsigned char* Kb = lds + OFF_K + ((j & 1) * TPS + h) * SLOT_B;
        const LAS unsigned char* Vb = Kb;
        int l2_ = lane; asm volatile("" : "+v"(l2_)); const int fr2 = l2_ & 15, fq2 = l2_ >> 4, swz = (fr2 >> 1) & 7;
        const int kb0 = fr2 * 128 + ((fq2 ^ swz) * 16), kb1 = kb0 ^ 64;
        if (MODE != 2) {
            f32x4 sa[4][4];
#pragma unroll
            for (int p = 0; p < 4; ++p) {
                const float cinit = (MODE == 1) ? lrow[p] : -((mrow[p] < -1e29f) ? 0.f : mrow[p]);
#pragma unroll
                for (int mt = 0; mt < 4; ++mt) sa[p][mt] = (f32x4){cinit, cinit, cinit, cinit};
            }
#pragma unroll
            for (int mt = 0; mt < 4; ++mt)
#pragma unroll
                for (int ks = 0; ks < 2; ++ks) {
                    const bf16x8 kf = *(const LAS bf16x8*)(Kb + (ks ? kb1 : kb0) + mt * 2048);
#pragma unroll
                    for (int p = 0; p < 4; ++p) sa[p][mt] = __builtin_amdgcn_mfma_f32_16x16x32_bf16(kf, qf[p][ks], sa[p][mt], 0, 0, 0);
                }
            bf16x8 pf[4][2];
#pragma unroll
            for (int p = 0; p < 4; ++p) {
                const int ttA = 8 * w + 2 * p, tt = ttA + (fr >> 3);
                bool needmask;
                if (MODE <= 1) needmask = (((64 * c + ttA - 31) >> 4) - 64 * s) < 63;
                else needmask = (s == c) || (c >= 8 && s == c - 8);
                if (needmask) {
                    int hi, lov = -1;
                    if (MODE <= 1) { const int t = 64 * c + tt; hi = ((t - 31) >> 4) - 64 * s; }
                    else { hi = (s == c) ? tt : 63; lov = (c >= 8 && s == c - 8) ? tt : -1; }
#pragma unroll
                    for (int mt = 0; mt < 4; ++mt)
#pragma unroll
                        for (int j = 0; j < 4; ++j) { const int kk = 16 * mt + 4 * fq + j; sa[p][mt][j] = (kk <= hi && kk > lov) ? sa[p][mt][j] : -1e30f; }
                }
                if (MODE != 1) {
                    float mx = fmaxf(fmaxf(sa[p][0][0], sa[p][0][1]), sa[p][0][2]);
                    mx = fmaxf(fmaxf(mx, sa[p][0][3]), sa[p][1][0]); mx = fmaxf(fmaxf(mx, sa[p][1][1]), sa[p][1][2]); mx = fmaxf(fmaxf(mx, sa[p][1][3]), sa[p][2][0]);
                    mx = fmaxf(fmaxf(mx, sa[p][2][1]), sa[p][2][2]); mx = fmaxf(fmaxf(mx, sa[p][2][3]), sa[p][3][0]); mx = fmaxf(fmaxf(mx, sa[p][3][1]), sa[p][3][2]); mx = fmaxf(mx, sa[p][3][3]);
                    mx = xrow16_max(mx);
                    const bool uninit = mrow[p] < -1e29f;
                    const bool resc = (mx > 8.0f) || (uninit && mx > -1e29f);
                    if (__any(resc)) {
                        const float delta = resc ? mx : 0.f;
                        const float alpha = (resc && !uninit) ? ex2(-delta) : 1.0f;
#pragma unroll
                        for (int mt = 0; mt < 4; ++mt) sa[p][mt] = sa[p][mt] - delta;
                        lrow[p] *= alpha;
                        if (MODE >= 2) {
#pragma unroll
                            for (int d = 0; d < 4; ++d) O[p][d] *= alpha;
                        }
                        if (resc) mrow[p] = (uninit ? 0.f : mrow[p]) + delta;
                    }
                }
#pragma unroll
                for (int mt = 0; mt < 4; ++mt)
#pragma unroll
                    for (int j = 0; j < 4; ++j) sa[p][mt][j] = ex2(sa[p][mt][j]);
                if (MODE != 1) { const f32x4 t4 = (sa[p][0] + sa[p][1]) + (sa[p][2] + sa[p][3]); lrow[p] += (t4[0] + t4[1]) + (t4[2] + t4[3]); }
                if (MODE >= 1) {
#pragma unroll
                    for (int k2 = 0; k2 < 2; ++k2) {
                        u32x4 wv; wv.x = cvt_pk_bf16(sa[p][2 * k2][0], sa[p][2 * k2][1]); wv.y = cvt_pk_bf16(sa[p][2 * k2][2], sa[p][2 * k2][3]); wv.z = cvt_pk_bf16(sa[p][2 * k2 + 1][0], sa[p][2 * k2 + 1][1]); wv.w = cvt_pk_bf16(sa[p][2 * k2 + 1][2], sa[p][2 * k2 + 1][3]);
                        pf[p][k2] = __builtin_bit_cast(bf16x8, wv);
                    }
                }
                if (MODE == 1) {
#pragma unroll
                    for (int mt = 0; mt < 4; ++mt) {
                        float a = sa[p][mt][0] + sa[p][mt][1] + sa[p][mt][2] + 0.5f * sa[p][mt][3], bn = 0.5f * sa[p][mt][3];
                        a = sum8(a); bn = sum8(bn);
                        const int sb = 16 * s + 4 * mt + fq;
                        if ((fr & 7) == 0) { (void)__hip_atomic_fetch_add(impL + tt * IMPW + sb, a, __ATOMIC_RELAXED, __HIP_MEMORY_SCOPE_WORKGROUP); (void)__hip_atomic_fetch_add(impL + tt * IMPW + sb + 1, bn, __ATOMIC_RELAXED, __HIP_MEMORY_SCOPE_WORKGROUP); }
                    }
                }
            }
            if (MODE >= 1) {
#pragma unroll
                for (int d = 0; d < 4; ++d)
#pragma unroll
                    for (int k2 = 0; k2 < 2; ++k2) {
                        const bf16x8 vf = *(const LAS bf16x8*)(Vb + 8192 + (k2 ? kb1 : kb0) + d * 2048);
#pragma unroll
                        for (int p = 0; p < 4; ++p) O[p][d] = __builtin_amdgcn_mfma_f32_16x16x32_bf16(vf, pf[p][k2], O[p][d], 0, 0, 0);
                    }
            }
            __builtin_amdgcn_sched_barrier(0);
        } else {
#pragma unroll
        for (int p = 0; p < 4; ++p) {
            const int ttA = 8 * w + 2 * p;
            const unsigned mA = (code >> (2 * p)) & 1u, mB = (code >> (2 * p + 1)) & 1u;
            if ((mA | mB) != 0u) {
            const int tt = ttA + (fr >> 3);
            float cinit;
            if (MODE == 1) cinit = lrow[p];
            else { const float mref = (mrow[p] < -1e29f) ? 0.f : mrow[p]; const bool colact = (MODE != 2) || (((fr >> 3) ? mB : mA) != 0u); cinit = colact ? -mref : -1e30f; }
            f32x4 sa[4];
#pragma unroll
            for (int mt = 0; mt < 4; ++mt) {
                sa[mt] = (f32x4){cinit, cinit, cinit, cinit};
#pragma unroll
                for (int ks = 0; ks < 2; ++ks) { const bf16x8 kf = *(const LAS bf16x8*)(Kb + (ks ? kb1 : kb0) + mt * 2048); sa[mt] = __builtin_amdgcn_mfma_f32_16x16x32_bf16(kf, qf[p][ks], sa[mt], 0, 0, 0); }
            }
            bool needmask;
            if (MODE <= 1) needmask = (((64 * c + ttA - 31) >> 4) - 64 * s) < 63;
            else if (MODE == 2) needmask = (s == c);
            else needmask = (s == c) || (c >= 8 && s == c - 8);
            if (needmask) {
                int hi, lov = -1;
                if (MODE <= 1) { const int t = 64 * c + tt; hi = ((t - 31) >> 4) - 64 * s; }
                else if (MODE == 2) hi = tt;
                else { hi = (s == c) ? tt : 63; lov = (c >= 8 && s == c - 8) ? tt : -1; }
#pragma unroll
                for (int mt = 0; mt < 4; ++mt)
#pragma unroll
                    for (int j = 0; j < 4; ++j) { const int kk = 16 * mt + 4 * fq + j; sa[mt][j] = (kk <= hi && kk > lov) ? sa[mt][j] : -1e30f; }
            }
            if (MODE != 1) {
                float mx = fmaxf(fmaxf(sa[0][0], sa[0][1]), sa[0][2]);
                mx = fmaxf(fmaxf(mx, sa[0][3]), sa[1][0]); mx = fmaxf(fmaxf(mx, sa[1][1]), sa[1][2]); mx = fmaxf(fmaxf(mx, sa[1][3]), sa[2][0]);
                mx = fmaxf(fmaxf(mx, sa[2][1]), sa[2][2]); mx = fmaxf(fmaxf(mx, sa[2][3]), sa[3][0]); mx = fmaxf(fmaxf(mx, sa[3][1]), sa[3][2]); mx = fmaxf(mx, sa[3][3]);
                mx = xrow16_max(mx);
                const bool uninit = mrow[p] < -1e29f;
                const bool resc = (mx > 8.0f) || (uninit && mx > -1e29f);
                if (__any(resc)) {
                    const float delta = resc ? mx : 0.f;
                    const float alpha = (resc && !uninit) ? ex2(-delta) : 1.0f;
#pragma unroll
                    for (int mt = 0; mt < 4; ++mt) sa[mt] = sa[mt] - delta;
                    lrow[p] *= alpha;
                    if (MODE >= 2) {
#pragma unroll
                        for (int d = 0; d < 4; ++d) O[p][d] *= alpha;
                    }
                    if (resc) mrow[p] = (uninit ? 0.f : mrow[p]) + delta;
                }
            }
            f32x4 pv[4];
#pragma unroll
            for (int mt = 0; mt < 4; ++mt)
#pragma unroll
                for (int j = 0; j < 4; ++j) pv[mt][j] = ex2(sa[mt][j]);
            if (MODE != 1) { const f32x4 t4 = (pv[0] + pv[1]) + (pv[2] + pv[3]); lrow[p] += (t4[0] + t4[1]) + (t4[2] + t4[3]); }
            if (MODE >= 1) {
                bf16x8 pf[2];
#pragma unroll
                for (int k2 = 0; k2 < 2; ++k2) {
                    u32x4 wv; wv.x = cvt_pk_bf16(pv[2 * k2][0], pv[2 * k2][1]); wv.y = cvt_pk_bf16(pv[2 * k2][2], pv[2 * k2][3]); wv.z = cvt_pk_bf16(pv[2 * k2 + 1][0], pv[2 * k2 + 1][1]); wv.w = cvt_pk_bf16(pv[2 * k2 + 1][2], pv[2 * k2 + 1][3]);
                    pf[k2] = __builtin_bit_cast(bf16x8, wv);
                }
#pragma unroll
                for (int d = 0; d < 4; ++d)
#pragma unroll
                    for (int k2 = 0; k2 < 2; ++k2) {
                        const bf16x8 vf = *(const LAS bf16x8*)(Vb + 8192 + (k2 ? kb1 : kb0) + d * 2048);
                        O[p][d] = __builtin_amdgcn_mfma_f32_16x16x32_bf16(vf, pf[k2], O[p][d], 0, 0, 0);
                    }
            }
            if (MODE == 1) {
#pragma unroll
                for (int mt = 0; mt < 4; ++mt) {
                    float a = pv[mt][0] + pv[mt][1] + pv[mt][2] + 0.5f * pv[mt][3], bn = 0.5f * pv[mt][3];
                    a = sum8(a); bn = sum8(bn);
                    const int sb = 16 * s + 4 * mt + fq;
                    if ((fr & 7) == 0) { (void)__hip_atomic_fetch_add(impL + tt * IMPW + sb, a, __ATOMIC_RELAXED, __HIP_MEMORY_SCOPE_WORKGROUP); (void)__hip_atomic_fetch_add(impL + tt * IMPW + sb + 1, bn, __ATOMIC_RELAXED, __HIP_MEMORY_SCOPE_WORKGROUP); }
                }
            }
            }
            __builtin_amdgcn_sched_barrier(0);
        }
        }
        }
    }
    WG_BAR();
#undef ATT_DMA
}

__device__ __forceinline__ void unit(LAS unsigned char* lds, const Ctx& X, int b, int g, int c, int tid_in) {
    int tid = tid_in; asm volatile("" : "+v"(tid));
    const int lane = tid & 63, w = __builtin_amdgcn_readfirstlane(tid >> 6), fr = lane & 15, fq = lane >> 4;
    LAS int* list = (LAS int*)(lds + OFF_LIST);
    LAS unsigned* selm = (LAS unsigned*)(lds + OFF_SEL);
    LAS unsigned* uni = (LAS unsigned*)(lds + OFF_UNI);
    LAS float* impL = (LAS float*)(lds + OFF_IMP);
    LAS int* nl = (LAS int*)(lds + OFF_N);
    const int bg = b * 2 + g; const size_t rowbase = (size_t)b * T + 64 * c;
    bf16x8 qf[4][2];
#pragma unroll
    for (int p = 0; p < 4; ++p) { const bf16_t* qp = X.Q + (rowbase + 8 * w + 2 * p + (fr >> 3)) * 1024 + (8 * g + (fr & 7)) * 64 + 8 * fq;
#pragma unroll
        for (int ks = 0; ks < 2; ++ks) qf[p][ks] = *(const bf16x8*)(qp + 32 * ks); }
    for (int i = lane; i < 8 * IMPW; i += 64) impL[(8 * w) * IMPW + i] = 0.f;
    const int ncmp = (4 * c + 3 + 63) >> 6;
    if (tid < 8) list[tid] = tid;
    float mrow[4], lrow[4]; f32x4 O[4][4];
#pragma unroll
    for (int p = 0; p < 4; ++p) { mrow[p] = -1e30f; lrow[p] = 0.f;
#pragma unroll
        for (int d = 0; d < 4; ++d) { O[p][d] = (f32x4){0.f, 0.f, 0.f, 0.f}; } }
    WG_BAR();
    const bf16_t* kcc = X.KCC + (size_t)bg * 512 * 64; const bf16_t* vct = X.VCT + (size_t)bg * 8 * 4096;
    branch<0>(lds, kcc, vct, 4096, ncmp, c, w, lane, tid, qf, mrow, lrow, O);
#pragma unroll
    for (int p = 0; p < 4; ++p) { float l = xrow16_sum(lrow[p]); lrow[p] = (l > 0.f) ? (-mrow[p] - __builtin_amdgcn_logf(l)) : -1e30f; }
    branch<1>(lds, kcc, vct, 4096, ncmp, c, w, lane, tid, qf, mrow, lrow, O);
#define ATT_GATE(br, scale_expr) do { _Pragma("unroll") for (int p = 0; p < 4; ++p) { \
        const size_t grow = rowbase + 8 * w + 2 * p + (fr >> 3); \
        const float gt = X.gates[grow * 48 + (8 * g + (fr & 7)) * 3 + (br)]; const float sc = gt * (scale_expr); \
        _Pragma("unroll") for (int d = 0; d < 4; ++d) { \
            u32x2* optr = (u32x2*)(X.O + grow * 1024 + (8 * g + (fr & 7)) * 64 + 4 * fq + 16 * d); u32x2 ot = (u32x2){0u, 0u}; if ((br) > 0) ot = *optr; \
            float o0 = __uint_as_float(ot.x << 16), o1 = __uint_as_float(ot.x & 0xffff0000u), o2 = __uint_as_float(ot.y << 16), o3 = __uint_as_float(ot.y & 0xffff0000u); \
            o0 += sc * O[p][d][0]; o1 += sc * O[p][d][1]; o2 += sc * O[p][d][2]; o3 += sc * O[p][d][3]; \
            ot.x = cvt_pk_bf16(o0, o1); ot.y = cvt_pk_bf16(o2, o3); O[p][d] = (f32x4){0.f, 0.f, 0.f, 0.f}; \
            *optr = ot; } \
        mrow[p] = -1e30f; lrow[p] = 0.f; } } while (0)
    ATT_GATE(0, 1.0f);
    LDS_WAIT();
    for (int q8 = 0; q8 < 8; ++q8) {
        const int tt = 8 * w + q8;
        unsigned long long blo, bhi;
        if (c + 1 <= 16) { blo = (1ull << (c + 1)) - 1ull; bhi = 0ull; }
        else {
            const int s1 = lane, s2 = lane + 64;
            const bool c1 = (s1 >= 1 && s1 <= c - 2), c2 = (s2 >= 1 && s2 <= c - 2);
            const float v1 = c1 ? impL[tt * IMPW + s1] : -1.f, v2 = c2 ? impL[tt * IMPW + s2] : -1.f;
            int r1 = 0, r2 = 0;
            const int nq = (c - 2) / 4 + 1;
#pragma unroll 2
            for (int q = 0; q < nq; ++q) {
                const f32x4 x4 = *(const LAS f32x4*)(impL + tt * IMPW + 4 * q);
#pragma unroll
                for (int e = 0; e < 4; ++e) { const int sp = 4 * q + e; const float x = (sp >= 1 && sp <= c - 2) ? x4[e] : -2.f;
                    r1 += (x > v1 || (x == v1 && sp < s1)) ? 1 : 0; r2 += (x > v2 || (x == v2 && sp < s2)) ? 1 : 0; }
            }
            const bool f1 = (s1 == 0 || s1 == c || s1 == c - 1), f2 = (s2 == c || s2 == c - 1);
            blo = __ballot((c1 && r1 < 13) || f1); bhi = __ballot((c2 && r2 < 13) || f2);
        }
        if (lane == 0) { selm[tt * 4 + 0] = (unsigned)blo; selm[tt * 4 + 1] = (unsigned)(blo >> 32); selm[tt * 4 + 2] = (unsigned)bhi; selm[tt * 4 + 3] = (unsigned)(bhi >> 32); }
    }
    WG_BAR();
    if (tid < 4) { unsigned o = 0; for (int i = 0; i < 64; ++i) o |= selm[i * 4 + tid]; uni[tid] = o; }
    WG_BAR();
    if (tid == 0) { int n = 0; for (int s = 0; s <= c; ++s) if ((uni[s >> 5] >> (s & 31)) & 1u) list[n++] = s; nl[0] = n; }
    WG_BAR();
    const int nsel = nl[0];
    { LAS unsigned char* cw_ = (LAS unsigned char*)(lds + OFF_CODE) + w * CODEW;
      for (int i = lane; i < nsel; i += 64) { const int s_ = list[i]; unsigned cd = 0;
#pragma unroll
          for (int q8 = 0; q8 < 8; ++q8) cd |= ((selm[(8 * w + q8) * 4 + (s_ >> 5)] >> (s_ & 31)) & 1u) << q8;
          cw_[i] = (unsigned char)cd; }
      LDS_WAIT(); }
    branch<2>(lds, X.KS + (size_t)bg * T * 64, X.VST + (size_t)bg * 128 * 4096, 4096, nsel, c, w, lane, tid, qf, mrow, lrow, O);
#pragma unroll
    for (int p = 0; p < 4; ++p) { float l = xrow16_sum(lrow[p]); lrow[p] = (l > 0.f) ? 1.0f / l : 0.f; }
    { float rl[4] = {lrow[0], lrow[1], lrow[2], lrow[3]}; ATT_GATE(1, rl[p]); }
    const int w0 = (c >= 8) ? c - 8 : 0, nwin = c - w0 + 1;
    if (tid < nwin) list[tid] = w0 + tid;
    WG_BAR();
    branch<3>(lds, X.KW + (size_t)bg * T * 64, X.VWT + (size_t)bg * 128 * 4096, 4096, nwin, c, w, lane, tid, qf, mrow, lrow, O);
#pragma unroll
    for (int p = 0; p < 4; ++p) { float l = xrow16_sum(lrow[p]); lrow[p] = (l > 0.f) ? 1.0f / l : 0.f; }
    { float rl[4] = {lrow[0], lrow[1], lrow[2], lrow[3]}; ATT_GATE(2, rl[p]); }
#undef ATT_GATE
    WG_BAR();
}
}

__device__ __forceinline__ unsigned f2bf(float f) { unsigned u = __builtin_bit_cast(unsigned, f); return (u + 0x7fffu + ((u >> 16) & 1u)) >> 16; }
__device__ __forceinline__ unsigned pk2(float lo, float hi) { return f2bf(lo) | (f2bf(hi) << 16); }
template <int MAP>
__device__ __forceinline__ int rowmap(int a) {
    if (MAP == 0) return perm8(a);
    if (MAP == 1) return a < 1792 ? ((a & ~63) | swap45(a & 63)) : a;
    if (MAP == 2) { if (a < FF) return 256 * (a >> 7) + perm8(a & 127); const int a2 = a - FF; return 256 * (a2 >> 7) + 128 + perm8(a2 & 127); }
    return swap45(a);
}
template <int MAP>
__device__ __forceinline__ void transpose_item(const float* W, int K, int N, bf16_t* WT, int row_off, const float* gain, LAS float* scr, int item, int lane) {
    const int nblk = (N + 31) / 32, kb = item / nblk, nb = item % nblk, k0 = 64 * kb, n0 = 32 * nb;
#pragma unroll
    for (int i = 0; i < 32; ++i) { const int kk = 2 * i + (lane >> 5); const int col = n0 + (lane & 31); float v = (col < N) ? W[(size_t)(k0 + kk) * N + col] : 0.f; if (gain) v *= gain[k0 + kk]; scr[kk * 33 + (lane & 31)] = v; }
    LDS_WAIT();
    const int cc = lane & 7;
#pragma unroll
    for (int j = 0; j < 4; ++j) { const int n = (lane >> 3) + 8 * j; const LAS float* s = scr + (8 * cc) * 33 + n;
        u32x4 o; o.x = pk2(s[0 * 33], s[1 * 33]); o.y = pk2(s[2 * 33], s[3 * 33]); o.z = pk2(s[4 * 33], s[5 * 33]); o.w = pk2(s[6 * 33], s[7 * 33]);
        if (n0 + n < N) *(u32x4*)(WT + (size_t)(row_off + rowmap<MAP>(n0 + n)) * K + k0 + 8 * cc) = o; }
    LDS_WAIT();
}

#define XB_TMO      128
#define XB_XCNT(j)  (256  + 64 * (j))
#define XB_XSUB(j)  (1280 + 64 * (j))
#define XB_XGEN(j)  (2304 + 64 * (j))
#define XB_TOP      3328
#define XB_TOPGEN   3392
#define XCD_BAR_WORDS 3456
#define XB_SPIN_CAP (1u << 18)
__device__ __forceinline__ unsigned xb_ld(unsigned* p)              { return __hip_atomic_load(p, __ATOMIC_RELAXED, __HIP_MEMORY_SCOPE_AGENT); }
__device__ __forceinline__ unsigned xb_add(unsigned* p, unsigned v) { return __hip_atomic_fetch_add(p, v, __ATOMIC_RELAXED, __HIP_MEMORY_SCOPE_AGENT); }
__device__ __forceinline__ unsigned xb_xcc_id() { return (unsigned)__builtin_amdgcn_s_getreg((3 << 11) | 20) & 0xFu; }
#define XB_SPIN(cond, bar) do { unsigned _sp = 0; while (cond) { __builtin_amdgcn_s_sleep(1); \
    if ((++_sp & 255u) == 0u) { if (xb_ld(&(bar)[XB_TMO])) break; if (_sp > XB_SPIN_CAP) { atomicAdd(&(bar)[XB_TMO], 1u); break; } } } } while (0)
struct XcdBarrier { unsigned* bar; unsigned x; volatile LAS unsigned* st; };
__device__ __forceinline__ XcdBarrier xcd_barrier_post(unsigned* bar, volatile LAS unsigned* st) {
    XcdBarrier b; b.bar = bar; b.x = xb_xcc_id(); b.st = st;
    if (threadIdx.x == 0) (void)xb_add(&bar[XB_XCNT(b.x)], 1u);
    return b;
}
__device__ __forceinline__ void xcd_barrier_complete(unsigned* bar, unsigned x, unsigned& nloc, unsigned& nx) {
    const unsigned G = gridDim.x * gridDim.y * gridDim.z;
    unsigned sum, cnt, mine, sp = 0u;
    for (;;) {
        sum = 0u; cnt = 0u; mine = 0u;
#pragma unroll
        for (unsigned j = 0; j < 16; ++j) { const unsigned c = xb_ld(&bar[XB_XCNT(j)]); sum += c; cnt += (c > 0u) ? 1u : 0u; mine = (j == x) ? c : mine; }
        if (sum == G) break;
        __builtin_amdgcn_s_sleep(1);
        if ((++sp & 255u) == 0u) { if (xb_ld(&bar[XB_TMO])) break; if (sp > XB_SPIN_CAP) { atomicAdd(&bar[XB_TMO], 1u); break; } }
    }
    nloc = mine > 0u ? mine : 1u; nx = cnt > 0u ? cnt : 1u;
}
__device__ __forceinline__ void xcd_barrier(const XcdBarrier& b) {
    asm volatile("s_waitcnt vmcnt(0)" ::: "memory");
    __syncthreads();
    if (threadIdx.x == 0) {
        unsigned* bar = b.bar;
        __builtin_amdgcn_s_waitcnt(0);
        unsigned nloc = b.st[0], nx = b.st[1];
        if (nloc == 0u) { xcd_barrier_complete(bar, b.x, nloc, nx); b.st[0] = nloc; b.st[1] = nx; }
        const unsigned old = xb_add(&bar[XB_XSUB(b.x)], 1u);
        const unsigned gen = old / nloc;
        if (old + 1u == (gen + 1u) * nloc) {
            __builtin_amdgcn_fence(__ATOMIC_RELEASE, "agent");
            asm volatile("s_waitcnt vmcnt(0)" ::: "memory");
            const unsigned og = xb_add(&bar[XB_TOP], 1u);
            const unsigned tg = og / nx;
            if (og + 1u == (tg + 1u) * nx) xb_add(&bar[XB_TOPGEN], 1u);
            else XB_SPIN(xb_ld(&bar[XB_TOPGEN]) == tg, bar);
            __builtin_amdgcn_fence(__ATOMIC_ACQUIRE, "agent");
            xb_add(&bar[XB_XGEN(b.x)], 1u);
            asm volatile("s_waitcnt vmcnt(0)" ::: "memory");
        } else {
            XB_SPIN(xb_ld(&bar[XB_XGEN(b.x)]) == gen, bar);
            __builtin_amdgcn_fence(__ATOMIC_ACQUIRE, "agent");
            asm volatile("s_waitcnt vmcnt(0)" ::: "memory");
        }
    }
    __syncthreads();
}

struct Args { const float* in[29]; float* out; unsigned char* ws; float inv[32]; int ph_lo, ph_hi; };

constexpr int DI_UP = 16 * 176, DI_DN = 44 * 32, DI_PL = 4 * 8, N_DEFER = 2 * DI_UP + 2 * DI_DN + 4 * DI_PL;
__device__ __forceinline__ void ffn_weight_item(const Args& a, unsigned char* ws, LAS float* scr, int r, int lane) {
    if (r < DI_UP) { transpose_item<2>(a.in[15], D, UP, (bf16_t*)(ws + WS_WUP0), 0, a.in[14], scr, r, lane); return; } r -= DI_UP;
    if (r < DI_UP) { transpose_item<2>(a.in[24], D, UP, (bf16_t*)(ws + WS_WUP1), 0, a.in[23], scr, r, lane); return; } r -= DI_UP;
    if (r < DI_DN) { transpose_item<0>(a.in[18], FF, D, (bf16_t*)(ws + WS_WDN0), 0, nullptr, scr, r, lane); return; } r -= DI_DN;
    if (r < DI_DN) { transpose_item<0>(a.in[27], FF, D, (bf16_t*)(ws + WS_WDN1), 0, nullptr, scr, r, lane); return; } r -= DI_DN;
    const int gi = r / DI_PL; transpose_item<0>(a.in[20] + (size_t)gi * 65536, 256, 256, (bf16_t*)(ws + WS_WPOOL), gi * 256, nullptr, scr, r % DI_PL, lane);
}

__global__ void __launch_bounds__(512) mk_fwd(Args a) {
    extern __shared__ __attribute__((aligned(16))) unsigned char lds_raw[];
    LAS unsigned char* lds = (LAS unsigned char*)lds_raw;
    LAS unsigned char* ldsx = lds + LDS_RING;
    cg::grid_group grid = cg::this_grid();
    if (threadIdx.x < 2) ((volatile LAS unsigned*)(lds + LDS_BYTES - 16))[threadIdx.x] = 0u;
    __syncthreads();
    if (a.ph_hi == 0x7fff) grid.sync();
    const XcdBarrier xbar = xcd_barrier_post((unsigned*)a.ws, (volatile LAS unsigned*)(lds + LDS_BYTES - 16));
    const int tid = threadIdx.x, lane = tid & 63, wave = __builtin_amdgcn_readfirstlane(tid >> 6);
    const int G = gridDim.x, bx = blockIdx.x;
    unsigned char* ws = a.ws;
#define cosT ((float*)(ws + WS_ROPE))
#define sinT ((float*)(ws + WS_ROPE) + T * 32)
#define ssp ((float*)(ws + WS_SSP))
#define c1p ((float*)(ws + WS_C1P))
#define rstdv ((float*)(ws + WS_RSTD))
#define HB ((float*)(ws + WS_HB))
#define FB ((float*)(ws + WS_FB))
#define gates ((float*)(ws + WS_GATE))
#define Wt_in ((bf16_t*)(ws + WS_WIN))
#define Wt_out ((bf16_t*)(ws + WS_WOUT))
#define Wt_pool ((bf16_t*)(ws + WS_WPOOL))
#define Wt_c1 (kv ? (bf16_t*)(ws + WS_WC1V) : (bf16_t*)(ws + WS_WC1K))
#define Wt_c2 (kv ? (bf16_t*)(ws + WS_WC2V) : (bf16_t*)(ws + WS_WC2K))
#define XB ((bf16_t*)(ws + WS_XB))
#define Qb ((bf16_t*)(ws + WS_Q))
#define KC ((bf16_t*)(ws + WS_KC))
#define VC ((bf16_t*)(ws + WS_VC))
#define KS ((bf16_t*)(ws + WS_KS))
#define VST ((bf16_t*)(ws + WS_VST))
#define KW ((bf16_t*)(ws + WS_KW))
#define VWT ((bf16_t*)(ws + WS_VWT))
#define KCC ((bf16_t*)(ws + WS_KCC))
#define VCT ((bf16_t*)(ws + WS_VCT))
#define Ob ((bf16_t*)(ws + WS_O))
#define ACT ((bf16_t*)(ws + WS_ACT))
#define POOLED ((bf16_t*)(ws + WS_POOLED))
    float* out = a.out;
    const int lo = a.ph_lo, hi = a.ph_hi;
    const bool defer = (G == 256);
#define IN(k) (lo <= (k) && (k) < hi)
#define SEAM(k) do { if (IN(k) && IN((k) + 1)) xcd_barrier(xbar); } while (0)

    if (IN(0)) {
        LAS float* scr = (LAS float*)(lds + wave * 16384);
        const int gw = bx * 8 + wave, NGW = G * 8;
        constexpr int I_IN = 16 * 58, I_OUT = 16 * 32, I_C1 = 32 * 8, I_C2 = 4 * 2;
        constexpr int NA = I_IN + I_OUT + 2 * I_C1 + 2 * I_C2;
        const int NIT = NA + (defer ? 0 : N_DEFER);
        for (int it = gw; it < NIT; it += NGW) {
            int r = it;
            if (r < I_IN) { transpose_item<1>(a.in[2], D, 1840, Wt_in, 0, a.in[1], scr, r, lane); continue; } r -= I_IN;
            if (r < I_OUT) { transpose_item<0>(a.in[13], D, D, Wt_out, 0, nullptr, scr, r, lane); continue; } r -= I_OUT;
            if (r < I_C1) { transpose_item<0>(a.in[4], 2048, 256, (bf16_t*)(ws + WS_WC1K), 0, nullptr, scr, r, lane); continue; } r -= I_C1;
            if (r < I_C1) { transpose_item<0>(a.in[9], 2048, 256, (bf16_t*)(ws + WS_WC1V), 0, nullptr, scr, r, lane); continue; } r -= I_C1;
            if (r < I_C2) { transpose_item<3>(a.in[6], 256, 64, (bf16_t*)(ws + WS_WC2K), 0, nullptr, scr, r, lane); continue; } r -= I_C2;
            if (r < I_C2) { transpose_item<3>(a.in[11], 256, 64, (bf16_t*)(ws + WS_WC2V), 0, nullptr, scr, r, lane); continue; } r -= I_C2;
            ffn_weight_item(a, ws, scr, r, lane);
        }
        for (int m = gw; m < M; m += 2 * NGW) {
            const int m2 = m + NGW;
            const f32x4* xr = (const f32x4*)(a.in[0] + (size_t)m * D) + lane; const f32x4* xr2 = (const f32x4*)(a.in[0] + (size_t)m2 * D) + lane;
            f32x4 v[4], w[4];
#pragma unroll
            for (int j = 0; j < 4; ++j) { v[j] = xr[64 * j]; w[j] = (m2 < M) ? xr2[64 * j] : (f32x4){0.f, 0.f, 0.f, 0.f}; }
            unsigned long long* o8 = (unsigned long long*)(XB + (size_t)m * D) + lane; unsigned long long* o82 = (unsigned long long*)(XB + (size_t)m2 * D) + lane; float s1 = 0.f, s2 = 0.f;
#pragma unroll
            for (int j = 0; j < 4; ++j) {
                s1 += (v[j][0] * v[j][0] + v[j][1] * v[j][1]) + (v[j][2] * v[j][2] + v[j][3] * v[j][3]); o8[64 * j] = (unsigned long long)pk2(v[j][0], v[j][1]) | ((unsigned long long)pk2(v[j][2], v[j][3]) << 32);
                s2 += (w[j][0] * w[j][0] + w[j][1] * w[j][1]) + (w[j][2] * w[j][2] + w[j][3] * w[j][3]); if (m2 < M) o82[64 * j] = (unsigned long long)pk2(w[j][0], w[j][1]) | ((unsigned long long)pk2(w[j][2], w[j][3]) << 32);
            }
#pragma unroll
            for (int o = 1; o < 64; o <<= 1) { s1 += __shfl_xor(s1, o); s2 += __shfl_xor(s2, o); }
            if (lane == 0) { rstdv[m] = 1.0f / sqrtf(s1 * (1.0f / D) + EPS); if (m2 < M) rstdv[m2] = 1.0f / sqrtf(s2 * (1.0f / D) + EPS); }
        }
        for (int i = bx * 512 + tid; i < T * 32; i += G * 512) {
            const int t = i >> 5, f = i & 31; const float ang = (float)t * a.inv[f];
            double x = (double)ang * 0.15915494309189535; x -= __builtin_rint(x); const float xf = (float)x;
            cosT[i] = __builtin_amdgcn_cosf(xf); sinT[i] = __builtin_amdgcn_sinf(xf);
        }
        for (int it = NGW - 1 - gw; it < 256; it += NGW) {
            const int kv = it >> 7, chunk = (it >> 2) & 31, nb = it & 3; const float* pos = a.in[kv ? 8 : 3]; const float* w1 = a.in[kv ? 9 : 4];
            float s = 0.f;
#pragma unroll 32
            for (int r = 0; r < 64; ++r) { const int rr = chunk * 64 + r; s += pos[rr] * w1[(size_t)rr * 256 + nb * 64 + lane]; }
            c1p[(kv * 32 + chunk) * 256 + nb * 64 + lane] = s;
        }
        asm volatile("s_waitcnt vmcnt(0) lgkmcnt(0)" ::: "memory"); __syncthreads();
    }
    SEAM(0);
    if (IN(1)) {
        pg8::Gemm g{XB, Wt_in, M, NIN, D, D, 0}; pg8::StaticOrder S; S.init(M, NIN, G, bx);
        EpiIn E{rstdv, cosT, sinT, Qb, KC, VC, KS, VST, KW, VWT, gates};
        pg8::gemm_phase(lds, ldsx, g, S, E);
    }
    SEAM(1);
    if (IN(2)) {
        const int tid = threadIdx.x, lane = tid & 63, w = __builtin_amdgcn_readfirstlane(tid >> 6), fr = lane & 15, fq = lane >> 4;
        LAS float* c1s = (LAS float*)lds;
        LAS unsigned char* hidL = lds + 4096;
        for (int i = tid; i < 512; i += 512) { const int kv = i >> 8, n = i & 255; const float* b1 = a.in[kv ? 10 : 5]; float sv = b1[n]; for (int q = 0; q < 32; ++q) sv += c1p[(kv * 32 + q) * 256 + n]; c1s[i] = sv; }
        __syncthreads();
        for (int u = bx; u < 256; u += G) {
            const int kv = u >> 7, r0 = (u & 127) * 16;
            const bf16_t* Ap = (kv ? VC : KC) + (size_t)(r0 + fr) * 1024 + 8 * fq;
            const bf16_t* Bp = Wt_c1 + (size_t)(32 * w + fr) * 2048 + 8 * fq;
            f32x4 h0 = (f32x4){0.f, 0.f, 0.f, 0.f}, h1 = h0;
#pragma unroll 1
            for (int k0 = 0; k0 < 2048; k0 += 256) {
                bf16x8 af[8], b0[8], b1f[8];
#pragma unroll
                for (int q = 0; q < 8; ++q) { af[q] = *(const bf16x8*)(Ap + k0 + 32 * q); b0[q] = *(const bf16x8*)(Bp + k0 + 32 * q); b1f[q] = *(const bf16x8*)(Bp + 16 * 2048 + k0 + 32 * q); }
#pragma unroll
                for (int q = 0; q < 8; ++q) { h0 = __builtin_amdgcn_mfma_f32_16x16x32_bf16(b0[q], af[q], h0, 0, 0, 0); h1 = __builtin_amdgcn_mfma_f32_16x16x32_bf16(b1f[q], af[q], h1, 0, 0, 0); }
            }
            { const int c0 = 32 * w + 8 * fq; float v[8];
#pragma unroll
              for (int e = 0; e < 8; ++e) { const float x = ((e >> 2) ? h1[e & 3] : h0[e & 3]) + c1s[kv * 256 + c0 + e]; const float y = 0.7978845608028654f * (x + 0.044715f * x * x * x); v[e] = x * sigmoidf_(2.0f * y); }
              u32x4 wv; wv.x = cvt_pk_bf16(v[0], v[1]); wv.y = cvt_pk_bf16(v[2], v[3]); wv.z = cvt_pk_bf16(v[4], v[5]); wv.w = cvt_pk_bf16(v[6], v[7]);
              *(LAS u32x4*)(hidL + fr * 528 + c0 * 2) = wv; }
            __syncthreads();
            if (w < 2) {
                const bf16_t* W2 = Wt_c2 + (size_t)(32 * w + fr) * 256 + 8 * fq;
                f32x4 oA = (f32x4){0.f, 0.f, 0.f, 0.f}, oB = oA;
#pragma unroll
                for (int q = 0; q < 8; ++q) {
                    const bf16x8 hf = *(const LAS bf16x8*)(hidL + fr * 528 + (32 * q + 8 * fq) * 2);
                    const bf16x8 wa = *(const bf16x8*)(W2 + 32 * q), wb = *(const bf16x8*)(W2 + 16 * 256 + 32 * q);
                    oA = __builtin_amdgcn_mfma_f32_16x16x32_bf16(wa, hf, oA, 0, 0, 0); oB = __builtin_amdgcn_mfma_f32_16x16x32_bf16(wb, hf, oB, 0, 0, 0);
                }
                const float* b2 = a.in[kv ? 12 : 7]; const int d0 = 16 * w + 4 * fq; const int row = r0 + fr, j = row & 511;
                f32x4 a1 = oA + *(const f32x4*)(b2 + d0), a2 = oB + *(const f32x4*)(b2 + d0 + 32);
                if (j == 511) { a1 = (f32x4){0.f, 0.f, 0.f, 0.f}; a2 = a1; }
                if (!kv) {
                    const int pos = (j == 511) ? 0 : 16 * j + 31;
                    const f32x4 cs = *(const f32x4*)(cosT + pos * 32 + d0), sn = *(const f32x4*)(sinT + pos * 32 + d0);
                    const f32x4 o1 = a1 * cs - a2 * sn, o2 = a1 * sn + a2 * cs;
                    bf16_t* p = KCC + (size_t)row * 64 + d0;
                    u32x2 w1; w1.x = cvt_pk_bf16(o1[0], o1[1]); w1.y = cvt_pk_bf16(o1[2], o1[3]); *(u32x2*)p = w1;
                    u32x2 w2; w2.x = cvt_pk_bf16(o2[0], o2[1]); w2.y = cvt_pk_bf16(o2[2], o2[3]); *(u32x2*)(p + 32) = w2;
                } else {
                    bf16_t* p = VCT + (size_t)(row >> 6) * 4096 + vperm(row & 63);
#pragma unroll
                    for (int e = 0; e < 4; ++e) { p[(d0 + e) * 64] = (bf16_t)(cvt_pk_bf16(a1[e], 0.f) & 0xffff); p[(d0 + 32 + e) * 64] = (bf16_t)(cvt_pk_bf16(a2[e], 0.f) & 0xffff); }
                }
            }
            __syncthreads();
        }
    }
    if (IN(2) && IN(4)) xcd_barrier(xbar);
    if (IN(4)) {
        att::Ctx X{Qb, KCC, VCT, KS, VST, KW, VWT, gates, Ob};
        for (int k = bx; k < 256; k += G) {
            for (int rep = 0; rep < 2; ++rep) { const int uu = rep ? 511 - k : k; const int c = 127 - (uu >> 2), bgi = uu & 3; att::unit(lds, X, bgi >> 1, bgi & 1, c, tid); }
        }
        if (defer) {
            int td = threadIdx.x; asm volatile("" : "+v"(td)); const int dl = td & 63, dw = __builtin_amdgcn_readfirstlane(td >> 6);
            LAS float* scr = (LAS float*)(lds + dw * 16384);
            for (int it = bx * 8 + dw; it < N_DEFER; it += 2048) ffn_weight_item(a, ws, scr, it, dl);
        }
    }
    SEAM(4);
    if (IN(5)) {
        pg8::Gemm g{Ob, Wt_out, M, D, D, D, 0}; pg8::StaticOrder S; S.init(M, D, G, bx);
        EpiRes E{a.in[0], out, XB, ssp, nullptr, nullptr};
        pg8::gemm_phase(lds, ldsx, g, S, E);
    }
    SEAM(5);
#pragma unroll
    for (int L = 0; L < 2; ++L) {
        const int pb = 6 + 5 * L;
        const float* cw = a.in[L ? 25 : 16]; const float* cb = a.in[L ? 26 : 17];
        if (IN(pb)) {
            pg8::Gemm g{XB, (const bf16_t*)(ws + (L ? WS_WUP1 : WS_WUP0)), M, UP, D, D, 0}; pg8::StaticOrder S; S.init(M, UP, G, bx);
            EpiUp E{ssp, cw, cb, ACT, HB, FB};
            pg8::gemm_phase(lds, ldsx, g, S, E);
        }
        SEAM(pb);
        if (IN(pb + 1)) {
            for (int i = bx * 512 + tid; i < 64 * FF; i += G * 512) {
                const int pm = i / FF, cidx = i % FF;
                float hg0 = 0.f, hg1 = 0.f, hv0 = 0.f, hv1 = 0.f;
                if (pm & 31) { const float* h = HB + (size_t)(pm - 1) * 2 * UP; hg0 = h[cidx]; hg1 = h[UP + cidx]; hv0 = h[FF + cidx]; hv1 = h[UP + FF + cidx]; }
                const float* f = FB + (size_t)pm * 2 * UP; const float fg0 = f[cidx], fg1 = f[UP + cidx], fv0 = f[FF + cidx], fv1 = f[UP + FF + cidx];
                const float g0 = cb[cidx] + cw[cidx] * hg0 + cw[UP + cidx] * hg1 + cw[2 * UP + cidx] * fg0;
                const float g1 = cb[cidx] + cw[cidx] * hg1 + cw[UP + cidx] * fg0 + cw[2 * UP + cidx] * fg1;
                const float v0 = cb[FF + cidx] + cw[FF + cidx] * hv0 + cw[UP + FF + cidx] * hv1 + cw[2 * UP + FF + cidx] * fv0;
                const float v1 = cb[FF + cidx] + cw[FF + cidx] * hv1 + cw[UP + FF + cidx] * fv0 + cw[2 * UP + FF + cidx] * fv1;
                ACT[(size_t)(pm * 256) * FF + cidx] = (bf16_t)f2bf(g0 * sigmoidf_(g0) * v0);
                ACT[(size_t)(pm * 256 + 1) * FF + cidx] = (bf16_t)f2bf(g1 * sigmoidf_(g1) * v1);
            }
        }
        SEAM(pb + 1);
        if (IN(pb + 2)) {
            pg8::Gemm g{ACT, (const bf16_t*)(ws + (L ? WS_WDN1 : WS_WDN0)), M, D, FF, FF, 0}; pg8::StaticOrder S; S.init(M, D, G, bx);
            if (L == 1 && G == 256) { EpiFinal E{out, a.in[28], (float*)(ws + WS_SSP + 512 * 1024), (unsigned*)(ws + 16384)}; pg8::gemm_phase(lds, ldsx, g, S, E); }
            else { EpiRes E{out, out, XB, ssp, nullptr, nullptr}; pg8::gemm_phase(lds, ldsx, g, S, E); }
        }
        if (!(L == 1 && G == 256)) SEAM(pb + 2);
        if (L == 0) {
            if (IN(9)) {
                LAS float* rsd = (LAS float*)lds;
                const float* gn = a.in[19];
                int tid = threadIdx.x; asm volatile("" : "+v"(tid));
                const int q = tid & 255, strip = tid >> 8, c4 = q * 4, wsz = 2 << (c4 >> 8), t0 = strip * 32;
                const f32x4 gv = *(const f32x4*)(gn + c4);
                for (int tile = bx; tile < 256; tile += G) {
                    const int r0 = tile * 64; const int tb = r0 & (T - 1);
                    __syncthreads();
                    if (tid < 80) { const int rr = r0 - 16 + tid; rsd[tid] = (tb - 16 + tid >= 0) ? row_rstd(ssp, 4, rr) : 0.f; }
                    __syncthreads();
                    const float* xb0 = out + (size_t)r0 * D + c4;
#define POOL_H(tl) (*(const f32x4*)(xb0 + (ptrdiff_t)(tl) * D) * rsd[16 + (tl)])
                    f32x4 sw = (f32x4){0.f, 0.f, 0.f, 0.f};
                    for (int i = 1; i <= wsz; ++i) { const int tl = t0 - i; if (tb + tl >= 0) sw += POOL_H(tl); }
#pragma unroll 4
                    for (int tl = t0; tl < t0 + 32; ++tl) {
                        const f32x4 hv = POOL_H(tl); sw += hv;
                        const int td = tl - wsz; if (tb + td >= 0) sw -= POOL_H(td);
                        const int t = tb + tl; const int cnt = (t + 1 < wsz) ? t + 1 : wsz;
                        const f32x4 pvv = (sw * (1.0f / (float)cnt) - hv) * gv;
                        u32x2 wv; wv.x = cvt_pk_bf16(pvv[0], pvv[1]); wv.y = cvt_pk_bf16(pvv[2], pvv[3]);
                        *(u32x2*)(POOLED + (size_t)(r0 + tl) * D + c4) = wv;
                    }
#undef POOL_H
                }
                __syncthreads();
            }
            SEAM(9);
            if (IN(10)) {
                pg8::Gemm g{POOLED, Wt_pool, M, D, 256, D, 512}; pg8::StaticOrder S; S.init(M, D, G, bx);
                EpiRes E{out, out, XB, ssp, a.in[21], a.in[22]};
                pg8::gemm_phase(lds, ldsx, g, S, E);
            }
            SEAM(10);
        }
    }
    if (IN(14) && G != 256) {
        int t14 = threadIdx.x; asm volatile("" : "+v"(t14)); const int lane = t14 & 63, wave = __builtin_amdgcn_readfirstlane(t14 >> 6);
        const int gw = bx * 8 + wave, NGW = G * 8; const float* gn = a.in[28];
        for (int m = gw; m < M; m += NGW) {
            const float rs = row_rstd(ssp, 4, m); f32x4* xr = (f32x4*)(out + (size_t)m * D) + lane; const f32x4* gr = (const f32x4*)gn + lane;
#pragma unroll
            for (int j = 0; j < 4; ++j) xr[64 * j] = xr[64 * j] * rs * gr[64 * j];
        }
    }
#undef IN
#undef SEAM
#undef cosT
#undef sinT
#undef ssp
#undef c1p
#undef rstdv
#undef HB
#undef FB
#undef gates
#undef Wt_in
#undef Wt_out
#undef Wt_pool
#undef Wt_c1
#undef Wt_c2
#undef XB
#undef Qb
#undef KC
#undef VC
#undef KS
#undef VST
#undef KW
#undef VWT
#undef KCC
#undef VCT
#undef Ob
#undef ACT
#undef POOLED
}

extern "C" void kernel_launch(void* const* d_in, const int* in_sizes, int n_in, void* d_out, int out_size, void* d_ws, size_t ws_size, hipStream_t stream) {
    static int grid = 0;
    if (grid == 0) {
        int dev = 0, cus = 0, per_cu = 0;
        hipGetDevice(&dev); hipDeviceGetAttribute(&cus, hipDeviceAttributeMultiprocessorCount, dev);
        hipFuncSetAttribute((const void*)mk_fwd, hipFuncAttributeMaxDynamicSharedMemorySize, LDS_BYTES);
        hipOccupancyMaxActiveBlocksPerMultiprocessor(&per_cu, (const void*)mk_fwd, 512, LDS_BYTES);
        if (per_cu < 1) per_cu = 1;
        grid = cus * per_cu; if (grid > 256) grid = 256;
        (void)hipGetLastError();
    }
    Args a{};
    for (int i = 0; i < 29; ++i) a.in[i] = (const float*)d_in[i];
    a.out = (float*)d_out; a.ws = (unsigned char*)d_ws;
    for (int i = 0; i < 32; ++i) a.inv[i] = 1.0f / powf(10000.0f, (float)(2 * i) / 64.0f);
    a.ph_lo = 0; a.ph_hi = 15;
    hipMemsetAsync(d_ws, 0, 65536, stream);
    void* args[] = {&a};
    hipError_t e = hipLaunchCooperativeKernel((const void*)mk_fwd, dim3(grid), dim3(512), args, LDS_BYTES, stream);
    if (e != hipSuccess) fprintf(stderr, "cooperative launch failed: %s (grid %d)\n", hipGetErrorString(e), grid);
}
```

```cpp
#include <hip/hip_runtime.h>
#include <hip/hip_cooperative_groups.h>
#include <cstdio>
#include <cstdint>
namespace cg = cooperative_groups;

#define LAS __attribute__((address_space(3)))
typedef unsigned short bf16_t;
typedef short bf16x8 __attribute__((ext_vector_type(8)));
typedef short s16x4 __attribute__((ext_vector_type(4)));
typedef float f32x4 __attribute__((ext_vector_type(4)));
typedef unsigned u32x4 __attribute__((ext_vector_type(4)));
typedef unsigned u32x2 __attribute__((ext_vector_type(2)));

constexpr int T = 8192, D = 1024, M = 16384, FF = 2816, UP = 5632, NIN = 2048;
constexpr float EPS = 1e-6f;
constexpr float QSCALE = 0.125f * 1.4426950408889634f;
constexpr size_t MiB = 1u << 20;
constexpr size_t WS_ROPE = 1 * MiB;
constexpr size_t WS_SSP = 3 * MiB;
constexpr size_t WS_C1P = 4 * MiB;
constexpr size_t WS_RSTD = 4 * MiB + 256 * 1024;
constexpr size_t WS_HB = 5 * MiB;
constexpr size_t WS_FB = 8 * MiB;
constexpr size_t WS_GATE = 11 * MiB;
constexpr size_t WS_WIN = 16 * MiB, WS_WOUT = 20 * MiB, WS_WUP0 = 22 * MiB, WS_WUP1 = 33 * MiB, WS_WDN0 = 44 * MiB, WS_WDN1 = 50 * MiB;
constexpr size_t WS_WPOOL = 56 * MiB, WS_WC1K = 57 * MiB, WS_WC1V = 58 * MiB, WS_WC2K = 59 * MiB, WS_WC2V = 59 * MiB + 512 * 1024;
constexpr size_t WS_XB = 64 * MiB;
constexpr size_t WS_Q = 96 * MiB;
constexpr size_t WS_KC = 128 * MiB, WS_VC = 132 * MiB, WS_KS = 136 * MiB, WS_VST = 140 * MiB, WS_KW = 144 * MiB, WS_VWT = 148 * MiB;
constexpr size_t WS_KCC = 152 * MiB, WS_VCT = 153 * MiB, WS_HIDK = 154 * MiB, WS_HIDV = 155 * MiB;
constexpr size_t WS_O = 160 * MiB;
constexpr size_t WS_ACT = 96 * MiB;
constexpr size_t WS_POOLED = 192 * MiB;
constexpr int LDS_RING = 131072, LDS_BYTES = 155648;

__device__ __forceinline__ unsigned cvt_pk_bf16(float lo, float hi) { unsigned r; asm volatile("v_cvt_pk_bf16_f32 %0, %1, %2" : "=v"(r) : "v"(lo), "v"(hi)); return r; }
__device__ __forceinline__ float bf2f(unsigned short b) { return __uint_as_float((unsigned)b << 16); }
__device__ __forceinline__ float ex2(float x) { return __builtin_amdgcn_exp2f(x); }
__device__ __forceinline__ float rcp(float x) { return __builtin_amdgcn_rcpf(x); }
__device__ __forceinline__ float sigmoidf_(float x) { return rcp(1.0f + ex2(-1.4426950408889634f * x)); }
__device__ __forceinline__ void unpk8(const u32x4 v, f32x4& lo, f32x4& hi) { lo = (f32x4){__uint_as_float(v.x << 16), __uint_as_float(v.x & 0xffff0000u), __uint_as_float(v.y << 16), __uint_as_float(v.y & 0xffff0000u)}; hi = (f32x4){__uint_as_float(v.z << 16), __uint_as_float(v.z & 0xffff0000u), __uint_as_float(v.w << 16), __uint_as_float(v.w & 0xffff0000u)}; }
__device__ __forceinline__ int perm8(int a) { return (a & ~31) | (16 * ((a >> 2) & 1) + 4 * ((a >> 3) & 3) + (a & 3)); }
__device__ __forceinline__ int vperm(int kk) { return (kk & 32) | (((kk >> 2) & 3) << 3) | (((kk >> 4) & 1) << 2) | (kk & 3); }
__device__ __forceinline__ int swap45(int a) { return (a & ~48) | (((a >> 4) & 1) << 5) | (((a >> 5) & 1) << 4); }
template <int CTRL> __device__ __forceinline__ float dppf(float x) { return __builtin_bit_cast(float, __builtin_amdgcn_mov_dpp(__builtin_bit_cast(int, x), CTRL, 0xf, 0xf, true)); }
__device__ __forceinline__ float xrow16_max(float x) {
    auto s = __builtin_amdgcn_permlane16_swap(__float_as_uint(x), __float_as_uint(x), false, false); x = fmaxf(__uint_as_float(s[0]), __uint_as_float(s[1]));
    auto t = __builtin_amdgcn_permlane32_swap(__float_as_uint(x), __float_as_uint(x), false, false); return fmaxf(__uint_as_float(t[0]), __uint_as_float(t[1])); }
__device__ __forceinline__ float xrow16_sum(float x) {
    auto s = __builtin_amdgcn_permlane16_swap(__float_as_uint(x), __float_as_uint(x), false, false); x = __uint_as_float(s[0]) + __uint_as_float(s[1]);
    auto t = __builtin_amdgcn_permlane32_swap(__float_as_uint(x), __float_as_uint(x), false, false); return __uint_as_float(t[0]) + __uint_as_float(t[1]); }
__device__ __forceinline__ float sum8(float x) { x += dppf<0xB1>(x); x += dppf<0x4E>(x); x += dppf<0x141>(x); return x; }
#define LDS_WAIT() asm volatile("s_waitcnt lgkmcnt(0)" ::: "memory")
#define WG_BAR() do { asm volatile("s_waitcnt lgkmcnt(0)" ::: "memory"); __builtin_amdgcn_s_barrier(); asm volatile("" ::: "memory"); } while (0)

namespace pg8 {
constexpr int BM = 256, BK = 64, HALF = 128, HTB = HALF * BK * 2, NXCD = 8, WGM = 8;
__host__ __device__ __forceinline__ int lds_byte(int r, int c) { const int st = (r >> 4) * 2 + (c >> 5), rr = r & 15, cc = c & 31, ob = rr * 64 + cc * 2; return st * 1024 + (ob ^ (((ob >> 9) & 1) << 5)); }
__host__ __device__ __forceinline__ void stage_rc(int b, int& R, int& C) { const int st = b / 1024, sb = b % 1024, swz = sb ^ (((sb >> 9) & 1) << 5); R = (st >> 1) * 16 + swz / 64; C = (st & 1) * 32 + (swz % 64) / 2; }
struct Unit { int pm, pn; };
struct Gemm { const bf16_t* A; const bf16_t* Bt; int M, N, K, lda, apn; };
struct StaticOrder {
    int nM, nN, nwg, G, c;
    __device__ void init(int M_, int N_, int G_, int c_) { nM = M_ / BM; nN = N_ / BM; nwg = nM * nN; G = G_; c = c_; }
    __device__ bool next(int i, Unit& u) const {
        const long L = (long)i * G + c; if (L >= nwg) return false;
        int wgid = (int)L; { const int q = nwg / NXCD, r = nwg % NXCD, xcd = wgid % NXCD, off = wgid / NXCD; wgid = (xcd < r ? xcd * (q + 1) : r * (q + 1) + (xcd - r) * q) + off; }
        const int nig = WGM * nN, gid = wgid / nig, fm = gid * WGM, gsz = (nM - fm) < WGM ? (nM - fm) : WGM;
        u.pm = fm + ((wgid % nig) % gsz); u.pn = (wgid % nig) / gsz; return true;
    }
};
template <class Epi>
__device__ __forceinline__ void gemm_phase(LAS unsigned char* lds, LAS unsigned char* ldsx, const Gemm g, const StaticOrder& S, const Epi& E) {
    int tid = threadIdx.x; asm volatile("" : "+v"(tid));
    const int wid = __builtin_amdgcn_readfirstlane(tid >> 6), lane = tid & 63, wr = wid >> 2, wc = wid & 3, fr = lane & 15, fq = lane >> 4;
    const int K = g.K, nt = K / BK;
    unsigned voffA[2], voffB[2];
#pragma unroll
    for (int i = 0; i < 2; ++i) { int R, C; stage_rc(tid * 16 + i * 8192, R, C); voffA[i] = (unsigned)(R * g.lda + C) * 2u; voffB[i] = (unsigned)(R * K + C) * 2u; }
    const size_t kstep = (size_t)(BK * 2);
    const size_t hstepA = (size_t)HALF * g.lda * 2, tstepA = 2 * hstepA, hstepB = (size_t)HALF * K * 2, tstepB = 2 * hstepB;
    const unsigned ldsw = (unsigned)wid * 1024u;
    const int aoff = lds_byte(wr * 64 + fr, fq * 8), boff = lds_byte(wc * 32 + fr, fq * 8);
#define PG8_SA(b, h) (((b) * 2 + (h)) * HTB)
#define PG8_SB(b, h) ((4 + (b) * 2 + (h)) * HTB)
#define PG8_STAGE(bufoff, gbase, voff) do { _Pragma("unroll") for (int _i = 0; _i < 2; ++_i) \
        __builtin_amdgcn_global_load_lds((const unsigned*)((const char*)(gbase) + (voff)[_i]), (LAS unsigned*)(lds + (bufoff) + ldsw + _i * 8192), 16, 0, 0); } while (0)
#define PG8_LDA(dst, b, h) do { _Pragma("unroll") for (int m = 0; m < 4; ++m) _Pragma("unroll") for (int k = 0; k < 2; ++k) dst[m][k] = *(const LAS bf16x8*)(lds + PG8_SA(b, h) + aoff + m * 2048 + k * 1024); } while (0)
#define PG8_LDB(dst, b, h) do { _Pragma("unroll") for (int n = 0; n < 2; ++n) _Pragma("unroll") for (int k = 0; k < 2; ++k) dst[n][k] = *(const LAS bf16x8*)(lds + PG8_SB(b, h) + boff + n * 2048 + k * 1024); } while (0)
#define PG8_MMA(ai, bj, At, Bt) do { __builtin_amdgcn_s_setprio(1); _Pragma("unroll") for (int m = 0; m < 4; ++m) _Pragma("unroll") for (int n = 0; n < 2; ++n) _Pragma("unroll") for (int k = 0; k < 2; ++k) \
        acc[ai][bj][m][n] = __builtin_amdgcn_mfma_f32_16x16x32_bf16(Bt[n][k], At[m][k], acc[ai][bj][m][n], 0, 0, 0); __builtin_amdgcn_s_setprio(0); } while (0)
#define PG8_WAIT_V(n) asm volatile("s_waitcnt vmcnt(" #n ")" ::: "memory")
#define PG8_WAIT_L(n) asm volatile("s_waitcnt lgkmcnt(" #n ")" ::: "memory")
#define PG8_BAR __builtin_amdgcn_s_barrier()
#define PG8_SCHED __builtin_amdgcn_sched_barrier(0)
    Unit cur, nxt; int ui = 0;
    if (!S.next(0, cur)) return;
    f32x4 acc[2][2][4][2];
#pragma unroll
    for (int a = 0; a < 2; ++a)
#pragma unroll
        for (int b = 0; b < 2; ++b)
#pragma unroll
            for (int m = 0; m < 4; ++m)
#pragma unroll
                for (int n = 0; n < 2; ++n) acc[a][b][m][n] = (f32x4){0.f, 0.f, 0.f, 0.f};
    bf16x8 At[4][2], B0[2][2], B1[2][2];
    const char* cA = (const char*)g.A + (size_t)cur.pm * tstepA + (size_t)cur.pn * g.apn; const char* cB = (const char*)g.Bt + (size_t)cur.pn * tstepB;
    PG8_STAGE(PG8_SB(0, 0), cB, voffB); PG8_STAGE(PG8_SB(0, 1), cB + hstepB, voffB); PG8_STAGE(PG8_SA(0, 0), cA, voffA); PG8_STAGE(PG8_SA(0, 1), cA + hstepA, voffA);
    if (wr == 1) PG8_BAR;
    PG8_WAIT_V(2); PG8_BAR;
    PG8_STAGE(PG8_SB(1, 0), cB + kstep, voffB); PG8_STAGE(PG8_SA(1, 0), cA + kstep, voffA); PG8_STAGE(PG8_SB(1, 1), cB + hstepB + kstep, voffB);
    PG8_WAIT_V(6); PG8_BAR;
    for (;;) {
        const bool has_next = S.next(ui + 1, nxt);
        const char* nA = has_next ? (const char*)g.A + (size_t)nxt.pm * tstepA + (size_t)nxt.pn * g.apn : cA; const char* nB = has_next ? (const char*)g.Bt + (size_t)nxt.pn * tstepB : cB;
        for (int t = 0; t < nt; t += 2) {
            const bool last = (t == nt - 2);
            const char* a1 = cA + (size_t)(t + 1) * kstep;
            const char* a2 = last ? nA : cA + (size_t)(t + 2) * kstep; const char* b2 = last ? nB : cB + (size_t)(t + 2) * kstep;
            const char* a3 = a2 + kstep; const char* b3 = b2 + kstep;
            PG8_LDB(B0, 0, 0); PG8_LDB(B1, 0, 1); PG8_SCHED; PG8_LDA(At, 0, 0); PG8_STAGE(PG8_SA(1, 1), a1 + hstepA, voffA);
            PG8_WAIT_V(8); PG8_WAIT_L(0); PG8_BAR; PG8_MMA(0, 0, At, B0); PG8_MMA(0, 1, At, B1); PG8_BAR; PG8_SCHED;
            PG8_LDA(At, 0, 1); PG8_STAGE(PG8_SB(0, 0), b2, voffB); PG8_STAGE(PG8_SB(0, 1), b2 + hstepB, voffB); PG8_STAGE(PG8_SA(0, 0), a2, voffA);
            PG8_WAIT_V(8); PG8_WAIT_L(0); PG8_BAR; PG8_MMA(1, 0, At, B0); PG8_MMA(1, 1, At, B1); PG8_BAR; PG8_SCHED;
            PG8_LDB(B0, 1, 0); PG8_LDB(B1, 1, 1); PG8_SCHED; PG8_LDA(At, 1, 0); PG8_STAGE(PG8_SA(0, 1), a2 + hstepA, voffA);
            PG8_WAIT_V(8); PG8_WAIT_L(0); PG8_BAR; PG8_MMA(0, 0, At, B0); PG8_MMA(0, 1, At, B1); PG8_BAR; PG8_SCHED;
            PG8_LDA(At, 1, 1); PG8_STAGE(PG8_SB(1, 0), b3, voffB); PG8_STAGE(PG8_SB(1, 1), b3 + hstepB, voffB); PG8_STAGE(PG8_SA(1, 0), a3, voffA);
            PG8_WAIT_V(8); PG8_WAIT_L(0); PG8_BAR; PG8_MMA(1, 0, At, B0); PG8_MMA(1, 1, At, B1); PG8_BAR; PG8_SCHED;
        }
        if (wr == 0) PG8_BAR;
        { int t2 = threadIdx.x; asm volatile("" : "+v"(t2));
          E(acc, cur, wr, wc, t2 & 15, (t2 & 63) >> 4, ldsx, t2); }
        if (!has_next) break;
#pragma unroll
        for (int a = 0; a < 2; ++a)
#pragma unroll
            for (int b = 0; b < 2; ++b)
#pragma unroll
                for (int m = 0; m < 4; ++m)
#pragma unroll
                    for (int n = 0; n < 2; ++n) acc[a][b][m][n] = (f32x4){0.f, 0.f, 0.f, 0.f};
        cur = nxt; cA = nA; cB = nB; ++ui;
        if (wr == 1) PG8_BAR;
    }
    PG8_WAIT_V(0);
    PG8_BAR;
#undef PG8_SA
#undef PG8_SB
#undef PG8_STAGE
#undef PG8_LDA
#undef PG8_LDB
#undef PG8_MMA
#undef PG8_WAIT_V
#undef PG8_WAIT_L
#undef PG8_BAR
#undef PG8_SCHED
}
}
using pg8::Unit;
typedef f32x4 Acc[2][2][4][2];

__device__ __forceinline__ float row_rstd(const float* ssp, int np, int row) {
    float s = 0.f; for (int i = 0; i < np; ++i) s += ssp[(size_t)i * M + row];
    return 1.0f / sqrtf(s * (1.0f / D) + EPS);
}

struct EpiIn {
    const float* rstdv; const float* cosT; const float* sinT;
    bf16_t *Q, *KC, *VC, *KS, *VST, *KW, *VWT; float* gates;
    __device__ __forceinline__ void operator()(Acc& acc, const Unit& u, int wr, int wc, int fr, int fq, LAS unsigned char*, int) const {
#pragma unroll
        for (int ai = 0; ai < 2; ++ai)
#pragma unroll
            for (int m = 0; m < 4; ++m) {
                const int row = u.pm * 256 + ai * 128 + wr * 64 + m * 16 + fr; const float rs = rstdv[row];
                const int t = row & (T - 1), b = row >> 13;
                const int d0 = 16 * (wc & 1) + 4 * fq;
                const f32x4 cs = *(const f32x4*)(cosT + t * 32 + d0), sn = *(const f32x4*)(sinT + t * 32 + d0);
#pragma unroll
                for (int bj = 0; bj < 2; ++bj) {
                    f32x4 a1 = acc[ai][bj][m][0] * rs, a2 = acc[ai][bj][m][1] * rs;
                    if (u.pn == 7) {
                        if (bj == 0) {
#pragma unroll
                            for (int n = 0; n < 2; ++n) { const int c0 = 32 * wc + 16 * n + 4 * fq; if (c0 < 48) { const f32x4 v = n ? a2 : a1; f32x4 o; o[0] = sigmoidf_(v[0]); o[1] = sigmoidf_(v[1]); o[2] = sigmoidf_(v[2]); o[3] = sigmoidf_(v[3]); *(f32x4*)(gates + (size_t)row * 48 + c0) = o; } }
                        }
                        continue;
                    }
                    const int hh = 2 * bj + (wc >> 1);
                    bool rope; if (u.pn < 4) rope = true; else rope = (u.pn >= 5) && (hh < 2);
                    f32x4 o1 = a1, o2 = a2;
                    if (rope) { o1 = a1 * cs - a2 * sn; o2 = a1 * sn + a2 * cs; }
                    if (u.pn < 4) {
                        o1 = o1 * QSCALE; o2 = o2 * QSCALE;
                        bf16_t* p = Q + (size_t)row * 1024 + (u.pn * 4 + hh) * 64 + d0;
                        u32x2 w1; w1.x = cvt_pk_bf16(o1[0], o1[1]); w1.y = cvt_pk_bf16(o1[2], o1[3]); *(u32x2*)p = w1;
                        u32x2 w2; w2.x = cvt_pk_bf16(o2[0], o2[1]); w2.y = cvt_pk_bf16(o2[2], o2[3]); *(u32x2*)(p + 32) = w2;
                    } else {
                        const int gg = hh & 1; const bool isv = hh >= 2;
                        if (!isv) {
                            bf16_t* base = (u.pn == 4) ? KC : (u.pn == 5) ? KS : KW;
                            bf16_t* p = base + ((size_t)(b * 2 + gg) * T + t) * 64 + d0;
                            u32x2 w1; w1.x = cvt_pk_bf16(o1[0], o1[1]); w1.y = cvt_pk_bf16(o1[2], o1[3]); *(u32x2*)p = w1;
                            u32x2 w2; w2.x = cvt_pk_bf16(o2[0], o2[1]); w2.y = cvt_pk_bf16(o2[2], o2[3]); *(u32x2*)(p + 32) = w2;
                        } else if (u.pn == 4) {
                            bf16_t* p = VC + ((size_t)(b * 2 + gg) * T + t) * 64 + d0;
                            u32x2 w1; w1.x = cvt_pk_bf16(o1[0], o1[1]); w1.y = cvt_pk_bf16(o1[2], o1[3]); *(u32x2*)p = w1;
                            u32x2 w2; w2.x = cvt_pk_bf16(o2[0], o2[1]); w2.y = cvt_pk_bf16(o2[2], o2[3]); *(u32x2*)(p + 32) = w2;
                        } else {
                            bf16_t* base = (u.pn == 5) ? VST : VWT;
                            bf16_t* p = base + ((size_t)(b * 2 + gg) * 128 + (t >> 6)) * 4096 + vperm(t & 63);
#pragma unroll
                            for (int j = 0; j < 4; ++j) { p[(d0 + j) * 64] = (bf16_t)(cvt_pk_bf16(o1[j], 0.f) & 0xffff); p[(d0 + 32 + j) * 64] = (bf16_t)(cvt_pk_bf16(o2[j], 0.f) & 0xffff); }
                        }
                    }
                }
                asm volatile("" ::: "memory"); __builtin_amdgcn_sched_barrier(0);
            }
    }
};

struct EpiC1 {
    bf16_t* hid;
    __device__ __forceinline__ void operator()(Acc& acc, const Unit& u, int wr, int wc, int fr, int fq, LAS unsigned char* ldsx, int) const {
        const LAS float* c1 = (const LAS float*)ldsx;
#pragma unroll
        for (int bj = 0; bj < 2; ++bj) {
            const int c0 = 128 * bj + 32 * wc + 8 * fq;
            const f32x4 bA = *(const LAS f32x4*)(c1 + c0), bB = *(const LAS f32x4*)(c1 + c0 + 4);
#pragma unroll
            for (int ai = 0; ai < 2; ++ai)
#pragma unroll
                for (int m = 0; m < 4; ++m) {
                    const int row = u.pm * 256 + ai * 128 + wr * 64 + m * 16 + fr;
                    float v[8];
#pragma unroll
                    for (int e = 0; e < 8; ++e) { const float x = acc[ai][bj][m][e >> 2][e & 3] + ((e >> 2) ? bB[e & 3] : bA[e & 3]); const float y = 0.7978845608028654f * (x + 0.044715f * x * x * x); v[e] = x * sigmoidf_(2.0f * y); }
                    u32x4 w; w.x = cvt_pk_bf16(v[0], v[1]); w.y = cvt_pk_bf16(v[2], v[3]); w.z = cvt_pk_bf16(v[4], v[5]); w.w = cvt_pk_bf16(v[6], v[7]);
                    *(u32x4*)(hid + (size_t)row * 256 + c0) = w;
                    asm volatile("" ::: "memory"); __builtin_amdgcn_sched_barrier(0);
                }
        }
    }
};
struct EpiC2 {
    const float* b2; const float* cosT; const float* sinT; bf16_t* out; int isv;
    __device__ __forceinline__ void operator()(Acc& acc, const Unit& u, int wr, int wc, int fr, int fq, LAS unsigned char*, int) const {
        if (wc >= 2) return;
        const int d0 = 16 * (wc & 1) + 4 * fq;
        const f32x4 bA = *(const f32x4*)(b2 + d0), bB = *(const f32x4*)(b2 + d0 + 32);
#pragma unroll
        for (int ai = 0; ai < 2; ++ai)
#pragma unroll
            for (int m = 0; m < 4; ++m) {
                const int row = u.pm * 256 + ai * 128 + wr * 64 + m * 16 + fr; const int j = row & 511;
                f32x4 a1 = acc[ai][0][m][0] + bA, a2 = acc[ai][0][m][1] + bB;
                if (j == 511) { a1 = (f32x4){0.f, 0.f, 0.f, 0.f}; a2 = a1; }
                if (!isv) {
                    const int pos = (j == 511) ? 0 : 16 * j + 31;
                    const f32x4 cs = *(const f32x4*)(cosT + pos * 32 + d0), sn = *(const f32x4*)(sinT + pos * 32 + d0);
                    const f32x4 o1 = a1 * cs - a2 * sn, o2 = a1 * sn + a2 * cs;
                    bf16_t* p = out + (size_t)row * 64 + d0;
                    u32x2 w1; w1.x = cvt_pk_bf16(o1[0], o1[1]); w1.y = cvt_pk_bf16(o1[2], o1[3]); *(u32x2*)p = w1;
                    u32x2 w2; w2.x = cvt_pk_bf16(o2[0], o2[1]); w2.y = cvt_pk_bf16(o2[2], o2[3]); *(u32x2*)(p + 32) = w2;
                } else {
                    bf16_t* p = out + (size_t)(row >> 6) * 4096 + vperm(row & 63);
#pragma unroll
                    for (int e = 0; e < 4; ++e) { p[(d0 + e) * 64] = (bf16_t)(cvt_pk_bf16(a1[e], 0.f) & 0xffff); p[(d0 + 32 + e) * 64] = (bf16_t)(cvt_pk_bf16(a2[e], 0.f) & 0xffff); }
                }
                asm volatile("" ::: "memory"); __builtin_amdgcn_sched_barrier(0);
            }
    }
};

struct EpiRes {
    const float* xold; float* xnew; bf16_t* xb; float* ssp; const float* pb; const float* ps;
    __device__ __forceinline__ void operator()(Acc& acc, const Unit& u, int wr, int wc, int fr, int fq, LAS unsigned char* ldsx, int tid) const {
#pragma unroll
        for (int ai = 0; ai < 2; ++ai)
#pragma unroll
            for (int m = 0; m < 4; ++m) {
                const int row = u.pm * 256 + ai * 128 + wr * 64 + m * 16 + fr; float ss = 0.f;
#pragma unroll
                for (int bj = 0; bj < 2; ++bj) {
                    const int col = u.pn * 256 + 128 * bj + 32 * wc + 8 * fq; const size_t off = (size_t)row * D + col;
                    f32x4 a0 = acc[ai][bj][m][0], a1 = acc[ai][bj][m][1];
                    if (pb) { a0 = (a0 + *(const f32x4*)(pb + col)) * *(const f32x4*)(ps + col); a1 = (a1 + *(const f32x4*)(pb + col + 4)) * *(const f32x4*)(ps + col + 4); }
                    f32x4 r0, r1; unpk8(*(const u32x4*)(xb + off), r0, r1);
                    const f32x4 x0 = r0 + a0, x1 = r1 + a1;
                    u32x4 w; w.x = cvt_pk_bf16(x0[0], x0[1]); w.y = cvt_pk_bf16(x0[2], x0[3]); w.z = cvt_pk_bf16(x1[0], x1[1]); w.w = cvt_pk_bf16(x1[2], x1[3]);
                    *(u32x4*)(xb + off) = w;
                    ss += (x0[0] * x0[0] + x0[1] * x0[1]) + (x0[2] * x0[2] + x0[3] * x0[3]) + (x1[0] * x1[0] + x1[1] * x1[1]) + (x1[2] * x1[2] + x1[3] * x1[3]);
                    asm volatile("" ::: "memory"); __builtin_amdgcn_sched_barrier(0);
                }
                ss = xrow16_sum(ss);
                if (fq == 0) ((LAS float*)ldsx)[wc * 256 + ai * 128 + wr * 64 + m * 16 + fr] = ss;
            }
        WG_BAR();
        if (tid < 256) { const LAS float* rd = (const LAS float*)ldsx; ssp[(size_t)u.pn * M + u.pm * 256 + tid] = (rd[tid] + rd[256 + tid]) + (rd[512 + tid] + rd[768 + tid]); }
        WG_BAR();
    }
};

struct EpiFinal {
    float* x; const float* gain; float* ssx; unsigned* cnt; const bf16_t* xb;
    __device__ __forceinline__ void operator()(Acc& acc, const Unit& u, int wr, int wc, int fr, int fq, LAS unsigned char* ldsx, int tid) const {
        LAS float* red = (LAS float*)ldsx; LAS float* rsl = (LAS float*)(ldsx + 4096);
#pragma unroll
        for (int ai = 0; ai < 2; ++ai)
#pragma unroll
            for (int m = 0; m < 4; ++m) {
                const int row = u.pm * 256 + ai * 128 + wr * 64 + m * 16 + fr; float ss = 0.f;
#pragma unroll
                for (int bj = 0; bj < 2; ++bj) {
                    const int col = u.pn * 256 + 128 * bj + 32 * wc + 8 * fq; const size_t off = (size_t)row * D + col;
                    f32x4 r0, r1; unpk8(*(const u32x4*)(xb + off), r0, r1);
                    const f32x4 x0 = r0 + acc[ai][bj][m][0], x1 = r1 + acc[ai][bj][m][1];
                    acc[ai][bj][m][0] = x0; acc[ai][bj][m][1] = x1;
                    ss += (x0[0] * x0[0] + x0[1] * x0[1]) + (x0[2] * x0[2] + x0[3] * x0[3]) + (x1[0] * x1[0] + x1[1] * x1[1]) + (x1[2] * x1[2] + x1[3] * x1[3]);
                    asm volatile("" ::: "memory"); __builtin_amdgcn_sched_barrier(0);
                }
                ss = xrow16_sum(ss);
                if (fq == 0) red[wc * 256 + ai * 128 + wr * 64 + m * 16 + fr] = ss;
            }
        WG_BAR();
        if (tid < 256) __hip_atomic_store(ssx + (size_t)u.pn * M + u.pm * 256 + tid, (red[tid] + red[256 + tid]) + (red[512 + tid] + red[768 + tid]), __ATOMIC_RELAXED, __HIP_MEMORY_SCOPE_AGENT);
        asm volatile("s_waitcnt vmcnt(0)" ::: "memory");
        WG_BAR();
        if (tid == 0) {
            unsigned* c = cnt + 64 * u.pm;
            __hip_atomic_fetch_add(c, 1u, __ATOMIC_RELAXED, __HIP_MEMORY_SCOPE_AGENT);
            unsigned spins = 0;
            while (__hip_atomic_load(c, __ATOMIC_RELAXED, __HIP_MEMORY_SCOPE_AGENT) < 4u) { __builtin_amdgcn_s_sleep(2); if (++spins > (1u << 22)) break; }
            __builtin_amdgcn_fence(__ATOMIC_ACQUIRE, "agent");
            asm volatile("s_waitcnt vmcnt(0)" ::: "memory");
        }
        WG_BAR();
        if (tid < 256) {
            const float* p = ssx + u.pm * 256 + tid;
            const float sq = (__hip_atomic_load(p, __ATOMIC_RELAXED, __HIP_MEMORY_SCOPE_AGENT) + __hip_atomic_load(p + M, __ATOMIC_RELAXED, __HIP_MEMORY_SCOPE_AGENT)) +
                             (__hip_atomic_load(p + 2 * M, __ATOMIC_RELAXED, __HIP_MEMORY_SCOPE_AGENT) + __hip_atomic_load(p + 3 * M, __ATOMIC_RELAXED, __HIP_MEMORY_SCOPE_AGENT));
            rsl[tid] = 1.0f / sqrtf(sq * (1.0f / D) + EPS);
        }
        WG_BAR();
#pragma unroll
        for (int ai = 0; ai < 2; ++ai)
#pragma unroll
            for (int m = 0; m < 4; ++m) {
                const int rl = ai * 128 + wr * 64 + m * 16 + fr; const float rs = rsl[rl]; const int row = u.pm * 256 + rl;
#pragma unroll
                for (int bj = 0; bj < 2; ++bj) {
                    const int col = u.pn * 256 + 128 * bj + 32 * wc + 8 * fq; const size_t off = (size_t)row * D + col;
                    *(f32x4*)(x + off) = acc[ai][bj][m][0] * rs * *(const f32x4*)(gain + col); *(f32x4*)(x + off + 4) = acc[ai][bj][m][1] * rs * *(const f32x4*)(gain + col + 4);
                }
                asm volatile("" ::: "memory"); __builtin_amdgcn_sched_barrier(0);
            }
    }
};

struct EpiUp {
    const float* ssp; const float* cw; const float* cb; bf16_t* act; float* HB; float* FB;
    __device__ __forceinline__ void operator()(Acc& acc, const Unit& u, int wr, int wc, int fr, int fq, LAS unsigned char* ldsx, int tid) const {
        LAS float* Hl = (LAS float*)ldsx;
        LAS float* rsl = (LAS float*)(ldsx + 10240);
        const int lane = tid & 63;
        if (tid < 256) { const int row = u.pm * 256 + tid; const float sq = (ssp[row] + ssp[M + row]) + (ssp[2 * M + row] + ssp[3 * M + row]); rsl[tid] = 1.0f / sqrtf(sq * (1.0f / D) + EPS); }
        WG_BAR();
#pragma unroll
        for (int ai = 0; ai < 2; ++ai)
#pragma unroll
            for (int m = 0; m < 4; ++m) {
                const float rs = rsl[ai * 128 + wr * 64 + m * 16 + fr];
#pragma unroll
                for (int bj = 0; bj < 2; ++bj) { acc[ai][bj][m][0] *= rs; acc[ai][bj][m][1] *= rs; }
                asm volatile("" ::: "memory"); __builtin_amdgcn_sched_barrier(0);
            }
        if (tid < 128) *(LAS f32x4*)(Hl + tid * 4) = (f32x4){0.f, 0.f, 0.f, 0.f};
#pragma unroll
        for (int ai = 0; ai < 2; ++ai) {
            const int k = 2 * ai + wr;
#pragma unroll
            for (int bj = 0; bj < 2; ++bj)
#pragma unroll
                for (int n = 0; n < 2; ++n) {
                    const int tc = 128 * bj + 32 * wc + 8 * fq + 4 * n; const int uc = bj * FF + u.pn * 128 + 32 * wc + 8 * fq + 4 * n;
                    if (fr >= 14) { *(LAS f32x4*)(Hl + ((k + 1) * 2 + (fr - 14)) * 256 + tc) = acc[ai][bj][3][n]; if (k == 3) *(f32x4*)(HB + ((size_t)u.pm * 2 + (fr - 14)) * UP + uc) = acc[ai][bj][3][n]; }
                    if (k == 0 && fr < 2) *(f32x4*)(FB + ((size_t)u.pm * 2 + fr) * UP + uc) = acc[0][bj][0][n];
                }
        }
        WG_BAR();
#pragma unroll
        for (int ai = 0; ai < 2; ++ai) {
            const int k = 2 * ai + wr;
#pragma unroll
            for (int n = 0; n < 2; ++n) {
                const int tc = 32 * wc + 8 * fq + 4 * n; const int ucg = u.pn * 128 + tc;
                f32x4 cg[4];
#pragma unroll
                for (int bj = 0; bj < 2; ++bj) {
                    const int uc = bj * FF + ucg;
                    const f32x4 w0 = *(const f32x4*)(cw + uc), w1 = *(const f32x4*)(cw + UP + uc), w2 = *(const f32x4*)(cw + 2 * UP + uc), bb = *(const f32x4*)(cb + uc);
                    const f32x4 h0 = *(const LAS f32x4*)(Hl + (k * 2 + 0) * 256 + 128 * bj + tc), h1 = *(const LAS f32x4*)(Hl + (k * 2 + 1) * 256 + 128 * bj + tc);
#pragma unroll
                    for (int m = 0; m < 4; ++m) {
                        const f32x4 V = acc[ai][bj][m][n]; f32x4 p1, p2;
#pragma unroll
                        for (int e = 0; e < 4; ++e) {
                            const float r1 = dppf<0x121>(V[e]), r2 = dppf<0x122>(V[e]); float x1, x2;
                            if (m > 0) { x1 = dppf<0x121>(acc[ai][bj][m > 0 ? m - 1 : 0][n][e]); x2 = dppf<0x122>(acc[ai][bj][m > 0 ? m - 1 : 0][n][e]); }
                            else { x1 = h1[e]; x2 = (fr == 0) ? h0[e] : h1[e]; }
                            p1[e] = (fr == 0) ? x1 : r1; p2[e] = (fr < 2) ? x2 : r2;
                        }
                        const f32x4 cv = bb + w0 * p2 + w1 * p1 + w2 * V;
                        __builtin_amdgcn_sched_barrier(0);
                        if (bj == 0) cg[m] = cv;
                        else {
                            const int row = u.pm * 256 + ai * 128 + wr * 64 + m * 16 + fr;
                            float o[4];
#pragma unroll
                            for (int e = 0; e < 4; ++e) { const float gt = cg[m][e]; o[e] = gt * sigmoidf_(gt) * cv[e]; }
                            u32x2 w; w.x = cvt_pk_bf16(o[0], o[1]); w.y = cvt_pk_bf16(o[2], o[3]);
                            *(u32x2*)(act + (size_t)row * FF + ucg) = w;
                        }
                    }
                    asm volatile("" ::: "memory"); __builtin_amdgcn_sched_barrier(0);
                }
            }
        }
        WG_BAR();
    }
};

namespace att {
constexpr int SLOT_B = 16384, NSLOT = 6;
constexpr int OFF_K = 0, OFF_IMP = NSLOT * SLOT_B, IMPW = 132, OFF_SEL = OFF_IMP + 64 * IMPW * 4, OFF_UNI = OFF_SEL + 1024, OFF_LIST = OFF_UNI + 64, OFF_N = OFF_LIST + 132 * 4, OFF_CODE = OFF_N + 48, CODEW = 144;
static_assert(OFF_CODE + 8 * CODEW <= LDS_BYTES - 16 && 8 * SLOT_B <= OFF_SEL, "attention LDS map");
struct Ctx {
    const bf16_t *Q, *KCC, *VCT, *KS, *VST, *KW, *VWT; const float* gates; bf16_t* O;
};
__device__ __forceinline__ bf16x8 mk8(s16x4 a, s16x4 b) { return (bf16x8){a[0], a[1], a[2], a[3], b[0], b[1], b[2], b[3]}; }

template <int MODE>
__device__ __forceinline__ void branch(LAS unsigned char* lds, const bf16_t* Kg, const bf16_t* Vg, int ktile_elems, int nt, int c, int w, int lane, int tid,
                                       const bf16x8 (&qf)[4][2], float (&mrow)[4], float (&lrow)[4], f32x4 (&O)[4][4]) {
    const int fr = lane & 15, fq = lane >> 4;
    const LAS int* list = (const LAS int*)(lds + OFF_LIST);
    LAS float* impL = (LAS float*)(lds + OFF_IMP);
    const LAS unsigned char* codeL = (const LAS unsigned char*)(lds + OFF_CODE) + w * CODEW;
    constexpr int TPS = (MODE >= 2) ? 4 : 3;
#define ATT_DMA(ti, slot) do { const int ti_ = (ti); const int s_ = list[ti_]; LAS unsigned char* d_ = lds + OFF_K + (slot) * SLOT_B + w * 1024; \
        int t2_ = tid; asm volatile("" : "+v"(t2_)); const int lr = t2_ >> 3, lq = t2_ & 7; const int goff = lr * 64 + ((lq ^ ((lr >> 1) & 7)) * 8); \
        __builtin_amdgcn_global_load_lds((const unsigned*)(Kg + (size_t)s_ * ktile_elems + goff), (LAS unsigned*)d_, 16, 0, 0); \
        if (MODE != 0) __builtin_amdgcn_global_load_lds((const unsigned*)(Vg + (size_t)s_ * 4096 + goff), (LAS unsigned*)(d_ + 8192), 16, 0, 0); } while (0)
    asm volatile("s_waitcnt vmcnt(0)" ::: "memory");
#pragma unroll
    for (int ti = 0; ti < TPS; ++ti) if (ti < nt) ATT_DMA(ti, ti);
    const int nst = (nt + TPS - 1) / TPS;
    for (int j = 0; j < nst; ++j) {
        asm volatile("s_waitcnt vmcnt(0)" ::: "memory");
        WG_BAR();
#pragma unroll
        for (int hh = 0; hh < TPS; ++hh) if (TPS * (j + 1) + hh < nt) ATT_DMA(TPS * (j + 1) + hh, ((j + 1) & 1) * TPS + hh);
        int sl0 = 0, sl1 = 0, sl2 = 0, sl3 = 0; unsigned codes4 = 0xffffffffu;
        if (TPS == 4) {
            const u32x4 l4 = *(const LAS u32x4*)(list + TPS * j);
            sl0 = __builtin_amdgcn_readfirstlane((int)l4.x); sl1 = __builtin_amdgcn_readfirstlane((int)l4.y); sl2 = __builtin_amdgcn_readfirstlane((int)l4.z); sl3 = __builtin_amdgcn_readfirstlane((int)l4.w);
            if (MODE == 2) codes4 = (unsigned)__builtin_amdgcn_readfirstlane((int)*(const LAS unsigned*)(codeL + TPS * j));
        }
#pragma unroll 1
        for (int h = 0; h < TPS; ++h) {
        const int i = TPS * j + h; if (i >= nt) break;
        const int s = (TPS == 4) ? (h == 0 ? sl0 : h == 1 ? sl1 : h == 2 ? sl2 : sl3) : list[i];
        unsigned code = 0xffu; if (MODE == 2) code = (codes4 >> (8 * h)) & 0xffu;
        const LAS unsigned char* Kb = lds + OFF_K + ((j & 1) * TPS + h) * SLOT_B;
        const LAS unsigned char* Vb = Kb;
        int l2_ = lane; asm volatile("" : "+v"(l2_)); const int fr2 = l2_ & 15, fq2 = l2_ >> 4, swz = (fr2 >> 1) & 7;
        const int kb0 = fr2 * 128 + ((fq2 ^ swz) * 16), kb1 = kb0 ^ 64;
        if (MODE != 2) {
            f32x4 sa[4][4];
#pragma unroll
            for (int p = 0; p < 4; ++p) {
                const float cinit = (MODE == 1) ? lrow[p] : -((mrow[p] < -1e29f) ? 0.f : mrow[p]);
#pragma unroll
                for (int mt = 0; mt < 4; ++mt) sa[p][mt] = (f32x4){cinit, cinit, cinit, cinit};
            }
#pragma unroll
            for (int mt = 0; mt < 4; ++mt)
#pragma unroll
                for (int ks = 0; ks < 2; ++ks) {
                    const bf16x8 kf = *(const LAS bf16x8*)(Kb + (ks ? kb1 : kb0) + mt * 2048);
#pragma unroll
                    for (int p = 0; p < 4; ++p) sa[p][mt] = __builtin_amdgcn_mfma_f32_16x16x32_bf16(kf, qf[p][ks], sa[p][mt], 0, 0, 0);
                }
            bf16x8 pf[4][2];
#pragma unroll
            for (int p = 0; p < 4; ++p) {
                const int ttA = 8 * w + 2 * p, tt = ttA + (fr >> 3);
                bool needmask;
                if (MODE <= 1) needmask = (((64 * c + ttA - 31) >> 4) - 64 * s) < 63;
                else needmask = (s == c) || (c >= 8 && s == c - 8);
                if (needmask) {
                    int hi, lov = -1;
                    if (MODE <= 1) { const int t = 64 * c + tt; hi = ((t - 31) >> 4) - 64 * s; }
                    else { hi = (s == c) ? tt : 63; lov = (c >= 8 && s == c - 8) ? tt : -1; }
#pragma unroll
                    for (int mt = 0; mt < 4; ++mt)
#pragma unroll
                        for (int j = 0; j < 4; ++j) { const int kk = 16 * mt + 4 * fq + j; sa[p][mt][j] = (kk <= hi && kk > lov) ? sa[p][mt][j] : -1e30f; }
                }
                if (MODE != 1) {
                    float mx = fmaxf(fmaxf(sa[p][0][0], sa[p][0][1]), sa[p][0][2]);
                    mx = fmaxf(fmaxf(mx, sa[p][0][3]), sa[p][1][0]); mx = fmaxf(fmaxf(mx, sa[p][1][1]), sa[p][1][2]); mx = fmaxf(fmaxf(mx, sa[p][1][3]), sa[p][2][0]);
                    mx = fmaxf(fmaxf(mx, sa[p][2][1]), sa[p][2][2]); mx = fmaxf(fmaxf(mx, sa[p][2][3]), sa[p][3][0]); mx = fmaxf(fmaxf(mx, sa[p][3][1]), sa[p][3][2]); mx = fmaxf(mx, sa[p][3][3]);
                    mx = xrow16_max(mx);
                    const bool uninit = mrow[p] < -1e29f;
                    const bool resc = (mx > 8.0f) || (uninit && mx > -1e29f);
                    if (__any(resc)) {
                        const float delta = resc ? mx : 0.f;
                        const float alpha = (resc && !uninit) ? ex2(-delta) : 1.0f;
#pragma unroll
                        for (int mt = 0; mt < 4; ++mt) sa[p][mt] = sa[p][mt] - delta;
                        lrow[p] *= alpha;
                        if (MODE >= 2) {
#pragma unroll
                            for (int d = 0; d < 4; ++d) O[p][d] *= alpha;
                        }
                        if (resc) mrow[p] = (uninit ? 0.f : mrow[p]) + delta;
                    }
                }
#pragma unroll
                for (int mt = 0; mt < 4; ++mt)
#pragma unroll
                    for (int j = 0; j < 4; ++j) sa[p][mt][j] = ex2(sa[p][mt][j]);
                if (MODE != 1) { const f32x4 t4 = (sa[p][0] + sa[p][1]) + (sa[p][2] + sa[p][3]); lrow[p] += (t4[0] + t4[1]) + (t4[2] + t4[3]); }
                if (MODE >= 1) {
#pragma unroll
                    for (int k2 = 0; k2 < 2; ++k2) {
                        u32x4 wv; wv.x = cvt_pk_bf16(sa[p][2 * k2][0], sa[p][2 * k2][1]); wv.y = cvt_pk_bf16(sa[p][2 * k2][2], sa[p][2 * k2][3]); wv.z = cvt_pk_bf16(sa[p][2 * k2 + 1][0], sa[p][2 * k2 + 1][1]); wv.w = cvt_pk_bf16(sa[p][2 * k2 + 1][2], sa[p][2 * k2 + 1][3]);
                        pf[p][k2] = __builtin_bit_cast(bf16x8, wv);
                    }
                }
                if (MODE == 1) {
#pragma unroll
                    for (int mt = 0; mt < 4; ++mt) {
                        float a = sa[p][mt][0] + sa[p][mt][1] + sa[p][mt][2] + 0.5f * sa[p][mt][3], bn = 0.5f * sa[p][mt][3];
                        a = sum8(a); bn = sum8(bn);
                        const int sb = 16 * s + 4 * mt + fq;
                        if ((fr & 7) == 0) { (void)__hip_atomic_fetch_add(impL + tt * IMPW + sb, a, __ATOMIC_RELAXED, __HIP_MEMORY_SCOPE_WORKGROUP); (void)__hip_atomic_fetch_add(impL + tt * IMPW + sb + 1, bn, __ATOMIC_RELAXED, __HIP_MEMORY_SCOPE_WORKGROUP); }
                    }
                }
            }
            if (MODE >= 1) {
#pragma unroll
                for (int d = 0; d < 4; ++d)
#pragma unroll
                    for (int k2 = 0; k2 < 2; ++k2) {
                        const bf16x8 vf = *(const LAS bf16x8*)(Vb + 8192 + (k2 ? kb1 : kb0) + d * 2048);
#pragma unroll
                        for (int p = 0; p < 4; ++p) O[p][d] = __builtin_amdgcn_mfma_f32_16x16x32_bf16(vf, pf[p][k2], O[p][d], 0, 0, 0);
                    }
            }
            __builtin_amdgcn_sched_barrier(0);
        } else {
#pragma unroll
        for (int p = 0; p < 4; ++p) {
            const int ttA = 8 * w + 2 * p;
            const unsigned mA = (code >> (2 * p)) & 1u, mB = (code >> (2 * p + 1)) & 1u;
            if ((mA | mB) != 0u) {
            const int tt = ttA + (fr >> 3);
            float cinit;
            if (MODE == 1) cinit = lrow[p];
            else { const float mref = (mrow[p] < -1e29f) ? 0.f : mrow[p]; const bool colact = (MODE != 2) || (((fr >> 3) ? mB : mA) != 0u); cinit = colact ? -mref : -1e30f; }
            f32x4 sa[4];
#pragma unroll
            for (int mt = 0; mt < 4; ++mt) {
                sa[mt] = (f32x4){cinit, cinit, cinit, cinit};
#pragma unroll
                for (int ks = 0; ks < 2; ++ks) { const bf16x8 kf = *(const LAS bf16x8*)(Kb + (ks ? kb1 : kb0) + mt * 2048); sa[mt] = __builtin_amdgcn_mfma_f32_16x16x32_bf16(kf, qf[p][ks], sa[mt], 0, 0, 0); }
            }
            bool needmask;
            if (MODE <= 1) needmask = (((64 * c + ttA - 31) >> 4) - 64 * s) < 63;
            else if (MODE == 2) needmask = (s == c);
            else needmask = (s == c) || (c >= 8 && s == c - 8);
            if (needmask) {
                int hi, lov = -1;
                if (MODE <= 1) { const int t = 64 * c + tt; hi = ((t - 31) >> 4) - 64 * s; }
                else if (MODE == 2) hi = tt;
                else { hi = (s == c) ? tt : 63; lov = (c >= 8 && s == c - 8) ? tt : -1; }
#pragma unroll
                for (int mt = 0; mt < 4; ++mt)
#pragma unroll
                    for (int j = 0; j < 4; ++j) { const int kk = 16 * mt + 4 * fq + j; sa[mt][j] = (kk <= hi && kk > lov) ? sa[mt][j] : -1e30f; }
            }
            if (MODE != 1) {
                float mx = fmaxf(fmaxf(sa[0][0], sa[0][1]), sa[0][2]);
                mx = fmaxf(fmaxf(mx, sa[0][3]), sa[1][0]); mx = fmaxf(fmaxf(mx, sa[1][1]), sa[1][2]); mx = fmaxf(fmaxf(mx, sa[1][3]), sa[2][0]);
                mx = fmaxf(fmaxf(mx, sa[2][1]), sa[2][2]); mx = fmaxf(fmaxf(mx, sa[2][3]), sa[3][0]); mx = fmaxf(fmaxf(mx, sa[3][1]), sa[3][2]); mx = fmaxf(mx, sa[3][3]);
                mx = xrow16_max(mx);
                const bool uninit = mrow[p] < -1e29f;
                const bool resc = (mx > 8.0f) || (uninit && mx > -1e29f);
                if (__any(resc)) {
                    const float delta = resc ? mx : 0.f;
                    const float alpha = (resc && !uninit) ? ex2(-delta) : 1.0f;
#pragma unroll
                    for (int mt = 0; mt < 4; ++mt) sa[mt] = sa[mt] - delta;
                    lrow[p] *= alpha;
                    if (MODE >= 2) {
#pragma unroll
                        for (int d = 0; d < 4; ++d) O[p][d] *= alpha;
                    }
                    if (resc) mrow[p] = (uninit ? 0.f : mrow[p]) + delta;
                }
            }
            f32x4 pv[4];
#pragma unroll
            for (int mt = 0; mt < 4; ++mt)
#pragma unroll
                for (int j = 0; j < 4; ++j) pv[mt][j] = ex2(sa[mt][j]);
            if (MODE != 1) { const f32x4 t4 = (pv[0] + pv[1]) + (pv[2] + pv[3]); lrow[p] += (t4[0] + t4[1]) + (t4[2] + t4[3]); }
            if (MODE >= 1) {
                bf16x8 pf[2];
#pragma unroll
                for (int k2 = 0; k2 < 2; ++k2) {
                    u32x4 wv; wv.x = cvt_pk_bf16(pv[2 * k2][0], pv[2 * k2][1]); wv.y = cvt_pk_bf16(pv[2 * k2][2], pv[2 * k2][3]); wv.z = cvt_pk_bf16(pv[2 * k2 + 1][0], pv[2 * k2 + 1][1]); wv.w = cvt_pk_bf16(pv[2 * k2 + 1][2], pv[2 * k2 + 1][3]);
                    pf[k2] = __builtin_bit_cast(bf16x8, wv);
                }
#pragma unroll
                for (int d = 0; d < 4; ++d)
#pragma unroll
                    for (int k2 = 0; k2 < 2; ++k2) {
                        const bf16x8 vf = *(const LAS bf16x8*)(Vb + 8192 + (k2 ? kb1 : kb0) + d * 2048);
                        O[p][d] = __builtin_amdgcn_mfma_f32_16x16x32_bf16(vf, pf[k2], O[p][d], 0, 0, 0);
                    }
            }
            if (MODE == 1) {
#pragma unroll
                for (int mt = 0; mt < 4; ++mt) {
                    float a = pv[mt][0] + pv[mt][1] + pv[mt][2] + 0.5f * pv[mt][3], bn = 0.5f * pv[mt][3];
                    a = sum8(a); bn = sum8(bn);
                    const int sb = 16 * s + 4 * mt + fq;
                    if ((fr & 7) == 0) { (void)__hip_atomic_fetch_add(impL + tt * IMPW + sb, a, __ATOMIC_RELAXED, __HIP_MEMORY_SCOPE_WORKGROUP); (void)__hip_atomic_fetch_add(impL + tt * IMPW + sb + 1, bn, __ATOMIC_RELAXED, __HIP_MEMORY_SCOPE_WORKGROUP); }
                }
            }
            }
            __builtin_amdgcn_sched_barrier(0);
        }
        }
        }
    }
    WG_BAR();
#undef ATT_DMA
}

__device__ __forceinline__ void unit(LAS unsigned char* lds, const Ctx& X, int b, int g, int c, int tid_in) {
    int tid = tid_in; asm volatile("" : "+v"(tid));
    const int lane = tid & 63, w = __builtin_amdgcn_readfirstlane(tid >> 6), fr = lane & 15, fq = lane >> 4;
    LAS int* list = (LAS int*)(lds + OFF_LIST);
    LAS unsigned* selm = (LAS unsigned*)(lds + OFF_SEL);
    LAS unsigned* uni = (LAS unsigned*)(lds + OFF_UNI);
    LAS float* impL = (LAS float*)(lds + OFF_IMP);
    LAS int* nl = (LAS int*)(lds + OFF_N);
    const int bg = b * 2 + g; const size_t rowbase = (size_t)b * T + 64 * c;
    bf16x8 qf[4][2];
#pragma unroll
    for (int p = 0; p < 4; ++p) { const bf16_t* qp = X.Q + (rowbase + 8 * w + 2 * p + (fr >> 3)) * 1024 + (8 * g + (fr & 7)) * 64 + 8 * fq;
#pragma unroll
        for (int ks = 0; ks < 2; ++ks) qf[p][ks] = *(const bf16x8*)(qp + 32 * ks); }
    for (int i = lane; i < 8 * IMPW; i += 64) impL[(8 * w) * IMPW + i] = 0.f;
    const int ncmp = (4 * c + 3 + 63) >> 6;
    if (tid < 8) list[tid] = tid;
    float mrow[4], lrow[4]; f32x4 O[4][4];
#pragma unroll
    for (int p = 0; p < 4; ++p) { mrow[p] = -1e30f; lrow[p] = 0.f;
#pragma unroll
        for (int d = 0; d < 4; ++d) { O[p][d] = (f32x4){0.f, 0.f, 0.f, 0.f}; } }
    WG_BAR();
    const bf16_t* kcc = X.KCC + (size_t)bg * 512 * 64; const bf16_t* vct = X.VCT + (size_t)bg * 8 * 4096;
    branch<0>(lds, kcc, vct, 4096, ncmp, c, w, lane, tid, qf, mrow, lrow, O);
#pragma unroll
    for (int p = 0; p < 4; ++p) { float l = xrow16_sum(lrow[p]); lrow[p] = (l > 0.f) ? (-mrow[p] - __builtin_amdgcn_logf(l)) : -1e30f; }
    branch<1>(lds, kcc, vct, 4096, ncmp, c, w, lane, tid, qf, mrow, lrow, O);
#define ATT_GATE(br, scale_expr) do { _Pragma("unroll") for (int p = 0; p < 4; ++p) { \
        const size_t grow = rowbase + 8 * w + 2 * p + (fr >> 3); \
        const float gt = X.gates[grow * 48 + (8 * g + (fr & 7)) * 3 + (br)]; const float sc = gt * (scale_expr); \
        _Pragma("unroll") for (int d = 0; d < 4; ++d) { \
            u32x2* optr = (u32x2*)(X.O + grow * 1024 + (8 * g + (fr & 7)) * 64 + 4 * fq + 16 * d); u32x2 ot = (u32x2){0u, 0u}; if ((br) > 0) ot = *optr; \
            float o0 = __uint_as_float(ot.x << 16), o1 = __uint_as_float(ot.x & 0xffff0000u), o2 = __uint_as_float(ot.y << 16), o3 = __uint_as_float(ot.y & 0xffff0000u); \
            o0 += sc * O[p][d][0]; o1 += sc * O[p][d][1]; o2 += sc * O[p][d][2]; o3 += sc * O[p][d][3]; \
            ot.x = cvt_pk_bf16(o0, o1); ot.y = cvt_pk_bf16(o2, o3); O[p][d] = (f32x4){0.f, 0.f, 0.f, 0.f}; \
            *optr = ot; } \
        mrow[p] = -1e30f; lrow[p] = 0.f; } } while (0)
    ATT_GATE(0, 1.0f);
    LDS_WAIT();
    for (int q8 = 0; q8 < 8; ++q8) {
        const int tt = 8 * w + q8;
        unsigned long long blo, bhi;
        if (c + 1 <= 16) { blo = (1ull << (c + 1)) - 1ull; bhi = 0ull; }
        else {
            const int s1 = lane, s2 = lane + 64;
            const bool c1 = (s1 >= 1 && s1 <= c - 2), c2 = (s2 >= 1 && s2 <= c - 2);
            const float v1 = c1 ? impL[tt * IMPW + s1] : -1.f, v2 = c2 ? impL[tt * IMPW + s2] : -1.f;
            int r1 = 0, r2 = 0;
            const int nq = (c - 2) / 4 + 1;
#pragma unroll 2
            for (int q = 0; q < nq; ++q) {
                const f32x4 x4 = *(const LAS f32x4*)(impL + tt * IMPW + 4 * q);
#pragma unroll
                for (int e = 0; e < 4; ++e) { const int sp = 4 * q + e; const float x = (sp >= 1 && sp <= c - 2) ? x4[e] : -2.f;
                    r1 += (x > v1 || (x == v1 && sp < s1)) ? 1 : 0; r2 += (x > v2 || (x == v2 && sp < s2)) ? 1 : 0; }
            }
            const bool f1 = (s1 == 0 || s1 == c || s1 == c - 1), f2 = (s2 == c || s2 == c - 1);
            blo = __ballot((c1 && r1 < 13) || f1); bhi = __ballot((c2 && r2 < 13) || f2);
        }
        if (lane == 0) { selm[tt * 4 + 0] = (unsigned)blo; selm[tt * 4 + 1] = (unsigned)(blo >> 32); selm[tt * 4 + 2] = (unsigned)bhi; selm[tt * 4 + 3] = (unsigned)(bhi >> 32); }
    }
    WG_BAR();
    if (tid < 4) { unsigned o = 0; for (int i = 0; i < 64; ++i) o |= selm[i * 4 + tid]; uni[tid] = o; }
    WG_BAR();
    if (tid == 0) { int n = 0; for (int s = 0; s <= c; ++s) if ((uni[s >> 5] >> (s & 31)) & 1u) list[n++] = s; nl[0] = n; }
    WG_BAR();
    const int nsel = nl[0];
    { LAS unsigned char* cw_ = (LAS unsigned char*)(lds + OFF_CODE) + w * CODEW;
      for (int i = lane; i < nsel; i += 64) { const int s_ = list[i]; unsigned cd = 0;
#pragma unroll
          for (int q8 = 0; q8 < 8; ++q8) cd |= ((selm[(8 * w + q8) * 4 + (s_ >> 5)] >> (s_ & 31)) & 1u) << q8;
          cw_[i] = (unsigned char)cd; }
      LDS_WAIT(); }
    branch<2>(lds, X.KS + (size_t)bg * T * 64, X.VST + (size_t)bg * 128 * 4096, 4096, nsel, c, w, lane, tid, qf, mrow, lrow, O);
#pragma unroll
    for (int p = 0; p < 4; ++p) { float l = xrow16_sum(lrow[p]); lrow[p] = (l > 0.f) ? 1.0f / l : 0.f; }
    { float rl[4] = {lrow[0], lrow[1], lrow[2], lrow[3]}; ATT_GATE(1, rl[p]); }
    const int w0 = (c >= 8) ? c - 8 : 0, nwin = c - w0 + 1;
    if (tid < nwin) list[tid] = w0 + tid;
    WG_BAR();
    branch<3>(lds, X.KW + (size_t)bg * T * 64, X.VWT + (size_t)bg * 128 * 4096, 4096, nwin, c, w, lane, tid, qf, mrow, lrow, O);
#pragma unroll
    for (int p = 0; p < 4; ++p) { float l = xrow16_sum(lrow[p]); lrow[p] = (l > 0.f) ? 1.0f / l : 0.f; }
    { float rl[4] = {lrow[0], lrow[1], lrow[2], lrow[3]}; ATT_GATE(2, rl[p]); }
#undef ATT_GATE
    WG_BAR();
}
}

__device__ __forceinline__ unsigned f2bf(float f) { unsigned u = __builtin_bit_cast(unsigned, f); return (u + 0x7fffu + ((u >> 16) & 1u)) >> 16; }
__device__ __forceinline__ unsigned pk2(float lo, float hi) { return f2bf(lo) | (f2bf(hi) << 16); }
template <int MAP>
__device__ __forceinline__ int rowmap(int a) {
    if (MAP == 0) return perm8(a);
    if (MAP == 1) return a < 1792 ? ((a & ~63) | swap45(a & 63)) : a;
    if (MAP == 2) { if (a < FF) return 256 * (a >> 7) + perm8(a & 127); const int a2 = a - FF; return 256 * (a2 >> 7) + 128 + perm8(a2 & 127); }
    return swap45(a);
}
template <int MAP>
__device__ __forceinline__ void transpose_item(const float* W, int K, int N, bf16_t* WT, int row_off, const float* gain, LAS float* scr, int item, int lane) {
    const int nblk = (N + 31) / 32, kb = item / nblk, nb = item % nblk, k0 = 64 * kb, n0 = 32 * nb;
#pragma unroll
    for (int i = 0; i < 32; ++i) { const int kk = 2 * i + (lane >> 5); const int col = n0 + (lane & 31); float v = (col < N) ? W[(size_t)(k0 + kk) * N + col] : 0.f; if (gain) v *= gain[k0 + kk]; scr[kk * 33 + (lane & 31)] = v; }
    LDS_WAIT();
    const int cc = lane & 7;
#pragma unroll
    for (int j = 0; j < 4; ++j) { const int n = (lane >> 3) + 8 * j; const LAS float* s = scr + (8 * cc) * 33 + n;
        u32x4 o; o.x = pk2(s[0 * 33], s[1 * 33]); o.y = pk2(s[2 * 33], s[3 * 33]); o.z = pk2(s[4 * 33], s[5 * 33]); o.w = pk2(s[6 * 33], s[7 * 33]);
        if (n0 + n < N) *(u32x4*)(WT + (size_t)(row_off + rowmap<MAP>(n0 + n)) * K + k0 + 8 * cc) = o; }
    LDS_WAIT();
}

#define XB_TMO      128
#define XB_XCNT(j)  (256  + 64 * (j))
#define XB_XSUB(j)  (1280 + 64 * (j))
#define XB_XGEN(j)  (2304 + 64 * (j))
#define XB_TOP      3328
#define XB_TOPGEN   3392
#define XCD_BAR_WORDS 3456
#define XB_SPIN_CAP (1u << 18)
__device__ __forceinline__ unsigned xb_ld(unsigned* p)              { return __hip_atomic_load(p, __ATOMIC_RELAXED, __HIP_MEMORY_SCOPE_AGENT); }
__device__ __forceinline__ unsigned xb_add(unsigned* p, unsigned v) { return __hip_atomic_fetch_add(p, v, __ATOMIC_RELAXED, __HIP_MEMORY_SCOPE_AGENT); }
__device__ __forceinline__ unsigned xb_xcc_id() { return (unsigned)__builtin_amdgcn_s_getreg((3 << 11) | 20) & 0xFu; }
#define XB_SPIN(cond, bar) do { unsigned _sp = 0; while (cond) { __builtin_amdgcn_s_sleep(1); \
    if ((++_sp & 255u) == 0u) { if (xb_ld(&(bar)[XB_TMO])) break; if (_sp > XB_SPIN_CAP) { atomicAdd(&(bar)[XB_TMO], 1u); break; } } } } while (0)
struct XcdBarrier { unsigned* bar; unsigned x; volatile LAS unsigned* st; };
__device__ __forceinline__ XcdBarrier xcd_barrier_post(unsigned* bar, volatile LAS unsigned* st) {
    XcdBarrier b; b.bar = bar; b.x = xb_xcc_id(); b.st = st;
    if (threadIdx.x == 0) (void)xb_add(&bar[XB_XCNT(b.x)], 1u);
    return b;
}
__device__ __forceinline__ void xcd_barrier_complete(unsigned* bar, unsigned x, unsigned& nloc, unsigned& nx) {
    const unsigned G = gridDim.x * gridDim.y * gridDim.z;
    unsigned sum, cnt, mine, sp = 0u;
    for (;;) {
        sum = 0u; cnt = 0u; mine = 0u;
#pragma unroll
        for (unsigned j = 0; j < 16; ++j) { const unsigned c = xb_ld(&bar[XB_XCNT(j)]); sum += c; cnt += (c > 0u) ? 1u : 0u; mine = (j == x) ? c : mine; }
        if (sum == G) break;
        __builtin_amdgcn_s_sleep(1);
        if ((++sp & 255u) == 0u) { if (xb_ld(&bar[XB_TMO])) break; if (sp > XB_SPIN_CAP) { atomicAdd(&bar[XB_TMO], 1u); break; } }
    }
    nloc = mine > 0u ? mine : 1u; nx = cnt > 0u ? cnt : 1u;
}
__device__ __forceinline__ void xcd_barrier(const XcdBarrier& b) {
    asm volatile("s_waitcnt vmcnt(0)" ::: "memory");
    __syncthreads();
    if (threadIdx.x == 0) {
        unsigned* bar = b.bar;
        __builtin_amdgcn_s_waitcnt(0);
        unsigned nloc = b.st[0], nx = b.st[1];
        if (nloc == 0u) { xcd_barrier_complete(bar, b.x, nloc, nx); b.st[0] = nloc; b.st[1] = nx; }
        const unsigned old = xb_add(&bar[XB_XSUB(b.x)], 1u);
        const unsigned gen = old / nloc;
        if (old + 1u == (gen + 1u) * nloc) {
            __builtin_amdgcn_fence(__ATOMIC_RELEASE, "agent");
            asm volatile("s_waitcnt vmcnt(0)" ::: "memory");
            const unsigned og = xb_add(&bar[XB_TOP], 1u);
            const unsigned tg = og / nx;
            if (og + 1u == (tg + 1u) * nx) xb_add(&bar[XB_TOPGEN], 1u);
            else XB_SPIN(xb_ld(&bar[XB_TOPGEN]) == tg, bar);
            __builtin_amdgcn_fence(__ATOMIC_ACQUIRE, "agent");
            xb_add(&bar[XB_XGEN(b.x)], 1u);
            asm volatile("s_waitcnt vmcnt(0)" ::: "memory");
        } else {
            XB_SPIN(xb_ld(&bar[XB_XGEN(b.x)]) == gen, bar);
            __builtin_amdgcn_fence(__ATOMIC_ACQUIRE, "agent");
            asm volatile("s_waitcnt vmcnt(0)" ::: "memory");
        }
    }
    __syncthreads();
}

struct Args { const float* in[29]; float* out; unsigned char* ws; float inv[32]; int ph_lo, ph_hi; };

constexpr int DI_UP = 16 * 176, DI_DN = 44 * 32, DI_PL = 4 * 8, N_DEFER = 2 * DI_UP + 2 * DI_DN + 4 * DI_PL;
__device__ __forceinline__ void ffn_weight_item(const Args& a, unsigned char* ws, LAS float* scr, int r, int lane) {
    if (r < DI_UP) { transpose_item<2>(a.in[15], D, UP, (bf16_t*)(ws + WS_WUP0), 0, a.in[14], scr, r, lane); return; } r -= DI_UP;
    if (r < DI_UP) { transpose_item<2>(a.in[24], D, UP, (bf16_t*)(ws + WS_WUP1), 0, a.in[23], scr, r, lane); return; } r -= DI_UP;
    if (r < DI_DN) { transpose_item<0>(a.in[18], FF, D, (bf16_t*)(ws + WS_WDN0), 0, nullptr, scr, r, lane); return; } r -= DI_DN;
    if (r < DI_DN) { transpose_item<0>(a.in[27], FF, D, (bf16_t*)(ws + WS_WDN1), 0, nullptr, scr, r, lane); return; } r -= DI_DN;
    const int gi = r / DI_PL; transpose_item<0>(a.in[20] + (size_t)gi * 65536, 256, 256, (bf16_t*)(ws + WS_WPOOL), gi * 256, nullptr, scr, r % DI_PL, lane);
}

__global__ void __launch_bounds__(512) mk_fwd(Args a) {
    extern __shared__ __attribute__((aligned(16))) unsigned char lds_raw[];
    LAS unsigned char* lds = (LAS unsigned char*)lds_raw;
    LAS unsigned char* ldsx = lds + LDS_RING;
    cg::grid_group grid = cg::this_grid();
    if (threadIdx.x < 2) ((volatile LAS unsigned*)(lds + LDS_BYTES - 16))[threadIdx.x] = 0u;
    __syncthreads();
    if (a.ph_hi == 0x7fff) grid.sync();
    const XcdBarrier xbar = xcd_barrier_post((unsigned*)a.ws, (volatile LAS unsigned*)(lds + LDS_BYTES - 16));
    const int tid = threadIdx.x, lane = tid & 63, wave = __builtin_amdgcn_readfirstlane(tid >> 6);
    const int G = gridDim.x, bx = blockIdx.x;
    unsigned char* ws = a.ws;
#define cosT ((float*)(ws + WS_ROPE))
#define sinT ((float*)(ws + WS_ROPE) + T * 32)
#define ssp ((float*)(ws + WS_SSP))
#define c1p ((float*)(ws + WS_C1P))
#define rstdv ((float*)(ws + WS_RSTD))
#define HB ((float*)(ws + WS_HB))
#define FB ((float*)(ws + WS_FB))
#define gates ((float*)(ws + WS_GATE))
#define Wt_in ((bf16_t*)(ws + WS_WIN))
#define Wt_out ((bf16_t*)(ws + WS_WOUT))
#define Wt_pool ((bf16_t*)(ws + WS_WPOOL))
#define Wt_c1 (kv ? (bf16_t*)(ws + WS_WC1V) : (bf16_t*)(ws + WS_WC1K))
#define Wt_c2 (kv ? (bf16_t*)(ws + WS_WC2V) : (bf16_t*)(ws + WS_WC2K))
#define XB ((bf16_t*)(ws + WS_XB))
#define Qb ((bf16_t*)(ws + WS_Q))
#define KC ((bf16_t*)(ws + WS_KC))
#define VC ((bf16_t*)(ws + WS_VC))
#define KS ((bf16_t*)(ws + WS_KS))
#define VST ((bf16_t*)(ws + WS_VST))
#define KW ((bf16_t*)(ws + WS_KW))
#define VWT ((bf16_t*)(ws + WS_VWT))
#define KCC ((bf16_t*)(ws + WS_KCC))
#define VCT ((bf16_t*)(ws + WS_VCT))
#define Ob ((bf16_t*)(ws + WS_O))
#define ACT ((bf16_t*)(ws + WS_ACT))
#define POOLED ((bf16_t*)(ws + WS_POOLED))
    float* out = a.out;
    const int lo = a.ph_lo, hi = a.ph_hi;
    const bool defer = (G == 256);
#define IN(k) (lo <= (k) && (k) < hi)
#define SEAM(k) do { if (IN(k) && IN((k) + 1)) xcd_barrier(xbar); } while (0)

    if (IN(0)) {
        LAS float* scr = (LAS float*)(lds + wave * 16384);
        const int gw = bx * 8 + wave, NGW = G * 8;
        constexpr int I_IN = 16 * 58, I_OUT = 16 * 32, I_C1 = 32 * 8, I_C2 = 4 * 2;
        constexpr int NA = I_IN + I_OUT + 2 * I_C1 + 2 * I_C2;
        const int NIT = NA + (defer ? 0 : N_DEFER);
        for (int it = gw; it < NIT; it += NGW) {
            int r = it;
            if (r < I_IN) { transpose_item<1>(a.in[2], D, 1840, Wt_in, 0, a.in[1], scr, r, lane); continue; } r -= I_IN;
            if (r < I_OUT) { transpose_item<0>(a.in[13], D, D, Wt_out, 0, nullptr, scr, r, lane); continue; } r -= I_OUT;
            if (r < I_C1) { transpose_item<0>(a.in[4], 2048, 256, (bf16_t*)(ws + WS_WC1K), 0, nullptr, scr, r, lane); continue; } r -= I_C1;
            if (r < I_C1) { transpose_item<0>(a.in[9], 2048, 256, (bf16_t*)(ws + WS_WC1V), 0, nullptr, scr, r, lane); continue; } r -= I_C1;
            if (r < I_C2) { transpose_item<3>(a.in[6], 256, 64, (bf16_t*)(ws + WS_WC2K), 0, nullptr, scr, r, lane); continue; } r -= I_C2;
            if (r < I_C2) { transpose_item<3>(a.in[11], 256, 64, (bf16_t*)(ws + WS_WC2V), 0, nullptr, scr, r, lane); continue; } r -= I_C2;
            ffn_weight_item(a, ws, scr, r, lane);
        }
        for (int m = gw; m < M; m += 2 * NGW) {
            const int m2 = m + NGW;
            const f32x4* xr = (const f32x4*)(a.in[0] + (size_t)m * D) + lane; const f32x4* xr2 = (const f32x4*)(a.in[0] + (size_t)m2 * D) + lane;
            f32x4 v[4], w[4];
#pragma unroll
            for (int j = 0; j < 4; ++j) { v[j] = xr[64 * j]; w[j] = (m2 < M) ? xr2[64 * j] : (f32x4){0.f, 0.f, 0.f, 0.f}; }
            unsigned long long* o8 = (unsigned long long*)(XB + (size_t)m * D) + lane; unsigned long long* o82 = (unsigned long long*)(XB + (size_t)m2 * D) + lane; float s1 = 0.f, s2 = 0.f;
#pragma unroll
            for (int j = 0; j < 4; ++j) {
                s1 += (v[j][0] * v[j][0] + v[j][1] * v[j][1]) + (v[j][2] * v[j][2] + v[j][3] * v[j][3]); o8[64 * j] = (unsigned long long)pk2(v[j][0], v[j][1]) | ((unsigned long long)pk2(v[j][2], v[j][3]) << 32);
                s2 += (w[j][0] * w[j][0] + w[j][1] * w[j][1]) + (w[j][2] * w[j][2] + w[j][3] * w[j][3]); if (m2 < M) o82[64 * j] = (unsigned long long)pk2(w[j][0], w[j][1]) | ((unsigned long long)pk2(w[j][2], w[j][3]) << 32);
            }
#pragma unroll
            for (int o = 1; o < 64; o <<= 1) { s1 += __shfl_xor(s1, o); s2 += __shfl_xor(s2, o); }
            if (lane == 0) { rstdv[m] = 1.0f / sqrtf(s1 * (1.0f / D) + EPS); if (m2 < M) rstdv[m2] = 1.0f / sqrtf(s2 * (1.0f / D) + EPS); }
        }
        for (int i = bx * 512 + tid; i < T * 32; i += G * 512) {
            const int t = i >> 5, f = i & 31; const float ang = (float)t * a.inv[f];
            double x = (double)ang * 0.15915494309189535; x -= __builtin_rint(x); const float xf = (float)x;
            cosT[i] = __builtin_amdgcn_cosf(xf); sinT[i] = __builtin_amdgcn_sinf(xf);
        }
        for (int it = NGW - 1 - gw; it < 256; it += NGW) {
            const int kv = it >> 7, chunk = (it >> 2) & 31, nb = it & 3; const float* pos = a.in[kv ? 8 : 3]; const float* w1 = a.in[kv ? 9 : 4];
            float s = 0.f;
#pragma unroll 32
            for (int r = 0; r < 64; ++r) { const int rr = chunk * 64 + r; s += pos[rr] * w1[(size_t)rr * 256 + nb * 64 + lane]; }
            c1p[(kv * 32 + chunk) * 256 + nb * 64 + lane] = s;
        }
        asm volatile("s_waitcnt vmcnt(0) lgkmcnt(0)" ::: "memory"); __syncthreads();
    }
    SEAM(0);
    if (IN(1)) {
        pg8::Gemm g{XB, Wt_in, M, NIN, D, D, 0}; pg8::StaticOrder S; S.init(M, NIN, G, bx);
        EpiIn E{rstdv, cosT, sinT, Qb, KC, VC, KS, VST, KW, VWT, gates};
        pg8::gemm_phase(lds, ldsx, g, S, E);
    }
    SEAM(1);
    if (IN(2)) {
        const int tid = threadIdx.x, lane = tid & 63, w = __builtin_amdgcn_readfirstlane(tid >> 6), fr = lane & 15, fq = lane >> 4;
        LAS float* c1s = (LAS float*)lds;
        LAS unsigned char* hidL = lds + 4096;
        for (int i = tid; i < 512; i += 512) { const int kv = i >> 8, n = i & 255; const float* b1 = a.in[kv ? 10 : 5]; float sv = b1[n]; for (int q = 0; q < 32; ++q) sv += c1p[(kv * 32 + q) * 256 + n]; c1s[i] = sv; }
        __syncthreads();
        for (int u = bx; u < 256; u += G) {
            const int kv = u >> 7, r0 = (u & 127) * 16;
            const bf16_t* Ap = (kv ? VC : KC) + (size_t)(r0 + fr) * 1024 + 8 * fq;
            const bf16_t* Bp = Wt_c1 + (size_t)(32 * w + fr) * 2048 + 8 * fq;
            f32x4 h0 = (f32x4){0.f, 0.f, 0.f, 0.f}, h1 = h0;
#pragma unroll 1
            for (int k0 = 0; k0 < 2048; k0 += 256) {
                bf16x8 af[8], b0[8], b1f[8];
#pragma unroll
                for (int q = 0; q < 8; ++q) { af[q] = *(const bf16x8*)(Ap + k0 + 32 * q); b0[q] = *(const bf16x8*)(Bp + k0 + 32 * q); b1f[q] = *(const bf16x8*)(Bp + 16 * 2048 + k0 + 32 * q); }
#pragma unroll
                for (int q = 0; q < 8; ++q) { h0 = __builtin_amdgcn_mfma_f32_16x16x32_bf16(b0[q], af[q], h0, 0, 0, 0); h1 = __builtin_amdgcn_mfma_f32_16x16x32_bf16(b1f[q], af[q], h1, 0, 0, 0); }
            }
            { const int c0 = 32 * w + 8 * fq; float v[8];
#pragma unroll
              for (int e = 0; e < 8; ++e) { const float x = ((e >> 2) ? h1[e & 3] : h0[e & 3]) + c1s[kv * 256 + c0 + e]; const float y = 0.7978845608028654f * (x + 0.044715f * x * x * x); v[e] = x * sigmoidf_(2.0f * y); }
              u32x4 wv; wv.x = cvt_pk_bf16(v[0], v[1]); wv.y = cvt_pk_bf16(v[2], v[3]); wv.z = cvt_pk_bf16(v[4], v[5]); wv.w = cvt_pk_bf16(v[6], v[7]);
              *(LAS u32x4*)(hidL + fr * 528 + c0 * 2) = wv; }
            __syncthreads();
            if (w < 2) {
                const bf16_t* W2 = Wt_c2 + (size_t)(32 * w + fr) * 256 + 8 * fq;
                f32x4 oA = (f32x4){0.f, 0.f, 0.f, 0.f}, oB = oA;
#pragma unroll
                for (int q = 0; q < 8; ++q) {
                    const bf16x8 hf = *(const LAS bf16x8*)(hidL + fr * 528 + (32 * q + 8 * fq) * 2);
                    const bf16x8 wa = *(const bf16x8*)(W2 + 32 * q), wb = *(const bf16x8*)(W2 + 16 * 256 + 32 * q);
                    oA = __builtin_amdgcn_mfma_f32_16x16x32_bf16(wa, hf, oA, 0, 0, 0); oB = __builtin_amdgcn_mfma_f32_16x16x32_bf16(wb, hf, oB, 0, 0, 0);
                }
                const float* b2 = a.in[kv ? 12 : 7]; const int d0 = 16 * w + 4 * fq; const int row = r0 + fr, j = row & 511;
                f32x4 a1 = oA + *(const f32x4*)(b2 + d0), a2 = oB + *(const f32x4*)(b2 + d0 + 32);
                if (j == 511) { a1 = (f32x4){0.f, 0.f, 0.f, 0.f}; a2 = a1; }
                if (!kv) {
                    const int pos = (j == 511) ? 0 : 16 * j + 31;
                    const f32x4 cs = *(const f32x4*)(cosT + pos * 32 + d0), sn = *(const f32x4*)(sinT + pos * 32 + d0);
                    const f32x4 o1 = a1 * cs - a2 * sn, o2 = a1 * sn + a2 * cs;
                    bf16_t* p = KCC + (size_t)row * 64 + d0;
                    u32x2 w1; w1.x = cvt_pk_bf16(o1[0], o1[1]); w1.y = cvt_pk_bf16(o1[2], o1[3]); *(u32x2*)p = w1;
                    u32x2 w2; w2.x = cvt_pk_bf16(o2[0], o2[1]); w2.y = cvt_pk_bf16(o2[2], o2[3]); *(u32x2*)(p + 32) = w2;
                } else {
                    bf16_t* p = VCT + (size_t)(row >> 6) * 4096 + vperm(row & 63);
#pragma unroll
                    for (int e = 0; e < 4; ++e) { p[(d0 + e) * 64] = (bf16_t)(cvt_pk_bf16(a1[e], 0.f) & 0xffff); p[(d0 + 32 + e) * 64] = (bf16_t)(cvt_pk_bf16(a2[e], 0.f) & 0xffff); }
                }
            }
            __syncthreads();
        }
    }
    if (IN(2) && IN(4)) xcd_barrier(xbar);
    if (IN(4)) {
        att::Ctx X{Qb, KCC, VCT, KS, VST, KW, VWT, gates, Ob};
        for (int k = bx; k < 256; k += G) {
            for (int rep = 0; rep < 2; ++rep) { const int uu = rep ? 511 - k : k; const int c = 127 - (uu >> 2), bgi = uu & 3; att::unit(lds, X, bgi >> 1, bgi & 1, c, tid); }
        }
        if (defer) {
            int td = threadIdx.x; asm volatile("" : "+v"(td)); const int dl = td & 63, dw = __builtin_amdgcn_readfirstlane(td >> 6);
            LAS float* scr = (LAS float*)(lds + dw * 16384);
            for (int it = bx * 8 + dw; it < N_DEFER; it += 2048) ffn_weight_item(a, ws, scr, it, dl);
        }
    }
    SEAM(4);
    if (IN(5)) {
        pg8::Gemm g{Ob, Wt_out, M, D, D, D, 0}; pg8::StaticOrder S; S.init(M, D, G, bx);
        EpiRes E{a.in[0], out, XB, ssp, nullptr, nullptr};
        pg8::gemm_phase(lds, ldsx, g, S, E);
    }
    SEAM(5);
#pragma unroll
    for (int L = 0; L < 2; ++L) {
        const int pb = 6 + 5 * L;
        const float* cw = a.in[L ? 25 : 16]; const float* cb = a.in[L ? 26 : 17];
        if (IN(pb)) {
            pg8::Gemm g{XB, (const bf16_t*)(ws + (L ? WS_WUP1 : WS_WUP0)), M, UP, D, D, 0}; pg8::StaticOrder S; S.init(M, UP, G, bx);
            EpiUp E{ssp, cw, cb, ACT, HB, FB};
            pg8::gemm_phase(lds, ldsx, g, S, E);
        }
        SEAM(pb);
        if (IN(pb + 1)) {
            for (int i = bx * 512 + tid; i < 64 * FF; i += G * 512) {
                const int pm = i / FF, cidx = i % FF;
                float hg0 = 0.f, hg1 = 0.f, hv0 = 0.f, hv1 = 0.f;
                if (pm & 31) { const float* h = HB + (size_t)(pm - 1) * 2 * UP; hg0 = h[cidx]; hg1 = h[UP + cidx]; hv0 = h[FF + cidx]; hv1 = h[UP + FF + cidx]; }
                const float* f = FB + (size_t)pm * 2 * UP; const float fg0 = f[cidx], fg1 = f[UP + cidx], fv0 = f[FF + cidx], fv1 = f[UP + FF + cidx];
                const float g0 = cb[cidx] + cw[cidx] * hg0 + cw[UP + cidx] * hg1 + cw[2 * UP + cidx] * fg0;
                const float g1 = cb[cidx] + cw[cidx] * hg1 + cw[UP + cidx] * fg0 + cw[2 * UP + cidx] * fg1;
                const float v0 = cb[FF + cidx] + cw[FF + cidx] * hv0 + cw[UP + FF + cidx] * hv1 + cw[2 * UP + FF + cidx] * fv0;
                const float v1 = cb[FF + cidx] + cw[FF + cidx] * hv1 + cw[UP + FF + cidx] * fv0 + cw[2 * UP + FF + cidx] * fv1;
                ACT[(size_t)(pm * 256) * FF + cidx] = (bf16_t)f2bf(g0 * sigmoidf_(g0) * v0);
                ACT[(size_t)(pm * 256 + 1) * FF + cidx] = (bf16_t)f2bf(g1 * sigmoidf_(g1) * v1);
            }
        }
        SEAM(pb + 1);
        if (IN(pb + 2)) {
            pg8::Gemm g{ACT, (const bf16_t*)(ws + (L ? WS_WDN1 : WS_WDN0)), M, D, FF, FF, 0}; pg8::StaticOrder S; S.init(M, D, G, bx);
            if (L == 1 && G == 256) { EpiFinal E{out, a.in[28], (float*)(ws + WS_SSP + 512 * 1024), (unsigned*)(ws + 16384), XB}; pg8::gemm_phase(lds, ldsx, g, S, E); }
            else { EpiRes E{out, out, XB, ssp, nullptr, nullptr}; pg8::gemm_phase(lds, ldsx, g, S, E); }
        }
        if (!(L == 1 && G == 256)) SEAM(pb + 2);
        if (L == 0) {
            if (IN(9)) {
                LAS float* rsd = (LAS float*)lds;
                const float* gn = a.in[19];
                int tid = threadIdx.x; asm volatile("" : "+v"(tid));
                const int q = tid & 127, strip = tid >> 7, c8 = q * 8, wsz = 2 << (c8 >> 8), t0 = strip * 16;
                const f32x4 gv0 = *(const f32x4*)(gn + c8), gv1 = *(const f32x4*)(gn + c8 + 4);
                for (int tile = bx; tile < 256; tile += G) {
                    const int r0 = tile * 64; const int tb = r0 & (T - 1);
                    __syncthreads();
                    if (tid < 80) { const int rr = r0 - 16 + tid; rsd[tid] = (tb - 16 + tid >= 0) ? row_rstd(ssp, 4, rr) : 0.f; }
                    __syncthreads();
                    const bf16_t* xb0 = XB + (size_t)r0 * D + c8;
#define POOL_H(tl, lo, hi) do { unpk8(*(const u32x4*)(xb0 + (ptrdiff_t)(tl) * D), lo, hi); const float rs_ = rsd[16 + (tl)]; lo = lo * rs_; hi = hi * rs_; } while (0)
                    f32x4 s0 = (f32x4){0.f, 0.f, 0.f, 0.f}, s1 = s0;
                    for (int i = 1; i <= wsz; ++i) { const int tl = t0 - i; if (tb + tl >= 0) { f32x4 a0, a1; POOL_H(tl, a0, a1); s0 += a0; s1 += a1; } }
#pragma unroll 4
                    for (int tl = t0; tl < t0 + 16; ++tl) {
                        f32x4 h0, h1; POOL_H(tl, h0, h1); s0 += h0; s1 += h1;
                        const int td = tl - wsz; if (tb + td >= 0) { f32x4 d0, d1; POOL_H(td, d0, d1); s0 -= d0; s1 -= d1; }
                        const int t = tb + tl; const int cnt = (t + 1 < wsz) ? t + 1 : wsz; const float ic = 1.0f / (float)cnt;
                        const f32x4 p0 = (s0 * ic - h0) * gv0, p1 = (s1 * ic - h1) * gv1;
                        u32x4 wv; wv.x = cvt_pk_bf16(p0[0], p0[1]); wv.y = cvt_pk_bf16(p0[2], p0[3]); wv.z = cvt_pk_bf16(p1[0], p1[1]); wv.w = cvt_pk_bf16(p1[2], p1[3]);
                        *(u32x4*)(POOLED + (size_t)(r0 + tl) * D + c8) = wv;
                    }
#undef POOL_H
                }
                __syncthreads();
            }
            SEAM(9);
            if (IN(10)) {
                pg8::Gemm g{POOLED, Wt_pool, M, D, 256, D, 512}; pg8::StaticOrder S; S.init(M, D, G, bx);
                EpiRes E{out, out, XB, ssp, a.in[21], a.in[22]};
                pg8::gemm_phase(lds, ldsx, g, S, E);
            }
            SEAM(10);
        }
    }
    if (IN(14) && G != 256) {
        int t14 = threadIdx.x; asm volatile("" : "+v"(t14)); const int lane = t14 & 63, wave = __builtin_amdgcn_readfirstlane(t14 >> 6);
        const int gw = bx * 8 + wave, NGW = G * 8; const float* gn = a.in[28];
        for (int m = gw; m < M; m += NGW) {
            const float rs = row_rstd(ssp, 4, m); f32x4* xr = (f32x4*)(out + (size_t)m * D) + lane; const f32x4* gr = (const f32x4*)gn + lane;
            const u32x2* xbr = (const u32x2*)(XB + (size_t)m * D) + lane;
#pragma unroll
            for (int j = 0; j < 4; ++j) { const u32x2 v = xbr[64 * j]; const f32x4 xv = (f32x4){__uint_as_float(v.x << 16), __uint_as_float(v.x & 0xffff0000u), __uint_as_float(v.y << 16), __uint_as_float(v.y & 0xffff0000u)}; xr[64 * j] = xv * rs * gr[64 * j]; }
        }
    }
#undef IN
#undef SEAM
#undef cosT
#undef sinT
#undef ssp
#undef c1p
#undef rstdv
#undef HB
#undef FB
#undef gates
#undef Wt_in
#undef Wt_out
#undef Wt_pool
#undef Wt_c1
#undef Wt_c2
#undef XB
#undef Qb
#undef KC
#undef VC
#undef KS
#undef VST
#undef KW
#undef VWT
#undef KCC
#undef VCT
#undef Ob
#undef ACT
#undef POOLED
}

extern "C" void kernel_launch(void* const* d_in, const int* in_sizes, int n_in, void* d_out, int out_size, void* d_ws, size_t ws_size, hipStream_t stream) {
    static int grid = 0;
    if (grid == 0) {
        int dev = 0, cus = 0, per_cu = 0;
        hipGetDevice(&dev); hipDeviceGetAttribute(&cus, hipDeviceAttributeMultiprocessorCount, dev);
        hipFuncSetAttribute((const void*)mk_fwd, hipFuncAttributeMaxDynamicSharedMemorySize, LDS_BYTES);
        hipOccupancyMaxActiveBlocksPerMultiprocessor(&per_cu, (const void*)mk_fwd, 512, LDS_BYTES);
        if (per_cu < 1) per_cu = 1;
        grid = cus * per_cu; if (grid > 256) grid = 256;
        (void)hipGetLastError();
    }
    Args a{};
    for (int i = 0; i < 29; ++i) a.in[i] = (const float*)d_in[i];
    a.out = (float*)d_out; a.ws = (unsigned char*)d_ws;
    for (int i = 0; i < 32; ++i) a.inv[i] = 1.0f / powf(10000.0f, (float)(2 * i) / 64.0f);
    a.ph_lo = 0; a.ph_hi = 15;
    hipMemsetAsync(d_ws, 0, 65536, stream);
    void* args[] = {&a};
    hipError_t e = hipLaunchCooperativeKernel((const void*)mk_fwd, dim3(grid), dim3(512), args, LDS_BYTES, stream);
    if (e != hipSuccess) fprintf(stderr, "cooperative launch failed: %s (grid %d)\n", hipGetErrorString(e), grid);
}
```

```cpp
#include <hip/hip_runtime.h>
#include <hip/hip_cooperative_groups.h>
#include <cstdio>
#include <cstdint>
namespace cg = cooperative_groups;

#define LAS __attribute__((address_space(3)))
typedef unsigned short bf16_t;
typedef short bf16x8 __attribute__((ext_vector_type(8)));
typedef short s16x4 __attribute__((ext_vector_type(4)));
typedef float f32x4 __attribute__((ext_vector_type(4)));
typedef unsigned u32x4 __attribute__((ext_vector_type(4)));
typedef unsigned u32x2 __attribute__((ext_vector_type(2)));

constexpr int T = 8192, D = 1024, M = 16384, FF = 2816, UP = 5632, NIN = 2048;
constexpr float EPS = 1e-6f;
constexpr float QSCALE = 0.125f * 1.4426950408889634f;
constexpr size_t MiB = 1u << 20;
constexpr size_t WS_ROPE = 1 * MiB;
constexpr size_t WS_SSP = 3 * MiB;
constexpr size_t WS_C1P = 4 * MiB;
constexpr size_t WS_RSTD = 4 * MiB + 256 * 1024;
constexpr size_t WS_HB = 5 * MiB;
constexpr size_t WS_FB = 8 * MiB;
constexpr size_t WS_GATE = 11 * MiB;
constexpr size_t WS_WIN = 16 * MiB, WS_WOUT = 20 * MiB, WS_WUP0 = 22 * MiB, WS_WUP1 = 33 * MiB, WS_WDN0 = 44 * MiB, WS_WDN1 = 50 * MiB;
constexpr size_t WS_WPOOL = 56 * MiB, WS_WC1K = 57 * MiB, WS_WC1V = 58 * MiB, WS_WC2K = 59 * MiB, WS_WC2V = 59 * MiB + 512 * 1024;
constexpr size_t WS_XB = 64 * MiB;
constexpr size_t WS_Q = 96 * MiB;
constexpr size_t WS_KC = 128 * MiB, WS_VC = 132 * MiB, WS_KS = 136 * MiB, WS_VST = 140 * MiB, WS_KW = 144 * MiB, WS_VWT = 148 * MiB;
constexpr size_t WS_KCC = 152 * MiB, WS_VCT = 153 * MiB, WS_HIDK = 154 * MiB, WS_HIDV = 155 * MiB;
constexpr size_t WS_O = 160 * MiB;
constexpr size_t WS_ACT = 96 * MiB;
constexpr size_t WS_POOLED = 192 * MiB;
constexpr int LDS_RING = 131072, LDS_BYTES = 155648;

__device__ __forceinline__ unsigned cvt_pk_bf16(float lo, float hi) { unsigned r; asm volatile("v_cvt_pk_bf16_f32 %0, %1, %2" : "=v"(r) : "v"(lo), "v"(hi)); return r; }
__device__ __forceinline__ float bf2f(unsigned short b) { return __uint_as_float((unsigned)b << 16); }
__device__ __forceinline__ float ex2(float x) { return __builtin_amdgcn_exp2f(x); }
__device__ __forceinline__ float rcp(float x) { return __builtin_amdgcn_rcpf(x); }
__device__ __forceinline__ float sigmoidf_(float x) { return rcp(1.0f + ex2(-1.4426950408889634f * x)); }
__device__ __forceinline__ void unpk8(const u32x4 v, f32x4& lo, f32x4& hi) { lo = (f32x4){__uint_as_float(v.x << 16), __uint_as_float(v.x & 0xffff0000u), __uint_as_float(v.y << 16), __uint_as_float(v.y & 0xffff0000u)}; hi = (f32x4){__uint_as_float(v.z << 16), __uint_as_float(v.z & 0xffff0000u), __uint_as_float(v.w << 16), __uint_as_float(v.w & 0xffff0000u)}; }
__device__ __forceinline__ int perm8(int a) { return (a & ~31) | (16 * ((a >> 2) & 1) + 4 * ((a >> 3) & 3) + (a & 3)); }
__device__ __forceinline__ int vperm(int kk) { return (kk & 32) | (((kk >> 2) & 3) << 3) | (((kk >> 4) & 1) << 2) | (kk & 3); }
__device__ __forceinline__ int swap45(int a) { return (a & ~48) | (((a >> 4) & 1) << 5) | (((a >> 5) & 1) << 4); }
template <int CTRL> __device__ __forceinline__ float dppf(float x) { return __builtin_bit_cast(float, __builtin_amdgcn_mov_dpp(__builtin_bit_cast(int, x), CTRL, 0xf, 0xf, true)); }
__device__ __forceinline__ float xrow16_max(float x) {
    auto s = __builtin_amdgcn_permlane16_swap(__float_as_uint(x), __float_as_uint(x), false, false); x = fmaxf(__uint_as_float(s[0]), __uint_as_float(s[1]));
    auto t = __builtin_amdgcn_permlane32_swap(__float_as_uint(x), __float_as_uint(x), false, false); return fmaxf(__uint_as_float(t[0]), __uint_as_float(t[1])); }
__device__ __forceinline__ float xrow16_sum(float x) {
    auto s = __builtin_amdgcn_permlane16_swap(__float_as_uint(x), __float_as_uint(x), false, false); x = __uint_as_float(s[0]) + __uint_as_float(s[1]);
    auto t = __builtin_amdgcn_permlane32_swap(__float_as_uint(x), __float_as_uint(x), false, false); return __uint_as_float(t[0]) + __uint_as_float(t[1]); }
__device__ __forceinline__ float sum8(float x) { x += dppf<0xB1>(x); x += dppf<0x4E>(x); x += dppf<0x141>(x); return x; }
#define LDS_WAIT() asm volatile("s_waitcnt lgkmcnt(0)" ::: "memory")
#define WG_BAR() do { asm volatile("s_waitcnt lgkmcnt(0)" ::: "memory"); __builtin_amdgcn_s_barrier(); asm volatile("" ::: "memory"); } while (0)

namespace pg8 {
constexpr int BM = 256, BK = 64, HALF = 128, HTB = HALF * BK * 2, NXCD = 8, WGM = 8;
__host__ __device__ __forceinline__ int lds_byte(int r, int c) { const int st = (r >> 4) * 2 + (c >> 5), rr = r & 15, cc = c & 31, ob = rr * 64 + cc * 2; return st * 1024 + (ob ^ (((ob >> 9) & 1) << 5)); }
__host__ __device__ __forceinline__ void stage_rc(int b, int& R, int& C) { const int st = b / 1024, sb = b % 1024, swz = sb ^ (((sb >> 9) & 1) << 5); R = (st >> 1) * 16 + swz / 64; C = (st & 1) * 32 + (swz % 64) / 2; }
struct Unit { int pm, pn; };
struct Gemm { const bf16_t* A; const bf16_t* Bt; int M, N, K, lda, apn; };
struct StaticOrder {
    int nM, nN, nwg, G, c;
    __device__ void init(int M_, int N_, int G_, int c_) { nM = M_ / BM; nN = N_ / BM; nwg = nM * nN; G = G_; c = c_; }
    __device__ bool next(int i, Unit& u) const {
        const long L = (long)i * G + c; if (L >= nwg) return false;
        int wgid = (int)L; { const int q = nwg / NXCD, r = nwg % NXCD, xcd = wgid % NXCD, off = wgid / NXCD; wgid = (xcd < r ? xcd * (q + 1) : r * (q + 1) + (xcd - r) * q) + off; }
        const int nig = WGM * nN, gid = wgid / nig, fm = gid * WGM, gsz = (nM - fm) < WGM ? (nM - fm) : WGM;
        u.pm = fm + ((wgid % nig) % gsz); u.pn = (wgid % nig) / gsz; return true;
    }
};
template <class Epi>
__device__ __forceinline__ void gemm_phase(LAS unsigned char* lds, LAS unsigned char* ldsx, const Gemm g, const StaticOrder& S, const Epi& E) {
    int tid = threadIdx.x; asm volatile("" : "+v"(tid));
    const int wid = __builtin_amdgcn_readfirstlane(tid >> 6), lane = tid & 63, wr = wid >> 2, wc = wid & 3, fr = lane & 15, fq = lane >> 4;
    const int K = g.K, nt = K / BK;
    unsigned voffA[2], voffB[2];
#pragma unroll
    for (int i = 0; i < 2; ++i) { int R, C; stage_rc(tid * 16 + i * 8192, R, C); voffA[i] = (unsigned)(R * g.lda + C) * 2u; voffB[i] = (unsigned)(R * K + C) * 2u; }
    const size_t kstep = (size_t)(BK * 2);
    const size_t hstepA = (size_t)HALF * g.lda * 2, tstepA = 2 * hstepA, hstepB = (size_t)HALF * K * 2, tstepB = 2 * hstepB;
    const unsigned ldsw = (unsigned)wid * 1024u;
    const int aoff = lds_byte(wr * 64 + fr, fq * 8), boff = lds_byte(wc * 32 + fr, fq * 8);
#define PG8_SA(b, h) (((b) * 2 + (h)) * HTB)
#define PG8_SB(b, h) ((4 + (b) * 2 + (h)) * HTB)
#define PG8_STAGE(bufoff, gbase, voff) do { _Pragma("unroll") for (int _i = 0; _i < 2; ++_i) \
        __builtin_amdgcn_global_load_lds((const unsigned*)((const char*)(gbase) + (voff)[_i]), (LAS unsigned*)(lds + (bufoff) + ldsw + _i * 8192), 16, 0, 0); } while (0)
#define PG8_LDA(dst, b, h) do { _Pragma("unroll") for (int m = 0; m < 4; ++m) _Pragma("unroll") for (int k = 0; k < 2; ++k) dst[m][k] = *(const LAS bf16x8*)(lds + PG8_SA(b, h) + aoff + m * 2048 + k * 1024); } while (0)
#define PG8_LDB(dst, b, h) do { _Pragma("unroll") for (int n = 0; n < 2; ++n) _Pragma("unroll") for (int k = 0; k < 2; ++k) dst[n][k] = *(const LAS bf16x8*)(lds + PG8_SB(b, h) + boff + n * 2048 + k * 1024); } while (0)
#define PG8_MMA(ai, bj, At, Bt) do { __builtin_amdgcn_s_setprio(1); _Pragma("unroll") for (int m = 0; m < 4; ++m) _Pragma("unroll") for (int n = 0; n < 2; ++n) _Pragma("unroll") for (int k = 0; k < 2; ++k) \
        acc[ai][bj][m][n] = __builtin_amdgcn_mfma_f32_16x16x32_bf16(Bt[n][k], At[m][k], acc[ai][bj][m][n], 0, 0, 0); __builtin_amdgcn_s_setprio(0); } while (0)
#define PG8_WAIT_V(n) asm volatile("s_waitcnt vmcnt(" #n ")" ::: "memory")
#define PG8_WAIT_L(n) asm volatile("s_waitcnt lgkmcnt(" #n ")" ::: "memory")
#define PG8_BAR __builtin_amdgcn_s_barrier()
#define PG8_SCHED __builtin_amdgcn_sched_barrier(0)
    Unit cur, nxt; int ui = 0;
    if (!S.next(0, cur)) return;
    f32x4 acc[2][2][4][2];
#pragma unroll
    for (int a = 0; a < 2; ++a)
#pragma unroll
        for (int b = 0; b < 2; ++b)
#pragma unroll
            for (int m = 0; m < 4; ++m)
#pragma unroll
                for (int n = 0; n < 2; ++n) acc[a][b][m][n] = (f32x4){0.f, 0.f, 0.f, 0.f};
    bf16x8 At[4][2], B0[2][2], B1[2][2];
    const char* cA = (const char*)g.A + (size_t)cur.pm * tstepA + (size_t)cur.pn * g.apn; const char* cB = (const char*)g.Bt + (size_t)cur.pn * tstepB;
    PG8_STAGE(PG8_SB(0, 0), cB, voffB); PG8_STAGE(PG8_SB(0, 1), cB + hstepB, voffB); PG8_STAGE(PG8_SA(0, 0), cA, voffA); PG8_STAGE(PG8_SA(0, 1), cA + hstepA, voffA);
    if (wr == 1) PG8_BAR;
    PG8_WAIT_V(2); PG8_BAR;
    PG8_STAGE(PG8_SB(1, 0), cB + kstep, voffB); PG8_STAGE(PG8_SA(1, 0), cA + kstep, voffA); PG8_STAGE(PG8_SB(1, 1), cB + hstepB + kstep, voffB);
    PG8_WAIT_V(6); PG8_BAR;
    for (;;) {
        const bool has_next = S.next(ui + 1, nxt);
        const char* nA = has_next ? (const char*)g.A + (size_t)nxt.pm * tstepA + (size_t)nxt.pn * g.apn : cA; const char* nB = has_next ? (const char*)g.Bt + (size_t)nxt.pn * tstepB : cB;
        for (int t = 0; t < nt; t += 2) {
            const bool last = (t == nt - 2);
            const char* a1 = cA + (size_t)(t + 1) * kstep;
            const char* a2 = last ? nA : cA + (size_t)(t + 2) * kstep; const char* b2 = last ? nB : cB + (size_t)(t + 2) * kstep;
            const char* a3 = a2 + kstep; const char* b3 = b2 + kstep;
            PG8_LDB(B0, 0, 0); PG8_LDB(B1, 0, 1); PG8_SCHED; PG8_LDA(At, 0, 0); PG8_STAGE(PG8_SA(1, 1), a1 + hstepA, voffA);
            PG8_WAIT_V(8); PG8_WAIT_L(0); PG8_BAR; PG8_MMA(0, 0, At, B0); PG8_MMA(0, 1, At, B1); PG8_BAR; PG8_SCHED;
            PG8_LDA(At, 0, 1); PG8_STAGE(PG8_SB(0, 0), b2, voffB); PG8_STAGE(PG8_SB(0, 1), b2 + hstepB, voffB); PG8_STAGE(PG8_SA(0, 0), a2, voffA);
            PG8_WAIT_V(8); PG8_WAIT_L(0); PG8_BAR; PG8_MMA(1, 0, At, B0); PG8_MMA(1, 1, At, B1); PG8_BAR; PG8_SCHED;
            PG8_LDB(B0, 1, 0); PG8_LDB(B1, 1, 1); PG8_SCHED; PG8_LDA(At, 1, 0); PG8_STAGE(PG8_SA(0, 1), a2 + hstepA, voffA);
            PG8_WAIT_V(8); PG8_WAIT_L(0); PG8_BAR; PG8_MMA(0, 0, At, B0); PG8_MMA(0, 1, At, B1); PG8_BAR; PG8_SCHED;
            PG8_LDA(At, 1, 1); PG8_STAGE(PG8_SB(1, 0), b3, voffB); PG8_STAGE(PG8_SB(1, 1), b3 + hstepB, voffB); PG8_STAGE(PG8_SA(1, 0), a3, voffA);
            PG8_WAIT_V(8); PG8_WAIT_L(0); PG8_BAR; PG8_MMA(1, 0, At, B0); PG8_MMA(1, 1, At, B1); PG8_BAR; PG8_SCHED;
        }
        if (wr == 0) PG8_BAR;
        { int t2 = threadIdx.x; asm volatile("" : "+v"(t2));
          E(acc, cur, wr, wc, t2 & 15, (t2 & 63) >> 4, ldsx, t2); }
        if (!has_next) break;
#pragma unroll
        for (int a = 0; a < 2; ++a)
#pragma unroll
            for (int b = 0; b < 2; ++b)
#pragma unroll
                for (int m = 0; m < 4; ++m)
#pragma unroll
                    for (int n = 0; n < 2; ++n) acc[a][b][m][n] = (f32x4){0.f, 0.f, 0.f, 0.f};
        cur = nxt; cA = nA; cB = nB; ++ui;
        if (wr == 1) PG8_BAR;
    }
    PG8_WAIT_V(0);
    PG8_BAR;
#undef PG8_SA
#undef PG8_SB
#undef PG8_STAGE
#undef PG8_LDA
#undef PG8_LDB
#undef PG8_MMA
#undef PG8_WAIT_V
#undef PG8_WAIT_L
#undef PG8_BAR
#undef PG8_SCHED
}
}
using pg8::Unit;
typedef f32x4 Acc[2][2][4][2];

__device__ __forceinline__ float row_rstd(const float* ssp, int np, int row) {
    float s = 0.f; for (int i = 0; i < np; ++i) s += ssp[(size_t)i * M + row];
    return 1.0f / sqrtf(s * (1.0f / D) + EPS);
}

struct EpiIn {
    const float* rstdv; const float* cosT; const float* sinT;
    bf16_t *Q, *KC, *VC, *KS, *VST, *KW, *VWT; float* gates;
    __device__ __forceinline__ void operator()(Acc& acc, const Unit& u, int wr, int wc, int fr, int fq, LAS unsigned char*, int) const {
#pragma unroll
        for (int ai = 0; ai < 2; ++ai)
#pragma unroll
            for (int m = 0; m < 4; ++m) {
                const int row = u.pm * 256 + ai * 128 + wr * 64 + m * 16 + fr; const float rs = rstdv[row];
                const int t = row & (T - 1), b = row >> 13;
                const int d0 = 16 * (wc & 1) + 4 * fq;
                const f32x4 cs = *(const f32x4*)(cosT + t * 32 + d0), sn = *(const f32x4*)(sinT + t * 32 + d0);
#pragma unroll
                for (int bj = 0; bj < 2; ++bj) {
                    f32x4 a1 = acc[ai][bj][m][0] * rs, a2 = acc[ai][bj][m][1] * rs;
                    if (u.pn == 7) {
                        if (bj == 0) {
#pragma unroll
                            for (int n = 0; n < 2; ++n) { const int c0 = 32 * wc + 16 * n + 4 * fq; if (c0 < 48) { const f32x4 v = n ? a2 : a1; f32x4 o; o[0] = sigmoidf_(v[0]); o[1] = sigmoidf_(v[1]); o[2] = sigmoidf_(v[2]); o[3] = sigmoidf_(v[3]); *(f32x4*)(gates + (size_t)row * 48 + c0) = o; } }
                        }
                        continue;
                    }
                    const int hh = 2 * bj + (wc >> 1);
                    bool rope; if (u.pn < 4) rope = true; else rope = (u.pn >= 5) && (hh < 2);
                    f32x4 o1 = a1, o2 = a2;
                    if (rope) { o1 = a1 * cs - a2 * sn; o2 = a1 * sn + a2 * cs; }
                    if (u.pn < 4) {
                        o1 = o1 * QSCALE; o2 = o2 * QSCALE;
                        bf16_t* p = Q + (size_t)row * 1024 + (u.pn * 4 + hh) * 64 + d0;
                        u32x2 w1; w1.x = cvt_pk_bf16(o1[0], o1[1]); w1.y = cvt_pk_bf16(o1[2], o1[3]); *(u32x2*)p = w1;
                        u32x2 w2; w2.x = cvt_pk_bf16(o2[0], o2[1]); w2.y = cvt_pk_bf16(o2[2], o2[3]); *(u32x2*)(p + 32) = w2;
                    } else {
                        const int gg = hh & 1; const bool isv = hh >= 2;
                        if (!isv) {
                            bf16_t* base = (u.pn == 4) ? KC : (u.pn == 5) ? KS : KW;
                            bf16_t* p = base + ((size_t)(b * 2 + gg) * T + t) * 64 + d0;
                            u32x2 w1; w1.x = cvt_pk_bf16(o1[0], o1[1]); w1.y = cvt_pk_bf16(o1[2], o1[3]); *(u32x2*)p = w1;
                            u32x2 w2; w2.x = cvt_pk_bf16(o2[0], o2[1]); w2.y = cvt_pk_bf16(o2[2], o2[3]); *(u32x2*)(p + 32) = w2;
                        } else if (u.pn == 4) {
                            bf16_t* p = VC + ((size_t)(b * 2 + gg) * T + t) * 64 + d0;
                            u32x2 w1; w1.x = cvt_pk_bf16(o1[0], o1[1]); w1.y = cvt_pk_bf16(o1[2], o1[3]); *(u32x2*)p = w1;
                            u32x2 w2; w2.x = cvt_pk_bf16(o2[0], o2[1]); w2.y = cvt_pk_bf16(o2[2], o2[3]); *(u32x2*)(p + 32) = w2;
                        } else {
                            bf16_t* base = (u.pn == 5) ? VST : VWT;
                            bf16_t* p = base + ((size_t)(b * 2 + gg) * 128 + (t >> 6)) * 4096 + vperm(t & 63);
#pragma unroll
                            for (int j = 0; j < 4; ++j) { p[(d0 + j) * 64] = (bf16_t)(cvt_pk_bf16(o1[j], 0.f) & 0xffff); p[(d0 + 32 + j) * 64] = (bf16_t)(cvt_pk_bf16(o2[j], 0.f) & 0xffff); }
                        }
                    }
                }
                asm volatile("" ::: "memory"); __builtin_amdgcn_sched_barrier(0);
            }
    }
};

struct EpiC1 {
    bf16_t* hid;
    __device__ __forceinline__ void operator()(Acc& acc, const Unit& u, int wr, int wc, int fr, int fq, LAS unsigned char* ldsx, int) const {
        const LAS float* c1 = (const LAS float*)ldsx;
#pragma unroll
        for (int bj = 0; bj < 2; ++bj) {
            const int c0 = 128 * bj + 32 * wc + 8 * fq;
            const f32x4 bA = *(const LAS f32x4*)(c1 + c0), bB = *(const LAS f32x4*)(c1 + c0 + 4);
#pragma unroll
            for (int ai = 0; ai < 2; ++ai)
#pragma unroll
                for (int m = 0; m < 4; ++m) {
                    const int row = u.pm * 256 + ai * 128 + wr * 64 + m * 16 + fr;
                    float v[8];
#pragma unroll
                    for (int e = 0; e < 8; ++e) { const float x = acc[ai][bj][m][e >> 2][e & 3] + ((e >> 2) ? bB[e & 3] : bA[e & 3]); const float y = 0.7978845608028654f * (x + 0.044715f * x * x * x); v[e] = x * sigmoidf_(2.0f * y); }
                    u32x4 w; w.x = cvt_pk_bf16(v[0], v[1]); w.y = cvt_pk_bf16(v[2], v[3]); w.z = cvt_pk_bf16(v[4], v[5]); w.w = cvt_pk_bf16(v[6], v[7]);
                    *(u32x4*)(hid + (size_t)row * 256 + c0) = w;
                    asm volatile("" ::: "memory"); __builtin_amdgcn_sched_barrier(0);
                }
        }
    }
};
struct EpiC2 {
    const float* b2; const float* cosT; const float* sinT; bf16_t* out; int isv;
    __device__ __forceinline__ void operator()(Acc& acc, const Unit& u, int wr, int wc, int fr, int fq, LAS unsigned char*, int) const {
        if (wc >= 2) return;
        const int d0 = 16 * (wc & 1) + 4 * fq;
        const f32x4 bA = *(const f32x4*)(b2 + d0), bB = *(const f32x4*)(b2 + d0 + 32);
#pragma unroll
        for (int ai = 0; ai < 2; ++ai)
#pragma unroll
            for (int m = 0; m < 4; ++m) {
                const int row = u.pm * 256 + ai * 128 + wr * 64 + m * 16 + fr; const int j = row & 511;
                f32x4 a1 = acc[ai][0][m][0] + bA, a2 = acc[ai][0][m][1] + bB;
                if (j == 511) { a1 = (f32x4){0.f, 0.f, 0.f, 0.f}; a2 = a1; }
                if (!isv) {
                    const int pos = (j == 511) ? 0 : 16 * j + 31;
                    const f32x4 cs = *(const f32x4*)(cosT + pos * 32 + d0), sn = *(const f32x4*)(sinT + pos * 32 + d0);
                    const f32x4 o1 = a1 * cs - a2 * sn, o2 = a1 * sn + a2 * cs;
                    bf16_t* p = out + (size_t)row * 64 + d0;
                    u32x2 w1; w1.x = cvt_pk_bf16(o1[0], o1[1]); w1.y = cvt_pk_bf16(o1[2], o1[3]); *(u32x2*)p = w1;
                    u32x2 w2; w2.x = cvt_pk_bf16(o2[0], o2[1]); w2.y = cvt_pk_bf16(o2[2], o2[3]); *(u32x2*)(p + 32) = w2;
                } else {
                    bf16_t* p = out + (size_t)(row >> 6) * 4096 + vperm(row & 63);
#pragma unroll
                    for (int e = 0; e < 4; ++e) { p[(d0 + e) * 64] = (bf16_t)(cvt_pk_bf16(a1[e], 0.f) & 0xffff); p[(d0 + 32 + e) * 64] = (bf16_t)(cvt_pk_bf16(a2[e], 0.f) & 0xffff); }
                }
                asm volatile("" ::: "memory"); __builtin_amdgcn_sched_barrier(0);
            }
    }
};

struct EpiRes {
    const float* xold; float* xnew; bf16_t* xb; float* ssp; const float* pb; const float* ps;
    __device__ __forceinline__ void operator()(Acc& acc, const Unit& u, int wr, int wc, int fr, int fq, LAS unsigned char* ldsx, int tid) const {
#pragma unroll
        for (int ai = 0; ai < 2; ++ai)
#pragma unroll
            for (int m = 0; m < 4; ++m) {
                const int row = u.pm * 256 + ai * 128 + wr * 64 + m * 16 + fr; float ss = 0.f;
#pragma unroll
                for (int bj = 0; bj < 2; ++bj) {
                    const int col = u.pn * 256 + 128 * bj + 32 * wc + 8 * fq; const size_t off = (size_t)row * D + col;
                    f32x4 a0 = acc[ai][bj][m][0], a1 = acc[ai][bj][m][1];
                    if (pb) { a0 = (a0 + *(const f32x4*)(pb + col)) * *(const f32x4*)(ps + col); a1 = (a1 + *(const f32x4*)(pb + col + 4)) * *(const f32x4*)(ps + col + 4); }
                    f32x4 r0, r1; unpk8(*(const u32x4*)(xb + off), r0, r1);
                    const f32x4 x0 = r0 + a0, x1 = r1 + a1;
                    u32x4 w; w.x = cvt_pk_bf16(x0[0], x0[1]); w.y = cvt_pk_bf16(x0[2], x0[3]); w.z = cvt_pk_bf16(x1[0], x1[1]); w.w = cvt_pk_bf16(x1[2], x1[3]);
                    *(u32x4*)(xb + off) = w;
                    ss += (x0[0] * x0[0] + x0[1] * x0[1]) + (x0[2] * x0[2] + x0[3] * x0[3]) + (x1[0] * x1[0] + x1[1] * x1[1]) + (x1[2] * x1[2] + x1[3] * x1[3]);
                    asm volatile("" ::: "memory"); __builtin_amdgcn_sched_barrier(0);
                }
                ss = xrow16_sum(ss);
                if (fq == 0) ((LAS float*)ldsx)[wc * 256 + ai * 128 + wr * 64 + m * 16 + fr] = ss;
            }
        WG_BAR();
        if (tid < 256) { const LAS float* rd = (const LAS float*)ldsx; ssp[(size_t)u.pn * M + u.pm * 256 + tid] = (rd[tid] + rd[256 + tid]) + (rd[512 + tid] + rd[768 + tid]); }
        WG_BAR();
    }
};

struct EpiFinal {
    float* x; const float* gain; float* ssx; unsigned* cnt; const bf16_t* xb;
    __device__ __forceinline__ void operator()(Acc& acc, const Unit& u, int wr, int wc, int fr, int fq, LAS unsigned char* ldsx, int tid) const {
        LAS float* red = (LAS float*)ldsx; LAS float* rsl = (LAS float*)(ldsx + 4096);
#pragma unroll
        for (int ai = 0; ai < 2; ++ai)
#pragma unroll
            for (int m = 0; m < 4; ++m) {
                const int row = u.pm * 256 + ai * 128 + wr * 64 + m * 16 + fr; float ss = 0.f;
#pragma unroll
                for (int bj = 0; bj < 2; ++bj) {
                    const int col = u.pn * 256 + 128 * bj + 32 * wc + 8 * fq; const size_t off = (size_t)row * D + col;
                    f32x4 r0, r1; unpk8(*(const u32x4*)(xb + off), r0, r1);
                    const f32x4 x0 = r0 + acc[ai][bj][m][0], x1 = r1 + acc[ai][bj][m][1];
                    acc[ai][bj][m][0] = x0; acc[ai][bj][m][1] = x1;
                    ss += (x0[0] * x0[0] + x0[1] * x0[1]) + (x0[2] * x0[2] + x0[3] * x0[3]) + (x1[0] * x1[0] + x1[1] * x1[1]) + (x1[2] * x1[2] + x1[3] * x1[3]);
                    asm volatile("" ::: "memory"); __builtin_amdgcn_sched_barrier(0);
                }
                ss = xrow16_sum(ss);
                if (fq == 0) red[wc * 256 + ai * 128 + wr * 64 + m * 16 + fr] = ss;
            }
        WG_BAR();
        if (tid < 256) __hip_atomic_store(ssx + (size_t)u.pn * M + u.pm * 256 + tid, (red[tid] + red[256 + tid]) + (red[512 + tid] + red[768 + tid]), __ATOMIC_RELAXED, __HIP_MEMORY_SCOPE_AGENT);
        asm volatile("s_waitcnt vmcnt(0)" ::: "memory");
        WG_BAR();
        if (tid == 0) {
            unsigned* c = cnt + 64 * u.pm;
            __hip_atomic_fetch_add(c, 1u, __ATOMIC_RELAXED, __HIP_MEMORY_SCOPE_AGENT);
            unsigned spins = 0;
            while (__hip_atomic_load(c, __ATOMIC_RELAXED, __HIP_MEMORY_SCOPE_AGENT) < 4u) { __builtin_amdgcn_s_sleep(2); if (++spins > (1u << 22)) break; }
            __builtin_amdgcn_fence(__ATOMIC_ACQUIRE, "agent");
            asm volatile("s_waitcnt vmcnt(0)" ::: "memory");
        }
        WG_BAR();
        if (tid < 256) {
            const float* p = ssx + u.pm * 256 + tid;
            const float sq = (__hip_atomic_load(p, __ATOMIC_RELAXED, __HIP_MEMORY_SCOPE_AGENT) + __hip_atomic_load(p + M, __ATOMIC_RELAXED, __HIP_MEMORY_SCOPE_AGENT)) +
                             (__hip_atomic_load(p + 2 * M, __ATOMIC_RELAXED, __HIP_MEMORY_SCOPE_AGENT) + __hip_atomic_load(p + 3 * M, __ATOMIC_RELAXED, __HIP_MEMORY_SCOPE_AGENT));
            rsl[tid] = 1.0f / sqrtf(sq * (1.0f / D) + EPS);
        }
        WG_BAR();
#pragma unroll
        for (int ai = 0; ai < 2; ++ai)
#pragma unroll
            for (int m = 0; m < 4; ++m) {
                const int rl = ai * 128 + wr * 64 + m * 16 + fr; const float rs = rsl[rl]; const int row = u.pm * 256 + rl;
#pragma unroll
                for (int bj = 0; bj < 2; ++bj) {
                    const int col = u.pn * 256 + 128 * bj + 32 * wc + 8 * fq; const size_t off = (size_t)row * D + col;
                    *(f32x4*)(x + off) = acc[ai][bj][m][0] * rs * *(const f32x4*)(gain + col); *(f32x4*)(x + off + 4) = acc[ai][bj][m][1] * rs * *(const f32x4*)(gain + col + 4);
                }
                asm volatile("" ::: "memory"); __builtin_amdgcn_sched_barrier(0);
            }
    }
};

struct EpiUp {
    const float* ssp; const float* cw; const float* cb; bf16_t* act; float* HB; float* FB;
    __device__ __forceinline__ void operator()(Acc& acc, const Unit& u, int wr, int wc, int fr, int fq, LAS unsigned char* ldsx, int tid) const {
        LAS float* Hl = (LAS float*)ldsx;
        LAS float* rsl = (LAS float*)(ldsx + 10240);
        const int lane = tid & 63;
        if (tid < 256) { const int row = u.pm * 256 + tid; const float sq = (ssp[row] + ssp[M + row]) + (ssp[2 * M + row] + ssp[3 * M + row]); rsl[tid] = 1.0f / sqrtf(sq * (1.0f / D) + EPS); }
        WG_BAR();
#pragma unroll
        for (int ai = 0; ai < 2; ++ai)
#pragma unroll
            for (int m = 0; m < 4; ++m) {
                const float rs = rsl[ai * 128 + wr * 64 + m * 16 + fr];
#pragma unroll
                for (int bj = 0; bj < 2; ++bj) { acc[ai][bj][m][0] *= rs; acc[ai][bj][m][1] *= rs; }
                asm volatile("" ::: "memory"); __builtin_amdgcn_sched_barrier(0);
            }
        if (tid < 128) *(LAS f32x4*)(Hl + tid * 4) = (f32x4){0.f, 0.f, 0.f, 0.f};
#pragma unroll
        for (int ai = 0; ai < 2; ++ai) {
            const int k = 2 * ai + wr;
#pragma unroll
            for (int bj = 0; bj < 2; ++bj)
#pragma unroll
                for (int n = 0; n < 2; ++n) {
                    const int tc = 128 * bj + 32 * wc + 8 * fq + 4 * n; const int uc = bj * FF + u.pn * 128 + 32 * wc + 8 * fq + 4 * n;
                    if (fr >= 14) { *(LAS f32x4*)(Hl + ((k + 1) * 2 + (fr - 14)) * 256 + tc) = acc[ai][bj][3][n]; if (k == 3) *(f32x4*)(HB + ((size_t)u.pm * 2 + (fr - 14)) * UP + uc) = acc[ai][bj][3][n]; }
                    if (k == 0 && fr < 2) *(f32x4*)(FB + ((size_t)u.pm * 2 + fr) * UP + uc) = acc[0][bj][0][n];
                }
        }
        WG_BAR();
#pragma unroll
        for (int ai = 0; ai < 2; ++ai) {
            const int k = 2 * ai + wr;
            u32x2 pk[4];
#pragma unroll
            for (int n = 0; n < 2; ++n) {
                const int tc = 32 * wc + 8 * fq + 4 * n; const int ucg = u.pn * 128 + tc;
                f32x4 cg[4];
#pragma unroll
                for (int bj = 0; bj < 2; ++bj) {
                    const int uc = bj * FF + ucg;
                    const f32x4 w0 = *(const f32x4*)(cw + uc), w1 = *(const f32x4*)(cw + UP + uc), w2 = *(const f32x4*)(cw + 2 * UP + uc), bb = *(const f32x4*)(cb + uc);
                    const f32x4 h0 = *(const LAS f32x4*)(Hl + (k * 2 + 0) * 256 + 128 * bj + tc), h1 = *(const LAS f32x4*)(Hl + (k * 2 + 1) * 256 + 128 * bj + tc);
#pragma unroll
                    for (int m = 0; m < 4; ++m) {
                        const f32x4 V = acc[ai][bj][m][n]; f32x4 p1, p2;
#pragma unroll
                        for (int e = 0; e < 4; ++e) {
                            const float r1 = dppf<0x121>(V[e]), r2 = dppf<0x122>(V[e]); float x1, x2;
                            if (m > 0) { x1 = dppf<0x121>(acc[ai][bj][m > 0 ? m - 1 : 0][n][e]); x2 = dppf<0x122>(acc[ai][bj][m > 0 ? m - 1 : 0][n][e]); }
                            else { x1 = h1[e]; x2 = (fr == 0) ? h0[e] : h1[e]; }
                            p1[e] = (fr == 0) ? x1 : r1; p2[e] = (fr < 2) ? x2 : r2;
                        }
                        const f32x4 cv = bb + w0 * p2 + w1 * p1 + w2 * V;
                        __builtin_amdgcn_sched_barrier(0);
                        if (bj == 0) cg[m] = cv;
                        else {
                            const int row = u.pm * 256 + ai * 128 + wr * 64 + m * 16 + fr;
                            float o[4];
#pragma unroll
                            for (int e = 0; e < 4; ++e) { const float gt = cg[m][e]; o[e] = gt * sigmoidf_(gt) * cv[e]; }
                            u32x2 w; w.x = cvt_pk_bf16(o[0], o[1]); w.y = cvt_pk_bf16(o[2], o[3]);
                            if (n == 0) pk[m] = w;
                            else { u32x4 w4; w4.x = pk[m].x; w4.y = pk[m].y; w4.z = w.x; w4.w = w.y; *(u32x4*)(act + (size_t)row * FF + ucg - 4) = w4; }
                        }
                    }
                    asm volatile("" ::: "memory"); __builtin_amdgcn_sched_barrier(0);
                }
            }
        }
        WG_BAR();
    }
};

namespace att {
constexpr int SLOT_B = 16384, NSLOT = 6;
constexpr int OFF_K = 0, OFF_IMP = NSLOT * SLOT_B, IMPW = 132, OFF_SEL = OFF_IMP + 64 * IMPW * 4, OFF_UNI = OFF_SEL + 1024, OFF_LIST = OFF_UNI + 64, OFF_N = OFF_LIST + 132 * 4, OFF_CODE = OFF_N + 48, CODEW = 144;
static_assert(OFF_CODE + 8 * CODEW <= LDS_BYTES - 16 && 8 * SLOT_B <= OFF_SEL, "attention LDS map");
struct Ctx {
    const bf16_t *Q, *KCC, *VCT, *KS, *VST, *KW, *VWT; const float* gates; bf16_t* O;
};
__device__ __forceinline__ bf16x8 mk8(s16x4 a, s16x4 b) { return (bf16x8){a[0], a[1], a[2], a[3], b[0], b[1], b[2], b[3]}; }

template <int MODE>
__device__ __forceinline__ void branch(LAS unsigned char* lds, const bf16_t* Kg, const bf16_t* Vg, int ktile_elems, int nt, int c, int w, int lane, int tid,
                                       const bf16x8 (&qf)[4][2], float (&mrow)[4], float (&lrow)[4], f32x4 (&O)[4][4]) {
    const int fr = lane & 15, fq = lane >> 4;
    const LAS int* list = (const LAS int*)(lds + OFF_LIST);
    LAS float* impL = (LAS float*)(lds + OFF_IMP);
    const LAS unsigned char* codeL = (const LAS unsigned char*)(lds + OFF_CODE) + w * CODEW;
    constexpr int TPS = (MODE >= 2) ? 4 : 3;
#define ATT_DMA(ti, slot) do { const int ti_ = (ti); const int s_ = list[ti_]; LAS unsigned char* d_ = lds + OFF_K + (slot) * SLOT_B + w * 1024; \
        int t2_ = tid; asm volatile("" : "+v"(t2_)); const int lr = t2_ >> 3, lq = t2_ & 7; const int goff = lr * 64 + ((lq ^ ((lr >> 1) & 7)) * 8); \
        __builtin_amdgcn_global_load_lds((const unsigned*)(Kg + (size_t)s_ * ktile_elems + goff), (LAS unsigned*)d_, 16, 0, 0); \
        if (MODE != 0) __builtin_amdgcn_global_load_lds((const unsigned*)(Vg + (size_t)s_ * 4096 + goff), (LAS unsigned*)(d_ + 8192), 16, 0, 0); } while (0)
    asm volatile("s_waitcnt vmcnt(0)" ::: "memory");
#pragma unroll
    for (int ti = 0; ti < TPS; ++ti) if (ti < nt) ATT_DMA(ti, ti);
    const int nst = (nt + TPS - 1) / TPS;
    for (int j = 0; j < nst; ++j) {
        asm volatile("s_waitcnt vmcnt(0)" ::: "memory");
        WG_BAR();
#pragma unroll
        for (int hh = 0; hh < TPS; ++hh) if (TPS * (j + 1) + hh < nt) ATT_DMA(TPS * (j + 1) + hh, ((j + 1) & 1) * TPS + hh);
        int sl0 = 0, sl1 = 0, sl2 = 0, sl3 = 0; unsigned codes4 = 0xffffffffu;
        if (TPS == 4) {
            const u32x4 l4 = *(const LAS u32x4*)(list + TPS * j);
            sl0 = __builtin_amdgcn_readfirstlane((int)l4.x); sl1 = __builtin_amdgcn_readfirstlane((int)l4.y); sl2 = __builtin_amdgcn_readfirstlane((int)l4.z); sl3 = __builtin_amdgcn_readfirstlane((int)l4.w);
            if (MODE == 2) codes4 = (unsigned)__builtin_amdgcn_readfirstlane((int)*(const LAS unsigned*)(codeL + TPS * j));
        }
#pragma unroll 1
        for (int h = 0; h < TPS; ++h) {
        const int i = TPS * j + h; if (i >= nt) break;
        const int s = (TPS == 4) ? (h == 0 ? sl0 : h == 1 ? sl1 : h == 2 ? sl2 : sl3) : list[i];
        unsigned code = 0xffu; if (MODE == 2) code = (codes4 >> (8 * h)) & 0xffu;
        const LAS unsigned char* Kb = lds + OFF_K + ((j & 1) * TPS + h) * SLOT_B;
        const LAS unsigned char* Vb = Kb;
        int l2_ = lane; asm volatile("" : "+v"(l2_)); const int fr2 = l2_ & 15, fq2 = l2_ >> 4, swz = (fr2 >> 1) & 7;
        const int kb0 = fr2 * 128 + ((fq2 ^ swz) * 16), kb1 = kb0 ^ 64;
        if (MODE != 2) {
            f32x4 sa[4][4];
#pragma unroll
            for (int p = 0; p < 4; ++p) {
                const float cinit = (MODE == 1) ? lrow[p] : -((mrow[p] < -1e29f) ? 0.f : mrow[p]);
#pragma unroll
                for (int mt = 0; mt < 4; ++mt) sa[p][mt] = (f32x4){cinit, cinit, cinit, cinit};
            }
#pragma unroll
            for (int mt = 0; mt < 4; ++mt)
#pragma unroll
                for (int ks = 0; ks < 2; ++ks) {
                    const bf16x8 kf = *(const LAS bf16x8*)(Kb + (ks ? kb1 : kb0) + mt * 2048);
#pragma unroll
                    for (int p = 0; p < 4; ++p) sa[p][mt] = __builtin_amdgcn_mfma_f32_16x16x32_bf16(kf, qf[p][ks], sa[p][mt], 0, 0, 0);
                }
            bf16x8 pf[4][2];
#pragma unroll
            for (int p = 0; p < 4; ++p) {
                const int ttA = 8 * w + 2 * p, tt = ttA + (fr >> 3);
                bool needmask;
                if (MODE <= 1) needmask = (((64 * c + ttA - 31) >> 4) - 64 * s) < 63;
                else needmask = (s == c) || (c >= 8 && s == c - 8);
                if (needmask) {
                    int hi, lov = -1;
                    if (MODE <= 1) { const int t = 64 * c + tt; hi = ((t - 31) >> 4) - 64 * s; }
                    else { hi = (s == c) ? tt : 63; lov = (c >= 8 && s == c - 8) ? tt : -1; }
#pragma unroll
                    for (int mt = 0; mt < 4; ++mt)
#pragma unroll
                        for (int j = 0; j < 4; ++j) { const int kk = 16 * mt + 4 * fq + j; sa[p][mt][j] = (kk <= hi && kk > lov) ? sa[p][mt][j] : -1e30f; }
                }
                if (MODE != 1) {
                    float mx = fmaxf(fmaxf(sa[p][0][0], sa[p][0][1]), sa[p][0][2]);
                    mx = fmaxf(fmaxf(mx, sa[p][0][3]), sa[p][1][0]); mx = fmaxf(fmaxf(mx, sa[p][1][1]), sa[p][1][2]); mx = fmaxf(fmaxf(mx, sa[p][1][3]), sa[p][2][0]);
                    mx = fmaxf(fmaxf(mx, sa[p][2][1]), sa[p][2][2]); mx = fmaxf(fmaxf(mx, sa[p][2][3]), sa[p][3][0]); mx = fmaxf(fmaxf(mx, sa[p][3][1]), sa[p][3][2]); mx = fmaxf(mx, sa[p][3][3]);
                    mx = xrow16_max(mx);
                    const bool uninit = mrow[p] < -1e29f;
                    const bool resc = (mx > 8.0f) || (uninit && mx > -1e29f);
                    if (__any(resc)) {
                        const float delta = resc ? mx : 0.f;
                        const float alpha = (resc && !uninit) ? ex2(-delta) : 1.0f;
#pragma unroll
                        for (int mt = 0; mt < 4; ++mt) sa[p][mt] = sa[p][mt] - delta;
                        lrow[p] *= alpha;
                        if (MODE >= 2) {
#pragma unroll
                            for (int d = 0; d < 4; ++d) O[p][d] *= alpha;
                        }
                        if (resc) mrow[p] = (uninit ? 0.f : mrow[p]) + delta;
                    }
                }
#pragma unroll
                for (int mt = 0; mt < 4; ++mt)
#pragma unroll
                    for (int j = 0; j < 4; ++j) sa[p][mt][j] = ex2(sa[p][mt][j]);
                if (MODE != 1) { const f32x4 t4 = (sa[p][0] + sa[p][1]) + (sa[p][2] + sa[p][3]); lrow[p] += (t4[0] + t4[1]) + (t4[2] + t4[3]); }
                if (MODE >= 1) {
#pragma unroll
                    for (int k2 = 0; k2 < 2; ++k2) {
                        u32x4 wv; wv.x = cvt_pk_bf16(sa[p][2 * k2][0], sa[p][2 * k2][1]); wv.y = cvt_pk_bf16(sa[p][2 * k2][2], sa[p][2 * k2][3]); wv.z = cvt_pk_bf16(sa[p][2 * k2 + 1][0], sa[p][2 * k2 + 1][1]); wv.w = cvt_pk_bf16(sa[p][2 * k2 + 1][2], sa[p][2 * k2 + 1][3]);
                        pf[p][k2] = __builtin_bit_cast(bf16x8, wv);
                    }
                }
                if (MODE == 1) {
#pragma unroll
                    for (int mt = 0; mt < 4; ++mt) {
                        float a = sa[p][mt][0] + sa[p][mt][1] + sa[p][mt][2] + 0.5f * sa[p][mt][3], bn = 0.5f * sa[p][mt][3];
                        a = sum8(a); bn = sum8(bn);
                        const int sb = 16 * s + 4 * mt + fq;
                        if ((fr & 7) == 0) { (void)__hip_atomic_fetch_add(impL + tt * IMPW + sb, a, __ATOMIC_RELAXED, __HIP_MEMORY_SCOPE_WORKGROUP); (void)__hip_atomic_fetch_add(impL + tt * IMPW + sb + 1, bn, __ATOMIC_RELAXED, __HIP_MEMORY_SCOPE_WORKGROUP); }
                    }
                }
            }
            if (MODE >= 1) {
#pragma unroll
                for (int d = 0; d < 4; ++d)
#pragma unroll
                    for (int k2 = 0; k2 < 2; ++k2) {
                        const bf16x8 vf = *(const LAS bf16x8*)(Vb + 8192 + (k2 ? kb1 : kb0) + d * 2048);
#pragma unroll
                        for (int p = 0; p < 4; ++p) O[p][d] = __builtin_amdgcn_mfma_f32_16x16x32_bf16(vf, pf[p][k2], O[p][d], 0, 0, 0);
                    }
            }
            __builtin_amdgcn_sched_barrier(0);
        } else {
#pragma unroll
        for (int p = 0; p < 4; ++p) {
            const int ttA = 8 * w + 2 * p;
            const unsigned mA = (code >> (2 * p)) & 1u, mB = (code >> (2 * p + 1)) & 1u;
            if ((mA | mB) != 0u) {
            const int tt = ttA + (fr >> 3);
            float cinit;
            if (MODE == 1) cinit = lrow[p];
            else { const float mref = (mrow[p] < -1e29f) ? 0.f : mrow[p]; const bool colact = (MODE != 2) || (((fr >> 3) ? mB : mA) != 0u); cinit = colact ? -mref : -1e30f; }
            f32x4 sa[4];
#pragma unroll
            for (int mt = 0; mt < 4; ++mt) {
                sa[mt] = (f32x4){cinit, cinit, cinit, cinit};
#pragma unroll
                for (int ks = 0; ks < 2; ++ks) { const bf16x8 kf = *(const LAS bf16x8*)(Kb + (ks ? kb1 : kb0) + mt * 2048); sa[mt] = __builtin_amdgcn_mfma_f32_16x16x32_bf16(kf, qf[p][ks], sa[mt], 0, 0, 0); }
            }
            bool needmask;
            if (MODE <= 1) needmask = (((64 * c + ttA - 31) >> 4) - 64 * s) < 63;
            else if (MODE == 2) needmask = (s == c);
            else needmask = (s == c) || (c >= 8 && s == c - 8);
            if (needmask) {
                int hi, lov = -1;
                if (MODE <= 1) { const int t = 64 * c + tt; hi = ((t - 31) >> 4) - 64 * s; }
                else if (MODE == 2) hi = tt;
                else { hi = (s == c) ? tt : 63; lov = (c >= 8 && s == c - 8) ? tt : -1; }
#pragma unroll
                for (int mt = 0; mt < 4; ++mt)
#pragma unroll
                    for (int j = 0; j < 4; ++j) { const int kk = 16 * mt + 4 * fq + j; sa[mt][j] = (kk <= hi && kk > lov) ? sa[mt][j] : -1e30f; }
            }
            if (MODE != 1) {
                float mx = fmaxf(fmaxf(sa[0][0], sa[0][1]), sa[0][2]);
                mx = fmaxf(fmaxf(mx, sa[0][3]), sa[1][0]); mx = fmaxf(fmaxf(mx, sa[1][1]), sa[1][2]); mx = fmaxf(fmaxf(mx, sa[1][3]), sa[2][0]);
                mx = fmaxf(fmaxf(mx, sa[2][1]), sa[2][2]); mx = fmaxf(fmaxf(mx, sa[2][3]), sa[3][0]); mx = fmaxf(fmaxf(mx, sa[3][1]), sa[3][2]); mx = fmaxf(mx, sa[3][3]);
                mx = xrow16_max(mx);
                const bool uninit = mrow[p] < -1e29f;
                const bool resc = (mx > 8.0f) || (uninit && mx > -1e29f);
                if (__any(resc)) {
                    const float delta = resc ? mx : 0.f;
                    const float alpha = (resc && !uninit) ? ex2(-delta) : 1.0f;
#pragma unroll
                    for (int mt = 0; mt < 4; ++mt) sa[mt] = sa[mt] - delta;
                    lrow[p] *= alpha;
                    if (MODE >= 2) {
#pragma unroll
                        for (int d = 0; d < 4; ++d) O[p][d] *= alpha;
                    }
                    if (resc) mrow[p] = (uninit ? 0.f : mrow[p]) + delta;
                }
            }
            f32x4 pv[4];
#pragma unroll
            for (int mt = 0; mt < 4; ++mt)
#pragma unroll
                for (int j = 0; j < 4; ++j) pv[mt][j] = ex2(sa[mt][j]);
            if (MODE != 1) { const f32x4 t4 = (pv[0] + pv[1]) + (pv[2] + pv[3]); lrow[p] += (t4[0] + t4[1]) + (t4[2] + t4[3]); }
            if (MODE >= 1) {
                bf16x8 pf[2];
#pragma unroll
                for (int k2 = 0; k2 < 2; ++k2) {
                    u32x4 wv; wv.x = cvt_pk_bf16(pv[2 * k2][0], pv[2 * k2][1]); wv.y = cvt_pk_bf16(pv[2 * k2][2], pv[2 * k2][3]); wv.z = cvt_pk_bf16(pv[2 * k2 + 1][0], pv[2 * k2 + 1][1]); wv.w = cvt_pk_bf16(pv[2 * k2 + 1][2], pv[2 * k2 + 1][3]);
                    pf[k2] = __builtin_bit_cast(bf16x8, wv);
                }
#pragma unroll
                for (int d = 0; d < 4; ++d)
#pragma unroll
                    for (int k2 = 0; k2 < 2; ++k2) {
                        const bf16x8 vf = *(const LAS bf16x8*)(Vb + 8192 + (k2 ? kb1 : kb0) + d * 2048);
                        O[p][d] = __builtin_amdgcn_mfma_f32_16x16x32_bf16(vf, pf[k2], O[p][d], 0, 0, 0);
                    }
            }
            if (MODE == 1) {
#pragma unroll
                for (int mt = 0; mt < 4; ++mt) {
                    float a = pv[mt][0] + pv[mt][1] + pv[mt][2] + 0.5f * pv[mt][3], bn = 0.5f * pv[mt][3];
                    a = sum8(a); bn = sum8(bn);
                    const int sb = 16 * s + 4 * mt + fq;
                    if ((fr & 7) == 0) { (void)__hip_atomic_fetch_add(impL + tt * IMPW + sb, a, __ATOMIC_RELAXED, __HIP_MEMORY_SCOPE_WORKGROUP); (void)__hip_atomic_fetch_add(impL + tt * IMPW + sb + 1, bn, __ATOMIC_RELAXED, __HIP_MEMORY_SCOPE_WORKGROUP); }
                }
            }
            }
            __builtin_amdgcn_sched_barrier(0);
        }
        }
        }
    }
    WG_BAR();
#undef ATT_DMA
}

__device__ __forceinline__ void unit(LAS unsigned char* lds, const Ctx& X, int b, int g, int c, int tid_in) {
    int tid = tid_in; asm volatile("" : "+v"(tid));
    const int lane = tid & 63, w = __builtin_amdgcn_readfirstlane(tid >> 6), fr = lane & 15, fq = lane >> 4;
    LAS int* list = (LAS int*)(lds + OFF_LIST);
    LAS unsigned* selm = (LAS unsigned*)(lds + OFF_SEL);
    LAS unsigned* uni = (LAS unsigned*)(lds + OFF_UNI);
    LAS float* impL = (LAS float*)(lds + OFF_IMP);
    LAS int* nl = (LAS int*)(lds + OFF_N);
    const int bg = b * 2 + g; const size_t rowbase = (size_t)b * T + 64 * c;
    bf16x8 qf[4][2];
#pragma unroll
    for (int p = 0; p < 4; ++p) { const bf16_t* qp = X.Q + (rowbase + 8 * w + 2 * p + (fr >> 3)) * 1024 + (8 * g + (fr & 7)) * 64 + 8 * fq;
#pragma unroll
        for (int ks = 0; ks < 2; ++ks) qf[p][ks] = *(const bf16x8*)(qp + 32 * ks); }
    for (int i = lane; i < 8 * IMPW; i += 64) impL[(8 * w) * IMPW + i] = 0.f;
    const int ncmp = (4 * c + 3 + 63) >> 6;
    if (tid < 8) list[tid] = tid;
    float mrow[4], lrow[4]; f32x4 O[4][4];
#pragma unroll
    for (int p = 0; p < 4; ++p) { mrow[p] = -1e30f; lrow[p] = 0.f;
#pragma unroll
        for (int d = 0; d < 4; ++d) { O[p][d] = (f32x4){0.f, 0.f, 0.f, 0.f}; } }
    WG_BAR();
    const bf16_t* kcc = X.KCC + (size_t)bg * 512 * 64; const bf16_t* vct = X.VCT + (size_t)bg * 8 * 4096;
    branch<0>(lds, kcc, vct, 4096, ncmp, c, w, lane, tid, qf, mrow, lrow, O);
#pragma unroll
    for (int p = 0; p < 4; ++p) { float l = xrow16_sum(lrow[p]); lrow[p] = (l > 0.f) ? (-mrow[p] - __builtin_amdgcn_logf(l)) : -1e30f; }
    branch<1>(lds, kcc, vct, 4096, ncmp, c, w, lane, tid, qf, mrow, lrow, O);
#define ATT_GATE(br, scale_expr) do { _Pragma("unroll") for (int p = 0; p < 4; ++p) { \
        const size_t grow = rowbase + 8 * w + 2 * p + (fr >> 3); \
        const float gt = X.gates[grow * 48 + (8 * g + (fr & 7)) * 3 + (br)]; const float sc = gt * (scale_expr); \
        _Pragma("unroll") for (int d = 0; d < 4; ++d) { \
            u32x2* optr = (u32x2*)(X.O + grow * 1024 + (8 * g + (fr & 7)) * 64 + 4 * fq + 16 * d); u32x2 ot = (u32x2){0u, 0u}; if ((br) > 0) ot = *optr; \
            float o0 = __uint_as_float(ot.x << 16), o1 = __uint_as_float(ot.x & 0xffff0000u), o2 = __uint_as_float(ot.y << 16), o3 = __uint_as_float(ot.y & 0xffff0000u); \
            o0 += sc * O[p][d][0]; o1 += sc * O[p][d][1]; o2 += sc * O[p][d][2]; o3 += sc * O[p][d][3]; \
            ot.x = cvt_pk_bf16(o0, o1); ot.y = cvt_pk_bf16(o2, o3); O[p][d] = (f32x4){0.f, 0.f, 0.f, 0.f}; \
            *optr = ot; } \
        mrow[p] = -1e30f; lrow[p] = 0.f; } } while (0)
    ATT_GATE(0, 1.0f);
    LDS_WAIT();
    for (int q8 = 0; q8 < 8; ++q8) {
        const int tt = 8 * w + q8;
        unsigned long long blo, bhi;
        if (c + 1 <= 16) { blo = (1ull << (c + 1)) - 1ull; bhi = 0ull; }
        else {
            const int s1 = lane, s2 = lane + 64;
            const bool c1 = (s1 >= 1 && s1 <= c - 2), c2 = (s2 >= 1 && s2 <= c - 2);
            const float v1 = c1 ? impL[tt * IMPW + s1] : -1.f, v2 = c2 ? impL[tt * IMPW + s2] : -1.f;
            int r1 = 0, r2 = 0;
            const int nq = (c - 2) / 4 + 1;
#pragma unroll 2
            for (int q = 0; q < nq; ++q) {
                const f32x4 x4 = *(const LAS f32x4*)(impL + tt * IMPW + 4 * q);
#pragma unroll
                for (int e = 0; e < 4; ++e) { const int sp = 4 * q + e; const float x = (sp >= 1 && sp <= c - 2) ? x4[e] : -2.f;
                    r1 += (x > v1 || (x == v1 && sp < s1)) ? 1 : 0; r2 += (x > v2 || (x == v2 && sp < s2)) ? 1 : 0; }
            }
            const bool f1 = (s1 == 0 || s1 == c || s1 == c - 1), f2 = (s2 == c || s2 == c - 1);
            blo = __ballot((c1 && r1 < 13) || f1); bhi = __ballot((c2 && r2 < 13) || f2);
        }
        if (lane == 0) { selm[tt * 4 + 0] = (unsigned)blo; selm[tt * 4 + 1] = (unsigned)(blo >> 32); selm[tt * 4 + 2] = (unsigned)bhi; selm[tt * 4 + 3] = (unsigned)(bhi >> 32); }
    }
    WG_BAR();
    if (tid < 4) { unsigned o = 0; for (int i = 0; i < 64; ++i) o |= selm[i * 4 + tid]; uni[tid] = o; }
    WG_BAR();
    if (tid == 0) { int n = 0; for (int s = 0; s <= c; ++s) if ((uni[s >> 5] >> (s & 31)) & 1u) list[n++] = s; nl[0] = n; }
    WG_BAR();
    const int nsel = nl[0];
    { LAS unsigned char* cw_ = (LAS unsigned char*)(lds + OFF_CODE) + w * CODEW;
      for (int i = lane; i < nsel; i += 64) { const int s_ = list[i]; unsigned cd = 0;
#pragma unroll
          for (int q8 = 0; q8 < 8; ++q8) cd |= ((selm[(8 * w + q8) * 4 + (s_ >> 5)] >> (s_ & 31)) & 1u) << q8;
          cw_[i] = (unsigned char)cd; }
      LDS_WAIT(); }
    branch<2>(lds, X.KS + (size_t)bg * T * 64, X.VST + (size_t)bg * 128 * 4096, 4096, nsel, c, w, lane, tid, qf, mrow, lrow, O);
#pragma unroll
    for (int p = 0; p < 4; ++p) { float l = xrow16_sum(lrow[p]); lrow[p] = (l > 0.f) ? 1.0f / l : 0.f; }
    { float rl[4] = {lrow[0], lrow[1], lrow[2], lrow[3]}; ATT_GATE(1, rl[p]); }
    const int w0 = (c >= 8) ? c - 8 : 0, nwin = c - w0 + 1;
    if (tid < nwin) list[tid] = w0 + tid;
    WG_BAR();
    branch<3>(lds, X.KW + (size_t)bg * T * 64, X.VWT + (size_t)bg * 128 * 4096, 4096, nwin, c, w, lane, tid, qf, mrow, lrow, O);
#pragma unroll
    for (int p = 0; p < 4; ++p) { float l = xrow16_sum(lrow[p]); lrow[p] = (l > 0.f) ? 1.0f / l : 0.f; }
    { float rl[4] = {lrow[0], lrow[1], lrow[2], lrow[3]}; ATT_GATE(2, rl[p]); }
#undef ATT_GATE
    WG_BAR();
}
}

__device__ __forceinline__ unsigned f2bf(float f) { unsigned u = __builtin_bit_cast(unsigned, f); return (u + 0x7fffu + ((u >> 16) & 1u)) >> 16; }
__device__ __forceinline__ unsigned pk2(float lo, float hi) { return f2bf(lo) | (f2bf(hi) << 16); }
template <int MAP>
__device__ __forceinline__ int rowmap(int a) {
    if (MAP == 0) return perm8(a);
    if (MAP == 1) return a < 1792 ? ((a & ~63) | swap45(a & 63)) : a;
    if (MAP == 2) { if (a < FF) return 256 * (a >> 7) + perm8(a & 127); const int a2 = a - FF; return 256 * (a2 >> 7) + 128 + perm8(a2 & 127); }
    return swap45(a);
}
template <int MAP>
__device__ __forceinline__ void transpose_item(const float* W, int K, int N, bf16_t* WT, int row_off, const float* gain, LAS float* scr, int item, int lane) {
    const int nblk = (N + 31) / 32, kb = item / nblk, nb = item % nblk, k0 = 64 * kb, n0 = 32 * nb;
#pragma unroll
    for (int i = 0; i < 32; ++i) { const int kk = 2 * i + (lane >> 5); const int col = n0 + (lane & 31); float v = (col < N) ? W[(size_t)(k0 + kk) * N + col] : 0.f; if (gain) v *= gain[k0 + kk]; scr[kk * 33 + (lane & 31)] = v; }
    LDS_WAIT();
    const int cc = lane & 7;
#pragma unroll
    for (int j = 0; j < 4; ++j) { const int n = (lane >> 3) + 8 * j; const LAS float* s = scr + (8 * cc) * 33 + n;
        u32x4 o; o.x = pk2(s[0 * 33], s[1 * 33]); o.y = pk2(s[2 * 33], s[3 * 33]); o.z = pk2(s[4 * 33], s[5 * 33]); o.w = pk2(s[6 * 33], s[7 * 33]);
        if (n0 + n < N) *(u32x4*)(WT + (size_t)(row_off + rowmap<MAP>(n0 + n)) * K + k0 + 8 * cc) = o; }
    LDS_WAIT();
}

#define XB_TMO      128
#define XB_XCNT(j)  (256  + 64 * (j))
#define XB_XSUB(j)  (1280 + 64 * (j))
#define XB_XGEN(j)  (2304 + 64 * (j))
#define XB_TOP      3328
#define XB_TOPGEN   3392
#define XCD_BAR_WORDS 3456
#define XB_SPIN_CAP (1u << 18)
__device__ __forceinline__ unsigned xb_ld(unsigned* p)              { return __hip_atomic_load(p, __ATOMIC_RELAXED, __HIP_MEMORY_SCOPE_AGENT); }
__device__ __forceinline__ unsigned xb_add(unsigned* p, unsigned v) { return __hip_atomic_fetch_add(p, v, __ATOMIC_RELAXED, __HIP_MEMORY_SCOPE_AGENT); }
__device__ __forceinline__ unsigned xb_xcc_id() { return (unsigned)__builtin_amdgcn_s_getreg((3 << 11) | 20) & 0xFu; }
#define XB_SPIN(cond, bar) do { unsigned _sp = 0; while (cond) { __builtin_amdgcn_s_sleep(1); \
    if ((++_sp & 255u) == 0u) { if (xb_ld(&(bar)[XB_TMO])) break; if (_sp > XB_SPIN_CAP) { atomicAdd(&(bar)[XB_TMO], 1u); break; } } } } while (0)
struct XcdBarrier { unsigned* bar; unsigned x; volatile LAS unsigned* st; };
__device__ __forceinline__ XcdBarrier xcd_barrier_post(unsigned* bar, volatile LAS unsigned* st) {
    XcdBarrier b; b.bar = bar; b.x = xb_xcc_id(); b.st = st;
    if (threadIdx.x == 0) (void)xb_add(&bar[XB_XCNT(b.x)], 1u);
    return b;
}
__device__ __forceinline__ void xcd_barrier_complete(unsigned* bar, unsigned x, unsigned& nloc, unsigned& nx) {
    const unsigned G = gridDim.x * gridDim.y * gridDim.z;
    unsigned sum, cnt, mine, sp = 0u;
    for (;;) {
        sum = 0u; cnt = 0u; mine = 0u;
#pragma unroll
        for (unsigned j = 0; j < 16; ++j) { const unsigned c = xb_ld(&bar[XB_XCNT(j)]); sum += c; cnt += (c > 0u) ? 1u : 0u; mine = (j == x) ? c : mine; }
        if (sum == G) break;
        __builtin_amdgcn_s_sleep(1);
        if ((++sp & 255u) == 0u) { if (xb_ld(&bar[XB_TMO])) break; if (sp > XB_SPIN_CAP) { atomicAdd(&bar[XB_TMO], 1u); break; } }
    }
    nloc = mine > 0u ? mine : 1u; nx = cnt > 0u ? cnt : 1u;
}
__device__ __forceinline__ void xcd_barrier(const XcdBarrier& b) {
    asm volatile("s_waitcnt vmcnt(0)" ::: "memory");
    __syncthreads();
    if (threadIdx.x == 0) {
        unsigned* bar = b.bar;
        __builtin_amdgcn_s_waitcnt(0);
        unsigned nloc = b.st[0], nx = b.st[1];
        if (nloc == 0u) { xcd_barrier_complete(bar, b.x, nloc, nx); b.st[0] = nloc; b.st[1] = nx; }
        const unsigned old = xb_add(&bar[XB_XSUB(b.x)], 1u);
        const unsigned gen = old / nloc;
        if (old + 1u == (gen + 1u) * nloc) {
            __builtin_amdgcn_fence(__ATOMIC_RELEASE, "agent");
            asm volatile("s_waitcnt vmcnt(0)" ::: "memory");
            const unsigned og = xb_add(&bar[XB_TOP], 1u);
            const unsigned tg = og / nx;
            if (og + 1u == (tg + 1u) * nx) xb_add(&bar[XB_TOPGEN], 1u);
            else XB_SPIN(xb_ld(&bar[XB_TOPGEN]) == tg, bar);
            __builtin_amdgcn_fence(__ATOMIC_ACQUIRE, "agent");
            xb_add(&bar[XB_XGEN(b.x)], 1u);
            asm volatile("s_waitcnt vmcnt(0)" ::: "memory");
        } else {
            XB_SPIN(xb_ld(&bar[XB_XGEN(b.x)]) == gen, bar);
            __builtin_amdgcn_fence(__ATOMIC_ACQUIRE, "agent");
            asm volatile("s_waitcnt vmcnt(0)" ::: "memory");
        }
    }
    __syncthreads();
}

struct Args { const float* in[29]; float* out; unsigned char* ws; float inv[32]; int ph_lo, ph_hi; };

constexpr int DI_UP = 16 * 176, DI_DN = 44 * 32, DI_PL = 4 * 8, N_DEFER = 2 * DI_UP + 2 * DI_DN + 4 * DI_PL;
__device__ __forceinline__ void ffn_weight_item(const Args& a, unsigned char* ws, LAS float* scr, int r, int lane) {
    if (r < DI_UP) { transpose_item<2>(a.in[15], D, UP, (bf16_t*)(ws + WS_WUP0), 0, a.in[14], scr, r, lane); return; } r -= DI_UP;
    if (r < DI_UP) { transpose_item<2>(a.in[24], D, UP, (bf16_t*)(ws + WS_WUP1), 0, a.in[23], scr, r, lane); return; } r -= DI_UP;
    if (r < DI_DN) { transpose_item<0>(a.in[18], FF, D, (bf16_t*)(ws + WS_WDN0), 0, nullptr, scr, r, lane); return; } r -= DI_DN;
    if (r < DI_DN) { transpose_item<0>(a.in[27], FF, D, (bf16_t*)(ws + WS_WDN1), 0, nullptr, scr, r, lane); return; } r -= DI_DN;
    const int gi = r / DI_PL; transpose_item<0>(a.in[20] + (size_t)gi * 65536, 256, 256, (bf16_t*)(ws + WS_WPOOL), gi * 256, nullptr, scr, r % DI_PL, lane);
}

__global__ void __launch_bounds__(512) mk_fwd(Args a) {
    extern __shared__ __attribute__((aligned(16))) unsigned char lds_raw[];
    LAS unsigned char* lds = (LAS unsigned char*)lds_raw;
    LAS unsigned char* ldsx = lds + LDS_RING;
    cg::grid_group grid = cg::this_grid();
    if (threadIdx.x < 2) ((volatile LAS unsigned*)(lds + LDS_BYTES - 16))[threadIdx.x] = 0u;
    __syncthreads();
    if (a.ph_hi == 0x7fff) grid.sync();
    const XcdBarrier xbar = xcd_barrier_post((unsigned*)a.ws, (volatile LAS unsigned*)(lds + LDS_BYTES - 16));
    const int tid = threadIdx.x, lane = tid & 63, wave = __builtin_amdgcn_readfirstlane(tid >> 6);
    const int G = gridDim.x, bx = blockIdx.x;
    unsigned char* ws = a.ws;
#define cosT ((float*)(ws + WS_ROPE))
#define sinT ((float*)(ws + WS_ROPE) + T * 32)
#define ssp ((float*)(ws + WS_SSP))
#define c1p ((float*)(ws + WS_C1P))
#define rstdv ((float*)(ws + WS_RSTD))
#define HB ((float*)(ws + WS_HB))
#define FB ((float*)(ws + WS_FB))
#define gates ((float*)(ws + WS_GATE))
#define Wt_in ((bf16_t*)(ws + WS_WIN))
#define Wt_out ((bf16_t*)(ws + WS_WOUT))
#define Wt_pool ((bf16_t*)(ws + WS_WPOOL))
#define Wt_c1 (kv ? (bf16_t*)(ws + WS_WC1V) : (bf16_t*)(ws + WS_WC1K))
#define Wt_c2 (kv ? (bf16_t*)(ws + WS_WC2V) : (bf16_t*)(ws + WS_WC2K))
#define XB ((bf16_t*)(ws + WS_XB))
#define Qb ((bf16_t*)(ws + WS_Q))
#define KC ((bf16_t*)(ws + WS_KC))
#define VC ((bf16_t*)(ws + WS_VC))
#define KS ((bf16_t*)(ws + WS_KS))
#define VST ((bf16_t*)(ws + WS_VST))
#define KW ((bf16_t*)(ws + WS_KW))
#define VWT ((bf16_t*)(ws + WS_VWT))
#define KCC ((bf16_t*)(ws + WS_KCC))
#define VCT ((bf16_t*)(ws + WS_VCT))
#define Ob ((bf16_t*)(ws + WS_O))
#define ACT ((bf16_t*)(ws + WS_ACT))
#define POOLED ((bf16_t*)(ws + WS_POOLED))
    float* out = a.out;
    const int lo = a.ph_lo, hi = a.ph_hi;
    const bool defer = (G == 256);
#define IN(k) (lo <= (k) && (k) < hi)
#define SEAM(k) do { if (IN(k) && IN((k) + 1)) xcd_barrier(xbar); } while (0)

    if (IN(0)) {
        LAS float* scr = (LAS float*)(lds + wave * 16384);
        const int gw = bx * 8 + wave, NGW = G * 8;
        constexpr int I_IN = 16 * 58, I_OUT = 16 * 32, I_C1 = 32 * 8, I_C2 = 4 * 2;
        constexpr int NA = I_IN + I_OUT + 2 * I_C1 + 2 * I_C2;
        const int NIT = NA + (defer ? 0 : N_DEFER);
        for (int it = gw; it < NIT; it += NGW) {
            int r = it;
            if (r < I_IN) { transpose_item<1>(a.in[2], D, 1840, Wt_in, 0, a.in[1], scr, r, lane); continue; } r -= I_IN;
            if (r < I_OUT) { transpose_item<0>(a.in[13], D, D, Wt_out, 0, nullptr, scr, r, lane); continue; } r -= I_OUT;
            if (r < I_C1) { transpose_item<0>(a.in[4], 2048, 256, (bf16_t*)(ws + WS_WC1K), 0, nullptr, scr, r, lane); continue; } r -= I_C1;
            if (r < I_C1) { transpose_item<0>(a.in[9], 2048, 256, (bf16_t*)(ws + WS_WC1V), 0, nullptr, scr, r, lane); continue; } r -= I_C1;
            if (r < I_C2) { transpose_item<3>(a.in[6], 256, 64, (bf16_t*)(ws + WS_WC2K), 0, nullptr, scr, r, lane); continue; } r -= I_C2;
            if (r < I_C2) { transpose_item<3>(a.in[11], 256, 64, (bf16_t*)(ws + WS_WC2V), 0, nullptr, scr, r, lane); continue; } r -= I_C2;
            ffn_weight_item(a, ws, scr, r, lane);
        }
        for (int m = gw; m < M; m += 2 * NGW) {
            const int m2 = m + NGW;
            const f32x4* xr = (const f32x4*)(a.in[0] + (size_t)m * D) + lane; const f32x4* xr2 = (const f32x4*)(a.in[0] + (size_t)m2 * D) + lane;
            f32x4 v[4], w[4];
#pragma unroll
            for (int j = 0; j < 4; ++j) { v[j] = xr[64 * j]; w[j] = (m2 < M) ? xr2[64 * j] : (f32x4){0.f, 0.f, 0.f, 0.f}; }
            unsigned long long* o8 = (unsigned long long*)(XB + (size_t)m * D) + lane; unsigned long long* o82 = (unsigned long long*)(XB + (size_t)m2 * D) + lane; float s1 = 0.f, s2 = 0.f;
#pragma unroll
            for (int j = 0; j < 4; ++j) {
                s1 += (v[j][0] * v[j][0] + v[j][1] * v[j][1]) + (v[j][2] * v[j][2] + v[j][3] * v[j][3]); o8[64 * j] = (unsigned long long)pk2(v[j][0], v[j][1]) | ((unsigned long long)pk2(v[j][2], v[j][3]) << 32);
                s2 += (w[j][0] * w[j][0] + w[j][1] * w[j][1]) + (w[j][2] * w[j][2] + w[j][3] * w[j][3]); if (m2 < M) o82[64 * j] = (unsigned long long)pk2(w[j][0], w[j][1]) | ((unsigned long long)pk2(w[j][2], w[j][3]) << 32);
            }
#pragma unroll
            for (int o = 1; o < 64; o <<= 1) { s1 += __shfl_xor(s1, o); s2 += __shfl_xor(s2, o); }
            if (lane == 0) { rstdv[m] = 1.0f / sqrtf(s1 * (1.0f / D) + EPS); if (m2 < M) rstdv[m2] = 1.0f / sqrtf(s2 * (1.0f / D) + EPS); }
        }
        for (int i = bx * 512 + tid; i < T * 32; i += G * 512) {
            const int t = i >> 5, f = i & 31; const float ang = (float)t * a.inv[f];
            double x = (double)ang * 0.15915494309189535; x -= __builtin_rint(x); const float xf = (float)x;
            cosT[i] = __builtin_amdgcn_cosf(xf); sinT[i] = __builtin_amdgcn_sinf(xf);
        }
        for (int it = NGW - 1 - gw; it < 256; it += NGW) {
            const int kv = it >> 7, chunk = (it >> 2) & 31, nb = it & 3; const float* pos = a.in[kv ? 8 : 3]; const float* w1 = a.in[kv ? 9 : 4];
            float s = 0.f;
#pragma unroll 32
            for (int r = 0; r < 64; ++r) { const int rr = chunk * 64 + r; s += pos[rr] * w1[(size_t)rr * 256 + nb * 64 + lane]; }
            c1p[(kv * 32 + chunk) * 256 + nb * 64 + lane] = s;
        }
        asm volatile("s_waitcnt vmcnt(0) lgkmcnt(0)" ::: "memory"); __syncthreads();
    }
    SEAM(0);
    if (IN(1)) {
        pg8::Gemm g{XB, Wt_in, M, NIN, D, D, 0}; pg8::StaticOrder S; S.init(M, NIN, G, bx);
        EpiIn E{rstdv, cosT, sinT, Qb, KC, VC, KS, VST, KW, VWT, gates};
        pg8::gemm_phase(lds, ldsx, g, S, E);
    }
    SEAM(1);
    if (IN(2)) {
        const int tid = threadIdx.x, lane = tid & 63, w = __builtin_amdgcn_readfirstlane(tid >> 6), fr = lane & 15, fq = lane >> 4;
        LAS float* c1s = (LAS float*)lds;
        LAS unsigned char* hidL = lds + 4096;
        for (int i = tid; i < 512; i += 512) { const int kv = i >> 8, n = i & 255; const float* b1 = a.in[kv ? 10 : 5]; float sv = b1[n]; for (int q = 0; q < 32; ++q) sv += c1p[(kv * 32 + q) * 256 + n]; c1s[i] = sv; }
        __syncthreads();
        for (int u = bx; u < 256; u += G) {
            const int kv = u >> 7, r0 = (u & 127) * 16;
            const bf16_t* Ap = (kv ? VC : KC) + (size_t)(r0 + fr) * 1024 + 8 * fq;
            const bf16_t* Bp = Wt_c1 + (size_t)(32 * w + fr) * 2048 + 8 * fq;
            f32x4 h0 = (f32x4){0.f, 0.f, 0.f, 0.f}, h1 = h0;
#pragma unroll 1
            for (int k0 = 0; k0 < 2048; k0 += 256) {
                bf16x8 af[8], b0[8], b1f[8];
#pragma unroll
                for (int q = 0; q < 8; ++q) { af[q] = *(const bf16x8*)(Ap + k0 + 32 * q); b0[q] = *(const bf16x8*)(Bp + k0 + 32 * q); b1f[q] = *(const bf16x8*)(Bp + 16 * 2048 + k0 + 32 * q); }
#pragma unroll
                for (int q = 0; q < 8; ++q) { h0 = __builtin_amdgcn_mfma_f32_16x16x32_bf16(b0[q], af[q], h0, 0, 0, 0); h1 = __builtin_amdgcn_mfma_f32_16x16x32_bf16(b1f[q], af[q], h1, 0, 0, 0); }
            }
            { const int c0 = 32 * w + 8 * fq; float v[8];
#pragma unroll
              for (int e = 0; e < 8; ++e) { const float x = ((e >> 2) ? h1[e & 3] : h0[e & 3]) + c1s[kv * 256 + c0 + e]; const float y = 0.7978845608028654f * (x + 0.044715f * x * x * x); v[e] = x * sigmoidf_(2.0f * y); }
              u32x4 wv; wv.x = cvt_pk_bf16(v[0], v[1]); wv.y = cvt_pk_bf16(v[2], v[3]); wv.z = cvt_pk_bf16(v[4], v[5]); wv.w = cvt_pk_bf16(v[6], v[7]);
              *(LAS u32x4*)(hidL + fr * 528 + c0 * 2) = wv; }
            __syncthreads();
            if (w < 2) {
                const bf16_t* W2 = Wt_c2 + (size_t)(32 * w + fr) * 256 + 8 * fq;
                f32x4 oA = (f32x4){0.f, 0.f, 0.f, 0.f}, oB = oA;
#pragma unroll
                for (int q = 0; q < 8; ++q) {
                    const bf16x8 hf = *(const LAS bf16x8*)(hidL + fr * 528 + (32 * q + 8 * fq) * 2);
                    const bf16x8 wa = *(const bf16x8*)(W2 + 32 * q), wb = *(const bf16x8*)(W2 + 16 * 256 + 32 * q);
                    oA = __builtin_amdgcn_mfma_f32_16x16x32_bf16(wa, hf, oA, 0, 0, 0); oB = __builtin_amdgcn_mfma_f32_16x16x32_bf16(wb, hf, oB, 0, 0, 0);
                }
                const float* b2 = a.in[kv ? 12 : 7]; const int d0 = 16 * w + 4 * fq; const int row = r0 + fr, j = row & 511;
                f32x4 a1 = oA + *(const f32x4*)(b2 + d0), a2 = oB + *(const f32x4*)(b2 + d0 + 32);
                if (j == 511) { a1 = (f32x4){0.f, 0.f, 0.f, 0.f}; a2 = a1; }
                if (!kv) {
                    const int pos = (j == 511) ? 0 : 16 * j + 31;
                    const f32x4 cs = *(const f32x4*)(cosT + pos * 32 + d0), sn = *(const f32x4*)(sinT + pos * 32 + d0);
                    const f32x4 o1 = a1 * cs - a2 * sn, o2 = a1 * sn + a2 * cs;
                    bf16_t* p = KCC + (size_t)row * 64 + d0;
                    u32x2 w1; w1.x = cvt_pk_bf16(o1[0], o1[1]); w1.y = cvt_pk_bf16(o1[2], o1[3]); *(u32x2*)p = w1;
                    u32x2 w2; w2.x = cvt_pk_bf16(o2[0], o2[1]); w2.y = cvt_pk_bf16(o2[2], o2[3]); *(u32x2*)(p + 32) = w2;
                } else {
                    bf16_t* p = VCT + (size_t)(row >> 6) * 4096 + vperm(row & 63);
#pragma unroll
                    for (int e = 0; e < 4; ++e) { p[(d0 + e) * 64] = (bf16_t)(cvt_pk_bf16(a1[e], 0.f) & 0xffff); p[(d0 + 32 + e) * 64] = (bf16_t)(cvt_pk_bf16(a2[e], 0.f) & 0xffff); }
                }
            }
            __syncthreads();
        }
    }
    if (IN(2) && IN(4)) xcd_barrier(xbar);
    if (IN(4)) {
        att::Ctx X{Qb, KCC, VCT, KS, VST, KW, VWT, gates, Ob};
        for (int k = bx; k < 256; k += G) {
            for (int rep = 0; rep < 2; ++rep) { const int uu = rep ? 511 - k : k; const int c = 127 - (uu >> 2), bgi = uu & 3; att::unit(lds, X, bgi >> 1, bgi & 1, c, tid); }
        }
        if (defer) {
            int td = threadIdx.x; asm volatile("" : "+v"(td)); const int dl = td & 63, dw = __builtin_amdgcn_readfirstlane(td >> 6);
            LAS float* scr = (LAS float*)(lds + dw * 16384);
            for (int it = bx * 8 + dw; it < N_DEFER; it += 2048) ffn_weight_item(a, ws, scr, it, dl);
        }
    }
    SEAM(4);
    if (IN(5)) {
        pg8::Gemm g{Ob, Wt_out, M, D, D, D, 0}; pg8::StaticOrder S; S.init(M, D, G, bx);
        EpiRes E{a.in[0], out, XB, ssp, nullptr, nullptr};
        pg8::gemm_phase(lds, ldsx, g, S, E);
    }
    SEAM(5);
#pragma unroll
    for (int L = 0; L < 2; ++L) {
        const int pb = 6 + 5 * L;
        const float* cw = a.in[L ? 25 : 16]; const float* cb = a.in[L ? 26 : 17];
        if (IN(pb)) {
            pg8::Gemm g{XB, (const bf16_t*)(ws + (L ? WS_WUP1 : WS_WUP0)), M, UP, D, D, 0}; pg8::StaticOrder S; S.init(M, UP, G, bx);
            EpiUp E{ssp, cw, cb, ACT, HB, FB};
            pg8::gemm_phase(lds, ldsx, g, S, E);
        }
        SEAM(pb);
        if (IN(pb + 1)) {
            for (int i = bx * 512 + tid; i < 64 * FF; i += G * 512) {
                const int pm = i / FF, cidx = i % FF;
                float hg0 = 0.f, hg1 = 0.f, hv0 = 0.f, hv1 = 0.f;
                if (pm & 31) { const float* h = HB + (size_t)(pm - 1) * 2 * UP; hg0 = h[cidx]; hg1 = h[UP + cidx]; hv0 = h[FF + cidx]; hv1 = h[UP + FF + cidx]; }
                const float* f = FB + (size_t)pm * 2 * UP; const float fg0 = f[cidx], fg1 = f[UP + cidx], fv0 = f[FF + cidx], fv1 = f[UP + FF + cidx];
                const float g0 = cb[cidx] + cw[cidx] * hg0 + cw[UP + cidx] * hg1 + cw[2 * UP + cidx] * fg0;
                const float g1 = cb[cidx] + cw[cidx] * hg1 + cw[UP + cidx] * fg0 + cw[2 * UP + cidx] * fg1;
                const float v0 = cb[FF + cidx] + cw[FF + cidx] * hv0 + cw[UP + FF + cidx] * hv1 + cw[2 * UP + FF + cidx] * fv0;
                const float v1 = cb[FF + cidx] + cw[FF + cidx] * hv1 + cw[UP + FF + cidx] * fv0 + cw[2 * UP + FF + cidx] * fv1;
                ACT[(size_t)(pm * 256) * FF + cidx] = (bf16_t)f2bf(g0 * sigmoidf_(g0) * v0);
                ACT[(size_t)(pm * 256 + 1) * FF + cidx] = (bf16_t)f2bf(g1 * sigmoidf_(g1) * v1);
            }
        }
        SEAM(pb + 1);
        if (IN(pb + 2)) {
            pg8::Gemm g{ACT, (const bf16_t*)(ws + (L ? WS_WDN1 : WS_WDN0)), M, D, FF, FF, 0}; pg8::StaticOrder S; S.init(M, D, G, bx);
            if (L == 1 && G == 256) { EpiFinal E{out, a.in[28], (float*)(ws + WS_SSP + 512 * 1024), (unsigned*)(ws + 16384), XB}; pg8::gemm_phase(lds, ldsx, g, S, E); }
            else { EpiRes E{out, out, XB, ssp, nullptr, nullptr}; pg8::gemm_phase(lds, ldsx, g, S, E); }
        }
        if (!(L == 1 && G == 256)) SEAM(pb + 2);
        if (L == 0) {
            if (IN(9)) {
                LAS float* rsd = (LAS float*)lds;
                const float* gn = a.in[19];
                int tid = threadIdx.x; asm volatile("" : "+v"(tid));
                const int q = tid & 127, strip = tid >> 7, c8 = q * 8, wsz = 2 << (c8 >> 8), t0 = strip * 16;
                const f32x4 gv0 = *(const f32x4*)(gn + c8), gv1 = *(const f32x4*)(gn + c8 + 4);
                for (int tile = bx; tile < 256; tile += G) {
                    const int r0 = tile * 64; const int tb = r0 & (T - 1);
                    __syncthreads();
                    if (tid < 80) { const int rr = r0 - 16 + tid; rsd[tid] = (tb - 16 + tid >= 0) ? row_rstd(ssp, 4, rr) : 0.f; }
                    __syncthreads();
                    const bf16_t* xb0 = XB + (size_t)r0 * D + c8;
#define POOL_H(tl, lo, hi) do { unpk8(*(const u32x4*)(xb0 + (ptrdiff_t)(tl) * D), lo, hi); const float rs_ = rsd[16 + (tl)]; lo = lo * rs_; hi = hi * rs_; } while (0)
                    f32x4 s0 = (f32x4){0.f, 0.f, 0.f, 0.f}, s1 = s0;
                    for (int i = 1; i <= wsz; ++i) { const int tl = t0 - i; if (tb + tl >= 0) { f32x4 a0, a1; POOL_H(tl, a0, a1); s0 += a0; s1 += a1; } }
#pragma unroll 4
                    for (int tl = t0; tl < t0 + 16; ++tl) {
                        f32x4 h0, h1; POOL_H(tl, h0, h1); s0 += h0; s1 += h1;
                        const int td = tl - wsz; if (tb + td >= 0) { f32x4 d0, d1; POOL_H(td, d0, d1); s0 -= d0; s1 -= d1; }
                        const int t = tb + tl; const int cnt = (t + 1 < wsz) ? t + 1 : wsz; const float ic = 1.0f / (float)cnt;
                        const f32x4 p0 = (s0 * ic - h0) * gv0, p1 = (s1 * ic - h1) * gv1;
                        u32x4 wv; wv.x = cvt_pk_bf16(p0[0], p0[1]); wv.y = cvt_pk_bf16(p0[2], p0[3]); wv.z = cvt_pk_bf16(p1[0], p1[1]); wv.w = cvt_pk_bf16(p1[2], p1[3]);
                        *(u32x4*)(POOLED + (size_t)(r0 + tl) * D + c8) = wv;
                    }
#undef POOL_H
                }
                __syncthreads();
            }
            SEAM(9);
            if (IN(10)) {
                pg8::Gemm g{POOLED, Wt_pool, M, D, 256, D, 512}; pg8::StaticOrder S; S.init(M, D, G, bx);
                EpiRes E{out, out, XB, ssp, a.in[21], a.in[22]};
                pg8::gemm_phase(lds, ldsx, g, S, E);
            }
            SEAM(10);
        }
    }
    if (IN(14) && G != 256) {
        int t14 = threadIdx.x; asm volatile("" : "+v"(t14)); const int lane = t14 & 63, wave = __builtin_amdgcn_readfirstlane(t14 >> 6);
        const int gw = bx * 8 + wave, NGW = G * 8; const float* gn = a.in[28];
        for (int m = gw; m < M; m += NGW) {
            const float rs = row_rstd(ssp, 4, m); f32x4* xr = (f32x4*)(out + (size_t)m * D) + lane; const f32x4* gr = (const f32x4*)gn + lane;
            const u32x2* xbr = (const u32x2*)(XB + (size_t)m * D) + lane;
#pragma unroll
            for (int j = 0; j < 4; ++j) { const u32x2 v = xbr[64 * j]; const f32x4 xv = (f32x4){__uint_as_float(v.x << 16), __uint_as_float(v.x & 0xffff0000u), __uint_as_float(v.y << 16), __uint_as_float(v.y & 0xffff0000u)}; xr[64 * j] = xv * rs * gr[64 * j]; }
        }
    }
#undef IN
#undef SEAM
#undef cosT
#undef sinT
#undef ssp
#undef c1p
#undef rstdv
#undef HB
#undef FB
#undef gates
#undef Wt_in
#undef Wt_out
#undef Wt_pool
#undef Wt_c1
#undef Wt_c2
#undef XB
#undef Qb
#undef KC
#undef VC
#undef KS
#undef VST
#undef KW
#undef VWT
#undef KCC
#undef VCT
#undef Ob
#undef ACT
#undef POOLED
}

extern "C" void kernel_launch(void* const* d_in, const int* in_sizes, int n_in, void* d_out, int out_size, void* d_ws, size_t ws_size, hipStream_t stream) {
    static int grid = 0;
    if (grid == 0) {
        int dev = 0, cus = 0, per_cu = 0;
        hipGetDevice(&dev); hipDeviceGetAttribute(&cus, hipDeviceAttributeMultiprocessorCount, dev);
        hipFuncSetAttribute((const void*)mk_fwd, hipFuncAttributeMaxDynamicSharedMemorySize, LDS_BYTES);
        hipOccupancyMaxActiveBlocksPerMultiprocessor(&per_cu, (const void*)mk_fwd, 512, LDS_BYTES);
        if (per_cu < 1) per_cu = 1;
        grid = cus * per_cu; if (grid > 256) grid = 256;
        (void)hipGetLastError();
    }
    Args a{};
    for (int i = 0; i < 29; ++i) a.in[i] = (const float*)d_in[i];
    a.out = (float*)d_out; a.ws = (unsigned char*)d_ws;
    for (int i = 0; i < 32; ++i) a.inv[i] = 1.0f / powf(10000.0f, (float)(2 * i) / 64.0f);
    a.ph_lo = 0; a.ph_hi = 15;
    hipMemsetAsync(d_ws, 0, 65536, stream);
    void* args[] = {&a};
    hipError_t e = hipLaunchCooperativeKernel((const void*)mk_fwd, dim3(grid), dim3(512), args, LDS_BYTES, stream);
    if (e != hipSuccess) fprintf(stderr, "cooperative launch failed: %s (grid %d)\n", hipGetErrorString(e), grid);
}
```

```cpp
#include <hip/hip_runtime.h>
#include <hip/hip_cooperative_groups.h>
#include <cstdio>
#include <cstdint>
namespace cg = cooperative_groups;

#define LAS __attribute__((address_space(3)))
typedef unsigned short bf16_t;
typedef short bf16x8 __attribute__((ext_vector_type(8)));
typedef short s16x4 __attribute__((ext_vector_type(4)));
typedef float f32x4 __attribute__((ext_vector_type(4)));
typedef unsigned u32x4 __attribute__((ext_vector_type(4)));
typedef unsigned u32x2 __attribute__((ext_vector_type(2)));

constexpr int T = 8192, D = 1024, M = 16384, FF = 2816, UP = 5632, NIN = 2048;
constexpr float EPS = 1e-6f;
constexpr float QSCALE = 0.125f * 1.4426950408889634f;
constexpr size_t MiB = 1u << 20;
constexpr size_t WS_ROPE = 1 * MiB;
constexpr size_t WS_SSP = 3 * MiB;
constexpr size_t WS_C1P = 4 * MiB;
constexpr size_t WS_RSTD = 4 * MiB + 256 * 1024;
constexpr size_t WS_HB = 5 * MiB;
constexpr size_t WS_FB = 8 * MiB;
constexpr size_t WS_GATE = 11 * MiB;
constexpr size_t WS_WIN = 16 * MiB, WS_WOUT = 20 * MiB, WS_WUP0 = 22 * MiB, WS_WUP1 = 33 * MiB, WS_WDN0 = 44 * MiB, WS_WDN1 = 50 * MiB;
constexpr size_t WS_WPOOL = 56 * MiB, WS_WC1K = 57 * MiB, WS_WC1V = 58 * MiB, WS_WC2K = 59 * MiB, WS_WC2V = 59 * MiB + 512 * 1024;
constexpr size_t WS_XB = 64 * MiB;
constexpr size_t WS_Q = 96 * MiB;
constexpr size_t WS_KC = 128 * MiB, WS_VC = 132 * MiB, WS_KS = 136 * MiB, WS_VST = 140 * MiB, WS_KW = 144 * MiB, WS_VWT = 148 * MiB;
constexpr size_t WS_KCC = 152 * MiB, WS_VCT = 153 * MiB, WS_HIDK = 154 * MiB, WS_HIDV = 155 * MiB;
constexpr size_t WS_O = 160 * MiB;
constexpr size_t WS_ACT = 96 * MiB;
constexpr size_t WS_POOLED = 192 * MiB;
constexpr size_t WS_XB2 = 224 * MiB;
constexpr int LDS_RING = 131072, LDS_BYTES = 155648;

__device__ __forceinline__ unsigned cvt_pk_bf16(float lo, float hi) { unsigned r; asm volatile("v_cvt_pk_bf16_f32 %0, %1, %2" : "=v"(r) : "v"(lo), "v"(hi)); return r; }
__device__ __forceinline__ float bf2f(unsigned short b) { return __uint_as_float((unsigned)b << 16); }
__device__ __forceinline__ float ex2(float x) { return __builtin_amdgcn_exp2f(x); }
__device__ __forceinline__ float rcp(float x) { return __builtin_amdgcn_rcpf(x); }
__device__ __forceinline__ float sigmoidf_(float x) { return rcp(1.0f + ex2(-1.4426950408889634f * x)); }
__device__ __forceinline__ void unpk8(const u32x4 v, f32x4& lo, f32x4& hi) { lo = (f32x4){__uint_as_float(v.x << 16), __uint_as_float(v.x & 0xffff0000u), __uint_as_float(v.y << 16), __uint_as_float(v.y & 0xffff0000u)}; hi = (f32x4){__uint_as_float(v.z << 16), __uint_as_float(v.z & 0xffff0000u), __uint_as_float(v.w << 16), __uint_as_float(v.w & 0xffff0000u)}; }
__device__ __forceinline__ int perm8(int a) { return (a & ~31) | (16 * ((a >> 2) & 1) + 4 * ((a >> 3) & 3) + (a & 3)); }
__device__ __forceinline__ int vperm(int kk) { return (kk & 32) | (((kk >> 2) & 3) << 3) | (((kk >> 4) & 1) << 2) | (kk & 3); }
__device__ __forceinline__ int swap45(int a) { return (a & ~48) | (((a >> 4) & 1) << 5) | (((a >> 5) & 1) << 4); }
template <int CTRL> __device__ __forceinline__ float dppf(float x) { return __builtin_bit_cast(float, __builtin_amdgcn_mov_dpp(__builtin_bit_cast(int, x), CTRL, 0xf, 0xf, true)); }
__device__ __forceinline__ float xrow16_max(float x) {
    auto s = __builtin_amdgcn_permlane16_swap(__float_as_uint(x), __float_as_uint(x), false, false); x = fmaxf(__uint_as_float(s[0]), __uint_as_float(s[1]));
    auto t = __builtin_amdgcn_permlane32_swap(__float_as_uint(x), __float_as_uint(x), false, false); return fmaxf(__uint_as_float(t[0]), __uint_as_float(t[1])); }
__device__ __forceinline__ float xrow16_sum(float x) {
    auto s = __builtin_amdgcn_permlane16_swap(__float_as_uint(x), __float_as_uint(x), false, false); x = __uint_as_float(s[0]) + __uint_as_float(s[1]);
    auto t = __builtin_amdgcn_permlane32_swap(__float_as_uint(x), __float_as_uint(x), false, false); return __uint_as_float(t[0]) + __uint_as_float(t[1]); }
__device__ __forceinline__ float sum8(float x) { x += dppf<0xB1>(x); x += dppf<0x4E>(x); x += dppf<0x141>(x); return x; }
#define LDS_WAIT() asm volatile("s_waitcnt lgkmcnt(0)" ::: "memory")
#define WG_BAR() do { asm volatile("s_waitcnt lgkmcnt(0)" ::: "memory"); __builtin_amdgcn_s_barrier(); asm volatile("" ::: "memory"); } while (0)

namespace pg8 {
constexpr int BM = 256, BK = 64, HALF = 128, HTB = HALF * BK * 2, NXCD = 8, WGM = 8;
__host__ __device__ __forceinline__ int lds_byte(int r, int c) { const int st = (r >> 4) * 2 + (c >> 5), rr = r & 15, cc = c & 31, ob = rr * 64 + cc * 2; return st * 1024 + (ob ^ (((ob >> 9) & 1) << 5)); }
__host__ __device__ __forceinline__ void stage_rc(int b, int& R, int& C) { const int st = b / 1024, sb = b % 1024, swz = sb ^ (((sb >> 9) & 1) << 5); R = (st >> 1) * 16 + swz / 64; C = (st & 1) * 32 + (swz % 64) / 2; }
struct Unit { int pm, pn; };
struct Gemm { const bf16_t* A; const bf16_t* Bt; int M, N, K, lda, apn; };
struct StaticOrder {
    int nM, nN, nwg, G, c;
    __device__ __forceinline__ void init(int M_, int N_, int G_, int c_) { nM = M_ / BM; nN = N_ / BM; nwg = nM * nN; G = G_; c = c_; }
    __device__ __forceinline__ bool next(int i, Unit& u) const {
        const long L = (long)i * G + c; if (L >= nwg) return false;
        int wgid = (int)L; { const int q = nwg / NXCD, r = nwg % NXCD, xcd = wgid % NXCD, off = wgid / NXCD; wgid = (xcd < r ? xcd * (q + 1) : r * (q + 1) + (xcd - r) * q) + off; }
        const int nig = WGM * nN, gid = wgid / nig, fm = gid * WGM, gsz = (nM - fm) < WGM ? (nM - fm) : WGM;
        u.pm = fm + ((wgid % nig) % gsz); u.pn = (wgid % nig) / gsz; return true;
    }
};
template <class Epi>
__device__ __forceinline__ void gemm_phase(LAS unsigned char* lds, LAS unsigned char* ldsx, const Gemm g, const StaticOrder& S, const Epi& E) {
    int tid = threadIdx.x; asm volatile("" : "+v"(tid));
    const int wid = __builtin_amdgcn_readfirstlane(tid >> 6), lane = tid & 63, wr = wid >> 2, wc = wid & 3, fr = lane & 15, fq = lane >> 4;
    const int K = g.K, nt = K / BK;
    unsigned voffA[2], voffB[2];
#pragma unroll
    for (int i = 0; i < 2; ++i) { int R, C; stage_rc(tid * 16 + i * 8192, R, C); voffA[i] = (unsigned)(R * g.lda + C) * 2u; voffB[i] = (unsigned)(R * K + C) * 2u; }
    const size_t kstep = (size_t)(BK * 2);
    const size_t hstepA = (size_t)HALF * g.lda * 2, tstepA = 2 * hstepA, hstepB = (size_t)HALF * K * 2, tstepB = 2 * hstepB;
    const unsigned ldsw = (unsigned)wid * 1024u;
    const int aoff = lds_byte(wr * 64 + fr, fq * 8), boff = lds_byte(wc * 32 + fr, fq * 8);
#define PG8_SA(b, h) (((b) * 2 + (h)) * HTB)
#define PG8_SB(b, h) ((4 + (b) * 2 + (h)) * HTB)
#define PG8_STAGE(bufoff, gbase, voff) do { _Pragma("unroll") for (int _i = 0; _i < 2; ++_i) \
        __builtin_amdgcn_global_load_lds((const unsigned*)((const char*)(gbase) + (voff)[_i]), (LAS unsigned*)(lds + (bufoff) + ldsw + _i * 8192), 16, 0, 0); } while (0)
#define PG8_LDA(dst, b, h) do { _Pragma("unroll") for (int m = 0; m < 4; ++m) _Pragma("unroll") for (int k = 0; k < 2; ++k) dst[m][k] = *(const LAS bf16x8*)(lds + PG8_SA(b, h) + aoff + m * 2048 + k * 1024); } while (0)
#define PG8_LDB(dst, b, h) do { _Pragma("unroll") for (int n = 0; n < 2; ++n) _Pragma("unroll") for (int k = 0; k < 2; ++k) dst[n][k] = *(const LAS bf16x8*)(lds + PG8_SB(b, h) + boff + n * 2048 + k * 1024); } while (0)
#define PG8_MMA(ai, bj, At, Bt) do { __builtin_amdgcn_s_setprio(1); _Pragma("unroll") for (int m = 0; m < 4; ++m) _Pragma("unroll") for (int n = 0; n < 2; ++n) _Pragma("unroll") for (int k = 0; k < 2; ++k) \
        acc[ai][bj][m][n] = __builtin_amdgcn_mfma_f32_16x16x32_bf16(Bt[n][k], At[m][k], acc[ai][bj][m][n], 0, 0, 0); __builtin_amdgcn_s_setprio(0); } while (0)
#define PG8_WAIT_V(n) asm volatile("s_waitcnt vmcnt(" #n ")" ::: "memory")
#define PG8_WAIT_L(n) asm volatile("s_waitcnt lgkmcnt(" #n ")" ::: "memory")
#define PG8_BAR __builtin_amdgcn_s_barrier()
#define PG8_SCHED __builtin_amdgcn_sched_barrier(0)
    Unit cur, nxt; int ui = 0;
    if (!S.next(0, cur)) return;
    f32x4 acc[2][2][4][2];
#pragma unroll
    for (int a = 0; a < 2; ++a)
#pragma unroll
        for (int b = 0; b < 2; ++b)
#pragma unroll
            for (int m = 0; m < 4; ++m)
#pragma unroll
                for (int n = 0; n < 2; ++n) acc[a][b][m][n] = (f32x4){0.f, 0.f, 0.f, 0.f};
    bf16x8 At[4][2], B0[2][2], B1[2][2];
    const char* cA = (const char*)g.A + (size_t)cur.pm * tstepA + (size_t)cur.pn * g.apn; const char* cB = (const char*)g.Bt + (size_t)cur.pn * tstepB;
    PG8_STAGE(PG8_SB(0, 0), cB, voffB); PG8_STAGE(PG8_SB(0, 1), cB + hstepB, voffB); PG8_STAGE(PG8_SA(0, 0), cA, voffA); PG8_STAGE(PG8_SA(0, 1), cA + hstepA, voffA);
    if (wr == 1) PG8_BAR;
    PG8_WAIT_V(2); PG8_BAR;
    PG8_STAGE(PG8_SB(1, 0), cB + kstep, voffB); PG8_STAGE(PG8_SA(1, 0), cA + kstep, voffA); PG8_STAGE(PG8_SB(1, 1), cB + hstepB + kstep, voffB);
    PG8_WAIT_V(6); PG8_BAR;
    for (;;) {
        const bool has_next = S.next(ui + 1, nxt);
        const char* nA = has_next ? (const char*)g.A + (size_t)nxt.pm * tstepA + (size_t)nxt.pn * g.apn : cA; const char* nB = has_next ? (const char*)g.Bt + (size_t)nxt.pn * tstepB : cB;
        for (int t = 0; t < nt; t += 2) {
            const bool last = (t == nt - 2);
            const char* a1 = cA + (size_t)(t + 1) * kstep;
            const char* a2 = last ? nA : cA + (size_t)(t + 2) * kstep; const char* b2 = last ? nB : cB + (size_t)(t + 2) * kstep;
            const char* a3 = a2 + kstep; const char* b3 = b2 + kstep;
            PG8_LDB(B0, 0, 0); PG8_LDB(B1, 0, 1); PG8_SCHED; PG8_LDA(At, 0, 0); PG8_STAGE(PG8_SA(1, 1), a1 + hstepA, voffA);
            PG8_WAIT_V(8); PG8_WAIT_L(0); PG8_BAR; PG8_MMA(0, 0, At, B0); PG8_MMA(0, 1, At, B1); PG8_BAR; PG8_SCHED;
            PG8_LDA(At, 0, 1); PG8_STAGE(PG8_SB(0, 0), b2, voffB); PG8_STAGE(PG8_SB(0, 1), b2 + hstepB, voffB); PG8_STAGE(PG8_SA(0, 0), a2, voffA);
            PG8_WAIT_V(8); PG8_WAIT_L(0); PG8_BAR; PG8_MMA(1, 0, At, B0); PG8_MMA(1, 1, At, B1); PG8_BAR; PG8_SCHED;
            PG8_LDB(B0, 1, 0); PG8_LDB(B1, 1, 1); PG8_SCHED; PG8_LDA(At, 1, 0); PG8_STAGE(PG8_SA(0, 1), a2 + hstepA, voffA);
            PG8_WAIT_V(8); PG8_WAIT_L(0); PG8_BAR; PG8_MMA(0, 0, At, B0); PG8_MMA(0, 1, At, B1); PG8_BAR; PG8_SCHED;
            PG8_LDA(At, 1, 1); PG8_STAGE(PG8_SB(1, 0), b3, voffB); PG8_STAGE(PG8_SB(1, 1), b3 + hstepB, voffB); PG8_STAGE(PG8_SA(1, 0), a3, voffA);
            PG8_WAIT_V(8); PG8_WAIT_L(0); PG8_BAR; PG8_MMA(1, 0, At, B0); PG8_MMA(1, 1, At, B1); PG8_BAR; PG8_SCHED;
        }
        if (wr == 0) PG8_BAR;
        { int t2 = threadIdx.x; asm volatile("" : "+v"(t2));
          E(acc, cur, wr, wc, t2 & 15, (t2 & 63) >> 4, ldsx, t2); }
        if (!has_next) break;
#pragma unroll
        for (int a = 0; a < 2; ++a)
#pragma unroll
            for (int b = 0; b < 2; ++b)
#pragma unroll
                for (int m = 0; m < 4; ++m)
#pragma unroll
                    for (int n = 0; n < 2; ++n) acc[a][b][m][n] = (f32x4){0.f, 0.f, 0.f, 0.f};
        cur = nxt; cA = nA; cB = nB; ++ui;
        if (wr == 1) PG8_BAR;
    }
    PG8_WAIT_V(0);
    PG8_BAR;
#undef PG8_SA
#undef PG8_SB
#undef PG8_STAGE
#undef PG8_LDA
#undef PG8_LDB
#undef PG8_MMA
#undef PG8_WAIT_V
#undef PG8_WAIT_L
#undef PG8_BAR
#undef PG8_SCHED
}
}
using pg8::Unit;
typedef f32x4 Acc[2][2][4][2];

__device__ __forceinline__ float row_rstd(const float* ssp, int np, int row) {
    float s = 0.f; for (int i = 0; i < np; ++i) s += ssp[(size_t)i * M + row];
    return 1.0f / sqrtf(s * (1.0f / D) + EPS);
}

struct EpiIn {
    const float* rstdv; const float* cosT; const float* sinT;
    bf16_t *Q, *KC, *VC, *KS, *VST, *KW, *VWT; float* gates;
    __device__ __forceinline__ void operator()(Acc& acc, const Unit& u, int wr, int wc, int fr, int fq, LAS unsigned char*, int) const {
#pragma unroll
        for (int ai = 0; ai < 2; ++ai)
#pragma unroll
            for (int m = 0; m < 4; ++m) {
                const int row = u.pm * 256 + ai * 128 + wr * 64 + m * 16 + fr; const float rs = rstdv[row];
                const int t = row & (T - 1), b = row >> 13;
                const int d0 = 16 * (wc & 1) + 4 * fq;
                const f32x4 cs = *(const f32x4*)(cosT + t * 32 + d0), sn = *(const f32x4*)(sinT + t * 32 + d0);
#pragma unroll
                for (int bj = 0; bj < 2; ++bj) {
                    f32x4 a1 = acc[ai][bj][m][0] * rs, a2 = acc[ai][bj][m][1] * rs;
                    if (u.pn == 7) {
                        if (bj == 0) {
#pragma unroll
                            for (int n = 0; n < 2; ++n) { const int c0 = 32 * wc + 16 * n + 4 * fq; if (c0 < 48) { const f32x4 v = n ? a2 : a1; f32x4 o; o[0] = sigmoidf_(v[0]); o[1] = sigmoidf_(v[1]); o[2] = sigmoidf_(v[2]); o[3] = sigmoidf_(v[3]); *(f32x4*)(gates + (size_t)row * 48 + c0) = o; } }
                        }
                        continue;
                    }
                    const int hh = 2 * bj + (wc >> 1);
                    bool rope; if (u.pn < 4) rope = true; else rope = (u.pn >= 5) && (hh < 2);
                    f32x4 o1 = a1, o2 = a2;
                    if (rope) { o1 = a1 * cs - a2 * sn; o2 = a1 * sn + a2 * cs; }
                    if (u.pn < 4) {
                        o1 = o1 * QSCALE; o2 = o2 * QSCALE;
                        bf16_t* p = Q + (size_t)row * 1024 + (u.pn * 4 + hh) * 64 + d0;
                        u32x2 w1; w1.x = cvt_pk_bf16(o1[0], o1[1]); w1.y = cvt_pk_bf16(o1[2], o1[3]); *(u32x2*)p = w1;
                        u32x2 w2; w2.x = cvt_pk_bf16(o2[0], o2[1]); w2.y = cvt_pk_bf16(o2[2], o2[3]); *(u32x2*)(p + 32) = w2;
                    } else {
                        const int gg = hh & 1; const bool isv = hh >= 2;
                        if (!isv) {
                            bf16_t* base = (u.pn == 4) ? KC : (u.pn == 5) ? KS : KW;
                            bf16_t* p = base + ((size_t)(b * 2 + gg) * T + t) * 64 + d0;
                            u32x2 w1; w1.x = cvt_pk_bf16(o1[0], o1[1]); w1.y = cvt_pk_bf16(o1[2], o1[3]); *(u32x2*)p = w1;
                            u32x2 w2; w2.x = cvt_pk_bf16(o2[0], o2[1]); w2.y = cvt_pk_bf16(o2[2], o2[3]); *(u32x2*)(p + 32) = w2;
                        } else if (u.pn == 4) {
                            bf16_t* p = VC + ((size_t)(b * 2 + gg) * T + t) * 64 + d0;
                            u32x2 w1; w1.x = cvt_pk_bf16(o1[0], o1[1]); w1.y = cvt_pk_bf16(o1[2], o1[3]); *(u32x2*)p = w1;
                            u32x2 w2; w2.x = cvt_pk_bf16(o2[0], o2[1]); w2.y = cvt_pk_bf16(o2[2], o2[3]); *(u32x2*)(p + 32) = w2;
                        } else {
                            bf16_t* base = (u.pn == 5) ? VST : VWT;
                            bf16_t* p = base + ((size_t)(b * 2 + gg) * 128 + (t >> 6)) * 4096 + vperm(t & 63);
#pragma unroll
                            for (int j = 0; j < 4; ++j) { p[(d0 + j) * 64] = (bf16_t)(cvt_pk_bf16(o1[j], 0.f) & 0xffff); p[(d0 + 32 + j) * 64] = (bf16_t)(cvt_pk_bf16(o2[j], 0.f) & 0xffff); }
                        }
                    }
                }
                asm volatile("" ::: "memory"); __builtin_amdgcn_sched_barrier(0);
            }
    }
};

struct EpiC1 {
    bf16_t* hid;
    __device__ __forceinline__ void operator()(Acc& acc, const Unit& u, int wr, int wc, int fr, int fq, LAS unsigned char* ldsx, int) const {
        const LAS float* c1 = (const LAS float*)ldsx;
#pragma unroll
        for (int bj = 0; bj < 2; ++bj) {
            const int c0 = 128 * bj + 32 * wc + 8 * fq;
            const f32x4 bA = *(const LAS f32x4*)(c1 + c0), bB = *(const LAS f32x4*)(c1 + c0 + 4);
#pragma unroll
            for (int ai = 0; ai < 2; ++ai)
#pragma unroll
                for (int m = 0; m < 4; ++m) {
                    const int row = u.pm * 256 + ai * 128 + wr * 64 + m * 16 + fr;
                    float v[8];
#pragma unroll
                    for (int e = 0; e < 8; ++e) { const float x = acc[ai][bj][m][e >> 2][e & 3] + ((e >> 2) ? bB[e & 3] : bA[e & 3]); const float y = 0.7978845608028654f * (x + 0.044715f * x * x * x); v[e] = x * sigmoidf_(2.0f * y); }
                    u32x4 w; w.x = cvt_pk_bf16(v[0], v[1]); w.y = cvt_pk_bf16(v[2], v[3]); w.z = cvt_pk_bf16(v[4], v[5]); w.w = cvt_pk_bf16(v[6], v[7]);
                    *(u32x4*)(hid + (size_t)row * 256 + c0) = w;
                    asm volatile("" ::: "memory"); __builtin_amdgcn_sched_barrier(0);
                }
        }
    }
};
struct EpiC2 {
    const float* b2; const float* cosT; const float* sinT; bf16_t* out; int isv;
    __device__ __forceinline__ void operator()(Acc& acc, const Unit& u, int wr, int wc, int fr, int fq, LAS unsigned char*, int) const {
        if (wc >= 2) return;
        const int d0 = 16 * (wc & 1) + 4 * fq;
        const f32x4 bA = *(const f32x4*)(b2 + d0), bB = *(const f32x4*)(b2 + d0 + 32);
#pragma unroll
        for (int ai = 0; ai < 2; ++ai)
#pragma unroll
            for (int m = 0; m < 4; ++m) {
                const int row = u.pm * 256 + ai * 128 + wr * 64 + m * 16 + fr; const int j = row & 511;
                f32x4 a1 = acc[ai][0][m][0] + bA, a2 = acc[ai][0][m][1] + bB;
                if (j == 511) { a1 = (f32x4){0.f, 0.f, 0.f, 0.f}; a2 = a1; }
                if (!isv) {
                    const int pos = (j == 511) ? 0 : 16 * j + 31;
                    const f32x4 cs = *(const f32x4*)(cosT + pos * 32 + d0), sn = *(const f32x4*)(sinT + pos * 32 + d0);
                    const f32x4 o1 = a1 * cs - a2 * sn, o2 = a1 * sn + a2 * cs;
                    bf16_t* p = out + (size_t)row * 64 + d0;
                    u32x2 w1; w1.x = cvt_pk_bf16(o1[0], o1[1]); w1.y = cvt_pk_bf16(o1[2], o1[3]); *(u32x2*)p = w1;
                    u32x2 w2; w2.x = cvt_pk_bf16(o2[0], o2[1]); w2.y = cvt_pk_bf16(o2[2], o2[3]); *(u32x2*)(p + 32) = w2;
                } else {
                    bf16_t* p = out + (size_t)(row >> 6) * 4096 + vperm(row & 63);
#pragma unroll
                    for (int e = 0; e < 4; ++e) { p[(d0 + e) * 64] = (bf16_t)(cvt_pk_bf16(a1[e], 0.f) & 0xffff); p[(d0 + 32 + e) * 64] = (bf16_t)(cvt_pk_bf16(a2[e], 0.f) & 0xffff); }
                }
                asm volatile("" ::: "memory"); __builtin_amdgcn_sched_barrier(0);
            }
    }
};

struct EpiRes {
    const float* xold; float* xnew; const bf16_t* xb; float* ssp; const float* pb; const float* ps; bf16_t* xbo;
    __device__ __forceinline__ void operator()(Acc& acc, const Unit& u, int wr, int wc, int fr, int fq, LAS unsigned char* ldsx, int tid) const {
#pragma unroll
        for (int ai = 0; ai < 2; ++ai)
#pragma unroll
            for (int m = 0; m < 4; ++m) {
                const int row = u.pm * 256 + ai * 128 + wr * 64 + m * 16 + fr; float ss = 0.f;
#pragma unroll
                for (int bj = 0; bj < 2; ++bj) {
                    const int col = u.pn * 256 + 128 * bj + 32 * wc + 8 * fq; const size_t off = (size_t)row * D + col;
                    f32x4 a0 = acc[ai][bj][m][0], a1 = acc[ai][bj][m][1];
                    if (pb) { a0 = (a0 + *(const f32x4*)(pb + col)) * *(const f32x4*)(ps + col); a1 = (a1 + *(const f32x4*)(pb + col + 4)) * *(const f32x4*)(ps + col + 4); }
                    f32x4 r0, r1; unpk8(*(const u32x4*)(xb + off), r0, r1);
                    const f32x4 x0 = r0 + a0, x1 = r1 + a1;
                    u32x4 w; w.x = cvt_pk_bf16(x0[0], x0[1]); w.y = cvt_pk_bf16(x0[2], x0[3]); w.z = cvt_pk_bf16(x1[0], x1[1]); w.w = cvt_pk_bf16(x1[2], x1[3]);
                    *(u32x4*)(xbo + off) = w;
                    ss += (x0[0] * x0[0] + x0[1] * x0[1]) + (x0[2] * x0[2] + x0[3] * x0[3]) + (x1[0] * x1[0] + x1[1] * x1[1]) + (x1[2] * x1[2] + x1[3] * x1[3]);
                    asm volatile("" ::: "memory"); __builtin_amdgcn_sched_barrier(0);
                }
                ss = xrow16_sum(ss);
                if (fq == 0) ((LAS float*)ldsx)[wc * 256 + ai * 128 + wr * 64 + m * 16 + fr] = ss;
            }
        WG_BAR();
        if (tid < 256) { const LAS float* rd = (const LAS float*)ldsx; ssp[(size_t)u.pn * M + u.pm * 256 + tid] = (rd[tid] + rd[256 + tid]) + (rd[512 + tid] + rd[768 + tid]); }
        WG_BAR();
    }
};

struct EpiFinal {
    float* x; const float* gain; float* ssx; unsigned* cnt; const bf16_t* xb;
    __device__ __forceinline__ void operator()(Acc& acc, const Unit& u, int wr, int wc, int fr, int fq, LAS unsigned char* ldsx, int tid) const {
        LAS float* red = (LAS float*)ldsx; LAS float* rsl = (LAS float*)(ldsx + 4096);
#pragma unroll
        for (int ai = 0; ai < 2; ++ai)
#pragma unroll
            for (int m = 0; m < 4; ++m) {
                const int row = u.pm * 256 + ai * 128 + wr * 64 + m * 16 + fr; float ss = 0.f;
#pragma unroll
                for (int bj = 0; bj < 2; ++bj) {
                    const int col = u.pn * 256 + 128 * bj + 32 * wc + 8 * fq; const size_t off = (size_t)row * D + col;
                    f32x4 r0, r1; unpk8(*(const u32x4*)(xb + off), r0, r1);
                    const f32x4 x0 = r0 + acc[ai][bj][m][0], x1 = r1 + acc[ai][bj][m][1];
                    acc[ai][bj][m][0] = x0; acc[ai][bj][m][1] = x1;
                    ss += (x0[0] * x0[0] + x0[1] * x0[1]) + (x0[2] * x0[2] + x0[3] * x0[3]) + (x1[0] * x1[0] + x1[1] * x1[1]) + (x1[2] * x1[2] + x1[3] * x1[3]);
                    asm volatile("" ::: "memory"); __builtin_amdgcn_sched_barrier(0);
                }
                ss = xrow16_sum(ss);
                if (fq == 0) red[wc * 256 + ai * 128 + wr * 64 + m * 16 + fr] = ss;
            }
        WG_BAR();
        if (tid < 256) __hip_atomic_store(ssx + (size_t)u.pn * M + u.pm * 256 + tid, (red[tid] + red[256 + tid]) + (red[512 + tid] + red[768 + tid]), __ATOMIC_RELAXED, __HIP_MEMORY_SCOPE_AGENT);
        asm volatile("s_waitcnt vmcnt(0)" ::: "memory");
        WG_BAR();
        if (tid == 0) {
            unsigned* c = cnt + 64 * u.pm;
            __hip_atomic_fetch_add(c, 1u, __ATOMIC_RELAXED, __HIP_MEMORY_SCOPE_AGENT);
            unsigned spins = 0;
            while (__hip_atomic_load(c, __ATOMIC_RELAXED, __HIP_MEMORY_SCOPE_AGENT) < 4u) { __builtin_amdgcn_s_sleep(2); if (++spins > (1u << 22)) break; }
            __builtin_amdgcn_fence(__ATOMIC_ACQUIRE, "agent");
            asm volatile("s_waitcnt vmcnt(0)" ::: "memory");
        }
        WG_BAR();
        if (tid < 256) {
            const float* p = ssx + u.pm * 256 + tid;
            const float sq = (__hip_atomic_load(p, __ATOMIC_RELAXED, __HIP_MEMORY_SCOPE_AGENT) + __hip_atomic_load(p + M, __ATOMIC_RELAXED, __HIP_MEMORY_SCOPE_AGENT)) +
                             (__hip_atomic_load(p + 2 * M, __ATOMIC_RELAXED, __HIP_MEMORY_SCOPE_AGENT) + __hip_atomic_load(p + 3 * M, __ATOMIC_RELAXED, __HIP_MEMORY_SCOPE_AGENT));
            rsl[tid] = 1.0f / sqrtf(sq * (1.0f / D) + EPS);
        }
        WG_BAR();
#pragma unroll
        for (int ai = 0; ai < 2; ++ai)
#pragma unroll
            for (int m = 0; m < 4; ++m) {
                const int rl = ai * 128 + wr * 64 + m * 16 + fr; const float rs = rsl[rl]; const int row = u.pm * 256 + rl;
#pragma unroll
                for (int bj = 0; bj < 2; ++bj) {
                    const int col = u.pn * 256 + 128 * bj + 32 * wc + 8 * fq; const size_t off = (size_t)row * D + col;
                    *(f32x4*)(x + off) = acc[ai][bj][m][0] * rs * *(const f32x4*)(gain + col); *(f32x4*)(x + off + 4) = acc[ai][bj][m][1] * rs * *(const f32x4*)(gain + col + 4);
                }
                asm volatile("" ::: "memory"); __builtin_amdgcn_sched_barrier(0);
            }
    }
};

struct EpiUp {
    const float* ssp; const float* cw; const float* cb; bf16_t* act; float* HB; float* FB;
    __device__ __forceinline__ void operator()(Acc& acc, const Unit& u, int wr, int wc, int fr, int fq, LAS unsigned char* ldsx, int tid) const {
        LAS float* Hl = (LAS float*)ldsx;
        LAS float* rsl = (LAS float*)(ldsx + 10240);
        const int lane = tid & 63;
        if (tid < 256) { const int row = u.pm * 256 + tid; const float sq = (ssp[row] + ssp[M + row]) + (ssp[2 * M + row] + ssp[3 * M + row]); rsl[tid] = 1.0f / sqrtf(sq * (1.0f / D) + EPS); }
        WG_BAR();
#pragma unroll
        for (int ai = 0; ai < 2; ++ai)
#pragma unroll
            for (int m = 0; m < 4; ++m) {
                const float rs = rsl[ai * 128 + wr * 64 + m * 16 + fr];
#pragma unroll
                for (int bj = 0; bj < 2; ++bj) { acc[ai][bj][m][0] *= rs; acc[ai][bj][m][1] *= rs; }
                asm volatile("" ::: "memory"); __builtin_amdgcn_sched_barrier(0);
            }
        if (tid < 128) *(LAS f32x4*)(Hl + tid * 4) = (f32x4){0.f, 0.f, 0.f, 0.f};
#pragma unroll
        for (int ai = 0; ai < 2; ++ai) {
            const int k = 2 * ai + wr;
#pragma unroll
            for (int bj = 0; bj < 2; ++bj)
#pragma unroll
                for (int n = 0; n < 2; ++n) {
                    const int tc = 128 * bj + 32 * wc + 8 * fq + 4 * n; const int uc = bj * FF + u.pn * 128 + 32 * wc + 8 * fq + 4 * n;
                    if (fr >= 14) { *(LAS f32x4*)(Hl + ((k + 1) * 2 + (fr - 14)) * 256 + tc) = acc[ai][bj][3][n]; if (k == 3) *(f32x4*)(HB + ((size_t)u.pm * 2 + (fr - 14)) * UP + uc) = acc[ai][bj][3][n]; }
                    if (k == 0 && fr < 2) *(f32x4*)(FB + ((size_t)u.pm * 2 + fr) * UP + uc) = acc[0][bj][0][n];
                }
        }
        WG_BAR();
#pragma unroll
        for (int ai = 0; ai < 2; ++ai) {
            const int k = 2 * ai + wr;
            u32x2 pk[4];
#pragma unroll
            for (int n = 0; n < 2; ++n) {
                const int tc = 32 * wc + 8 * fq + 4 * n; const int ucg = u.pn * 128 + tc;
                f32x4 cg[4];
#pragma unroll
                for (int bj = 0; bj < 2; ++bj) {
                    const int uc = bj * FF + ucg;
                    const f32x4 w0 = *(const f32x4*)(cw + uc), w1 = *(const f32x4*)(cw + UP + uc), w2 = *(const f32x4*)(cw + 2 * UP + uc), bb = *(const f32x4*)(cb + uc);
                    const f32x4 h0 = *(const LAS f32x4*)(Hl + (k * 2 + 0) * 256 + 128 * bj + tc), h1 = *(const LAS f32x4*)(Hl + (k * 2 + 1) * 256 + 128 * bj + tc);
#pragma unroll
                    for (int m = 0; m < 4; ++m) {
                        const f32x4 V = acc[ai][bj][m][n]; f32x4 p1, p2;
#pragma unroll
                        for (int e = 0; e < 4; ++e) {
                            const float r1 = dppf<0x121>(V[e]), r2 = dppf<0x122>(V[e]); float x1, x2;
                            if (m > 0) { x1 = dppf<0x121>(acc[ai][bj][m > 0 ? m - 1 : 0][n][e]); x2 = dppf<0x122>(acc[ai][bj][m > 0 ? m - 1 : 0][n][e]); }
                            else { x1 = h1[e]; x2 = (fr == 0) ? h0[e] : h1[e]; }
                            p1[e] = (fr == 0) ? x1 : r1; p2[e] = (fr < 2) ? x2 : r2;
                        }
                        const f32x4 cv = bb + w0 * p2 + w1 * p1 + w2 * V;
                        __builtin_amdgcn_sched_barrier(0);
                        if (bj == 0) cg[m] = cv;
                        else {
                            const int row = u.pm * 256 + ai * 128 + wr * 64 + m * 16 + fr;
                            float o[4];
#pragma unroll
                            for (int e = 0; e < 4; ++e) { const float gt = cg[m][e]; o[e] = gt * sigmoidf_(gt) * cv[e]; }
                            u32x2 w; w.x = cvt_pk_bf16(o[0], o[1]); w.y = cvt_pk_bf16(o[2], o[3]);
                            if (n == 0) pk[m] = w;
                            else { u32x4 w4; w4.x = pk[m].x; w4.y = pk[m].y; w4.z = w.x; w4.w = w.y; *(u32x4*)(act + (size_t)row * FF + ucg - 4) = w4; }
                        }
                    }
                    asm volatile("" ::: "memory"); __builtin_amdgcn_sched_barrier(0);
                }
            }
        }
        WG_BAR();
    }
};

namespace att {
constexpr int SLOT_B = 16384, NSLOT = 6;
constexpr int OFF_K = 0, OFF_IMP = NSLOT * SLOT_B, IMPW = 132, OFF_SEL = OFF_IMP + 64 * IMPW * 4, OFF_UNI = OFF_SEL + 1024, OFF_LIST = OFF_UNI + 64, OFF_N = OFF_LIST + 132 * 4, OFF_CODE = OFF_N + 48, CODEW = 144;
static_assert(OFF_CODE + 8 * CODEW <= LDS_BYTES - 16 && 8 * SLOT_B <= OFF_SEL, "attention LDS map");
struct Ctx {
    const bf16_t *Q, *KCC, *VCT, *KS, *VST, *KW, *VWT; const float* gates; bf16_t* O;
};
__device__ __forceinline__ bf16x8 mk8(s16x4 a, s16x4 b) { return (bf16x8){a[0], a[1], a[2], a[3], b[0], b[1], b[2], b[3]}; }

template <int MODE>
__device__ __forceinline__ void branch(LAS unsigned char* lds, const bf16_t* Kg, const bf16_t* Vg, int ktile_elems, int nt, int c, int w, int lane, int tid,
                                       const bf16x8 (&qf)[4][2], float (&mrow)[4], float (&lrow)[4], f32x4 (&O)[4][4]) {
    const int fr = lane & 15, fq = lane >> 4;
    const LAS int* list = (const LAS int*)(lds + OFF_LIST);
    LAS float* impL = (LAS float*)(lds + OFF_IMP);
    const LAS unsigned char* codeL = (const LAS unsigned char*)(lds + OFF_CODE) + w * CODEW;
    constexpr int TPS = (MODE >= 2) ? 4 : 3;
#define ATT_DMA(ti, slot) do { const int ti_ = (ti); const int s_ = list[ti_]; LAS unsigned char* d_ = lds + OFF_K + (slot) * SLOT_B + w * 1024; \
        int t2_ = tid; asm volatile("" : "+v"(t2_)); const int lr = t2_ >> 3, lq = t2_ & 7; const int goff = lr * 64 + ((lq ^ ((lr >> 1) & 7)) * 8); \
        __builtin_amdgcn_global_load_lds((const unsigned*)(Kg + (size_t)s_ * ktile_elems + goff), (LAS unsigned*)d_, 16, 0, 0); \
        if (MODE != 0) __builtin_amdgcn_global_load_lds((const unsigned*)(Vg + (size_t)s_ * 4096 + goff), (LAS unsigned*)(d_ + 8192), 16, 0, 0); } while (0)
    asm volatile("s_waitcnt vmcnt(0)" ::: "memory");
#pragma unroll
    for (int ti = 0; ti < TPS; ++ti) if (ti < nt) ATT_DMA(ti, ti);
    const int nst = (nt + TPS - 1) / TPS;
    for (int j = 0; j < nst; ++j) {
        asm volatile("s_waitcnt vmcnt(0)" ::: "memory");
        WG_BAR();
#pragma unroll
        for (int hh = 0; hh < TPS; ++hh) if (TPS * (j + 1) + hh < nt) ATT_DMA(TPS * (j + 1) + hh, ((j + 1) & 1) * TPS + hh);
        int sl0 = 0, sl1 = 0, sl2 = 0, sl3 = 0; unsigned codes4 = 0xffffffffu;
        if (TPS == 4) {
            const u32x4 l4 = *(const LAS u32x4*)(list + TPS * j);
            sl0 = __builtin_amdgcn_readfirstlane((int)l4.x); sl1 = __builtin_amdgcn_readfirstlane((int)l4.y); sl2 = __builtin_amdgcn_readfirstlane((int)l4.z); sl3 = __builtin_amdgcn_readfirstlane((int)l4.w);
            if (MODE == 2) codes4 = (unsigned)__builtin_amdgcn_readfirstlane((int)*(const LAS unsigned*)(codeL + TPS * j));
        }
#pragma unroll 1
        for (int h = 0; h < TPS; ++h) {
        const int i = TPS * j + h; if (i >= nt) break;
        const int s = (TPS == 4) ? (h == 0 ? sl0 : h == 1 ? sl1 : h == 2 ? sl2 : sl3) : list[i];
        unsigned code = 0xffu; if (MODE == 2) code = (codes4 >> (8 * h)) & 0xffu;
        const LAS unsigned char* Kb = lds + OFF_K + ((j & 1) * TPS + h) * SLOT_B;
        const LAS unsigned char* Vb = Kb;
        int l2_ = lane; asm volatile("" : "+v"(l2_)); const int fr2 = l2_ & 15, fq2 = l2_ >> 4, swz = (fr2 >> 1) & 7;
        const int kb0 = fr2 * 128 + ((fq2 ^ swz) * 16), kb1 = kb0 ^ 64;
        if (MODE != 2) {
            f32x4 sa[4][4];
#pragma unroll
            for (int p = 0; p < 4; ++p) {
                const float cinit = (MODE == 1) ? lrow[p] : -((mrow[p] < -1e29f) ? 0.f : mrow[p]);
#pragma unroll
                for (int mt = 0; mt < 4; ++mt) sa[p][mt] = (f32x4){cinit, cinit, cinit, cinit};
            }
#pragma unroll
            for (int mt = 0; mt < 4; ++mt)
#pragma unroll
                for (int ks = 0; ks < 2; ++ks) {
                    const bf16x8 kf = *(const LAS bf16x8*)(Kb + (ks ? kb1 : kb0) + mt * 2048);
#pragma unroll
                    for (int p = 0; p < 4; ++p) sa[p][mt] = __builtin_amdgcn_mfma_f32_16x16x32_bf16(kf, qf[p][ks], sa[p][mt], 0, 0, 0);
                }
            bf16x8 pf[4][2];
#pragma unroll
            for (int p = 0; p < 4; ++p) {
                const int ttA = 8 * w + 2 * p, tt = ttA + (fr >> 3);
                bool needmask;
                if (MODE <= 1) needmask = (((64 * c + ttA - 31) >> 4) - 64 * s) < 63;
                else needmask = (s == c) || (c >= 8 && s == c - 8);
                if (needmask) {
                    int hi, lov = -1;
                    if (MODE <= 1) { const int t = 64 * c + tt; hi = ((t - 31) >> 4) - 64 * s; }
                    else { hi = (s == c) ? tt : 63; lov = (c >= 8 && s == c - 8) ? tt : -1; }
#pragma unroll
                    for (int mt = 0; mt < 4; ++mt)
#pragma unroll
                        for (int j = 0; j < 4; ++j) { const int kk = 16 * mt + 4 * fq + j; sa[p][mt][j] = (kk <= hi && kk > lov) ? sa[p][mt][j] : -1e30f; }
                }
                if (MODE != 1) {
                    float mx = fmaxf(fmaxf(sa[p][0][0], sa[p][0][1]), sa[p][0][2]);
                    mx = fmaxf(fmaxf(mx, sa[p][0][3]), sa[p][1][0]); mx = fmaxf(fmaxf(mx, sa[p][1][1]), sa[p][1][2]); mx = fmaxf(fmaxf(mx, sa[p][1][3]), sa[p][2][0]);
                    mx = fmaxf(fmaxf(mx, sa[p][2][1]), sa[p][2][2]); mx = fmaxf(fmaxf(mx, sa[p][2][3]), sa[p][3][0]); mx = fmaxf(fmaxf(mx, sa[p][3][1]), sa[p][3][2]); mx = fmaxf(mx, sa[p][3][3]);
                    mx = xrow16_max(mx);
                    const bool uninit = mrow[p] < -1e29f;
                    const bool resc = (mx > 8.0f) || (uninit && mx > -1e29f);
                    if (__any(resc)) {
                        const float delta = resc ? mx : 0.f;
                        const float alpha = (resc && !uninit) ? ex2(-delta) : 1.0f;
#pragma unroll
                        for (int mt = 0; mt < 4; ++mt) sa[p][mt] = sa[p][mt] - delta;
                        lrow[p] *= alpha;
                        if (MODE >= 2) {
#pragma unroll
                            for (int d = 0; d < 4; ++d) O[p][d] *= alpha;
                        }
                        if (resc) mrow[p] = (uninit ? 0.f : mrow[p]) + delta;
                    }
                }
#pragma unroll
                for (int mt = 0; mt < 4; ++mt)
#pragma unroll
                    for (int j = 0; j < 4; ++j) sa[p][mt][j] = ex2(sa[p][mt][j]);
                if (MODE != 1) { const f32x4 t4 = (sa[p][0] + sa[p][1]) + (sa[p][2] + sa[p][3]); lrow[p] += (t4[0] + t4[1]) + (t4[2] + t4[3]); }
                if (MODE >= 1) {
#pragma unroll
                    for (int k2 = 0; k2 < 2; ++k2) {
                        u32x4 wv; wv.x = cvt_pk_bf16(sa[p][2 * k2][0], sa[p][2 * k2][1]); wv.y = cvt_pk_bf16(sa[p][2 * k2][2], sa[p][2 * k2][3]); wv.z = cvt_pk_bf16(sa[p][2 * k2 + 1][0], sa[p][2 * k2 + 1][1]); wv.w = cvt_pk_bf16(sa[p][2 * k2 + 1][2], sa[p][2 * k2 + 1][3]);
                        pf[p][k2] = __builtin_bit_cast(bf16x8, wv);
                    }
                }
                if (MODE == 1) {
#pragma unroll
                    for (int mt = 0; mt < 4; ++mt) {
                        float a = sa[p][mt][0] + sa[p][mt][1] + sa[p][mt][2] + 0.5f * sa[p][mt][3], bn = 0.5f * sa[p][mt][3];
                        a = sum8(a); bn = sum8(bn);
                        const int sb = 16 * s + 4 * mt + fq;
                        if ((fr & 7) == 0) { (void)__hip_atomic_fetch_add(impL + tt * IMPW + sb, a, __ATOMIC_RELAXED, __HIP_MEMORY_SCOPE_WORKGROUP); (void)__hip_atomic_fetch_add(impL + tt * IMPW + sb + 1, bn, __ATOMIC_RELAXED, __HIP_MEMORY_SCOPE_WORKGROUP); }
                    }
                }
            }
            if (MODE >= 1) {
#pragma unroll
                for (int d = 0; d < 4; ++d)
#pragma unroll
                    for (int k2 = 0; k2 < 2; ++k2) {
                        const bf16x8 vf = *(const LAS bf16x8*)(Vb + 8192 + (k2 ? kb1 : kb0) + d * 2048);
#pragma unroll
                        for (int p = 0; p < 4; ++p) O[p][d] = __builtin_amdgcn_mfma_f32_16x16x32_bf16(vf, pf[p][k2], O[p][d], 0, 0, 0);
                    }
            }
            __builtin_amdgcn_sched_barrier(0);
        } else {
#pragma unroll
        for (int p = 0; p < 4; ++p) {
            const int ttA = 8 * w + 2 * p;
            const unsigned mA = (code >> (2 * p)) & 1u, mB = (code >> (2 * p + 1)) & 1u;
            if ((mA | mB) != 0u) {
            const int tt = ttA + (fr >> 3);
            float cinit;
            if (MODE == 1) cinit = lrow[p];
            else { const float mref = (mrow[p] < -1e29f) ? 0.f : mrow[p]; const bool colact = (MODE != 2) || (((fr >> 3) ? mB : mA) != 0u); cinit = colact ? -mref : -1e30f; }
            f32x4 sa[4];
#pragma unroll
            for (int mt = 0; mt < 4; ++mt) {
                sa[mt] = (f32x4){cinit, cinit, cinit, cinit};
#pragma unroll
                for (int ks = 0; ks < 2; ++ks) { const bf16x8 kf = *(const LAS bf16x8*)(Kb + (ks ? kb1 : kb0) + mt * 2048); sa[mt] = __builtin_amdgcn_mfma_f32_16x16x32_bf16(kf, qf[p][ks], sa[mt], 0, 0, 0); }
            }
            bool needmask;
            if (MODE <= 1) needmask = (((64 * c + ttA - 31) >> 4) - 64 * s) < 63;
            else if (MODE == 2) needmask = (s == c);
            else needmask = (s == c) || (c >= 8 && s == c - 8);
            if (needmask) {
                int hi, lov = -1;
                if (MODE <= 1) { const int t = 64 * c + tt; hi = ((t - 31) >> 4) - 64 * s; }
                else if (MODE == 2) hi = tt;
                else { hi = (s == c) ? tt : 63; lov = (c >= 8 && s == c - 8) ? tt : -1; }
#pragma unroll
                for (int mt = 0; mt < 4; ++mt)
#pragma unroll
                    for (int j = 0; j < 4; ++j) { const int kk = 16 * mt + 4 * fq + j; sa[mt][j] = (kk <= hi && kk > lov) ? sa[mt][j] : -1e30f; }
            }
            if (MODE != 1) {
                float mx = fmaxf(fmaxf(sa[0][0], sa[0][1]), sa[0][2]);
                mx = fmaxf(fmaxf(mx, sa[0][3]), sa[1][0]); mx = fmaxf(fmaxf(mx, sa[1][1]), sa[1][2]); mx = fmaxf(fmaxf(mx, sa[1][3]), sa[2][0]);
                mx = fmaxf(fmaxf(mx, sa[2][1]), sa[2][2]); mx = fmaxf(fmaxf(mx, sa[2][3]), sa[3][0]); mx = fmaxf(fmaxf(mx, sa[3][1]), sa[3][2]); mx = fmaxf(mx, sa[3][3]);
                mx = xrow16_max(mx);
                const bool uninit = mrow[p] < -1e29f;
                const bool resc = (mx > 8.0f) || (uninit && mx > -1e29f);
                if (__any(resc)) {
                    const float delta = resc ? mx : 0.f;
                    const float alpha = (resc && !uninit) ? ex2(-delta) : 1.0f;
#pragma unroll
                    for (int mt = 0; mt < 4; ++mt) sa[mt] = sa[mt] - delta;
                    lrow[p] *= alpha;
                    if (MODE >= 2) {
#pragma unroll
                        for (int d = 0; d < 4; ++d) O[p][d] *= alpha;
                    }
                    if (resc) mrow[p] = (uninit ? 0.f : mrow[p]) + delta;
                }
            }
            f32x4 pv[4];
#pragma unroll
            for (int mt = 0; mt < 4; ++mt)
#pragma unroll
                for (int j = 0; j < 4; ++j) pv[mt][j] = ex2(sa[mt][j]);
            if (MODE != 1) { const f32x4 t4 = (pv[0] + pv[1]) + (pv[2] + pv[3]); lrow[p] += (t4[0] + t4[1]) + (t4[2] + t4[3]); }
            if (MODE >= 1) {
                bf16x8 pf[2];
#pragma unroll
                for (int k2 = 0; k2 < 2; ++k2) {
                    u32x4 wv; wv.x = cvt_pk_bf16(pv[2 * k2][0], pv[2 * k2][1]); wv.y = cvt_pk_bf16(pv[2 * k2][2], pv[2 * k2][3]); wv.z = cvt_pk_bf16(pv[2 * k2 + 1][0], pv[2 * k2 + 1][1]); wv.w = cvt_pk_bf16(pv[2 * k2 + 1][2], pv[2 * k2 + 1][3]);
                    pf[k2] = __builtin_bit_cast(bf16x8, wv);
                }
#pragma unroll
                for (int d = 0; d < 4; ++d)
#pragma unroll
                    for (int k2 = 0; k2 < 2; ++k2) {
                        const bf16x8 vf = *(const LAS bf16x8*)(Vb + 8192 + (k2 ? kb1 : kb0) + d * 2048);
                        O[p][d] = __builtin_amdgcn_mfma_f32_16x16x32_bf16(vf, pf[k2], O[p][d], 0, 0, 0);
                    }
            }
            if (MODE == 1) {
#pragma unroll
                for (int mt = 0; mt < 4; ++mt) {
                    float a = pv[mt][0] + pv[mt][1] + pv[mt][2] + 0.5f * pv[mt][3], bn = 0.5f * pv[mt][3];
                    a = sum8(a); bn = sum8(bn);
                    const int sb = 16 * s + 4 * mt + fq;
                    if ((fr & 7) == 0) { (void)__hip_atomic_fetch_add(impL + tt * IMPW + sb, a, __ATOMIC_RELAXED, __HIP_MEMORY_SCOPE_WORKGROUP); (void)__hip_atomic_fetch_add(impL + tt * IMPW + sb + 1, bn, __ATOMIC_RELAXED, __HIP_MEMORY_SCOPE_WORKGROUP); }
                }
            }
            }
            __builtin_amdgcn_sched_barrier(0);
        }
        }
        }
    }
    WG_BAR();
#undef ATT_DMA
}

__device__ __forceinline__ void unit(LAS unsigned char* lds, const Ctx& X, int b, int g, int c, int tid_in) {
    int tid = tid_in; asm volatile("" : "+v"(tid));
    const int lane = tid & 63, w = __builtin_amdgcn_readfirstlane(tid >> 6), fr = lane & 15, fq = lane >> 4;
    LAS int* list = (LAS int*)(lds + OFF_LIST);
    LAS unsigned* selm = (LAS unsigned*)(lds + OFF_SEL);
    LAS unsigned* uni = (LAS unsigned*)(lds + OFF_UNI);
    LAS float* impL = (LAS float*)(lds + OFF_IMP);
    LAS int* nl = (LAS int*)(lds + OFF_N);
    const int bg = b * 2 + g; const size_t rowbase = (size_t)b * T + 64 * c;
    bf16x8 qf[4][2];
#pragma unroll
    for (int p = 0; p < 4; ++p) { const bf16_t* qp = X.Q + (rowbase + 8 * w + 2 * p + (fr >> 3)) * 1024 + (8 * g + (fr & 7)) * 64 + 8 * fq;
#pragma unroll
        for (int ks = 0; ks < 2; ++ks) qf[p][ks] = *(const bf16x8*)(qp + 32 * ks); }
    for (int i = lane; i < 8 * IMPW; i += 64) impL[(8 * w) * IMPW + i] = 0.f;
    const int ncmp = (4 * c + 3 + 63) >> 6;
    if (tid < 8) list[tid] = tid;
    float mrow[4], lrow[4]; f32x4 O[4][4];
#pragma unroll
    for (int p = 0; p < 4; ++p) { mrow[p] = -1e30f; lrow[p] = 0.f;
#pragma unroll
        for (int d = 0; d < 4; ++d) { O[p][d] = (f32x4){0.f, 0.f, 0.f, 0.f}; } }
    WG_BAR();
    const bf16_t* kcc = X.KCC + (size_t)bg * 512 * 64; const bf16_t* vct = X.VCT + (size_t)bg * 8 * 4096;
    branch<0>(lds, kcc, vct, 4096, ncmp, c, w, lane, tid, qf, mrow, lrow, O);
#pragma unroll
    for (int p = 0; p < 4; ++p) { float l = xrow16_sum(lrow[p]); lrow[p] = (l > 0.f) ? (-mrow[p] - __builtin_amdgcn_logf(l)) : -1e30f; }
    branch<1>(lds, kcc, vct, 4096, ncmp, c, w, lane, tid, qf, mrow, lrow, O);
#define ATT_GATE(br, scale_expr) do { _Pragma("unroll") for (int p = 0; p < 4; ++p) { \
        const size_t grow = rowbase + 8 * w + 2 * p + (fr >> 3); \
        const float gt = X.gates[grow * 48 + (8 * g + (fr & 7)) * 3 + (br)]; const float sc = gt * (scale_expr); \
        _Pragma("unroll") for (int d = 0; d < 4; ++d) { \
            u32x2* optr = (u32x2*)(X.O + grow * 1024 + (8 * g + (fr & 7)) * 64 + 4 * fq + 16 * d); u32x2 ot = (u32x2){0u, 0u}; if ((br) > 0) ot = *optr; \
            float o0 = __uint_as_float(ot.x << 16), o1 = __uint_as_float(ot.x & 0xffff0000u), o2 = __uint_as_float(ot.y << 16), o3 = __uint_as_float(ot.y & 0xffff0000u); \
            o0 += sc * O[p][d][0]; o1 += sc * O[p][d][1]; o2 += sc * O[p][d][2]; o3 += sc * O[p][d][3]; \
            ot.x = cvt_pk_bf16(o0, o1); ot.y = cvt_pk_bf16(o2, o3); O[p][d] = (f32x4){0.f, 0.f, 0.f, 0.f}; \
            *optr = ot; } \
        mrow[p] = -1e30f; lrow[p] = 0.f; } } while (0)
    ATT_GATE(0, 1.0f);
    LDS_WAIT();
    for (int q8 = 0; q8 < 8; ++q8) {
        const int tt = 8 * w + q8;
        unsigned long long blo, bhi;
        if (c + 1 <= 16) { blo = (1ull << (c + 1)) - 1ull; bhi = 0ull; }
        else {
            const int s1 = lane, s2 = lane + 64;
            const bool c1 = (s1 >= 1 && s1 <= c - 2), c2 = (s2 >= 1 && s2 <= c - 2);
            const float v1 = c1 ? impL[tt * IMPW + s1] : -1.f, v2 = c2 ? impL[tt * IMPW + s2] : -1.f;
            int r1 = 0, r2 = 0;
            const int nq = (c - 2) / 4 + 1;
#pragma unroll 2
            for (int q = 0; q < nq; ++q) {
                const f32x4 x4 = *(const LAS f32x4*)(impL + tt * IMPW + 4 * q);
#pragma unroll
                for (int e = 0; e < 4; ++e) { const int sp = 4 * q + e; const float x = (sp >= 1 && sp <= c - 2) ? x4[e] : -2.f;
                    r1 += (x > v1 || (x == v1 && sp < s1)) ? 1 : 0; r2 += (x > v2 || (x == v2 && sp < s2)) ? 1 : 0; }
            }
            const bool f1 = (s1 == 0 || s1 == c || s1 == c - 1), f2 = (s2 == c || s2 == c - 1);
            blo = __ballot((c1 && r1 < 13) || f1); bhi = __ballot((c2 && r2 < 13) || f2);
        }
        if (lane == 0) { selm[tt * 4 + 0] = (unsigned)blo; selm[tt * 4 + 1] = (unsigned)(blo >> 32); selm[tt * 4 + 2] = (unsigned)bhi; selm[tt * 4 + 3] = (unsigned)(bhi >> 32); }
    }
    WG_BAR();
    if (tid < 4) { unsigned o = 0; for (int i = 0; i < 64; ++i) o |= selm[i * 4 + tid]; uni[tid] = o; }
    WG_BAR();
    if (tid == 0) { int n = 0; for (int s = 0; s <= c; ++s) if ((uni[s >> 5] >> (s & 31)) & 1u) list[n++] = s; nl[0] = n; }
    WG_BAR();
    const int nsel = nl[0];
    { LAS unsigned char* cw_ = (LAS unsigned char*)(lds + OFF_CODE) + w * CODEW;
      for (int i = lane; i < nsel; i += 64) { const int s_ = list[i]; unsigned cd = 0;
#pragma unroll
          for (int q8 = 0; q8 < 8; ++q8) cd |= ((selm[(8 * w + q8) * 4 + (s_ >> 5)] >> (s_ & 31)) & 1u) << q8;
          cw_[i] = (unsigned char)cd; }
      LDS_WAIT(); }
    branch<2>(lds, X.KS + (size_t)bg * T * 64, X.VST + (size_t)bg * 128 * 4096, 4096, nsel, c, w, lane, tid, qf, mrow, lrow, O);
#pragma unroll
    for (int p = 0; p < 4; ++p) { float l = xrow16_sum(lrow[p]); lrow[p] = (l > 0.f) ? 1.0f / l : 0.f; }
    { float rl[4] = {lrow[0], lrow[1], lrow[2], lrow[3]}; ATT_GATE(1, rl[p]); }
    const int w0 = (c >= 8) ? c - 8 : 0, nwin = c - w0 + 1;
    if (tid < nwin) list[tid] = w0 + tid;
    WG_BAR();
    branch<3>(lds, X.KW + (size_t)bg * T * 64, X.VWT + (size_t)bg * 128 * 4096, 4096, nwin, c, w, lane, tid, qf, mrow, lrow, O);
#pragma unroll
    for (int p = 0; p < 4; ++p) { float l = xrow16_sum(lrow[p]); lrow[p] = (l > 0.f) ? 1.0f / l : 0.f; }
    { float rl[4] = {lrow[0], lrow[1], lrow[2], lrow[3]}; ATT_GATE(2, rl[p]); }
#undef ATT_GATE
    WG_BAR();
}
}

__device__ __forceinline__ unsigned f2bf(float f) { unsigned u = __builtin_bit_cast(unsigned, f); return (u + 0x7fffu + ((u >> 16) & 1u)) >> 16; }
__device__ __forceinline__ unsigned pk2(float lo, float hi) { return f2bf(lo) | (f2bf(hi) << 16); }
template <int MAP>
__device__ __forceinline__ int rowmap(int a) {
    if (MAP == 0) return perm8(a);
    if (MAP == 1) return a < 1792 ? ((a & ~63) | swap45(a & 63)) : a;
    if (MAP == 2) { if (a < FF) return 256 * (a >> 7) + perm8(a & 127); const int a2 = a - FF; return 256 * (a2 >> 7) + 128 + perm8(a2 & 127); }
    return swap45(a);
}
template <int MAP>
__device__ __forceinline__ void transpose_item(const float* W, int K, int N, bf16_t* WT, int row_off, const float* gain, LAS float* scr, int item, int lane) {
    const int nblk = (N + 31) / 32, kb = item / nblk, nb = item % nblk, k0 = 64 * kb, n0 = 32 * nb;
#pragma unroll
    for (int i = 0; i < 32; ++i) { const int kk = 2 * i + (lane >> 5); const int col = n0 + (lane & 31); float v = (col < N) ? W[(size_t)(k0 + kk) * N + col] : 0.f; if (gain) v *= gain[k0 + kk]; scr[kk * 33 + (lane & 31)] = v; }
    LDS_WAIT();
    const int cc = lane & 7;
#pragma unroll
    for (int j = 0; j < 4; ++j) { const int n = (lane >> 3) + 8 * j; const LAS float* s = scr + (8 * cc) * 33 + n;
        u32x4 o; o.x = pk2(s[0 * 33], s[1 * 33]); o.y = pk2(s[2 * 33], s[3 * 33]); o.z = pk2(s[4 * 33], s[5 * 33]); o.w = pk2(s[6 * 33], s[7 * 33]);
        if (n0 + n < N) *(u32x4*)(WT + (size_t)(row_off + rowmap<MAP>(n0 + n)) * K + k0 + 8 * cc) = o; }
    LDS_WAIT();
}

#define XB_TMO      128
#define XB_XCNT(j)  (256  + 64 * (j))
#define XB_XSUB(j)  (1280 + 64 * (j))
#define XB_XGEN(j)  (2304 + 64 * (j))
#define XB_TOP      3328
#define XB_TOPGEN   3392
#define XCD_BAR_WORDS 3456
#define XB_SPIN_CAP (1u << 18)
__device__ __forceinline__ unsigned xb_ld(unsigned* p)              { return __hip_atomic_load(p, __ATOMIC_RELAXED, __HIP_MEMORY_SCOPE_AGENT); }
__device__ __forceinline__ unsigned xb_add(unsigned* p, unsigned v) { return __hip_atomic_fetch_add(p, v, __ATOMIC_RELAXED, __HIP_MEMORY_SCOPE_AGENT); }
__device__ __forceinline__ unsigned xb_xcc_id() { return (unsigned)__builtin_amdgcn_s_getreg((3 << 11) | 20) & 0xFu; }
#define XB_SPIN(cond, bar) do { unsigned _sp = 0; while (cond) { __builtin_amdgcn_s_sleep(1); \
    if ((++_sp & 255u) == 0u) { if (xb_ld(&(bar)[XB_TMO])) break; if (_sp > XB_SPIN_CAP) { atomicAdd(&(bar)[XB_TMO], 1u); break; } } } } while (0)
struct XcdBarrier { unsigned* bar; unsigned x; volatile LAS unsigned* st; };
__device__ __forceinline__ XcdBarrier xcd_barrier_post(unsigned* bar, volatile LAS unsigned* st) {
    XcdBarrier b; b.bar = bar; b.x = xb_xcc_id(); b.st = st;
    if (threadIdx.x == 0) (void)xb_add(&bar[XB_XCNT(b.x)], 1u);
    return b;
}
__device__ __forceinline__ void xcd_barrier_complete(unsigned* bar, unsigned x, unsigned& nloc, unsigned& nx) {
    const unsigned G = gridDim.x * gridDim.y * gridDim.z;
    unsigned sum, cnt, mine, sp = 0u;
    for (;;) {
        sum = 0u; cnt = 0u; mine = 0u;
#pragma unroll
        for (unsigned j = 0; j < 16; ++j) { const unsigned c = xb_ld(&bar[XB_XCNT(j)]); sum += c; cnt += (c > 0u) ? 1u : 0u; mine = (j == x) ? c : mine; }
        if (sum == G) break;
        __builtin_amdgcn_s_sleep(1);
        if ((++sp & 255u) == 0u) { if (xb_ld(&bar[XB_TMO])) break; if (sp > XB_SPIN_CAP) { atomicAdd(&bar[XB_TMO], 1u); break; } }
    }
    nloc = mine > 0u ? mine : 1u; nx = cnt > 0u ? cnt : 1u;
}
__device__ __forceinline__ void xcd_barrier(const XcdBarrier& b) {
    asm volatile("s_waitcnt vmcnt(0)" ::: "memory");
    __syncthreads();
    if (threadIdx.x == 0) {
        unsigned* bar = b.bar;
        __builtin_amdgcn_s_waitcnt(0);
        unsigned nloc = b.st[0], nx = b.st[1];
        if (nloc == 0u) { xcd_barrier_complete(bar, b.x, nloc, nx); b.st[0] = nloc; b.st[1] = nx; }
        const unsigned old = xb_add(&bar[XB_XSUB(b.x)], 1u);
        const unsigned gen = old / nloc;
        if (old + 1u == (gen + 1u) * nloc) {
            __builtin_amdgcn_fence(__ATOMIC_RELEASE, "agent");
            asm volatile("s_waitcnt vmcnt(0)" ::: "memory");
            const unsigned og = xb_add(&bar[XB_TOP], 1u);
            const unsigned tg = og / nx;
            if (og + 1u == (tg + 1u) * nx) xb_add(&bar[XB_TOPGEN], 1u);
            else XB_SPIN(xb_ld(&bar[XB_TOPGEN]) == tg, bar);
            __builtin_amdgcn_fence(__ATOMIC_ACQUIRE, "agent");
            xb_add(&bar[XB_XGEN(b.x)], 1u);
            asm volatile("s_waitcnt vmcnt(0)" ::: "memory");
        } else {
            XB_SPIN(xb_ld(&bar[XB_XGEN(b.x)]) == gen, bar);
            __builtin_amdgcn_fence(__ATOMIC_ACQUIRE, "agent");
            asm volatile("s_waitcnt vmcnt(0)" ::: "memory");
        }
    }
    __syncthreads();
}

struct Args { const float* in[29]; float* out; unsigned char* ws; float inv[32]; int ph_lo, ph_hi; };

constexpr int DI_UP = 16 * 176, DI_DN = 44 * 32, DI_PL = 4 * 8, N_DEFER = 2 * DI_UP + 2 * DI_DN + 4 * DI_PL;
__device__ __forceinline__ void ffn_weight_item(const Args& a, unsigned char* ws, LAS float* scr, int r, int lane) {
    if (r < DI_UP) { transpose_item<2>(a.in[15], D, UP, (bf16_t*)(ws + WS_WUP0), 0, a.in[14], scr, r, lane); return; } r -= DI_UP;
    if (r < DI_UP) { transpose_item<2>(a.in[24], D, UP, (bf16_t*)(ws + WS_WUP1), 0, a.in[23], scr, r, lane); return; } r -= DI_UP;
    if (r < DI_DN) { transpose_item<0>(a.in[18], FF, D, (bf16_t*)(ws + WS_WDN0), 0, nullptr, scr, r, lane); return; } r -= DI_DN;
    if (r < DI_DN) { transpose_item<0>(a.in[27], FF, D, (bf16_t*)(ws + WS_WDN1), 0, nullptr, scr, r, lane); return; } r -= DI_DN;
    const int gi = r / DI_PL; transpose_item<0>(a.in[20] + (size_t)gi * 65536, 256, 256, (bf16_t*)(ws + WS_WPOOL), gi * 256, nullptr, scr, r % DI_PL, lane);
}

__global__ void __launch_bounds__(512) mk_fwd(Args a) {
    extern __shared__ __attribute__((aligned(16))) unsigned char lds_raw[];
    LAS unsigned char* lds = (LAS unsigned char*)lds_raw;
    LAS unsigned char* ldsx = lds + LDS_RING;
    cg::grid_group grid = cg::this_grid();
    if (threadIdx.x < 2) ((volatile LAS unsigned*)(lds + LDS_BYTES - 16))[threadIdx.x] = 0u;
    __syncthreads();
    if (a.ph_hi == 0x7fff) grid.sync();
    const XcdBarrier xbar = xcd_barrier_post((unsigned*)a.ws, (volatile LAS unsigned*)(lds + LDS_BYTES - 16));
    const int tid = threadIdx.x, lane = tid & 63, wave = __builtin_amdgcn_readfirstlane(tid >> 6);
    const int G = gridDim.x, bx = blockIdx.x;
    unsigned char* ws = a.ws;
#define cosT ((float*)(ws + WS_ROPE))
#define sinT ((float*)(ws + WS_ROPE) + T * 32)
#define ssp ((float*)(ws + WS_SSP))
#define c1p ((float*)(ws + WS_C1P))
#define rstdv ((float*)(ws + WS_RSTD))
#define HB ((float*)(ws + WS_HB))
#define FB ((float*)(ws + WS_FB))
#define gates ((float*)(ws + WS_GATE))
#define Wt_in ((bf16_t*)(ws + WS_WIN))
#define Wt_out ((bf16_t*)(ws + WS_WOUT))
#define Wt_pool ((bf16_t*)(ws + WS_WPOOL))
#define Wt_c1 (kv ? (bf16_t*)(ws + WS_WC1V) : (bf16_t*)(ws + WS_WC1K))
#define Wt_c2 (kv ? (bf16_t*)(ws + WS_WC2V) : (bf16_t*)(ws + WS_WC2K))
#define XB ((bf16_t*)(ws + WS_XB))
#define Qb ((bf16_t*)(ws + WS_Q))
#define KC ((bf16_t*)(ws + WS_KC))
#define VC ((bf16_t*)(ws + WS_VC))
#define KS ((bf16_t*)(ws + WS_KS))
#define VST ((bf16_t*)(ws + WS_VST))
#define KW ((bf16_t*)(ws + WS_KW))
#define VWT ((bf16_t*)(ws + WS_VWT))
#define KCC ((bf16_t*)(ws + WS_KCC))
#define VCT ((bf16_t*)(ws + WS_VCT))
#define Ob ((bf16_t*)(ws + WS_O))
#define ACT ((bf16_t*)(ws + WS_ACT))
#define POOLED ((bf16_t*)(ws + WS_POOLED))
    float* out = a.out;
    const int lo = a.ph_lo, hi = a.ph_hi;
    const bool defer = (G == 256);
#define IN(k) (lo <= (k) && (k) < hi)
#define SEAM(k) do { if (IN(k) && IN((k) + 1)) xcd_barrier(xbar); } while (0)

    if (IN(0)) {
        LAS float* scr = (LAS float*)(lds + wave * 16384);
        const int gw = bx * 8 + wave, NGW = G * 8;
        constexpr int I_IN = 16 * 58, I_OUT = 16 * 32, I_C1 = 32 * 8, I_C2 = 4 * 2;
        constexpr int NA = I_IN + I_OUT + 2 * I_C1 + 2 * I_C2;
        const int NIT = NA + (defer ? 0 : N_DEFER);
        for (int it = gw; it < NIT; it += NGW) {
            int r = it;
            if (r < I_IN) { transpose_item<1>(a.in[2], D, 1840, Wt_in, 0, a.in[1], scr, r, lane); continue; } r -= I_IN;
            if (r < I_OUT) { transpose_item<0>(a.in[13], D, D, Wt_out, 0, nullptr, scr, r, lane); continue; } r -= I_OUT;
            if (r < I_C1) { transpose_item<0>(a.in[4], 2048, 256, (bf16_t*)(ws + WS_WC1K), 0, nullptr, scr, r, lane); continue; } r -= I_C1;
            if (r < I_C1) { transpose_item<0>(a.in[9], 2048, 256, (bf16_t*)(ws + WS_WC1V), 0, nullptr, scr, r, lane); continue; } r -= I_C1;
            if (r < I_C2) { transpose_item<3>(a.in[6], 256, 64, (bf16_t*)(ws + WS_WC2K), 0, nullptr, scr, r, lane); continue; } r -= I_C2;
            if (r < I_C2) { transpose_item<3>(a.in[11], 256, 64, (bf16_t*)(ws + WS_WC2V), 0, nullptr, scr, r, lane); continue; } r -= I_C2;
            ffn_weight_item(a, ws, scr, r, lane);
        }
        for (int m = gw; m < M; m += 2 * NGW) {
            const int m2 = m + NGW;
            const f32x4* xr = (const f32x4*)(a.in[0] + (size_t)m * D) + lane; const f32x4* xr2 = (const f32x4*)(a.in[0] + (size_t)m2 * D) + lane;
            f32x4 v[4], w[4];
#pragma unroll
            for (int j = 0; j < 4; ++j) { v[j] = xr[64 * j]; w[j] = (m2 < M) ? xr2[64 * j] : (f32x4){0.f, 0.f, 0.f, 0.f}; }
            unsigned long long* o8 = (unsigned long long*)(XB + (size_t)m * D) + lane; unsigned long long* o82 = (unsigned long long*)(XB + (size_t)m2 * D) + lane; float s1 = 0.f, s2 = 0.f;
#pragma unroll
            for (int j = 0; j < 4; ++j) {
                s1 += (v[j][0] * v[j][0] + v[j][1] * v[j][1]) + (v[j][2] * v[j][2] + v[j][3] * v[j][3]); o8[64 * j] = (unsigned long long)pk2(v[j][0], v[j][1]) | ((unsigned long long)pk2(v[j][2], v[j][3]) << 32);
                s2 += (w[j][0] * w[j][0] + w[j][1] * w[j][1]) + (w[j][2] * w[j][2] + w[j][3] * w[j][3]); if (m2 < M) o82[64 * j] = (unsigned long long)pk2(w[j][0], w[j][1]) | ((unsigned long long)pk2(w[j][2], w[j][3]) << 32);
            }
#pragma unroll
            for (int o = 1; o < 64; o <<= 1) { s1 += __shfl_xor(s1, o); s2 += __shfl_xor(s2, o); }
            if (lane == 0) { rstdv[m] = 1.0f / sqrtf(s1 * (1.0f / D) + EPS); if (m2 < M) rstdv[m2] = 1.0f / sqrtf(s2 * (1.0f / D) + EPS); }
        }
        for (int i = bx * 512 + tid; i < T * 32; i += G * 512) {
            const int t = i >> 5, f = i & 31; const float ang = (float)t * a.inv[f];
            double x = (double)ang * 0.15915494309189535; x -= __builtin_rint(x); const float xf = (float)x;
            cosT[i] = __builtin_amdgcn_cosf(xf); sinT[i] = __builtin_amdgcn_sinf(xf);
        }
        for (int it = NGW - 1 - gw; it < 256; it += NGW) {
            const int kv = it >> 7, chunk = (it >> 2) & 31, nb = it & 3; const float* pos = a.in[kv ? 8 : 3]; const float* w1 = a.in[kv ? 9 : 4];
            float s = 0.f;
#pragma unroll 32
            for (int r = 0; r < 64; ++r) { const int rr = chunk * 64 + r; s += pos[rr] * w1[(size_t)rr * 256 + nb * 64 + lane]; }
            c1p[(kv * 32 + chunk) * 256 + nb * 64 + lane] = s;
        }
        asm volatile("s_waitcnt vmcnt(0) lgkmcnt(0)" ::: "memory"); __syncthreads();
    }
    SEAM(0);
    if (IN(1)) {
        pg8::Gemm g{XB, Wt_in, M, NIN, D, D, 0}; pg8::StaticOrder S; S.init(M, NIN, G, bx);
        EpiIn E{rstdv, cosT, sinT, Qb, KC, VC, KS, VST, KW, VWT, gates};
        pg8::gemm_phase(lds, ldsx, g, S, E);
    }
    SEAM(1);
    if (IN(2)) {
        const int tid = threadIdx.x, lane = tid & 63, w = __builtin_amdgcn_readfirstlane(tid >> 6), fr = lane & 15, fq = lane >> 4;
        LAS float* c1s = (LAS float*)lds;
        LAS unsigned char* hidL = lds + 4096;
        for (int i = tid; i < 512; i += 512) { const int kv = i >> 8, n = i & 255; const float* b1 = a.in[kv ? 10 : 5]; float sv = b1[n]; for (int q = 0; q < 32; ++q) sv += c1p[(kv * 32 + q) * 256 + n]; c1s[i] = sv; }
        __syncthreads();
        for (int u = bx; u < 256; u += G) {
            const int kv = u >> 7, r0 = (u & 127) * 16;
            const bf16_t* Ap = (kv ? VC : KC) + (size_t)(r0 + fr) * 1024 + 8 * fq;
            const bf16_t* Bp = Wt_c1 + (size_t)(32 * w + fr) * 2048 + 8 * fq;
            f32x4 h0 = (f32x4){0.f, 0.f, 0.f, 0.f}, h1 = h0;
#pragma unroll 1
            for (int k0 = 0; k0 < 2048; k0 += 256) {
                bf16x8 af[8], b0[8], b1f[8];
#pragma unroll
                for (int q = 0; q < 8; ++q) { af[q] = *(const bf16x8*)(Ap + k0 + 32 * q); b0[q] = *(const bf16x8*)(Bp + k0 + 32 * q); b1f[q] = *(const bf16x8*)(Bp + 16 * 2048 + k0 + 32 * q); }
#pragma unroll
                for (int q = 0; q < 8; ++q) { h0 = __builtin_amdgcn_mfma_f32_16x16x32_bf16(b0[q], af[q], h0, 0, 0, 0); h1 = __builtin_amdgcn_mfma_f32_16x16x32_bf16(b1f[q], af[q], h1, 0, 0, 0); }
            }
            { const int c0 = 32 * w + 8 * fq; float v[8];
#pragma unroll
              for (int e = 0; e < 8; ++e) { const float x = ((e >> 2) ? h1[e & 3] : h0[e & 3]) + c1s[kv * 256 + c0 + e]; const float y = 0.7978845608028654f * (x + 0.044715f * x * x * x); v[e] = x * sigmoidf_(2.0f * y); }
              u32x4 wv; wv.x = cvt_pk_bf16(v[0], v[1]); wv.y = cvt_pk_bf16(v[2], v[3]); wv.z = cvt_pk_bf16(v[4], v[5]); wv.w = cvt_pk_bf16(v[6], v[7]);
              *(LAS u32x4*)(hidL + fr * 528 + c0 * 2) = wv; }
            __syncthreads();
            if (w < 2) {
                const bf16_t* W2 = Wt_c2 + (size_t)(32 * w + fr) * 256 + 8 * fq;
                f32x4 oA = (f32x4){0.f, 0.f, 0.f, 0.f}, oB = oA;
#pragma unroll
                for (int q = 0; q < 8; ++q) {
                    const bf16x8 hf = *(const LAS bf16x8*)(hidL + fr * 528 + (32 * q + 8 * fq) * 2);
                    const bf16x8 wa = *(const bf16x8*)(W2 + 32 * q), wb = *(const bf16x8*)(W2 + 16 * 256 + 32 * q);
                    oA = __builtin_amdgcn_mfma_f32_16x16x32_bf16(wa, hf, oA, 0, 0, 0); oB = __builtin_amdgcn_mfma_f32_16x16x32_bf16(wb, hf, oB, 0, 0, 0);
                }
                const float* b2 = a.in[kv ? 12 : 7]; const int d0 = 16 * w + 4 * fq; const int row = r0 + fr, j = row & 511;
                f32x4 a1 = oA + *(const f32x4*)(b2 + d0), a2 = oB + *(const f32x4*)(b2 + d0 + 32);
                if (j == 511) { a1 = (f32x4){0.f, 0.f, 0.f, 0.f}; a2 = a1; }
                if (!kv) {
                    const int pos = (j == 511) ? 0 : 16 * j + 31;
                    const f32x4 cs = *(const f32x4*)(cosT + pos * 32 + d0), sn = *(const f32x4*)(sinT + pos * 32 + d0);
                    const f32x4 o1 = a1 * cs - a2 * sn, o2 = a1 * sn + a2 * cs;
                    bf16_t* p = KCC + (size_t)row * 64 + d0;
                    u32x2 w1; w1.x = cvt_pk_bf16(o1[0], o1[1]); w1.y = cvt_pk_bf16(o1[2], o1[3]); *(u32x2*)p = w1;
                    u32x2 w2; w2.x = cvt_pk_bf16(o2[0], o2[1]); w2.y = cvt_pk_bf16(o2[2], o2[3]); *(u32x2*)(p + 32) = w2;
                } else {
                    bf16_t* p = VCT + (size_t)(row >> 6) * 4096 + vperm(row & 63);
#pragma unroll
                    for (int e = 0; e < 4; ++e) { p[(d0 + e) * 64] = (bf16_t)(cvt_pk_bf16(a1[e], 0.f) & 0xffff); p[(d0 + 32 + e) * 64] = (bf16_t)(cvt_pk_bf16(a2[e], 0.f) & 0xffff); }
                }
            }
            __syncthreads();
        }
    }
    if (IN(2) && IN(4)) xcd_barrier(xbar);
    if (IN(4)) {
        att::Ctx X{Qb, KCC, VCT, KS, VST, KW, VWT, gates, Ob};
        for (int k = bx; k < 256; k += G) {
            for (int rep = 0; rep < 2; ++rep) { const int uu = rep ? 511 - k : k; const int c = 127 - (uu >> 2), bgi = uu & 3; att::unit(lds, X, bgi >> 1, bgi & 1, c, tid); }
        }
        if (defer) {
            int td = threadIdx.x; asm volatile("" : "+v"(td)); const int dl = td & 63, dw = __builtin_amdgcn_readfirstlane(td >> 6);
            LAS float* scr = (LAS float*)(lds + dw * 16384);
            for (int it = bx * 8 + dw; it < N_DEFER; it += 2048) ffn_weight_item(a, ws, scr, it, dl);
        }
    }
    SEAM(4);
    if (IN(5)) {
        pg8::Gemm g{Ob, Wt_out, M, D, D, D, 0}; pg8::StaticOrder S; S.init(M, D, G, bx);
        EpiRes E{a.in[0], out, XB, ssp, nullptr, nullptr, XB};
        pg8::gemm_phase(lds, ldsx, g, S, E);
    }
    SEAM(5);
#pragma unroll
    for (int L = 0; L < 2; ++L) {
        const int pb = 6 + 5 * L;
        const float* cw = a.in[L ? 25 : 16]; const float* cb = a.in[L ? 26 : 17];
        if (IN(pb)) {
            pg8::Gemm g{(const bf16_t*)(ws + (L ? WS_XB2 : WS_XB)), (const bf16_t*)(ws + (L ? WS_WUP1 : WS_WUP0)), M, UP, D, D, 0}; pg8::StaticOrder S; S.init(M, UP, G, bx);
            EpiUp E{L ? ssp + 4 * M : ssp, cw, cb, ACT, HB, FB};
            pg8::gemm_phase(lds, ldsx, g, S, E);
        }
        SEAM(pb);
        if (IN(pb + 1)) {
            for (int i = bx * 512 + tid; i < 64 * FF; i += G * 512) {
                const int pm = i / FF, cidx = i % FF;
                float hg0 = 0.f, hg1 = 0.f, hv0 = 0.f, hv1 = 0.f;
                if (pm & 31) { const float* h = HB + (size_t)(pm - 1) * 2 * UP; hg0 = h[cidx]; hg1 = h[UP + cidx]; hv0 = h[FF + cidx]; hv1 = h[UP + FF + cidx]; }
                const float* f = FB + (size_t)pm * 2 * UP; const float fg0 = f[cidx], fg1 = f[UP + cidx], fv0 = f[FF + cidx], fv1 = f[UP + FF + cidx];
                const float g0 = cb[cidx] + cw[cidx] * hg0 + cw[UP + cidx] * hg1 + cw[2 * UP + cidx] * fg0;
                const float g1 = cb[cidx] + cw[cidx] * hg1 + cw[UP + cidx] * fg0 + cw[2 * UP + cidx] * fg1;
                const float v0 = cb[FF + cidx] + cw[FF + cidx] * hv0 + cw[UP + FF + cidx] * hv1 + cw[2 * UP + FF + cidx] * fv0;
                const float v1 = cb[FF + cidx] + cw[FF + cidx] * hv1 + cw[UP + FF + cidx] * fv0 + cw[2 * UP + FF + cidx] * fv1;
                ACT[(size_t)(pm * 256) * FF + cidx] = (bf16_t)f2bf(g0 * sigmoidf_(g0) * v0);
                ACT[(size_t)(pm * 256 + 1) * FF + cidx] = (bf16_t)f2bf(g1 * sigmoidf_(g1) * v1);
            }
        }
        SEAM(pb + 1);
        if (IN(pb + 2)) {
            pg8::Gemm g{ACT, (const bf16_t*)(ws + (L ? WS_WDN1 : WS_WDN0)), M, D, FF, FF, 0}; pg8::StaticOrder S; S.init(M, D, G, bx);
            bf16_t* XBL = (bf16_t*)(ws + (L ? WS_XB2 : WS_XB));
            if (L == 1 && G == 256) { EpiFinal E{out, a.in[28], (float*)(ws + WS_SSP + 512 * 1024), (unsigned*)(ws + 16384), XBL}; pg8::gemm_phase(lds, ldsx, g, S, E); }
            else { EpiRes E{out, out, XBL, ssp, nullptr, nullptr, XBL}; pg8::gemm_phase(lds, ldsx, g, S, E); }
        }
        if (!(L == 1 && G == 256)) { if (IN(pb + 2)) xcd_barrier(xbar); }
        if (L == 0) {
            if (IN(10)) {
                pg8::Gemm g{POOLED, Wt_pool, M, D, 256, D, 512}; pg8::StaticOrder S; S.init(M, D, G, bx);
                {
                    LAS float* rsd = (LAS float*)lds;
                    const float* gn = a.in[19];
                    int tid = threadIdx.x; asm volatile("" : "+v"(tid));
                    pg8::Unit pu;
                    for (int ui = 0; S.next(ui, pu); ++ui) {
                        const int r0 = pu.pm * 256, tb = r0 & (T - 1), wsz = 2 << pu.pn;
                        const int c8 = pu.pn * 256 + (tid & 31) * 8, t0 = (tid >> 5) * 16;
                        const f32x4 gv0 = *(const f32x4*)(gn + c8), gv1 = *(const f32x4*)(gn + c8 + 4);
                        __syncthreads();
                        if (tid < 272) { const int rr = r0 - 16 + tid; rsd[tid] = (tb - 16 + tid >= 0) ? row_rstd(ssp, 4, rr) : 0.f; }
                        __syncthreads();
                        const bf16_t* xb0 = XB + (size_t)r0 * D + c8;
#define POOL_H(tl, lo, hi) do { unpk8(*(const u32x4*)(xb0 + (ptrdiff_t)(tl) * D), lo, hi); const float rs_ = rsd[16 + (tl)]; lo = lo * rs_; hi = hi * rs_; } while (0)
                        f32x4 s0 = (f32x4){0.f, 0.f, 0.f, 0.f}, s1 = s0;
                        for (int i = 1; i <= wsz; ++i) { const int tl = t0 - i; if (tb + tl >= 0) { f32x4 a0, a1; POOL_H(tl, a0, a1); s0 += a0; s1 += a1; } }
#pragma unroll 4
                        for (int tl = t0; tl < t0 + 16; ++tl) {
                            f32x4 h0, h1; POOL_H(tl, h0, h1); s0 += h0; s1 += h1;
                            const int td = tl - wsz; if (tb + td >= 0) { f32x4 d0, d1; POOL_H(td, d0, d1); s0 -= d0; s1 -= d1; }
                            const int t = tb + tl; const int cnt = (t + 1 < wsz) ? t + 1 : wsz; const float ic = 1.0f / (float)cnt;
                            const f32x4 p0 = (s0 * ic - h0) * gv0, p1 = (s1 * ic - h1) * gv1;
                            u32x4 wv; wv.x = cvt_pk_bf16(p0[0], p0[1]); wv.y = cvt_pk_bf16(p0[2], p0[3]); wv.z = cvt_pk_bf16(p1[0], p1[1]); wv.w = cvt_pk_bf16(p1[2], p1[3]);
                            *(u32x4*)(POOLED + (size_t)(r0 + tl) * D + c8) = wv;
                        }
#undef POOL_H
                    }
                    asm volatile("s_waitcnt vmcnt(0)" ::: "memory"); __syncthreads();
                }
                EpiRes E{out, out, XB, ssp + 4 * M, a.in[21], a.in[22], (bf16_t*)(ws + WS_XB2)};
                pg8::gemm_phase(lds, ldsx, g, S, E);
            }
            SEAM(10);
        }
    }
    if (IN(14) && G != 256) {
        int t14 = threadIdx.x; asm volatile("" : "+v"(t14)); const int lane = t14 & 63, wave = __builtin_amdgcn_readfirstlane(t14 >> 6);
        const int gw = bx * 8 + wave, NGW = G * 8; const float* gn = a.in[28];
        for (int m = gw; m < M; m += NGW) {
            const float rs = row_rstd(ssp, 4, m); f32x4* xr = (f32x4*)(out + (size_t)m * D) + lane; const f32x4* gr = (const f32x4*)gn + lane;
            const u32x2* xbr = (const u32x2*)(ws + WS_XB2) + (size_t)m * (D / 4) + lane;
#pragma unroll
            for (int j = 0; j < 4; ++j) { const u32x2 v = xbr[64 * j]; const f32x4 xv = (f32x4){__uint_as_float(v.x << 16), __uint_as_float(v.x & 0xffff0000u), __uint_as_float(v.y << 16), __uint_as_float(v.y & 0xffff0000u)}; xr[64 * j] = xv * rs * gr[64 * j]; }
        }
    }
#undef IN
#undef SEAM
#undef cosT
#undef sinT
#undef ssp
#undef c1p
#undef rstdv
#undef HB
#undef FB
#undef gates
#undef Wt_in
#undef Wt_out
#undef Wt_pool
#undef Wt_c1
#undef Wt_c2
#undef XB
#undef Qb
#undef KC
#undef VC
#undef KS
#undef VST
#undef KW
#undef VWT
#undef KCC
#undef VCT
#undef Ob
#undef ACT
#undef POOLED
}

extern "C" void kernel_launch(void* const* d_in, const int* in_sizes, int n_in, void* d_out, int out_size, void* d_ws, size_t ws_size, hipStream_t stream) {
    static int grid = 0;
    if (grid == 0) {
        int dev = 0, cus = 0, per_cu = 0;
        hipGetDevice(&dev); hipDeviceGetAttribute(&cus, hipDeviceAttributeMultiprocessorCount, dev);
        hipFuncSetAttribute((const void*)mk_fwd, hipFuncAttributeMaxDynamicSharedMemorySize, LDS_BYTES);
        hipOccupancyMaxActiveBlocksPerMultiprocessor(&per_cu, (const void*)mk_fwd, 512, LDS_BYTES);
        if (per_cu < 1) per_cu = 1;
        grid = cus * per_cu; if (grid > 256) grid = 256;
        (void)hipGetLastError();
    }
    Args a{};
    for (int i = 0; i < 29; ++i) a.in[i] = (const float*)d_in[i];
    a.out = (float*)d_out; a.ws = (unsigned char*)d_ws;
    for (int i = 0; i < 32; ++i) a.inv[i] = 1.0f / powf(10000.0f, (float)(2 * i) / 64.0f);
    a.ph_lo = 0; a.ph_hi = 15;
    hipMemsetAsync(d_ws, 0, 65536, stream);
    void* args[] = {&a};
    hipError_t e = hipLaunchCooperativeKernel((const void*)mk_fwd, dim3(grid), dim3(512), args, LDS_BYTES, stream);
    if (e != hipSuccess) fprintf(stderr, "cooperative launch failed: %s (grid %d)\n", hipGetErrorString(e), grid);
}
```

```cpp
#include <hip/hip_runtime.h>
#include <hip/hip_cooperative_groups.h>
#include <cstdio>
#include <cstdint>
namespace cg = cooperative_groups;

#define LAS __attribute__((address_space(3)))
typedef unsigned short bf16_t;
typedef short bf16x8 __attribute__((ext_vector_type(8)));
typedef short s16x4 __attribute__((ext_vector_type(4)));
typedef float f32x4 __attribute__((ext_vector_type(4)));
typedef unsigned u32x4 __attribute__((ext_vector_type(4)));
typedef unsigned u32x2 __attribute__((ext_vector_type(2)));

constexpr int T = 8192, D = 1024, M = 16384, FF = 2816, UP = 5632, NIN = 2048;
constexpr float EPS = 1e-6f;
constexpr float QSCALE = 0.125f * 1.4426950408889634f;
constexpr size_t MiB = 1u << 20;
constexpr size_t WS_ROPE = 1 * MiB;
constexpr size_t WS_SSP = 3 * MiB;
constexpr size_t WS_C1P = 4 * MiB;
constexpr size_t WS_RSTD = 4 * MiB + 256 * 1024;
constexpr size_t WS_HB = 5 * MiB;
constexpr size_t WS_FB = 8 * MiB;
constexpr size_t WS_GATE = 11 * MiB;
constexpr size_t WS_WIN = 16 * MiB, WS_WOUT = 20 * MiB, WS_WUP0 = 22 * MiB, WS_WUP1 = 33 * MiB, WS_WDN0 = 44 * MiB, WS_WDN1 = 50 * MiB;
constexpr size_t WS_WPOOL = 56 * MiB, WS_WC1K = 57 * MiB, WS_WC1V = 58 * MiB, WS_WC2K = 59 * MiB, WS_WC2V = 59 * MiB + 512 * 1024;
constexpr size_t WS_XB = 64 * MiB;
constexpr size_t WS_Q = 96 * MiB;
constexpr size_t WS_KC = 128 * MiB, WS_VC = 132 * MiB, WS_KS = 136 * MiB, WS_VST = 140 * MiB, WS_KW = 144 * MiB, WS_VWT = 148 * MiB;
constexpr size_t WS_KCC = 152 * MiB, WS_VCT = 153 * MiB, WS_HIDK = 154 * MiB, WS_HIDV = 155 * MiB;
constexpr size_t WS_O = 160 * MiB;
constexpr size_t WS_ACT = 96 * MiB;
constexpr size_t WS_POOLED = 192 * MiB;
constexpr size_t WS_XB2 = 224 * MiB;
constexpr int LDS_RING = 131072, LDS_BYTES = 155648;

__device__ __forceinline__ unsigned cvt_pk_bf16(float lo, float hi) { unsigned r; asm volatile("v_cvt_pk_bf16_f32 %0, %1, %2" : "=v"(r) : "v"(lo), "v"(hi)); return r; }
__device__ __forceinline__ float bf2f(unsigned short b) { return __uint_as_float((unsigned)b << 16); }
__device__ __forceinline__ float ex2(float x) { return __builtin_amdgcn_exp2f(x); }
__device__ __forceinline__ float rcp(float x) { return __builtin_amdgcn_rcpf(x); }
__device__ __forceinline__ float sigmoidf_(float x) { return rcp(1.0f + ex2(-1.4426950408889634f * x)); }
__device__ __forceinline__ void unpk8(const u32x4 v, f32x4& lo, f32x4& hi) { lo = (f32x4){__uint_as_float(v.x << 16), __uint_as_float(v.x & 0xffff0000u), __uint_as_float(v.y << 16), __uint_as_float(v.y & 0xffff0000u)}; hi = (f32x4){__uint_as_float(v.z << 16), __uint_as_float(v.z & 0xffff0000u), __uint_as_float(v.w << 16), __uint_as_float(v.w & 0xffff0000u)}; }
__device__ __forceinline__ int perm8(int a) { return (a & ~31) | (16 * ((a >> 2) & 1) + 4 * ((a >> 3) & 3) + (a & 3)); }
__device__ __forceinline__ int vperm(int kk) { return (kk & 32) | (((kk >> 2) & 3) << 3) | (((kk >> 4) & 1) << 2) | (kk & 3); }
__device__ __forceinline__ int swap45(int a) { return (a & ~48) | (((a >> 4) & 1) << 5) | (((a >> 5) & 1) << 4); }
template <int CTRL> __device__ __forceinline__ float dppf(float x) { return __builtin_bit_cast(float, __builtin_amdgcn_mov_dpp(__builtin_bit_cast(int, x), CTRL, 0xf, 0xf, true)); }
__device__ __forceinline__ float xrow16_max(float x) {
    auto s = __builtin_amdgcn_permlane16_swap(__float_as_uint(x), __float_as_uint(x), false, false); x = fmaxf(__uint_as_float(s[0]), __uint_as_float(s[1]));
    auto t = __builtin_amdgcn_permlane32_swap(__float_as_uint(x), __float_as_uint(x), false, false); return fmaxf(__uint_as_float(t[0]), __uint_as_float(t[1])); }
__device__ __forceinline__ float xrow16_sum(float x) {
    auto s = __builtin_amdgcn_permlane16_swap(__float_as_uint(x), __float_as_uint(x), false, false); x = __uint_as_float(s[0]) + __uint_as_float(s[1]);
    auto t = __builtin_amdgcn_permlane32_swap(__float_as_uint(x), __float_as_uint(x), false, false); return __uint_as_float(t[0]) + __uint_as_float(t[1]); }
__device__ __forceinline__ float sum8(float x) { x += dppf<0xB1>(x); x += dppf<0x4E>(x); x += dppf<0x141>(x); return x; }
#define LDS_WAIT() asm volatile("s_waitcnt lgkmcnt(0)" ::: "memory")
#define WG_BAR() do { asm volatile("s_waitcnt lgkmcnt(0)" ::: "memory"); __builtin_amdgcn_s_barrier(); asm volatile("" ::: "memory"); } while (0)

namespace pg8 {
constexpr int BM = 256, BK = 64, HALF = 128, HTB = HALF * BK * 2, NXCD = 8, WGM = 8;
__host__ __device__ __forceinline__ int lds_byte(int r, int c) { const int st = (r >> 4) * 2 + (c >> 5), rr = r & 15, cc = c & 31, ob = rr * 64 + cc * 2; return st * 1024 + (ob ^ (((ob >> 9) & 1) << 5)); }
__host__ __device__ __forceinline__ void stage_rc(int b, int& R, int& C) { const int st = b / 1024, sb = b % 1024, swz = sb ^ (((sb >> 9) & 1) << 5); R = (st >> 1) * 16 + swz / 64; C = (st & 1) * 32 + (swz % 64) / 2; }
struct Unit { int pm, pn; };
struct Gemm { const bf16_t* A; const bf16_t* Bt; int M, N, K, lda, apn; };
struct StaticOrder {
    int nM, nN, nwg, G, c;
    __device__ __forceinline__ void init(int M_, int N_, int G_, int c_) { nM = M_ / BM; nN = N_ / BM; nwg = nM * nN; G = G_; c = c_; }
    __device__ __forceinline__ bool next(int i, Unit& u) const {
        const long L = (long)i * G + c; if (L >= nwg) return false;
        int wgid = (int)L; { const int q = nwg / NXCD, r = nwg % NXCD, xcd = wgid % NXCD, off = wgid / NXCD; wgid = (xcd < r ? xcd * (q + 1) : r * (q + 1) + (xcd - r) * q) + off; }
        const int nig = WGM * nN, gid = wgid / nig, fm = gid * WGM, gsz = (nM - fm) < WGM ? (nM - fm) : WGM;
        u.pm = fm + ((wgid % nig) % gsz); u.pn = (wgid % nig) / gsz; return true;
    }
};
template <class Epi>
__device__ __forceinline__ void gemm_phase(LAS unsigned char* lds, LAS unsigned char* ldsx, const Gemm g, const StaticOrder& S, const Epi& E) {
    int tid = threadIdx.x; asm volatile("" : "+v"(tid));
    const int wid = __builtin_amdgcn_readfirstlane(tid >> 6), lane = tid & 63, wr = wid >> 2, wc = wid & 3, fr = lane & 15, fq = lane >> 4;
    const int K = g.K, nt = K / BK;
    unsigned voffA[2], voffB[2];
#pragma unroll
    for (int i = 0; i < 2; ++i) { int R, C; stage_rc(tid * 16 + i * 8192, R, C); voffA[i] = (unsigned)(R * g.lda + C) * 2u; voffB[i] = (unsigned)(R * K + C) * 2u; }
    const size_t kstep = (size_t)(BK * 2);
    const size_t hstepA = (size_t)HALF * g.lda * 2, tstepA = 2 * hstepA, hstepB = (size_t)HALF * K * 2, tstepB = 2 * hstepB;
    const unsigned ldsw = (unsigned)wid * 1024u;
    const int aoff = lds_byte(wr * 64 + fr, fq * 8), boff = lds_byte(wc * 32 + fr, fq * 8);
#define PG8_SA(b, h) (((b) * 2 + (h)) * HTB)
#define PG8_SB(b, h) ((4 + (b) * 2 + (h)) * HTB)
#define PG8_STAGE(bufoff, gbase, voff) do { _Pragma("unroll") for (int _i = 0; _i < 2; ++_i) \
        __builtin_amdgcn_global_load_lds((const unsigned*)((const char*)(gbase) + (voff)[_i]), (LAS unsigned*)(lds + (bufoff) + ldsw + _i * 8192), 16, 0, 0); } while (0)
#define PG8_LDA(dst, b, h) do { _Pragma("unroll") for (int m = 0; m < 4; ++m) _Pragma("unroll") for (int k = 0; k < 2; ++k) dst[m][k] = *(const LAS bf16x8*)(lds + PG8_SA(b, h) + aoff + m * 2048 + k * 1024); } while (0)
#define PG8_LDB(dst, b, h) do { _Pragma("unroll") for (int n = 0; n < 2; ++n) _Pragma("unroll") for (int k = 0; k < 2; ++k) dst[n][k] = *(const LAS bf16x8*)(lds + PG8_SB(b, h) + boff + n * 2048 + k * 1024); } while (0)
#define PG8_MMA(ai, bj, At, Bt) do { __builtin_amdgcn_s_setprio(1); _Pragma("unroll") for (int m = 0; m < 4; ++m) _Pragma("unroll") for (int n = 0; n < 2; ++n) _Pragma("unroll") for (int k = 0; k < 2; ++k) \
        acc[ai][bj][m][n] = __builtin_amdgcn_mfma_f32_16x16x32_bf16(Bt[n][k], At[m][k], acc[ai][bj][m][n], 0, 0, 0); __builtin_amdgcn_s_setprio(0); } while (0)
#define PG8_WAIT_V(n) asm volatile("s_waitcnt vmcnt(" #n ")" ::: "memory")
#define PG8_WAIT_L(n) asm volatile("s_waitcnt lgkmcnt(" #n ")" ::: "memory")
#define PG8_BAR __builtin_amdgcn_s_barrier()
#define PG8_SCHED __builtin_amdgcn_sched_barrier(0)
    Unit cur, nxt; int ui = 0;
    if (!S.next(0, cur)) return;
    f32x4 acc[2][2][4][2];
#pragma unroll
    for (int a = 0; a < 2; ++a)
#pragma unroll
        for (int b = 0; b < 2; ++b)
#pragma unroll
            for (int m = 0; m < 4; ++m)
#pragma unroll
                for (int n = 0; n < 2; ++n) acc[a][b][m][n] = (f32x4){0.f, 0.f, 0.f, 0.f};
    bf16x8 At[4][2], B0[2][2], B1[2][2];
    const char* cA = (const char*)g.A + (size_t)cur.pm * tstepA + (size_t)cur.pn * g.apn; const char* cB = (const char*)g.Bt + (size_t)cur.pn * tstepB;
    PG8_STAGE(PG8_SB(0, 0), cB, voffB); PG8_STAGE(PG8_SB(0, 1), cB + hstepB, voffB); PG8_STAGE(PG8_SA(0, 0), cA, voffA); PG8_STAGE(PG8_SA(0, 1), cA + hstepA, voffA);
    if (wr == 1) PG8_BAR;
    PG8_WAIT_V(2); PG8_BAR;
    PG8_STAGE(PG8_SB(1, 0), cB + kstep, voffB); PG8_STAGE(PG8_SA(1, 0), cA + kstep, voffA); PG8_STAGE(PG8_SB(1, 1), cB + hstepB + kstep, voffB);
    PG8_WAIT_V(6); PG8_BAR;
    for (;;) {
        const bool has_next = S.next(ui + 1, nxt);
        const char* nA = has_next ? (const char*)g.A + (size_t)nxt.pm * tstepA + (size_t)nxt.pn * g.apn : cA; const char* nB = has_next ? (const char*)g.Bt + (size_t)nxt.pn * tstepB : cB;
        for (int t = 0; t < nt; t += 2) {
            const bool last = (t == nt - 2);
            const char* a1 = cA + (size_t)(t + 1) * kstep;
            const char* a2 = last ? nA : cA + (size_t)(t + 2) * kstep; const char* b2 = last ? nB : cB + (size_t)(t + 2) * kstep;
            const char* a3 = a2 + kstep; const char* b3 = b2 + kstep;
            PG8_LDB(B0, 0, 0); PG8_LDB(B1, 0, 1); PG8_SCHED; PG8_LDA(At, 0, 0); PG8_STAGE(PG8_SA(1, 1), a1 + hstepA, voffA);
            PG8_WAIT_V(8); PG8_WAIT_L(0); PG8_BAR; PG8_MMA(0, 0, At, B0); PG8_MMA(0, 1, At, B1); PG8_BAR; PG8_SCHED;
            PG8_LDA(At, 0, 1); PG8_STAGE(PG8_SB(0, 0), b2, voffB); PG8_STAGE(PG8_SB(0, 1), b2 + hstepB, voffB); PG8_STAGE(PG8_SA(0, 0), a2, voffA);
            PG8_WAIT_V(8); PG8_WAIT_L(0); PG8_BAR; PG8_MMA(1, 0, At, B0); PG8_MMA(1, 1, At, B1); PG8_BAR; PG8_SCHED;
            PG8_LDB(B0, 1, 0); PG8_LDB(B1, 1, 1); PG8_SCHED; PG8_LDA(At, 1, 0); PG8_STAGE(PG8_SA(0, 1), a2 + hstepA, voffA);
            PG8_WAIT_V(8); PG8_WAIT_L(0); PG8_BAR; PG8_MMA(0, 0, At, B0); PG8_MMA(0, 1, At, B1); PG8_BAR; PG8_SCHED;
            PG8_LDA(At, 1, 1); PG8_STAGE(PG8_SB(1, 0), b3, voffB); PG8_STAGE(PG8_SB(1, 1), b3 + hstepB, voffB); PG8_STAGE(PG8_SA(1, 0), a3, voffA);
            PG8_WAIT_V(8); PG8_WAIT_L(0); PG8_BAR; PG8_MMA(1, 0, At, B0); PG8_MMA(1, 1, At, B1); PG8_BAR; PG8_SCHED;
        }
        if (wr == 0) PG8_BAR;
        { int t2 = threadIdx.x; asm volatile("" : "+v"(t2));
          E(acc, cur, wr, wc, t2 & 15, (t2 & 63) >> 4, ldsx, t2); }
        if (!has_next) break;
#pragma unroll
        for (int a = 0; a < 2; ++a)
#pragma unroll
            for (int b = 0; b < 2; ++b)
#pragma unroll
                for (int m = 0; m < 4; ++m)
#pragma unroll
                    for (int n = 0; n < 2; ++n) acc[a][b][m][n] = (f32x4){0.f, 0.f, 0.f, 0.f};
        cur = nxt; cA = nA; cB = nB; ++ui;
        if (wr == 1) PG8_BAR;
    }
    PG8_WAIT_V(0);
    PG8_BAR;
#undef PG8_SA
#undef PG8_SB
#undef PG8_STAGE
#undef PG8_LDA
#undef PG8_LDB
#undef PG8_MMA
#undef PG8_WAIT_V
#undef PG8_WAIT_L
#undef PG8_BAR
#undef PG8_SCHED
}
}
using pg8::Unit;
typedef f32x4 Acc[2][2][4][2];

__device__ __forceinline__ float row_rstd(const float* ssp, int np, int row) {
    float s = 0.f; for (int i = 0; i < np; ++i) s += ssp[(size_t)i * M + row];
    return 1.0f / sqrtf(s * (1.0f / D) + EPS);
}

struct EpiIn {
    const float* rstdv; const float* cosT; const float* sinT;
    bf16_t *Q, *KC, *VC, *KS, *VST, *KW, *VWT; float* gates;
    __device__ __forceinline__ void operator()(Acc& acc, const Unit& u, int wr, int wc, int fr, int fq, LAS unsigned char*, int) const {
#pragma unroll
        for (int ai = 0; ai < 2; ++ai)
#pragma unroll
            for (int m = 0; m < 4; ++m) {
                const int row = u.pm * 256 + ai * 128 + wr * 64 + m * 16 + fr; const float rs = rstdv[row];
                const int t = row & (T - 1), b = row >> 13;
                const int d0 = 16 * (wc & 1) + 4 * fq;
                const f32x4 cs = *(const f32x4*)(cosT + t * 32 + d0), sn = *(const f32x4*)(sinT + t * 32 + d0);
#pragma unroll
                for (int bj = 0; bj < 2; ++bj) {
                    f32x4 a1 = acc[ai][bj][m][0] * rs, a2 = acc[ai][bj][m][1] * rs;
                    if (u.pn == 7) {
                        if (bj == 0) {
#pragma unroll
                            for (int n = 0; n < 2; ++n) { const int c0 = 32 * wc + 16 * n + 4 * fq; if (c0 < 48) { const f32x4 v = n ? a2 : a1; f32x4 o; o[0] = sigmoidf_(v[0]); o[1] = sigmoidf_(v[1]); o[2] = sigmoidf_(v[2]); o[3] = sigmoidf_(v[3]); *(f32x4*)(gates + (size_t)row * 48 + c0) = o; } }
                        }
                        continue;
                    }
                    const int hh = 2 * bj + (wc >> 1);
                    bool rope; if (u.pn < 4) rope = true; else rope = (u.pn >= 5) && (hh < 2);
                    f32x4 o1 = a1, o2 = a2;
                    if (rope) { o1 = a1 * cs - a2 * sn; o2 = a1 * sn + a2 * cs; }
                    if (u.pn < 4) {
                        o1 = o1 * QSCALE; o2 = o2 * QSCALE;
                        bf16_t* p = Q + (size_t)row * 1024 + (u.pn * 4 + hh) * 64 + d0;
                        u32x2 w1; w1.x = cvt_pk_bf16(o1[0], o1[1]); w1.y = cvt_pk_bf16(o1[2], o1[3]); *(u32x2*)p = w1;
                        u32x2 w2; w2.x = cvt_pk_bf16(o2[0], o2[1]); w2.y = cvt_pk_bf16(o2[2], o2[3]); *(u32x2*)(p + 32) = w2;
                    } else {
                        const int gg = hh & 1; const bool isv = hh >= 2;
                        if (!isv) {
                            bf16_t* base = (u.pn == 4) ? KC : (u.pn == 5) ? KS : KW;
                            bf16_t* p = base + ((size_t)(b * 2 + gg) * T + t) * 64 + d0;
                            u32x2 w1; w1.x = cvt_pk_bf16(o1[0], o1[1]); w1.y = cvt_pk_bf16(o1[2], o1[3]); *(u32x2*)p = w1;
                            u32x2 w2; w2.x = cvt_pk_bf16(o2[0], o2[1]); w2.y = cvt_pk_bf16(o2[2], o2[3]); *(u32x2*)(p + 32) = w2;
                        } else if (u.pn == 4) {
                            bf16_t* p = VC + ((size_t)(b * 2 + gg) * T + t) * 64 + d0;
                            u32x2 w1; w1.x = cvt_pk_bf16(o1[0], o1[1]); w1.y = cvt_pk_bf16(o1[2], o1[3]); *(u32x2*)p = w1;
                            u32x2 w2; w2.x = cvt_pk_bf16(o2[0], o2[1]); w2.y = cvt_pk_bf16(o2[2], o2[3]); *(u32x2*)(p + 32) = w2;
                        } else {
                            bf16_t* base = (u.pn == 5) ? VST : VWT;
                            bf16_t* p = base + ((size_t)(b * 2 + gg) * 128 + (t >> 6)) * 4096 + vperm(t & 63);
#pragma unroll
                            for (int j = 0; j < 4; ++j) { p[(d0 + j) * 64] = (bf16_t)(cvt_pk_bf16(o1[j], 0.f) & 0xffff); p[(d0 + 32 + j) * 64] = (bf16_t)(cvt_pk_bf16(o2[j], 0.f) & 0xffff); }
                        }
                    }
                }
                asm volatile("" ::: "memory"); __builtin_amdgcn_sched_barrier(0);
            }
    }
};

struct EpiC1 {
    bf16_t* hid;
    __device__ __forceinline__ void operator()(Acc& acc, const Unit& u, int wr, int wc, int fr, int fq, LAS unsigned char* ldsx, int) const {
        const LAS float* c1 = (const LAS float*)ldsx;
#pragma unroll
        for (int bj = 0; bj < 2; ++bj) {
            const int c0 = 128 * bj + 32 * wc + 8 * fq;
            const f32x4 bA = *(const LAS f32x4*)(c1 + c0), bB = *(const LAS f32x4*)(c1 + c0 + 4);
#pragma unroll
            for (int ai = 0; ai < 2; ++ai)
#pragma unroll
                for (int m = 0; m < 4; ++m) {
                    const int row = u.pm * 256 + ai * 128 + wr * 64 + m * 16 + fr;
                    float v[8];
#pragma unroll
                    for (int e = 0; e < 8; ++e) { const float x = acc[ai][bj][m][e >> 2][e & 3] + ((e >> 2) ? bB[e & 3] : bA[e & 3]); const float y = 0.7978845608028654f * (x + 0.044715f * x * x * x); v[e] = x * sigmoidf_(2.0f * y); }
                    u32x4 w; w.x = cvt_pk_bf16(v[0], v[1]); w.y = cvt_pk_bf16(v[2], v[3]); w.z = cvt_pk_bf16(v[4], v[5]); w.w = cvt_pk_bf16(v[6], v[7]);
                    *(u32x4*)(hid + (size_t)row * 256 + c0) = w;
                    asm volatile("" ::: "memory"); __builtin_amdgcn_sched_barrier(0);
                }
        }
    }
};
struct EpiC2 {
    const float* b2; const float* cosT; const float* sinT; bf16_t* out; int isv;
    __device__ __forceinline__ void operator()(Acc& acc, const Unit& u, int wr, int wc, int fr, int fq, LAS unsigned char*, int) const {
        if (wc >= 2) return;
        const int d0 = 16 * (wc & 1) + 4 * fq;
        const f32x4 bA = *(const f32x4*)(b2 + d0), bB = *(const f32x4*)(b2 + d0 + 32);
#pragma unroll
        for (int ai = 0; ai < 2; ++ai)
#pragma unroll
            for (int m = 0; m < 4; ++m) {
                const int row = u.pm * 256 + ai * 128 + wr * 64 + m * 16 + fr; const int j = row & 511;
                f32x4 a1 = acc[ai][0][m][0] + bA, a2 = acc[ai][0][m][1] + bB;
                if (j == 511) { a1 = (f32x4){0.f, 0.f, 0.f, 0.f}; a2 = a1; }
                if (!isv) {
                    const int pos = (j == 511) ? 0 : 16 * j + 31;
                    const f32x4 cs = *(const f32x4*)(cosT + pos * 32 + d0), sn = *(const f32x4*)(sinT + pos * 32 + d0);
                    const f32x4 o1 = a1 * cs - a2 * sn, o2 = a1 * sn + a2 * cs;
                    bf16_t* p = out + (size_t)row * 64 + d0;
                    u32x2 w1; w1.x = cvt_pk_bf16(o1[0], o1[1]); w1.y = cvt_pk_bf16(o1[2], o1[3]); *(u32x2*)p = w1;
                    u32x2 w2; w2.x = cvt_pk_bf16(o2[0], o2[1]); w2.y = cvt_pk_bf16(o2[2], o2[3]); *(u32x2*)(p + 32) = w2;
                } else {
                    bf16_t* p = out + (size_t)(row >> 6) * 4096 + vperm(row & 63);
#pragma unroll
                    for (int e = 0; e < 4; ++e) { p[(d0 + e) * 64] = (bf16_t)(cvt_pk_bf16(a1[e], 0.f) & 0xffff); p[(d0 + 32 + e) * 64] = (bf16_t)(cvt_pk_bf16(a2[e], 0.f) & 0xffff); }
                }
                asm volatile("" ::: "memory"); __builtin_amdgcn_sched_barrier(0);
            }
    }
};

struct EpiRes {
    const float* xold; float* xnew; const bf16_t* xb; float* ssp; const float* pb; const float* ps; bf16_t* xbo;
    __device__ __forceinline__ void operator()(Acc& acc, const Unit& u, int wr, int wc, int fr, int fq, LAS unsigned char* ldsx, int tid) const {
#pragma unroll
        for (int ai = 0; ai < 2; ++ai)
#pragma unroll
            for (int m = 0; m < 4; ++m) {
                const int row = u.pm * 256 + ai * 128 + wr * 64 + m * 16 + fr; float ss = 0.f;
#pragma unroll
                for (int bj = 0; bj < 2; ++bj) {
                    const int col = u.pn * 256 + 128 * bj + 32 * wc + 8 * fq; const size_t off = (size_t)row * D + col;
                    f32x4 a0 = acc[ai][bj][m][0], a1 = acc[ai][bj][m][1];
                    if (pb) { a0 = (a0 + *(const f32x4*)(pb + col)) * *(const f32x4*)(ps + col); a1 = (a1 + *(const f32x4*)(pb + col + 4)) * *(const f32x4*)(ps + col + 4); }
                    f32x4 r0, r1; unpk8(*(const u32x4*)(xb + off), r0, r1);
                    const f32x4 x0 = r0 + a0, x1 = r1 + a1;
                    u32x4 w; w.x = cvt_pk_bf16(x0[0], x0[1]); w.y = cvt_pk_bf16(x0[2], x0[3]); w.z = cvt_pk_bf16(x1[0], x1[1]); w.w = cvt_pk_bf16(x1[2], x1[3]);
                    *(u32x4*)(xbo + off) = w;
                    ss += (x0[0] * x0[0] + x0[1] * x0[1]) + (x0[2] * x0[2] + x0[3] * x0[3]) + (x1[0] * x1[0] + x1[1] * x1[1]) + (x1[2] * x1[2] + x1[3] * x1[3]);
                    asm volatile("" ::: "memory"); __builtin_amdgcn_sched_barrier(0);
                }
                ss = xrow16_sum(ss);
                if (fq == 0) ((LAS float*)ldsx)[wc * 256 + ai * 128 + wr * 64 + m * 16 + fr] = ss;
            }
        WG_BAR();
        if (tid < 256) { const LAS float* rd = (const LAS float*)ldsx; ssp[(size_t)u.pn * M + u.pm * 256 + tid] = (rd[tid] + rd[256 + tid]) + (rd[512 + tid] + rd[768 + tid]); }
        WG_BAR();
    }
};

struct EpiFinal {
    float* x; const float* gain; float* ssx; unsigned* cnt; const bf16_t* xb;
    __device__ __forceinline__ void operator()(Acc& acc, const Unit& u, int wr, int wc, int fr, int fq, LAS unsigned char* ldsx, int tid) const {
        LAS float* red = (LAS float*)ldsx; LAS float* rsl = (LAS float*)(ldsx + 4096);
#pragma unroll
        for (int ai = 0; ai < 2; ++ai)
#pragma unroll
            for (int m = 0; m < 4; ++m) {
                const int row = u.pm * 256 + ai * 128 + wr * 64 + m * 16 + fr; float ss = 0.f;
#pragma unroll
                for (int bj = 0; bj < 2; ++bj) {
                    const int col = u.pn * 256 + 128 * bj + 32 * wc + 8 * fq; const size_t off = (size_t)row * D + col;
                    f32x4 r0, r1; unpk8(*(const u32x4*)(xb + off), r0, r1);
                    const f32x4 x0 = r0 + acc[ai][bj][m][0], x1 = r1 + acc[ai][bj][m][1];
                    acc[ai][bj][m][0] = x0; acc[ai][bj][m][1] = x1;
                    ss += (x0[0] * x0[0] + x0[1] * x0[1]) + (x0[2] * x0[2] + x0[3] * x0[3]) + (x1[0] * x1[0] + x1[1] * x1[1]) + (x1[2] * x1[2] + x1[3] * x1[3]);
                    asm volatile("" ::: "memory"); __builtin_amdgcn_sched_barrier(0);
                }
                ss = xrow16_sum(ss);
                if (fq == 0) red[wc * 256 + ai * 128 + wr * 64 + m * 16 + fr] = ss;
            }
        WG_BAR();
        if (tid < 256) __hip_atomic_store(ssx + (size_t)u.pn * M + u.pm * 256 + tid, (red[tid] + red[256 + tid]) + (red[512 + tid] + red[768 + tid]), __ATOMIC_RELAXED, __HIP_MEMORY_SCOPE_AGENT);
        asm volatile("s_waitcnt vmcnt(0)" ::: "memory");
        WG_BAR();
        if (tid == 0) {
            unsigned* c = cnt + 64 * u.pm;
            __hip_atomic_fetch_add(c, 1u, __ATOMIC_RELAXED, __HIP_MEMORY_SCOPE_AGENT);
            unsigned spins = 0;
            while (__hip_atomic_load(c, __ATOMIC_RELAXED, __HIP_MEMORY_SCOPE_AGENT) < 4u) { __builtin_amdgcn_s_sleep(2); if (++spins > (1u << 22)) break; }
            __builtin_amdgcn_fence(__ATOMIC_ACQUIRE, "agent");
            asm volatile("s_waitcnt vmcnt(0)" ::: "memory");
        }
        WG_BAR();
        if (tid < 256) {
            const float* p = ssx + u.pm * 256 + tid;
            const float sq = (__hip_atomic_load(p, __ATOMIC_RELAXED, __HIP_MEMORY_SCOPE_AGENT) + __hip_atomic_load(p + M, __ATOMIC_RELAXED, __HIP_MEMORY_SCOPE_AGENT)) +
                             (__hip_atomic_load(p + 2 * M, __ATOMIC_RELAXED, __HIP_MEMORY_SCOPE_AGENT) + __hip_atomic_load(p + 3 * M, __ATOMIC_RELAXED, __HIP_MEMORY_SCOPE_AGENT));
            rsl[tid] = 1.0f / sqrtf(sq * (1.0f / D) + EPS);
        }
        WG_BAR();
#pragma unroll
        for (int ai = 0; ai < 2; ++ai)
#pragma unroll
            for (int m = 0; m < 4; ++m) {
                const int rl = ai * 128 + wr * 64 + m * 16 + fr; const float rs = rsl[rl]; const int row = u.pm * 256 + rl;
#pragma unroll
                for (int bj = 0; bj < 2; ++bj) {
                    const int col = u.pn * 256 + 128 * bj + 32 * wc + 8 * fq; const size_t off = (size_t)row * D + col;
                    *(f32x4*)(x + off) = acc[ai][bj][m][0] * rs * *(const f32x4*)(gain + col); *(f32x4*)(x + off + 4) = acc[ai][bj][m][1] * rs * *(const f32x4*)(gain + col + 4);
                }
                asm volatile("" ::: "memory"); __builtin_amdgcn_sched_barrier(0);
            }
    }
};

struct EpiUp {
    const float* ssp; const float* cw; const float* cb; bf16_t* act; float* HB; float* FB;
    __device__ __forceinline__ void operator()(Acc& acc, const Unit& u, int wr, int wc, int fr, int fq, LAS unsigned char* ldsx, int tid) const {
        LAS float* Hl = (LAS float*)ldsx;
        LAS float* rsl = (LAS float*)(ldsx + 10240);
        const int lane = tid & 63;
        if (tid < 256) { const int row = u.pm * 256 + tid; const float sq = (ssp[row] + ssp[M + row]) + (ssp[2 * M + row] + ssp[3 * M + row]); rsl[tid] = 1.0f / sqrtf(sq * (1.0f / D) + EPS); }
        WG_BAR();
#pragma unroll
        for (int ai = 0; ai < 2; ++ai)
#pragma unroll
            for (int m = 0; m < 4; ++m) {
                const float rs = rsl[ai * 128 + wr * 64 + m * 16 + fr];
#pragma unroll
                for (int bj = 0; bj < 2; ++bj) { acc[ai][bj][m][0] *= rs; acc[ai][bj][m][1] *= rs; }
                asm volatile("" ::: "memory"); __builtin_amdgcn_sched_barrier(0);
            }
        if (tid < 128) *(LAS f32x4*)(Hl + tid * 4) = (f32x4){0.f, 0.f, 0.f, 0.f};
#pragma unroll
        for (int ai = 0; ai < 2; ++ai) {
            const int k = 2 * ai + wr;
#pragma unroll
            for (int bj = 0; bj < 2; ++bj)
#pragma unroll
                for (int n = 0; n < 2; ++n) {
                    const int tc = 128 * bj + 32 * wc + 8 * fq + 4 * n; const int uc = bj * FF + u.pn * 128 + 32 * wc + 8 * fq + 4 * n;
                    if (fr >= 14) { *(LAS f32x4*)(Hl + ((k + 1) * 2 + (fr - 14)) * 256 + tc) = acc[ai][bj][3][n]; if (k == 3) *(f32x4*)(HB + ((size_t)u.pm * 2 + (fr - 14)) * UP + uc) = acc[ai][bj][3][n]; }
                    if (k == 0 && fr < 2) *(f32x4*)(FB + ((size_t)u.pm * 2 + fr) * UP + uc) = acc[0][bj][0][n];
                }
        }
        WG_BAR();
#pragma unroll
        for (int ai = 0; ai < 2; ++ai) {
            const int k = 2 * ai + wr;
            u32x2 pk[4];
#pragma unroll
            for (int n = 0; n < 2; ++n) {
                const int tc = 32 * wc + 8 * fq + 4 * n; const int ucg = u.pn * 128 + tc;
                f32x4 cg[4];
#pragma unroll
                for (int bj = 0; bj < 2; ++bj) {
                    const int uc = bj * FF + ucg;
                    const f32x4 w0 = *(const f32x4*)(cw + uc), w1 = *(const f32x4*)(cw + UP + uc), w2 = *(const f32x4*)(cw + 2 * UP + uc), bb = *(const f32x4*)(cb + uc);
                    const f32x4 h0 = *(const LAS f32x4*)(Hl + (k * 2 + 0) * 256 + 128 * bj + tc), h1 = *(const LAS f32x4*)(Hl + (k * 2 + 1) * 256 + 128 * bj + tc);
#pragma unroll
                    for (int m = 0; m < 4; ++m) {
                        const f32x4 V = acc[ai][bj][m][n]; f32x4 p1, p2;
#pragma unroll
                        for (int e = 0; e < 4; ++e) {
                            const float r1 = dppf<0x121>(V[e]), r2 = dppf<0x122>(V[e]); float x1, x2;
                            if (m > 0) { x1 = dppf<0x121>(acc[ai][bj][m > 0 ? m - 1 : 0][n][e]); x2 = dppf<0x122>(acc[ai][bj][m > 0 ? m - 1 : 0][n][e]); }
                            else { x1 = h1[e]; x2 = (fr == 0) ? h0[e] : h1[e]; }
                            p1[e] = (fr == 0) ? x1 : r1; p2[e] = (fr < 2) ? x2 : r2;
                        }
                        const f32x4 cv = bb + w0 * p2 + w1 * p1 + w2 * V;
                        __builtin_amdgcn_sched_barrier(0);
                        if (bj == 0) cg[m] = cv;
                        else {
                            const int row = u.pm * 256 + ai * 128 + wr * 64 + m * 16 + fr;
                            float o[4];
#pragma unroll
                            for (int e = 0; e < 4; ++e) { const float gt = cg[m][e]; o[e] = gt * sigmoidf_(gt) * cv[e]; }
                            u32x2 w; w.x = cvt_pk_bf16(o[0], o[1]); w.y = cvt_pk_bf16(o[2], o[3]);
                            if (n == 0) pk[m] = w;
                            else { u32x4 w4; w4.x = pk[m].x; w4.y = pk[m].y; w4.z = w.x; w4.w = w.y; *(u32x4*)(act + (size_t)row * FF + ucg - 4) = w4; }
                        }
                    }
                    asm volatile("" ::: "memory"); __builtin_amdgcn_sched_barrier(0);
                }
            }
        }
        WG_BAR();
    }
};

namespace att {
constexpr int SLOT_B = 16384, NSLOT = 6;
constexpr int OFF_K = 0, OFF_IMP = NSLOT * SLOT_B, IMPW = 132, OFF_SEL = OFF_IMP + 64 * IMPW * 4, OFF_UNI = OFF_SEL + 1024, OFF_LIST = OFF_UNI + 64, OFF_N = OFF_LIST + 132 * 4, OFF_CODE = OFF_N + 48, CODEW = 144;
static_assert(OFF_CODE + 8 * CODEW <= LDS_BYTES - 16 && 8 * SLOT_B <= OFF_SEL, "attention LDS map");
struct Ctx {
    const bf16_t *Q, *KCC, *VCT, *KS, *VST, *KW, *VWT; const float* gates; bf16_t* O;
};
__device__ __forceinline__ bf16x8 mk8(s16x4 a, s16x4 b) { return (bf16x8){a[0], a[1], a[2], a[3], b[0], b[1], b[2], b[3]}; }

template <int MODE>
__device__ __forceinline__ void branch(LAS unsigned char* lds, const bf16_t* Kg, const bf16_t* Vg, int ktile_elems, int nt, int c, int w, int lane, int tid,
                                       const bf16x8 (&qf)[4][2], float (&mrow)[4], float (&lrow)[4], f32x4 (&O)[4][4]) {
    const int fr = lane & 15, fq = lane >> 4;
    const LAS int* list = (const LAS int*)(lds + OFF_LIST);
    LAS float* impL = (LAS float*)(lds + OFF_IMP);
    const LAS unsigned char* codeL = (const LAS unsigned char*)(lds + OFF_CODE) + w * CODEW;
    constexpr int TPS = (MODE >= 2) ? 4 : 3;
#define ATT_DMA(ti, slot) do { const int ti_ = (ti); const int s_ = list[ti_]; LAS unsigned char* d_ = lds + OFF_K + (slot) * SLOT_B + w * 1024; \
        int t2_ = tid; asm volatile("" : "+v"(t2_)); const int lr = t2_ >> 3, lq = t2_ & 7; const int goff = lr * 64 + ((lq ^ ((lr >> 1) & 7)) * 8); \
        __builtin_amdgcn_global_load_lds((const unsigned*)(Kg + (size_t)s_ * ktile_elems + goff), (LAS unsigned*)d_, 16, 0, 0); \
        if (MODE != 0) __builtin_amdgcn_global_load_lds((const unsigned*)(Vg + (size_t)s_ * 4096 + goff), (LAS unsigned*)(d_ + 8192), 16, 0, 0); } while (0)
    asm volatile("s_waitcnt vmcnt(0)" ::: "memory");
#pragma unroll
    for (int ti = 0; ti < TPS; ++ti) if (ti < nt) ATT_DMA(ti, ti);
    const int nst = (nt + TPS - 1) / TPS;
    for (int j = 0; j < nst; ++j) {
        asm volatile("s_waitcnt vmcnt(0)" ::: "memory");
        WG_BAR();
#pragma unroll
        for (int hh = 0; hh < TPS; ++hh) if (TPS * (j + 1) + hh < nt) ATT_DMA(TPS * (j + 1) + hh, ((j + 1) & 1) * TPS + hh);
        int sl0 = 0, sl1 = 0, sl2 = 0, sl3 = 0; unsigned codes4 = 0xffffffffu;
        if (TPS == 4) {
            const u32x4 l4 = *(const LAS u32x4*)(list + TPS * j);
            sl0 = __builtin_amdgcn_readfirstlane((int)l4.x); sl1 = __builtin_amdgcn_readfirstlane((int)l4.y); sl2 = __builtin_amdgcn_readfirstlane((int)l4.z); sl3 = __builtin_amdgcn_readfirstlane((int)l4.w);
            if (MODE == 2) codes4 = (unsigned)__builtin_amdgcn_readfirstlane((int)*(const LAS unsigned*)(codeL + TPS * j));
        }
#pragma unroll 1
        for (int h = 0; h < TPS; ++h) {
        const int i = TPS * j + h; if (i >= nt) break;
        const int s = (TPS == 4) ? (h == 0 ? sl0 : h == 1 ? sl1 : h == 2 ? sl2 : sl3) : list[i];
        unsigned code = 0xffu; if (MODE == 2) code = (codes4 >> (8 * h)) & 0xffu;
        const LAS unsigned char* Kb = lds + OFF_K + ((j & 1) * TPS + h) * SLOT_B;
        const LAS unsigned char* Vb = Kb;
        int l2_ = lane; asm volatile("" : "+v"(l2_)); const int fr2 = l2_ & 15, fq2 = l2_ >> 4, swz = (fr2 >> 1) & 7;
        const int kb0 = fr2 * 128 + ((fq2 ^ swz) * 16), kb1 = kb0 ^ 64;
        if (MODE != 2) {
            f32x4 sa[4][4];
#pragma unroll
            for (int p = 0; p < 4; ++p) {
                const float cinit = (MODE == 1) ? lrow[p] : -((mrow[p] < -1e29f) ? 0.f : mrow[p]);
#pragma unroll
                for (int mt = 0; mt < 4; ++mt) sa[p][mt] = (f32x4){cinit, cinit, cinit, cinit};
            }
#pragma unroll
            for (int mt = 0; mt < 4; ++mt)
#pragma unroll
                for (int ks = 0; ks < 2; ++ks) {
                    const bf16x8 kf = *(const LAS bf16x8*)(Kb + (ks ? kb1 : kb0) + mt * 2048);
#pragma unroll
                    for (int p = 0; p < 4; ++p) sa[p][mt] = __builtin_amdgcn_mfma_f32_16x16x32_bf16(kf, qf[p][ks], sa[p][mt], 0, 0, 0);
                }
            bf16x8 pf[4][2];
#pragma unroll
            for (int p = 0; p < 4; ++p) {
                const int ttA = 8 * w + 2 * p, tt = ttA + (fr >> 3);
                bool needmask;
                if (MODE <= 1) needmask = (((64 * c + ttA - 31) >> 4) - 64 * s) < 63;
                else needmask = (s == c) || (c >= 8 && s == c - 8);
                if (needmask) {
                    int hi, lov = -1;
                    if (MODE <= 1) { const int t = 64 * c + tt; hi = ((t - 31) >> 4) - 64 * s; }
                    else { hi = (s == c) ? tt : 63; lov = (c >= 8 && s == c - 8) ? tt : -1; }
#pragma unroll
                    for (int mt = 0; mt < 4; ++mt)
#pragma unroll
                        for (int j = 0; j < 4; ++j) { const int kk = 16 * mt + 4 * fq + j; sa[p][mt][j] = (kk <= hi && kk > lov) ? sa[p][mt][j] : -1e30f; }
                }
                if (MODE != 1) {
                    float mx = fmaxf(fmaxf(sa[p][0][0], sa[p][0][1]), sa[p][0][2]);
                    mx = fmaxf(fmaxf(mx, sa[p][0][3]), sa[p][1][0]); mx = fmaxf(fmaxf(mx, sa[p][1][1]), sa[p][1][2]); mx = fmaxf(fmaxf(mx, sa[p][1][3]), sa[p][2][0]);
                    mx = fmaxf(fmaxf(mx, sa[p][2][1]), sa[p][2][2]); mx = fmaxf(fmaxf(mx, sa[p][2][3]), sa[p][3][0]); mx = fmaxf(fmaxf(mx, sa[p][3][1]), sa[p][3][2]); mx = fmaxf(mx, sa[p][3][3]);
                    mx = xrow16_max(mx);
                    const bool uninit = mrow[p] < -1e29f;
                    const bool resc = (mx > 8.0f) || (uninit && mx > -1e29f);
                    if (__any(resc)) {
                        const float delta = resc ? mx : 0.f;
                        const float alpha = (resc && !uninit) ? ex2(-delta) : 1.0f;
#pragma unroll
                        for (int mt = 0; mt < 4; ++mt) sa[p][mt] = sa[p][mt] - delta;
                        lrow[p] *= alpha;
                        if (MODE >= 2) {
#pragma unroll
                            for (int d = 0; d < 4; ++d) O[p][d] *= alpha;
                        }
                        if (resc) mrow[p] = (uninit ? 0.f : mrow[p]) + delta;
                    }
                }
#pragma unroll
                for (int mt = 0; mt < 4; ++mt)
#pragma unroll
                    for (int j = 0; j < 4; ++j) sa[p][mt][j] = ex2(sa[p][mt][j]);
                if (MODE != 1) { const f32x4 t4 = (sa[p][0] + sa[p][1]) + (sa[p][2] + sa[p][3]); lrow[p] += (t4[0] + t4[1]) + (t4[2] + t4[3]); }
                if (MODE >= 1) {
#pragma unroll
                    for (int k2 = 0; k2 < 2; ++k2) {
                        u32x4 wv; wv.x = cvt_pk_bf16(sa[p][2 * k2][0], sa[p][2 * k2][1]); wv.y = cvt_pk_bf16(sa[p][2 * k2][2], sa[p][2 * k2][3]); wv.z = cvt_pk_bf16(sa[p][2 * k2 + 1][0], sa[p][2 * k2 + 1][1]); wv.w = cvt_pk_bf16(sa[p][2 * k2 + 1][2], sa[p][2 * k2 + 1][3]);
                        pf[p][k2] = __builtin_bit_cast(bf16x8, wv);
                    }
                }
                if (MODE == 1) {
#pragma unroll
                    for (int mt = 0; mt < 4; ++mt) {
                        float a = sa[p][mt][0] + sa[p][mt][1] + sa[p][mt][2] + 0.5f * sa[p][mt][3], bn = 0.5f * sa[p][mt][3];
                        a = sum8(a); bn = sum8(bn);
                        const int sb = 16 * s + 4 * mt + fq;
                        if ((fr & 7) == 0) { (void)__hip_atomic_fetch_add(impL + tt * IMPW + sb, a, __ATOMIC_RELAXED, __HIP_MEMORY_SCOPE_WORKGROUP); (void)__hip_atomic_fetch_add(impL + tt * IMPW + sb + 1, bn, __ATOMIC_RELAXED, __HIP_MEMORY_SCOPE_WORKGROUP); }
                    }
                }
            }
            if (MODE >= 1) {
#pragma unroll
                for (int d = 0; d < 4; ++d)
#pragma unroll
                    for (int k2 = 0; k2 < 2; ++k2) {
                        const bf16x8 vf = *(const LAS bf16x8*)(Vb + 8192 + (k2 ? kb1 : kb0) + d * 2048);
#pragma unroll
                        for (int p = 0; p < 4; ++p) O[p][d] = __builtin_amdgcn_mfma_f32_16x16x32_bf16(vf, pf[p][k2], O[p][d], 0, 0, 0);
                    }
            }
            __builtin_amdgcn_sched_barrier(0);
        } else {
#pragma unroll
        for (int p = 0; p < 4; ++p) {
            const int ttA = 8 * w + 2 * p;
            const unsigned mA = (code >> (2 * p)) & 1u, mB = (code >> (2 * p + 1)) & 1u;
            if ((mA | mB) != 0u) {
            const int tt = ttA + (fr >> 3);
            float cinit;
            if (MODE == 1) cinit = lrow[p];
            else { const float mref = (mrow[p] < -1e29f) ? 0.f : mrow[p]; const bool colact = (MODE != 2) || (((fr >> 3) ? mB : mA) != 0u); cinit = colact ? -mref : -1e30f; }
            f32x4 sa[4];
#pragma unroll
            for (int mt = 0; mt < 4; ++mt) sa[mt] = (f32x4){cinit, cinit, cinit, cinit};
#pragma unroll
            for (int hf_ = 0; hf_ < 2; ++hf_) {
                bf16x8 kf[4];
#pragma unroll
                for (int i4 = 0; i4 < 4; ++i4) kf[i4] = *(const LAS bf16x8*)(Kb + ((i4 & 1) ? kb1 : kb0) + (2 * hf_ + (i4 >> 1)) * 2048);
                __builtin_amdgcn_sched_barrier(0);
#pragma unroll
                for (int i4 = 0; i4 < 4; ++i4) sa[2 * hf_ + (i4 >> 1)] = __builtin_amdgcn_mfma_f32_16x16x32_bf16(kf[i4], qf[p][i4 & 1], sa[2 * hf_ + (i4 >> 1)], 0, 0, 0);
            }
            bool needmask;
            if (MODE <= 1) needmask = (((64 * c + ttA - 31) >> 4) - 64 * s) < 63;
            else if (MODE == 2) needmask = (s == c);
            else needmask = (s == c) || (c >= 8 && s == c - 8);
            if (needmask) {
                int hi, lov = -1;
                if (MODE <= 1) { const int t = 64 * c + tt; hi = ((t - 31) >> 4) - 64 * s; }
                else if (MODE == 2) hi = tt;
                else { hi = (s == c) ? tt : 63; lov = (c >= 8 && s == c - 8) ? tt : -1; }
#pragma unroll
                for (int mt = 0; mt < 4; ++mt)
#pragma unroll
                    for (int j = 0; j < 4; ++j) { const int kk = 16 * mt + 4 * fq + j; sa[mt][j] = (kk <= hi && kk > lov) ? sa[mt][j] : -1e30f; }
            }
            if (MODE != 1) {
                float mx = fmaxf(fmaxf(sa[0][0], sa[0][1]), sa[0][2]);
                mx = fmaxf(fmaxf(mx, sa[0][3]), sa[1][0]); mx = fmaxf(fmaxf(mx, sa[1][1]), sa[1][2]); mx = fmaxf(fmaxf(mx, sa[1][3]), sa[2][0]);
                mx = fmaxf(fmaxf(mx, sa[2][1]), sa[2][2]); mx = fmaxf(fmaxf(mx, sa[2][3]), sa[3][0]); mx = fmaxf(fmaxf(mx, sa[3][1]), sa[3][2]); mx = fmaxf(mx, sa[3][3]);
                mx = xrow16_max(mx);
                const bool uninit = mrow[p] < -1e29f;
                const bool resc = (mx > 8.0f) || (uninit && mx > -1e29f);
                if (__any(resc)) {
                    const float delta = resc ? mx : 0.f;
                    const float alpha = (resc && !uninit) ? ex2(-delta) : 1.0f;
#pragma unroll
                    for (int mt = 0; mt < 4; ++mt) sa[mt] = sa[mt] - delta;
                    lrow[p] *= alpha;
                    if (MODE >= 2) {
#pragma unroll
                        for (int d = 0; d < 4; ++d) O[p][d] *= alpha;
                    }
                    if (resc) mrow[p] = (uninit ? 0.f : mrow[p]) + delta;
                }
            }
            f32x4 pv[4];
#pragma unroll
            for (int mt = 0; mt < 4; ++mt)
#pragma unroll
                for (int j = 0; j < 4; ++j) pv[mt][j] = ex2(sa[mt][j]);
            if (MODE != 1) { const f32x4 t4 = (pv[0] + pv[1]) + (pv[2] + pv[3]); lrow[p] += (t4[0] + t4[1]) + (t4[2] + t4[3]); }
            if (MODE >= 1) {
                bf16x8 pf[2];
#pragma unroll
                for (int k2 = 0; k2 < 2; ++k2) {
                    u32x4 wv; wv.x = cvt_pk_bf16(pv[2 * k2][0], pv[2 * k2][1]); wv.y = cvt_pk_bf16(pv[2 * k2][2], pv[2 * k2][3]); wv.z = cvt_pk_bf16(pv[2 * k2 + 1][0], pv[2 * k2 + 1][1]); wv.w = cvt_pk_bf16(pv[2 * k2 + 1][2], pv[2 * k2 + 1][3]);
                    pf[k2] = __builtin_bit_cast(bf16x8, wv);
                }
#pragma unroll
                for (int hf_ = 0; hf_ < 2; ++hf_) {
                    bf16x8 vf[4];
#pragma unroll
                    for (int i4 = 0; i4 < 4; ++i4) vf[i4] = *(const LAS bf16x8*)(Vb + 8192 + ((i4 & 1) ? kb1 : kb0) + (2 * hf_ + (i4 >> 1)) * 2048);
                    __builtin_amdgcn_sched_barrier(0);
#pragma unroll
                    for (int i4 = 0; i4 < 4; ++i4) O[p][2 * hf_ + (i4 >> 1)] = __builtin_amdgcn_mfma_f32_16x16x32_bf16(vf[i4], pf[i4 & 1], O[p][2 * hf_ + (i4 >> 1)], 0, 0, 0);
                }
            }
            if (MODE == 1) {
#pragma unroll
                for (int mt = 0; mt < 4; ++mt) {
                    float a = pv[mt][0] + pv[mt][1] + pv[mt][2] + 0.5f * pv[mt][3], bn = 0.5f * pv[mt][3];
                    a = sum8(a); bn = sum8(bn);
                    const int sb = 16 * s + 4 * mt + fq;
                    if ((fr & 7) == 0) { (void)__hip_atomic_fetch_add(impL + tt * IMPW + sb, a, __ATOMIC_RELAXED, __HIP_MEMORY_SCOPE_WORKGROUP); (void)__hip_atomic_fetch_add(impL + tt * IMPW + sb + 1, bn, __ATOMIC_RELAXED, __HIP_MEMORY_SCOPE_WORKGROUP); }
                }
            }
            }
            __builtin_amdgcn_sched_barrier(0);
        }
        }
        }
    }
    WG_BAR();
#undef ATT_DMA
}

__device__ __forceinline__ void unit(LAS unsigned char* lds, const Ctx& X, int b, int g, int c, int tid_in) {
    int tid = tid_in; asm volatile("" : "+v"(tid));
    const int lane = tid & 63, w = __builtin_amdgcn_readfirstlane(tid >> 6), fr = lane & 15, fq = lane >> 4;
    LAS int* list = (LAS int*)(lds + OFF_LIST);
    LAS unsigned* selm = (LAS unsigned*)(lds + OFF_SEL);
    LAS unsigned* uni = (LAS unsigned*)(lds + OFF_UNI);
    LAS float* impL = (LAS float*)(lds + OFF_IMP);
    LAS int* nl = (LAS int*)(lds + OFF_N);
    const int bg = b * 2 + g; const size_t rowbase = (size_t)b * T + 64 * c;
    bf16x8 qf[4][2];
#pragma unroll
    for (int p = 0; p < 4; ++p) { const bf16_t* qp = X.Q + (rowbase + 8 * w + 2 * p + (fr >> 3)) * 1024 + (8 * g + (fr & 7)) * 64 + 8 * fq;
#pragma unroll
        for (int ks = 0; ks < 2; ++ks) qf[p][ks] = *(const bf16x8*)(qp + 32 * ks); }
    for (int i = lane; i < 8 * IMPW; i += 64) impL[(8 * w) * IMPW + i] = 0.f;
    const int ncmp = (4 * c + 3 + 63) >> 6;
    if (tid < 8) list[tid] = tid;
    float mrow[4], lrow[4]; f32x4 O[4][4];
#pragma unroll
    for (int p = 0; p < 4; ++p) { mrow[p] = -1e30f; lrow[p] = 0.f;
#pragma unroll
        for (int d = 0; d < 4; ++d) { O[p][d] = (f32x4){0.f, 0.f, 0.f, 0.f}; } }
    WG_BAR();
    const bf16_t* kcc = X.KCC + (size_t)bg * 512 * 64; const bf16_t* vct = X.VCT + (size_t)bg * 8 * 4096;
    branch<0>(lds, kcc, vct, 4096, ncmp, c, w, lane, tid, qf, mrow, lrow, O);
#pragma unroll
    for (int p = 0; p < 4; ++p) { float l = xrow16_sum(lrow[p]); lrow[p] = (l > 0.f) ? (-mrow[p] - __builtin_amdgcn_logf(l)) : -1e30f; }
    branch<1>(lds, kcc, vct, 4096, ncmp, c, w, lane, tid, qf, mrow, lrow, O);
#define ATT_GATE(br, scale_expr) do { _Pragma("unroll") for (int p = 0; p < 4; ++p) { \
        const size_t grow = rowbase + 8 * w + 2 * p + (fr >> 3); \
        const float gt = X.gates[grow * 48 + (8 * g + (fr & 7)) * 3 + (br)]; const float sc = gt * (scale_expr); \
        _Pragma("unroll") for (int d = 0; d < 4; ++d) { \
            u32x2* optr = (u32x2*)(X.O + grow * 1024 + (8 * g + (fr & 7)) * 64 + 4 * fq + 16 * d); u32x2 ot = (u32x2){0u, 0u}; if ((br) > 0) ot = *optr; \
            float o0 = __uint_as_float(ot.x << 16), o1 = __uint_as_float(ot.x & 0xffff0000u), o2 = __uint_as_float(ot.y << 16), o3 = __uint_as_float(ot.y & 0xffff0000u); \
            o0 += sc * O[p][d][0]; o1 += sc * O[p][d][1]; o2 += sc * O[p][d][2]; o3 += sc * O[p][d][3]; \
            ot.x = cvt_pk_bf16(o0, o1); ot.y = cvt_pk_bf16(o2, o3); O[p][d] = (f32x4){0.f, 0.f, 0.f, 0.f}; \
            *optr = ot; } \
        mrow[p] = -1e30f; lrow[p] = 0.f; } } while (0)
    ATT_GATE(0, 1.0f);
    LDS_WAIT();
    for (int q8 = 0; q8 < 8; ++q8) {
        const int tt = 8 * w + q8;
        unsigned long long blo, bhi;
        if (c + 1 <= 16) { blo = (1ull << (c + 1)) - 1ull; bhi = 0ull; }
        else {
            const int s1 = lane, s2 = lane + 64;
            const bool c1 = (s1 >= 1 && s1 <= c - 2), c2 = (s2 >= 1 && s2 <= c - 2);
            const float v1 = c1 ? impL[tt * IMPW + s1] : -1.f, v2 = c2 ? impL[tt * IMPW + s2] : -1.f;
            int r1 = 0, r2 = 0;
            const int nq = (c - 2) / 4 + 1;
#pragma unroll 2
            for (int q = 0; q < nq; ++q) {
                const f32x4 x4 = *(const LAS f32x4*)(impL + tt * IMPW + 4 * q);
#pragma unroll
                for (int e = 0; e < 4; ++e) { const int sp = 4 * q + e; const float x = (sp >= 1 && sp <= c - 2) ? x4[e] : -2.f;
                    r1 += (x > v1 || (x == v1 && sp < s1)) ? 1 : 0; r2 += (x > v2 || (x == v2 && sp < s2)) ? 1 : 0; }
            }
            const bool f1 = (s1 == 0 || s1 == c || s1 == c - 1), f2 = (s2 == c || s2 == c - 1);
            blo = __ballot((c1 && r1 < 13) || f1); bhi = __ballot((c2 && r2 < 13) || f2);
        }
        if (lane == 0) { selm[tt * 4 + 0] = (unsigned)blo; selm[tt * 4 + 1] = (unsigned)(blo >> 32); selm[tt * 4 + 2] = (unsigned)bhi; selm[tt * 4 + 3] = (unsigned)(bhi >> 32); }
    }
    WG_BAR();
    if (tid < 4) { unsigned o = 0; for (int i = 0; i < 64; ++i) o |= selm[i * 4 + tid]; uni[tid] = o; }
    WG_BAR();
    if (tid == 0) { int n = 0; for (int s = 0; s <= c; ++s) if ((uni[s >> 5] >> (s & 31)) & 1u) list[n++] = s; nl[0] = n; }
    WG_BAR();
    const int nsel = nl[0];
    { LAS unsigned char* cw_ = (LAS unsigned char*)(lds + OFF_CODE) + w * CODEW;
      for (int i = lane; i < nsel; i += 64) { const int s_ = list[i]; unsigned cd = 0;
#pragma unroll
          for (int q8 = 0; q8 < 8; ++q8) cd |= ((selm[(8 * w + q8) * 4 + (s_ >> 5)] >> (s_ & 31)) & 1u) << q8;
          cw_[i] = (unsigned char)cd; }
      LDS_WAIT(); }
    branch<2>(lds, X.KS + (size_t)bg * T * 64, X.VST + (size_t)bg * 128 * 4096, 4096, nsel, c, w, lane, tid, qf, mrow, lrow, O);
#pragma unroll
    for (int p = 0; p < 4; ++p) { float l = xrow16_sum(lrow[p]); lrow[p] = (l > 0.f) ? 1.0f / l : 0.f; }
    { float rl[4] = {lrow[0], lrow[1], lrow[2], lrow[3]}; ATT_GATE(1, rl[p]); }
    const int w0 = (c >= 8) ? c - 8 : 0, nwin = c - w0 + 1;
    if (tid < nwin) list[tid] = w0 + tid;
    WG_BAR();
    branch<3>(lds, X.KW + (size_t)bg * T * 64, X.VWT + (size_t)bg * 128 * 4096, 4096, nwin, c, w, lane, tid, qf, mrow, lrow, O);
#pragma unroll
    for (int p = 0; p < 4; ++p) { float l = xrow16_sum(lrow[p]); lrow[p] = (l > 0.f) ? 1.0f / l : 0.f; }
    { float rl[4] = {lrow[0], lrow[1], lrow[2], lrow[3]}; ATT_GATE(2, rl[p]); }
#undef ATT_GATE
    WG_BAR();
}
}

__device__ __forceinline__ unsigned f2bf(float f) { unsigned u = __builtin_bit_cast(unsigned, f); return (u + 0x7fffu + ((u >> 16) & 1u)) >> 16; }
__device__ __forceinline__ unsigned pk2(float lo, float hi) { return f2bf(lo) | (f2bf(hi) << 16); }
template <int MAP>
__device__ __forceinline__ int rowmap(int a) {
    if (MAP == 0) return perm8(a);
    if (MAP == 1) return a < 1792 ? ((a & ~63) | swap45(a & 63)) : a;
    if (MAP == 2) { if (a < FF) return 256 * (a >> 7) + perm8(a & 127); const int a2 = a - FF; return 256 * (a2 >> 7) + 128 + perm8(a2 & 127); }
    return swap45(a);
}
template <int MAP>
__device__ __forceinline__ void transpose_item(const float* W, int K, int N, bf16_t* WT, int row_off, const float* gain, LAS float* scr, int item, int lane) {
    const int nblk = (N + 31) / 32, kb = item / nblk, nb = item % nblk, k0 = 64 * kb, n0 = 32 * nb;
#pragma unroll
    for (int i = 0; i < 32; ++i) { const int kk = 2 * i + (lane >> 5); const int col = n0 + (lane & 31); float v = (col < N) ? W[(size_t)(k0 + kk) * N + col] : 0.f; if (gain) v *= gain[k0 + kk]; scr[kk * 33 + (lane & 31)] = v; }
    LDS_WAIT();
    const int cc = lane & 7;
#pragma unroll
    for (int j = 0; j < 4; ++j) { const int n = (lane >> 3) + 8 * j; const LAS float* s = scr + (8 * cc) * 33 + n;
        u32x4 o; o.x = pk2(s[0 * 33], s[1 * 33]); o.y = pk2(s[2 * 33], s[3 * 33]); o.z = pk2(s[4 * 33], s[5 * 33]); o.w = pk2(s[6 * 33], s[7 * 33]);
        if (n0 + n < N) *(u32x4*)(WT + (size_t)(row_off + rowmap<MAP>(n0 + n)) * K + k0 + 8 * cc) = o; }
    LDS_WAIT();
}

#define XB_TMO      128
#define XB_XCNT(j)  (256  + 64 * (j))
#define XB_XSUB(j)  (1280 + 64 * (j))
#define XB_XGEN(j)  (2304 + 64 * (j))
#define XB_TOP      3328
#define XB_TOPGEN   3392
#define XCD_BAR_WORDS 3456
#define XB_SPIN_CAP (1u << 18)
__device__ __forceinline__ unsigned xb_ld(unsigned* p)              { return __hip_atomic_load(p, __ATOMIC_RELAXED, __HIP_MEMORY_SCOPE_AGENT); }
__device__ __forceinline__ unsigned xb_add(unsigned* p, unsigned v) { return __hip_atomic_fetch_add(p, v, __ATOMIC_RELAXED, __HIP_MEMORY_SCOPE_AGENT); }
__device__ __forceinline__ unsigned xb_xcc_id() { return (unsigned)__builtin_amdgcn_s_getreg((3 << 11) | 20) & 0xFu; }
#define XB_SPIN(cond, bar) do { unsigned _sp = 0; while (cond) { __builtin_amdgcn_s_sleep(1); \
    if ((++_sp & 255u) == 0u) { if (xb_ld(&(bar)[XB_TMO])) break; if (_sp > XB_SPIN_CAP) { atomicAdd(&(bar)[XB_TMO], 1u); break; } } } } while (0)
struct XcdBarrier { unsigned* bar; unsigned x; volatile LAS unsigned* st; };
__device__ __forceinline__ XcdBarrier xcd_barrier_post(unsigned* bar, volatile LAS unsigned* st) {
    XcdBarrier b; b.bar = bar; b.x = xb_xcc_id(); b.st = st;
    if (threadIdx.x == 0) (void)xb_add(&bar[XB_XCNT(b.x)], 1u);
    return b;
}
__device__ __forceinline__ void xcd_barrier_complete(unsigned* bar, unsigned x, unsigned& nloc, unsigned& nx) {
    const unsigned G = gridDim.x * gridDim.y * gridDim.z;
    unsigned sum, cnt, mine, sp = 0u;
    for (;;) {
        sum = 0u; cnt = 0u; mine = 0u;
#pragma unroll
        for (unsigned j = 0; j < 16; ++j) { const unsigned c = xb_ld(&bar[XB_XCNT(j)]); sum += c; cnt += (c > 0u) ? 1u : 0u; mine = (j == x) ? c : mine; }
        if (sum == G) break;
        __builtin_amdgcn_s_sleep(1);
        if ((++sp & 255u) == 0u) { if (xb_ld(&bar[XB_TMO])) break; if (sp > XB_SPIN_CAP) { atomicAdd(&bar[XB_TMO], 1u); break; } }
    }
    nloc = mine > 0u ? mine : 1u; nx = cnt > 0u ? cnt : 1u;
}
__device__ __forceinline__ void xcd_barrier(const XcdBarrier& b) {
    asm volatile("s_waitcnt vmcnt(0)" ::: "memory");
    __syncthreads();
    if (threadIdx.x == 0) {
        unsigned* bar = b.bar;
        __builtin_amdgcn_s_waitcnt(0);
        unsigned nloc = b.st[0], nx = b.st[1];
        if (nloc == 0u) { xcd_barrier_complete(bar, b.x, nloc, nx); b.st[0] = nloc; b.st[1] = nx; }
        const unsigned old = xb_add(&bar[XB_XSUB(b.x)], 1u);
        const unsigned gen = old / nloc;
        if (old + 1u == (gen + 1u) * nloc) {
            __builtin_amdgcn_fence(__ATOMIC_RELEASE, "agent");
            asm volatile("s_waitcnt vmcnt(0)" ::: "memory");
            const unsigned og = xb_add(&bar[XB_TOP], 1u);
            const unsigned tg = og / nx;
            if (og + 1u == (tg + 1u) * nx) xb_add(&bar[XB_TOPGEN], 1u);
            else XB_SPIN(xb_ld(&bar[XB_TOPGEN]) == tg, bar);
            __builtin_amdgcn_fence(__ATOMIC_ACQUIRE, "agent");
            xb_add(&bar[XB_XGEN(b.x)], 1u);
            asm volatile("s_waitcnt vmcnt(0)" ::: "memory");
        } else {
            XB_SPIN(xb_ld(&bar[XB_XGEN(b.x)]) == gen, bar);
            __builtin_amdgcn_fence(__ATOMIC_ACQUIRE, "agent");
            asm volatile("s_waitcnt vmcnt(0)" ::: "memory");
        }
    }
    __syncthreads();
}

struct Args { const float* in[29]; float* out; unsigned char* ws; float inv[32]; int ph_lo, ph_hi; };

constexpr int DI_UP = 16 * 176, DI_DN = 44 * 32, DI_PL = 4 * 8, N_DEFER = 2 * DI_UP + 2 * DI_DN + 4 * DI_PL;
__device__ __forceinline__ void ffn_weight_item(const Args& a, unsigned char* ws, LAS float* scr, int r, int lane) {
    if (r < DI_UP) { transpose_item<2>(a.in[15], D, UP, (bf16_t*)(ws + WS_WUP0), 0, a.in[14], scr, r, lane); return; } r -= DI_UP;
    if (r < DI_UP) { transpose_item<2>(a.in[24], D, UP, (bf16_t*)(ws + WS_WUP1), 0, a.in[23], scr, r, lane); return; } r -= DI_UP;
    if (r < DI_DN) { transpose_item<0>(a.in[18], FF, D, (bf16_t*)(ws + WS_WDN0), 0, nullptr, scr, r, lane); return; } r -= DI_DN;
    if (r < DI_DN) { transpose_item<0>(a.in[27], FF, D, (bf16_t*)(ws + WS_WDN1), 0, nullptr, scr, r, lane); return; } r -= DI_DN;
    const int gi = r / DI_PL; transpose_item<0>(a.in[20] + (size_t)gi * 65536, 256, 256, (bf16_t*)(ws + WS_WPOOL), gi * 256, nullptr, scr, r % DI_PL, lane);
}

__global__ void __launch_bounds__(512) mk_fwd(Args a) {
    extern __shared__ __attribute__((aligned(16))) unsigned char lds_raw[];
    LAS unsigned char* lds = (LAS unsigned char*)lds_raw;
    LAS unsigned char* ldsx = lds + LDS_RING;
    cg::grid_group grid = cg::this_grid();
    if (threadIdx.x < 2) ((volatile LAS unsigned*)(lds + LDS_BYTES - 16))[threadIdx.x] = 0u;
    __syncthreads();
    if (a.ph_hi == 0x7fff) grid.sync();
    const XcdBarrier xbar = xcd_barrier_post((unsigned*)a.ws, (volatile LAS unsigned*)(lds + LDS_BYTES - 16));
    const int tid = threadIdx.x, lane = tid & 63, wave = __builtin_amdgcn_readfirstlane(tid >> 6);
    const int G = gridDim.x, bx = blockIdx.x;
    unsigned char* ws = a.ws;
#define cosT ((float*)(ws + WS_ROPE))
#define sinT ((float*)(ws + WS_ROPE) + T * 32)
#define ssp ((float*)(ws + WS_SSP))
#define c1p ((float*)(ws + WS_C1P))
#define rstdv ((float*)(ws + WS_RSTD))
#define HB ((float*)(ws + WS_HB))
#define FB ((float*)(ws + WS_FB))
#define gates ((float*)(ws + WS_GATE))
#define Wt_in ((bf16_t*)(ws + WS_WIN))
#define Wt_out ((bf16_t*)(ws + WS_WOUT))
#define Wt_pool ((bf16_t*)(ws + WS_WPOOL))
#define Wt_c1 (kv ? (bf16_t*)(ws + WS_WC1V) : (bf16_t*)(ws + WS_WC1K))
#define Wt_c2 (kv ? (bf16_t*)(ws + WS_WC2V) : (bf16_t*)(ws + WS_WC2K))
#define XB ((bf16_t*)(ws + WS_XB))
#define Qb ((bf16_t*)(ws + WS_Q))
#define KC ((bf16_t*)(ws + WS_KC))
#define VC ((bf16_t*)(ws + WS_VC))
#define KS ((bf16_t*)(ws + WS_KS))
#define VST ((bf16_t*)(ws + WS_VST))
#define KW ((bf16_t*)(ws + WS_KW))
#define VWT ((bf16_t*)(ws + WS_VWT))
#define KCC ((bf16_t*)(ws + WS_KCC))
#define VCT ((bf16_t*)(ws + WS_VCT))
#define Ob ((bf16_t*)(ws + WS_O))
#define ACT ((bf16_t*)(ws + WS_ACT))
#define POOLED ((bf16_t*)(ws + WS_POOLED))
    float* out = a.out;
    const int lo = a.ph_lo, hi = a.ph_hi;
    const bool defer = (G == 256);
#define IN(k) (lo <= (k) && (k) < hi)
#define SEAM(k) do { if (IN(k) && IN((k) + 1)) xcd_barrier(xbar); } while (0)

    if (IN(0)) {
        LAS float* scr = (LAS float*)(lds + wave * 16384);
        const int gw = bx * 8 + wave, NGW = G * 8;
        constexpr int I_IN = 16 * 58, I_OUT = 16 * 32, I_C1 = 32 * 8, I_C2 = 4 * 2;
        constexpr int NA = I_IN + I_OUT + 2 * I_C1 + 2 * I_C2;
        const int NIT = NA + (defer ? 0 : N_DEFER);
        for (int it = gw; it < NIT; it += NGW) {
            int r = it;
            if (r < I_IN) { transpose_item<1>(a.in[2], D, 1840, Wt_in, 0, a.in[1], scr, r, lane); continue; } r -= I_IN;
            if (r < I_OUT) { transpose_item<0>(a.in[13], D, D, Wt_out, 0, nullptr, scr, r, lane); continue; } r -= I_OUT;
            if (r < I_C1) { transpose_item<0>(a.in[4], 2048, 256, (bf16_t*)(ws + WS_WC1K), 0, nullptr, scr, r, lane); continue; } r -= I_C1;
            if (r < I_C1) { transpose_item<0>(a.in[9], 2048, 256, (bf16_t*)(ws + WS_WC1V), 0, nullptr, scr, r, lane); continue; } r -= I_C1;
            if (r < I_C2) { transpose_item<3>(a.in[6], 256, 64, (bf16_t*)(ws + WS_WC2K), 0, nullptr, scr, r, lane); continue; } r -= I_C2;
            if (r < I_C2) { transpose_item<3>(a.in[11], 256, 64, (bf16_t*)(ws + WS_WC2V), 0, nullptr, scr, r, lane); continue; } r -= I_C2;
            ffn_weight_item(a, ws, scr, r, lane);
        }
        for (int m = gw; m < M; m += 2 * NGW) {
            const int m2 = m + NGW;
            const f32x4* xr = (const f32x4*)(a.in[0] + (size_t)m * D) + lane; const f32x4* xr2 = (const f32x4*)(a.in[0] + (size_t)m2 * D) + lane;
            f32x4 v[4], w[4];
#pragma unroll
            for (int j = 0; j < 4; ++j) { v[j] = xr[64 * j]; w[j] = (m2 < M) ? xr2[64 * j] : (f32x4){0.f, 0.f, 0.f, 0.f}; }
            unsigned long long* o8 = (unsigned long long*)(XB + (size_t)m * D) + lane; unsigned long long* o82 = (unsigned long long*)(XB + (size_t)m2 * D) + lane; float s1 = 0.f, s2 = 0.f;
#pragma unroll
            for (int j = 0; j < 4; ++j) {
                s1 += (v[j][0] * v[j][0] + v[j][1] * v[j][1]) + (v[j][2] * v[j][2] + v[j][3] * v[j][3]); o8[64 * j] = (unsigned long long)pk2(v[j][0], v[j][1]) | ((unsigned long long)pk2(v[j][2], v[j][3]) << 32);
                s2 += (w[j][0] * w[j][0] + w[j][1] * w[j][1]) + (w[j][2] * w[j][2] + w[j][3] * w[j][3]); if (m2 < M) o82[64 * j] = (unsigned long long)pk2(w[j][0], w[j][1]) | ((unsigned long long)pk2(w[j][2], w[j][3]) << 32);
            }
#pragma unroll
            for (int o = 1; o < 64; o <<= 1) { s1 += __shfl_xor(s1, o); s2 += __shfl_xor(s2, o); }
            if (lane == 0) { rstdv[m] = 1.0f / sqrtf(s1 * (1.0f / D) + EPS); if (m2 < M) rstdv[m2] = 1.0f / sqrtf(s2 * (1.0f / D) + EPS); }
        }
        for (int i = bx * 512 + tid; i < T * 32; i += G * 512) {
            const int t = i >> 5, f = i & 31; const float ang = (float)t * a.inv[f];
            double x = (double)ang * 0.15915494309189535; x -= __builtin_rint(x); const float xf = (float)x;
            cosT[i] = __builtin_amdgcn_cosf(xf); sinT[i] = __builtin_amdgcn_sinf(xf);
        }
        for (int it = NGW - 1 - gw; it < 256; it += NGW) {
            const int kv = it >> 7, chunk = (it >> 2) & 31, nb = it & 3; const float* pos = a.in[kv ? 8 : 3]; const float* w1 = a.in[kv ? 9 : 4];
            float s = 0.f;
#pragma unroll 32
            for (int r = 0; r < 64; ++r) { const int rr = chunk * 64 + r; s += pos[rr] * w1[(size_t)rr * 256 + nb * 64 + lane]; }
            c1p[(kv * 32 + chunk) * 256 + nb * 64 + lane] = s;
        }
        asm volatile("s_waitcnt vmcnt(0) lgkmcnt(0)" ::: "memory"); __syncthreads();
    }
    SEAM(0);
    if (IN(1)) {
        pg8::Gemm g{XB, Wt_in, M, NIN, D, D, 0}; pg8::StaticOrder S; S.init(M, NIN, G, bx);
        EpiIn E{rstdv, cosT, sinT, Qb, KC, VC, KS, VST, KW, VWT, gates};
        pg8::gemm_phase(lds, ldsx, g, S, E);
    }
    SEAM(1);
    if (IN(2)) {
        const int tid = threadIdx.x, lane = tid & 63, w = __builtin_amdgcn_readfirstlane(tid >> 6), fr = lane & 15, fq = lane >> 4;
        LAS float* c1s = (LAS float*)lds;
        LAS unsigned char* hidL = lds + 4096;
        for (int i = tid; i < 512; i += 512) { const int kv = i >> 8, n = i & 255; const float* b1 = a.in[kv ? 10 : 5]; float sv = b1[n]; for (int q = 0; q < 32; ++q) sv += c1p[(kv * 32 + q) * 256 + n]; c1s[i] = sv; }
        __syncthreads();
        for (int u = bx; u < 256; u += G) {
            const int kv = u >> 7, r0 = (u & 127) * 16;
            const bf16_t* Ap = (kv ? VC : KC) + (size_t)(r0 + fr) * 1024 + 8 * fq;
            const bf16_t* Bp = Wt_c1 + (size_t)(32 * w + fr) * 2048 + 8 * fq;
            f32x4 h0 = (f32x4){0.f, 0.f, 0.f, 0.f}, h1 = h0;
#pragma unroll 1
            for (int k0 = 0; k0 < 2048; k0 += 256) {
                bf16x8 af[8], b0[8], b1f[8];
#pragma unroll
                for (int q = 0; q < 8; ++q) { af[q] = *(const bf16x8*)(Ap + k0 + 32 * q); b0[q] = *(const bf16x8*)(Bp + k0 + 32 * q); b1f[q] = *(const bf16x8*)(Bp + 16 * 2048 + k0 + 32 * q); }
#pragma unroll
                for (int q = 0; q < 8; ++q) { h0 = __builtin_amdgcn_mfma_f32_16x16x32_bf16(b0[q], af[q], h0, 0, 0, 0); h1 = __builtin_amdgcn_mfma_f32_16x16x32_bf16(b1f[q], af[q], h1, 0, 0, 0); }
            }
            { const int c0 = 32 * w + 8 * fq; float v[8];
#pragma unroll
              for (int e = 0; e < 8; ++e) { const float x = ((e >> 2) ? h1[e & 3] : h0[e & 3]) + c1s[kv * 256 + c0 + e]; const float y = 0.7978845608028654f * (x + 0.044715f * x * x * x); v[e] = x * sigmoidf_(2.0f * y); }
              u32x4 wv; wv.x = cvt_pk_bf16(v[0], v[1]); wv.y = cvt_pk_bf16(v[2], v[3]); wv.z = cvt_pk_bf16(v[4], v[5]); wv.w = cvt_pk_bf16(v[6], v[7]);
              *(LAS u32x4*)(hidL + fr * 528 + c0 * 2) = wv; }
            __syncthreads();
            if (w < 2) {
                const bf16_t* W2 = Wt_c2 + (size_t)(32 * w + fr) * 256 + 8 * fq;
                f32x4 oA = (f32x4){0.f, 0.f, 0.f, 0.f}, oB = oA;
#pragma unroll
                for (int q = 0; q < 8; ++q) {
                    const bf16x8 hf = *(const LAS bf16x8*)(hidL + fr * 528 + (32 * q + 8 * fq) * 2);
                    const bf16x8 wa = *(const bf16x8*)(W2 + 32 * q), wb = *(const bf16x8*)(W2 + 16 * 256 + 32 * q);
                    oA = __builtin_amdgcn_mfma_f32_16x16x32_bf16(wa, hf, oA, 0, 0, 0); oB = __builtin_amdgcn_mfma_f32_16x16x32_bf16(wb, hf, oB, 0, 0, 0);
                }
                const float* b2 = a.in[kv ? 12 : 7]; const int d0 = 16 * w + 4 * fq; const int row = r0 + fr, j = row & 511;
                f32x4 a1 = oA + *(const f32x4*)(b2 + d0), a2 = oB + *(const f32x4*)(b2 + d0 + 32);
                if (j == 511) { a1 = (f32x4){0.f, 0.f, 0.f, 0.f}; a2 = a1; }
                if (!kv) {
                    const int pos = (j == 511) ? 0 : 16 * j + 31;
                    const f32x4 cs = *(const f32x4*)(cosT + pos * 32 + d0), sn = *(const f32x4*)(sinT + pos * 32 + d0);
                    const f32x4 o1 = a1 * cs - a2 * sn, o2 = a1 * sn + a2 * cs;
                    bf16_t* p = KCC + (size_t)row * 64 + d0;
                    u32x2 w1; w1.x = cvt_pk_bf16(o1[0], o1[1]); w1.y = cvt_pk_bf16(o1[2], o1[3]); *(u32x2*)p = w1;
                    u32x2 w2; w2.x = cvt_pk_bf16(o2[0], o2[1]); w2.y = cvt_pk_bf16(o2[2], o2[3]); *(u32x2*)(p + 32) = w2;
                } else {
                    bf16_t* p = VCT + (size_t)(row >> 6) * 4096 + vperm(row & 63);
#pragma unroll
                    for (int e = 0; e < 4; ++e) { p[(d0 + e) * 64] = (bf16_t)(cvt_pk_bf16(a1[e], 0.f) & 0xffff); p[(d0 + 32 + e) * 64] = (bf16_t)(cvt_pk_bf16(a2[e], 0.f) & 0xffff); }
                }
            }
            __syncthreads();
        }
    }
    if (IN(2) && IN(4)) xcd_barrier(xbar);
    if (IN(4)) {
        att::Ctx X{Qb, KCC, VCT, KS, VST, KW, VWT, gates, Ob};
        for (int k = bx; k < 256; k += G) {
            for (int rep = 0; rep < 2; ++rep) { const int uu = rep ? 511 - k : k; const int c = 127 - (uu >> 2), bgi = uu & 3; att::unit(lds, X, bgi >> 1, bgi & 1, c, tid); }
        }
        if (defer) {
            int td = threadIdx.x; asm volatile("" : "+v"(td)); const int dl = td & 63, dw = __builtin_amdgcn_readfirstlane(td >> 6);
            LAS float* scr = (LAS float*)(lds + dw * 16384);
            for (int it = bx * 8 + dw; it < N_DEFER; it += 2048) ffn_weight_item(a, ws, scr, it, dl);
        }
    }
    SEAM(4);
    if (IN(5)) {
        pg8::Gemm g{Ob, Wt_out, M, D, D, D, 0}; pg8::StaticOrder S; S.init(M, D, G, bx);
        EpiRes E{a.in[0], out, XB, ssp, nullptr, nullptr, XB};
        pg8::gemm_phase(lds, ldsx, g, S, E);
    }
    SEAM(5);
#pragma unroll
    for (int L = 0; L < 2; ++L) {
        const int pb = 6 + 5 * L;
        const float* cw = a.in[L ? 25 : 16]; const float* cb = a.in[L ? 26 : 17];
        if (IN(pb)) {
            pg8::Gemm g{(const bf16_t*)(ws + (L ? WS_XB2 : WS_XB)), (const bf16_t*)(ws + (L ? WS_WUP1 : WS_WUP0)), M, UP, D, D, 0}; pg8::StaticOrder S; S.init(M, UP, G, bx);
            EpiUp E{L ? ssp + 4 * M : ssp, cw, cb, ACT, HB, FB};
            pg8::gemm_phase(lds, ldsx, g, S, E);
        }
        SEAM(pb);
        if (IN(pb + 1)) {
            for (int i = bx * 512 + tid; i < 64 * FF; i += G * 512) {
                const int pm = i / FF, cidx = i % FF;
                float hg0 = 0.f, hg1 = 0.f, hv0 = 0.f, hv1 = 0.f;
                if (pm & 31) { const float* h = HB + (size_t)(pm - 1) * 2 * UP; hg0 = h[cidx]; hg1 = h[UP + cidx]; hv0 = h[FF + cidx]; hv1 = h[UP + FF + cidx]; }
                const float* f = FB + (size_t)pm * 2 * UP; const float fg0 = f[cidx], fg1 = f[UP + cidx], fv0 = f[FF + cidx], fv1 = f[UP + FF + cidx];
                const float g0 = cb[cidx] + cw[cidx] * hg0 + cw[UP + cidx] * hg1 + cw[2 * UP + cidx] * fg0;
                const float g1 = cb[cidx] + cw[cidx] * hg1 + cw[UP + cidx] * fg0 + cw[2 * UP + cidx] * fg1;
                const float v0 = cb[FF + cidx] + cw[FF + cidx] * hv0 + cw[UP + FF + cidx] * hv1 + cw[2 * UP + FF + cidx] * fv0;
                const float v1 = cb[FF + cidx] + cw[FF + cidx] * hv1 + cw[UP + FF + cidx] * fv0 + cw[2 * UP + FF + cidx] * fv1;
                ACT[(size_t)(pm * 256) * FF + cidx] = (bf16_t)f2bf(g0 * sigmoidf_(g0) * v0);
                ACT[(size_t)(pm * 256 + 1) * FF + cidx] = (bf16_t)f2bf(g1 * sigmoidf_(g1) * v1);
            }
        }
        SEAM(pb + 1);
        if (IN(pb + 2)) {
            pg8::Gemm g{ACT, (const bf16_t*)(ws + (L ? WS_WDN1 : WS_WDN0)), M, D, FF, FF, 0}; pg8::StaticOrder S; S.init(M, D, G, bx);
            bf16_t* XBL = (bf16_t*)(ws + (L ? WS_XB2 : WS_XB));
            if (L == 1 && G == 256) { EpiFinal E{out, a.in[28], (float*)(ws + WS_SSP + 512 * 1024), (unsigned*)(ws + 16384), XBL}; pg8::gemm_phase(lds, ldsx, g, S, E); }
            else { EpiRes E{out, out, XBL, ssp, nullptr, nullptr, XBL}; pg8::gemm_phase(lds, ldsx, g, S, E); }
        }
        if (!(L == 1 && G == 256)) { if (IN(pb + 2)) xcd_barrier(xbar); }
        if (L == 0) {
            if (IN(10)) {
                pg8::Gemm g{POOLED, Wt_pool, M, D, 256, D, 512}; pg8::StaticOrder S; S.init(M, D, G, bx);
                {
                    LAS float* rsd = (LAS float*)lds;
                    const float* gn = a.in[19];
                    int tid = threadIdx.x; asm volatile("" : "+v"(tid));
                    pg8::Unit pu;
                    for (int ui = 0; S.next(ui, pu); ++ui) {
                        const int r0 = pu.pm * 256, tb = r0 & (T - 1), wsz = 2 << pu.pn;
                        const int c8 = pu.pn * 256 + (tid & 31) * 8, t0 = (tid >> 5) * 16;
                        const f32x4 gv0 = *(const f32x4*)(gn + c8), gv1 = *(const f32x4*)(gn + c8 + 4);
                        __syncthreads();
                        if (tid < 272) { const int rr = r0 - 16 + tid; rsd[tid] = (tb - 16 + tid >= 0) ? row_rstd(ssp, 4, rr) : 0.f; }
                        __syncthreads();
                        const bf16_t* xb0 = XB + (size_t)r0 * D + c8;
#define POOL_H(tl, lo, hi) do { unpk8(*(const u32x4*)(xb0 + (ptrdiff_t)(tl) * D), lo, hi); const float rs_ = rsd[16 + (tl)]; lo = lo * rs_; hi = hi * rs_; } while (0)
                        f32x4 s0 = (f32x4){0.f, 0.f, 0.f, 0.f}, s1 = s0;
                        for (int i = 1; i <= wsz; ++i) { const int tl = t0 - i; if (tb + tl >= 0) { f32x4 a0, a1; POOL_H(tl, a0, a1); s0 += a0; s1 += a1; } }
#pragma unroll 4
                        for (int tl = t0; tl < t0 + 16; ++tl) {
                            f32x4 h0, h1; POOL_H(tl, h0, h1); s0 += h0; s1 += h1;
                            const int td = tl - wsz; if (tb + td >= 0) { f32x4 d0, d1; POOL_H(td, d0, d1); s0 -= d0; s1 -= d1; }
                            const int t = tb + tl; const int cnt = (t + 1 < wsz) ? t + 1 : wsz; const float ic = 1.0f / (float)cnt;
                            const f32x4 p0 = (s0 * ic - h0) * gv0, p1 = (s1 * ic - h1) * gv1;
                            u32x4 wv; wv.x = cvt_pk_bf16(p0[0], p0[1]); wv.y = cvt_pk_bf16(p0[2], p0[3]); wv.z = cvt_pk_bf16(p1[0], p1[1]); wv.w = cvt_pk_bf16(p1[2], p1[3]);
                            *(u32x4*)(POOLED + (size_t)(r0 + tl) * D + c8) = wv;
                        }
#undef POOL_H
                    }
                    asm volatile("s_waitcnt vmcnt(0)" ::: "memory"); __syncthreads();
                }
                EpiRes E{out, out, XB, ssp + 4 * M, a.in[21], a.in[22], (bf16_t*)(ws + WS_XB2)};
                pg8::gemm_phase(lds, ldsx, g, S, E);
            }
            SEAM(10);
        }
    }
    if (IN(14) && G != 256) {
        int t14 = threadIdx.x; asm volatile("" : "+v"(t14)); const int lane = t14 & 63, wave = __builtin_amdgcn_readfirstlane(t14 >> 6);
        const int gw = bx * 8 + wave, NGW = G * 8; const float* gn = a.in[28];
        for (int m = gw; m < M; m += NGW) {
            const float rs = row_rstd(ssp, 4, m); f32x4* xr = (f32x4*)(out + (size_t)m * D) + lane; const f32x4* gr = (const f32x4*)gn + lane;
            const u32x2* xbr = (const u32x2*)(ws + WS_XB2) + (size_t)m * (D / 4) + lane;
#pragma unroll
            for (int j = 0; j < 4; ++j) { const u32x2 v = xbr[64 * j]; const f32x4 xv = (f32x4){__uint_as_float(v.x << 16), __uint_as_float(v.x & 0xffff0000u), __uint_as_float(v.y << 16), __uint_as_float(v.y & 0xffff0000u)}; xr[64 * j] = xv * rs * gr[64 * j]; }
        }
    }
#undef IN
#undef SEAM
#undef cosT
#undef sinT
#undef ssp
#undef c1p
#undef rstdv
#undef HB
#undef FB
#undef gates
#undef Wt_in
#undef Wt_out
#undef Wt_pool
#undef Wt_c1
#undef Wt_c2
#undef XB
#undef Qb
#undef KC
#undef VC
#undef KS
#undef VST
#undef KW
#undef VWT
#undef KCC
#undef VCT
#undef Ob
#undef ACT
#undef POOLED
}

extern "C" void kernel_launch(void* const* d_in, const int* in_sizes, int n_in, void* d_out, int out_size, void* d_ws, size_t ws_size, hipStream_t stream) {
    static int grid = 0;
    if (grid == 0) {
        int dev = 0, cus = 0, per_cu = 0;
        hipGetDevice(&dev); hipDeviceGetAttribute(&cus, hipDeviceAttributeMultiprocessorCount, dev);
        hipFuncSetAttribute((const void*)mk_fwd, hipFuncAttributeMaxDynamicSharedMemorySize, LDS_BYTES);
        hipOccupancyMaxActiveBlocksPerMultiprocessor(&per_cu, (const void*)mk_fwd, 512, LDS_BYTES);
        if (per_cu < 1) per_cu = 1;
        grid = cus * per_cu; if (grid > 256) grid = 256;
        (void)hipGetLastError();
    }
    Args a{};
    for (int i = 0; i < 29; ++i) a.in[i] = (const float*)d_in[i];
    a.out = (float*)d_out; a.ws = (unsigned char*)d_ws;
    for (int i = 0; i < 32; ++i) a.inv[i] = 1.0f / powf(10000.0f, (float)(2 * i) / 64.0f);
    a.ph_lo = 0; a.ph_hi = 15;
    hipMemsetAsync(d_ws, 0, 65536, stream);
    void* args[] = {&a};
    hipError_t e = hipLaunchCooperativeKernel((const void*)mk_fwd, dim3(grid), dim3(512), args, LDS_BYTES, stream);
    if (e != hipSuccess) fprintf(stderr, "cooperative launch failed: %s (grid %d)\n", hipGetErrorString(e), grid);
}
```

```cpp
#include <hip/hip_runtime.h>
#include <hip/hip_cooperative_groups.h>
#include <cstdio>
#include <cstdint>
namespace cg = cooperative_groups;

#define LAS __attribute__((address_space(3)))
typedef unsigned short bf16_t;
typedef short bf16x8 __attribute__((ext_vector_type(8)));
typedef short s16x4 __attribute__((ext_vector_type(4)));
typedef float f32x4 __attribute__((ext_vector_type(4)));
typedef unsigned u32x4 __attribute__((ext_vector_type(4)));
typedef unsigned u32x2 __attribute__((ext_vector_type(2)));

constexpr int T = 8192, D = 1024, M = 16384, FF = 2816, UP = 5632, NIN = 2048;
constexpr float EPS = 1e-6f;
constexpr float QSCALE = 0.125f * 1.4426950408889634f;
constexpr size_t MiB = 1u << 20;
constexpr size_t WS_ROPE = 1 * MiB;
constexpr size_t WS_SSP = 3 * MiB;
constexpr size_t WS_C1P = 4 * MiB;
constexpr size_t WS_RSTD = 4 * MiB + 256 * 1024;
constexpr size_t WS_HB = 5 * MiB;
constexpr size_t WS_FB = 8 * MiB;
constexpr size_t WS_GATE = 11 * MiB;
constexpr size_t WS_WIN = 16 * MiB, WS_WOUT = 20 * MiB, WS_WUP0 = 22 * MiB, WS_WUP1 = 33 * MiB, WS_WDN0 = 44 * MiB, WS_WDN1 = 50 * MiB;
constexpr size_t WS_WPOOL = 56 * MiB, WS_WC1K = 57 * MiB, WS_WC1V = 58 * MiB, WS_WC2K = 59 * MiB, WS_WC2V = 59 * MiB + 512 * 1024;
constexpr size_t WS_XB = 64 * MiB;
constexpr size_t WS_Q = 96 * MiB;
constexpr size_t WS_KC = 128 * MiB, WS_VC = 132 * MiB, WS_KS = 136 * MiB, WS_VST = 140 * MiB, WS_KW = 144 * MiB, WS_VWT = 148 * MiB;
constexpr size_t WS_KCC = 152 * MiB, WS_VCT = 153 * MiB, WS_HIDK = 154 * MiB, WS_HIDV = 155 * MiB;
constexpr size_t WS_O = 160 * MiB;
constexpr size_t WS_ACT = 96 * MiB;
constexpr size_t WS_POOLED = 192 * MiB;
constexpr size_t WS_XB2 = 224 * MiB;
constexpr int LDS_RING = 131072, LDS_BYTES = 155648;

__device__ __forceinline__ unsigned cvt_pk_bf16(float lo, float hi) { unsigned r; asm volatile("v_cvt_pk_bf16_f32 %0, %1, %2" : "=v"(r) : "v"(lo), "v"(hi)); return r; }
__device__ __forceinline__ float bf2f(unsigned short b) { return __uint_as_float((unsigned)b << 16); }
__device__ __forceinline__ float ex2(float x) { return __builtin_amdgcn_exp2f(x); }
__device__ __forceinline__ float rcp(float x) { return __builtin_amdgcn_rcpf(x); }
__device__ __forceinline__ float sigmoidf_(float x) { return rcp(1.0f + ex2(-1.4426950408889634f * x)); }
__device__ __forceinline__ void unpk8(const u32x4 v, f32x4& lo, f32x4& hi) { lo = (f32x4){__uint_as_float(v.x << 16), __uint_as_float(v.x & 0xffff0000u), __uint_as_float(v.y << 16), __uint_as_float(v.y & 0xffff0000u)}; hi = (f32x4){__uint_as_float(v.z << 16), __uint_as_float(v.z & 0xffff0000u), __uint_as_float(v.w << 16), __uint_as_float(v.w & 0xffff0000u)}; }
__device__ __forceinline__ int perm8(int a) { return (a & ~31) | (16 * ((a >> 2) & 1) + 4 * ((a >> 3) & 3) + (a & 3)); }
__device__ __forceinline__ int vperm(int kk) { return (kk & 32) | (((kk >> 2) & 3) << 3) | (((kk >> 4) & 1) << 2) | (kk & 3); }
__device__ __forceinline__ int swap45(int a) { return (a & ~48) | (((a >> 4) & 1) << 5) | (((a >> 5) & 1) << 4); }
template <int CTRL> __device__ __forceinline__ float dppf(float x) { return __builtin_bit_cast(float, __builtin_amdgcn_mov_dpp(__builtin_bit_cast(int, x), CTRL, 0xf, 0xf, true)); }
__device__ __forceinline__ float xrow16_max(float x) {
    auto s = __builtin_amdgcn_permlane16_swap(__float_as_uint(x), __float_as_uint(x), false, false); x = fmaxf(__uint_as_float(s[0]), __uint_as_float(s[1]));
    auto t = __builtin_amdgcn_permlane32_swap(__float_as_uint(x), __float_as_uint(x), false, false); return fmaxf(__uint_as_float(t[0]), __uint_as_float(t[1])); }
__device__ __forceinline__ float xrow16_sum(float x) {
    auto s = __builtin_amdgcn_permlane16_swap(__float_as_uint(x), __float_as_uint(x), false, false); x = __uint_as_float(s[0]) + __uint_as_float(s[1]);
    auto t = __builtin_amdgcn_permlane32_swap(__float_as_uint(x), __float_as_uint(x), false, false); return __uint_as_float(t[0]) + __uint_as_float(t[1]); }
__device__ __forceinline__ float sum8(float x) { x += dppf<0xB1>(x); x += dppf<0x4E>(x); x += dppf<0x141>(x); return x; }
#define LDS_WAIT() asm volatile("s_waitcnt lgkmcnt(0)" ::: "memory")
#define WG_BAR() do { asm volatile("s_waitcnt lgkmcnt(0)" ::: "memory"); __builtin_amdgcn_s_barrier(); asm volatile("" ::: "memory"); } while (0)

namespace pg8 {
constexpr int BM = 256, BK = 64, HALF = 128, HTB = HALF * BK * 2, NXCD = 8, WGM = 8;
__host__ __device__ __forceinline__ int lds_byte(int r, int c) { const int st = (r >> 4) * 2 + (c >> 5), rr = r & 15, cc = c & 31, ob = rr * 64 + cc * 2; return st * 1024 + (ob ^ (((ob >> 9) & 1) << 5)); }
__host__ __device__ __forceinline__ void stage_rc(int b, int& R, int& C) { const int st = b / 1024, sb = b % 1024, swz = sb ^ (((sb >> 9) & 1) << 5); R = (st >> 1) * 16 + swz / 64; C = (st & 1) * 32 + (swz % 64) / 2; }
struct Unit { int pm, pn; };
struct Gemm { const bf16_t* A; const bf16_t* Bt; int M, N, K, lda, apn; };
struct StaticOrder {
    int nM, nN, nwg, G, c;
    __device__ __forceinline__ void init(int M_, int N_, int G_, int c_) { nM = M_ / BM; nN = N_ / BM; nwg = nM * nN; G = G_; c = c_; }
    __device__ __forceinline__ bool next(int i, Unit& u) const {
        const long L = (long)i * G + c; if (L >= nwg) return false;
        int wgid = (int)L; { const int q = nwg / NXCD, r = nwg % NXCD, xcd = wgid % NXCD, off = wgid / NXCD; wgid = (xcd < r ? xcd * (q + 1) : r * (q + 1) + (xcd - r) * q) + off; }
        const int nig = WGM * nN, gid = wgid / nig, fm = gid * WGM, gsz = (nM - fm) < WGM ? (nM - fm) : WGM;
        u.pm = fm + ((wgid % nig) % gsz); u.pn = (wgid % nig) / gsz; return true;
    }
};
template <class Epi>
__device__ __forceinline__ void gemm_phase(LAS unsigned char* lds, LAS unsigned char* ldsx, const Gemm g, const StaticOrder& S, const Epi& E) {
    int tid = threadIdx.x; asm volatile("" : "+v"(tid));
    const int wid = __builtin_amdgcn_readfirstlane(tid >> 6), lane = tid & 63, wr = wid >> 2, wc = wid & 3, fr = lane & 15, fq = lane >> 4;
    const int K = g.K, nt = K / BK;
    unsigned voffA[2], voffB[2];
#pragma unroll
    for (int i = 0; i < 2; ++i) { int R, C; stage_rc(tid * 16 + i * 8192, R, C); voffA[i] = (unsigned)(R * g.lda + C) * 2u; voffB[i] = (unsigned)(R * K + C) * 2u; }
    const size_t kstep = (size_t)(BK * 2);
    const size_t hstepA = (size_t)HALF * g.lda * 2, tstepA = 2 * hstepA, hstepB = (size_t)HALF * K * 2, tstepB = 2 * hstepB;
    const unsigned ldsw = (unsigned)wid * 1024u;
    const int aoff = lds_byte(wr * 64 + fr, fq * 8), boff = lds_byte(wc * 32 + fr, fq * 8);
#define PG8_SA(b, h) (((b) * 2 + (h)) * HTB)
#define PG8_SB(b, h) ((4 + (b) * 2 + (h)) * HTB)
#define PG8_STAGE(bufoff, gbase, voff) do { _Pragma("unroll") for (int _i = 0; _i < 2; ++_i) \
        __builtin_amdgcn_global_load_lds((const unsigned*)((const char*)(gbase) + (voff)[_i]), (LAS unsigned*)(lds + (bufoff) + ldsw + _i * 8192), 16, 0, 0); } while (0)
#define PG8_LDA(dst, b, h) do { _Pragma("unroll") for (int m = 0; m < 4; ++m) _Pragma("unroll") for (int k = 0; k < 2; ++k) dst[m][k] = *(const LAS bf16x8*)(lds + PG8_SA(b, h) + aoff + m * 2048 + k * 1024); } while (0)
#define PG8_LDB(dst, b, h) do { _Pragma("unroll") for (int n = 0; n < 2; ++n) _Pragma("unroll") for (int k = 0; k < 2; ++k) dst[n][k] = *(const LAS bf16x8*)(lds + PG8_SB(b, h) + boff + n * 2048 + k * 1024); } while (0)
#define PG8_MMA(ai, bj, At, Bt) do { __builtin_amdgcn_s_setprio(1); _Pragma("unroll") for (int m = 0; m < 4; ++m) _Pragma("unroll") for (int n = 0; n < 2; ++n) _Pragma("unroll") for (int k = 0; k < 2; ++k) \
        acc[ai][bj][m][n] = __builtin_amdgcn_mfma_f32_16x16x32_bf16(Bt[n][k], At[m][k], acc[ai][bj][m][n], 0, 0, 0); __builtin_amdgcn_s_setprio(0); } while (0)
#define PG8_WAIT_V(n) asm volatile("s_waitcnt vmcnt(" #n ")" ::: "memory")
#define PG8_WAIT_L(n) asm volatile("s_waitcnt lgkmcnt(" #n ")" ::: "memory")
#define PG8_BAR __builtin_amdgcn_s_barrier()
#define PG8_SCHED __builtin_amdgcn_sched_barrier(0)
    Unit cur, nxt; int ui = 0;
    if (!S.next(0, cur)) return;
    f32x4 acc[2][2][4][2];
#pragma unroll
    for (int a = 0; a < 2; ++a)
#pragma unroll
        for (int b = 0; b < 2; ++b)
#pragma unroll
            for (int m = 0; m < 4; ++m)
#pragma unroll
                for (int n = 0; n < 2; ++n) acc[a][b][m][n] = (f32x4){0.f, 0.f, 0.f, 0.f};
    bf16x8 At[4][2], B0[2][2], B1[2][2];
    const char* cA = (const char*)g.A + (size_t)cur.pm * tstepA + (size_t)cur.pn * g.apn; const char* cB = (const char*)g.Bt + (size_t)cur.pn * tstepB;
    PG8_STAGE(PG8_SB(0, 0), cB, voffB); PG8_STAGE(PG8_SB(0, 1), cB + hstepB, voffB); PG8_STAGE(PG8_SA(0, 0), cA, voffA); PG8_STAGE(PG8_SA(0, 1), cA + hstepA, voffA);
    if (wr == 1) PG8_BAR;
    PG8_WAIT_V(2); PG8_BAR;
    PG8_STAGE(PG8_SB(1, 0), cB + kstep, voffB); PG8_STAGE(PG8_SA(1, 0), cA + kstep, voffA); PG8_STAGE(PG8_SB(1, 1), cB + hstepB + kstep, voffB);
    PG8_WAIT_V(6); PG8_BAR;
    for (;;) {
        const bool has_next = S.next(ui + 1, nxt);
        const char* nA = has_next ? (const char*)g.A + (size_t)nxt.pm * tstepA + (size_t)nxt.pn * g.apn : cA; const char* nB = has_next ? (const char*)g.Bt + (size_t)nxt.pn * tstepB : cB;
        for (int t = 0; t < nt; t += 2) {
            const bool last = (t == nt - 2);
            const char* a1 = cA + (size_t)(t + 1) * kstep;
            const char* a2 = last ? nA : cA + (size_t)(t + 2) * kstep; const char* b2 = last ? nB : cB + (size_t)(t + 2) * kstep;
            const char* a3 = a2 + kstep; const char* b3 = b2 + kstep;
            PG8_LDB(B0, 0, 0); PG8_LDB(B1, 0, 1); PG8_SCHED; PG8_LDA(At, 0, 0); PG8_STAGE(PG8_SA(1, 1), a1 + hstepA, voffA);
            PG8_WAIT_V(8); PG8_WAIT_L(0); PG8_BAR; PG8_MMA(0, 0, At, B0); PG8_MMA(0, 1, At, B1); PG8_BAR; PG8_SCHED;
            PG8_LDA(At, 0, 1); PG8_STAGE(PG8_SB(0, 0), b2, voffB); PG8_STAGE(PG8_SB(0, 1), b2 + hstepB, voffB); PG8_STAGE(PG8_SA(0, 0), a2, voffA);
            PG8_WAIT_V(8); PG8_WAIT_L(0); PG8_BAR; PG8_MMA(1, 0, At, B0); PG8_MMA(1, 1, At, B1); PG8_BAR; PG8_SCHED;
            PG8_LDB(B0, 1, 0); PG8_LDB(B1, 1, 1); PG8_SCHED; PG8_LDA(At, 1, 0); PG8_STAGE(PG8_SA(0, 1), a2 + hstepA, voffA);
            PG8_WAIT_V(8); PG8_WAIT_L(0); PG8_BAR; PG8_MMA(0, 0, At, B0); PG8_MMA(0, 1, At, B1); PG8_BAR; PG8_SCHED;
            PG8_LDA(At, 1, 1); PG8_STAGE(PG8_SB(1, 0), b3, voffB); PG8_STAGE(PG8_SB(1, 1), b3 + hstepB, voffB); PG8_STAGE(PG8_SA(1, 0), a3, voffA);
            PG8_WAIT_V(8); PG8_WAIT_L(0); PG8_BAR; PG8_MMA(1, 0, At, B0); PG8_MMA(1, 1, At, B1); PG8_BAR; PG8_SCHED;
        }
        if (wr == 0) PG8_BAR;
        { int t2 = threadIdx.x; asm volatile("" : "+v"(t2));
          E(acc, cur, wr, wc, t2 & 15, (t2 & 63) >> 4, ldsx, t2); }
        if (!has_next) break;
#pragma unroll
        for (int a = 0; a < 2; ++a)
#pragma unroll
            for (int b = 0; b < 2; ++b)
#pragma unroll
                for (int m = 0; m < 4; ++m)
#pragma unroll
                    for (int n = 0; n < 2; ++n) acc[a][b][m][n] = (f32x4){0.f, 0.f, 0.f, 0.f};
        cur = nxt; cA = nA; cB = nB; ++ui;
        if (wr == 1) PG8_BAR;
    }
    PG8_WAIT_V(0);
    PG8_BAR;
#undef PG8_SA
#undef PG8_SB
#undef PG8_STAGE
#undef PG8_LDA
#undef PG8_LDB
#undef PG8_MMA
#undef PG8_WAIT_V
#undef PG8_WAIT_L
#undef PG8_BAR
#undef PG8_SCHED
}
}
using pg8::Unit;
typedef f32x4 Acc[2][2][4][2];

__device__ __forceinline__ float row_rstd(const float* ssp, int np, int row) {
    float s = 0.f; for (int i = 0; i < np; ++i) s += ssp[(size_t)i * M + row];
    return 1.0f / sqrtf(s * (1.0f / D) + EPS);
}

struct EpiIn {
    const float* rstdv; const float* cosT; const float* sinT;
    bf16_t *Q, *KC, *VC, *KS, *VST, *KW, *VWT; float* gates;
    __device__ __forceinline__ void operator()(Acc& acc, const Unit& u, int wr, int wc, int fr, int fq, LAS unsigned char*, int) const {
#pragma unroll
        for (int ai = 0; ai < 2; ++ai)
#pragma unroll
            for (int m = 0; m < 4; ++m) {
                const int row = u.pm * 256 + ai * 128 + wr * 64 + m * 16 + fr; const float rs = rstdv[row];
                const int t = row & (T - 1), b = row >> 13;
                const int d0 = 16 * (wc & 1) + 4 * fq;
                const f32x4 cs = *(const f32x4*)(cosT + t * 32 + d0), sn = *(const f32x4*)(sinT + t * 32 + d0);
#pragma unroll
                for (int bj = 0; bj < 2; ++bj) {
                    f32x4 a1 = acc[ai][bj][m][0] * rs, a2 = acc[ai][bj][m][1] * rs;
                    if (u.pn == 7) {
                        if (bj == 0) {
#pragma unroll
                            for (int n = 0; n < 2; ++n) { const int c0 = 32 * wc + 16 * n + 4 * fq; if (c0 < 48) { const f32x4 v = n ? a2 : a1; f32x4 o; o[0] = sigmoidf_(v[0]); o[1] = sigmoidf_(v[1]); o[2] = sigmoidf_(v[2]); o[3] = sigmoidf_(v[3]); *(f32x4*)(gates + (size_t)row * 48 + c0) = o; } }
                        }
                        continue;
                    }
                    const int hh = 2 * bj + (wc >> 1);
                    bool rope; if (u.pn < 4) rope = true; else rope = (u.pn >= 5) && (hh < 2);
                    f32x4 o1 = a1, o2 = a2;
                    if (rope) { o1 = a1 * cs - a2 * sn; o2 = a1 * sn + a2 * cs; }
                    if (u.pn < 4) {
                        o1 = o1 * QSCALE; o2 = o2 * QSCALE;
                        bf16_t* p = Q + (size_t)row * 1024 + (u.pn * 4 + hh) * 64 + d0;
                        u32x2 w1; w1.x = cvt_pk_bf16(o1[0], o1[1]); w1.y = cvt_pk_bf16(o1[2], o1[3]); *(u32x2*)p = w1;
                        u32x2 w2; w2.x = cvt_pk_bf16(o2[0], o2[1]); w2.y = cvt_pk_bf16(o2[2], o2[3]); *(u32x2*)(p + 32) = w2;
                    } else {
                        const int gg = hh & 1; const bool isv = hh >= 2;
                        if (!isv) {
                            bf16_t* base = (u.pn == 4) ? KC : (u.pn == 5) ? KS : KW;
                            bf16_t* p = base + ((size_t)(b * 2 + gg) * T + t) * 64 + d0;
                            u32x2 w1; w1.x = cvt_pk_bf16(o1[0], o1[1]); w1.y = cvt_pk_bf16(o1[2], o1[3]); *(u32x2*)p = w1;
                            u32x2 w2; w2.x = cvt_pk_bf16(o2[0], o2[1]); w2.y = cvt_pk_bf16(o2[2], o2[3]); *(u32x2*)(p + 32) = w2;
                        } else if (u.pn == 4) {
                            bf16_t* p = VC + ((size_t)(b * 2 + gg) * T + t) * 64 + d0;
                            u32x2 w1; w1.x = cvt_pk_bf16(o1[0], o1[1]); w1.y = cvt_pk_bf16(o1[2], o1[3]); *(u32x2*)p = w1;
                            u32x2 w2; w2.x = cvt_pk_bf16(o2[0], o2[1]); w2.y = cvt_pk_bf16(o2[2], o2[3]); *(u32x2*)(p + 32) = w2;
                        } else {
                            bf16_t* base = (u.pn == 5) ? VST : VWT;
                            bf16_t* p = base + ((size_t)(b * 2 + gg) * 128 + (t >> 6)) * 4096 + vperm(t & 63);
#pragma unroll
                            for (int j = 0; j < 4; ++j) { p[(d0 + j) * 64] = (bf16_t)(cvt_pk_bf16(o1[j], 0.f) & 0xffff); p[(d0 + 32 + j) * 64] = (bf16_t)(cvt_pk_bf16(o2[j], 0.f) & 0xffff); }
                        }
                    }
                }
                asm volatile("" ::: "memory"); __builtin_amdgcn_sched_barrier(0);
            }
    }
};

struct EpiC1 {
    bf16_t* hid;
    __device__ __forceinline__ void operator()(Acc& acc, const Unit& u, int wr, int wc, int fr, int fq, LAS unsigned char* ldsx, int) const {
        const LAS float* c1 = (const LAS float*)ldsx;
#pragma unroll
        for (int bj = 0; bj < 2; ++bj) {
            const int c0 = 128 * bj + 32 * wc + 8 * fq;
            const f32x4 bA = *(const LAS f32x4*)(c1 + c0), bB = *(const LAS f32x4*)(c1 + c0 + 4);
#pragma unroll
            for (int ai = 0; ai < 2; ++ai)
#pragma unroll
                for (int m = 0; m < 4; ++m) {
                    const int row = u.pm * 256 + ai * 128 + wr * 64 + m * 16 + fr;
                    float v[8];
#pragma unroll
                    for (int e = 0; e < 8; ++e) { const float x = acc[ai][bj][m][e >> 2][e & 3] + ((e >> 2) ? bB[e & 3] : bA[e & 3]); const float y = 0.7978845608028654f * (x + 0.044715f * x * x * x); v[e] = x * sigmoidf_(2.0f * y); }
                    u32x4 w; w.x = cvt_pk_bf16(v[0], v[1]); w.y = cvt_pk_bf16(v[2], v[3]); w.z = cvt_pk_bf16(v[4], v[5]); w.w = cvt_pk_bf16(v[6], v[7]);
                    *(u32x4*)(hid + (size_t)row * 256 + c0) = w;
                    asm volatile("" ::: "memory"); __builtin_amdgcn_sched_barrier(0);
                }
        }
    }
};
struct EpiC2 {
    const float* b2; const float* cosT; const float* sinT; bf16_t* out; int isv;
    __device__ __forceinline__ void operator()(Acc& acc, const Unit& u, int wr, int wc, int fr, int fq, LAS unsigned char*, int) const {
        if (wc >= 2) return;
        const int d0 = 16 * (wc & 1) + 4 * fq;
        const f32x4 bA = *(const f32x4*)(b2 + d0), bB = *(const f32x4*)(b2 + d0 + 32);
#pragma unroll
        for (int ai = 0; ai < 2; ++ai)
#pragma unroll
            for (int m = 0; m < 4; ++m) {
                const int row = u.pm * 256 + ai * 128 + wr * 64 + m * 16 + fr; const int j = row & 511;
                f32x4 a1 = acc[ai][0][m][0] + bA, a2 = acc[ai][0][m][1] + bB;
                if (j == 511) { a1 = (f32x4){0.f, 0.f, 0.f, 0.f}; a2 = a1; }
                if (!isv) {
                    const int pos = (j == 511) ? 0 : 16 * j + 31;
                    const f32x4 cs = *(const f32x4*)(cosT + pos * 32 + d0), sn = *(const f32x4*)(sinT + pos * 32 + d0);
                    const f32x4 o1 = a1 * cs - a2 * sn, o2 = a1 * sn + a2 * cs;
                    bf16_t* p = out + (size_t)row * 64 + d0;
                    u32x2 w1; w1.x = cvt_pk_bf16(o1[0], o1[1]); w1.y = cvt_pk_bf16(o1[2], o1[3]); *(u32x2*)p = w1;
                    u32x2 w2; w2.x = cvt_pk_bf16(o2[0], o2[1]); w2.y = cvt_pk_bf16(o2[2], o2[3]); *(u32x2*)(p + 32) = w2;
                } else {
                    bf16_t* p = out + (size_t)(row >> 6) * 4096 + vperm(row & 63);
#pragma unroll
                    for (int e = 0; e < 4; ++e) { p[(d0 + e) * 64] = (bf16_t)(cvt_pk_bf16(a1[e], 0.f) & 0xffff); p[(d0 + 32 + e) * 64] = (bf16_t)(cvt_pk_bf16(a2[e], 0.f) & 0xffff); }
                }
                asm volatile("" ::: "memory"); __builtin_amdgcn_sched_barrier(0);
            }
    }
};

struct EpiRes {
    const float* xold; float* xnew; const bf16_t* xb; float* ssp; const float* pb; const float* ps; bf16_t* xbo;
    __device__ __forceinline__ void operator()(Acc& acc, const Unit& u, int wr, int wc, int fr, int fq, LAS unsigned char* ldsx, int tid) const {
#pragma unroll
        for (int ai = 0; ai < 2; ++ai)
#pragma unroll
            for (int m = 0; m < 4; ++m) {
                const int row = u.pm * 256 + ai * 128 + wr * 64 + m * 16 + fr; float ss = 0.f;
#pragma unroll
                for (int bj = 0; bj < 2; ++bj) {
                    const int col = u.pn * 256 + 128 * bj + 32 * wc + 8 * fq; const size_t off = (size_t)row * D + col;
                    f32x4 a0 = acc[ai][bj][m][0], a1 = acc[ai][bj][m][1];
                    if (pb) { a0 = (a0 + *(const f32x4*)(pb + col)) * *(const f32x4*)(ps + col); a1 = (a1 + *(const f32x4*)(pb + col + 4)) * *(const f32x4*)(ps + col + 4); }
                    f32x4 r0, r1; unpk8(*(const u32x4*)(xb + off), r0, r1);
                    const f32x4 x0 = r0 + a0, x1 = r1 + a1;
                    u32x4 w; w.x = cvt_pk_bf16(x0[0], x0[1]); w.y = cvt_pk_bf16(x0[2], x0[3]); w.z = cvt_pk_bf16(x1[0], x1[1]); w.w = cvt_pk_bf16(x1[2], x1[3]);
                    *(u32x4*)(xbo + off) = w;
                    ss += (x0[0] * x0[0] + x0[1] * x0[1]) + (x0[2] * x0[2] + x0[3] * x0[3]) + (x1[0] * x1[0] + x1[1] * x1[1]) + (x1[2] * x1[2] + x1[3] * x1[3]);
                    asm volatile("" ::: "memory"); __builtin_amdgcn_sched_barrier(0);
                }
                ss = xrow16_sum(ss);
                if (fq == 0) ((LAS float*)ldsx)[wc * 256 + ai * 128 + wr * 64 + m * 16 + fr] = ss;
            }
        WG_BAR();
        if (tid < 256) { const LAS float* rd = (const LAS float*)ldsx; ssp[(size_t)u.pn * M + u.pm * 256 + tid] = (rd[tid] + rd[256 + tid]) + (rd[512 + tid] + rd[768 + tid]); }
        WG_BAR();
    }
};

struct EpiFinal {
    float* x; const float* gain; float* ssx; unsigned* cnt; const bf16_t* xb;
    __device__ __forceinline__ void operator()(Acc& acc, const Unit& u, int wr, int wc, int fr, int fq, LAS unsigned char* ldsx, int tid) const {
        LAS float* red = (LAS float*)ldsx; LAS float* rsl = (LAS float*)(ldsx + 4096);
#pragma unroll
        for (int ai = 0; ai < 2; ++ai)
#pragma unroll
            for (int m = 0; m < 4; ++m) {
                const int row = u.pm * 256 + ai * 128 + wr * 64 + m * 16 + fr; float ss = 0.f;
#pragma unroll
                for (int bj = 0; bj < 2; ++bj) {
                    const int col = u.pn * 256 + 128 * bj + 32 * wc + 8 * fq; const size_t off = (size_t)row * D + col;
                    f32x4 r0, r1; unpk8(*(const u32x4*)(xb + off), r0, r1);
                    const f32x4 x0 = r0 + acc[ai][bj][m][0], x1 = r1 + acc[ai][bj][m][1];
                    acc[ai][bj][m][0] = x0; acc[ai][bj][m][1] = x1;
                    ss += (x0[0] * x0[0] + x0[1] * x0[1]) + (x0[2] * x0[2] + x0[3] * x0[3]) + (x1[0] * x1[0] + x1[1] * x1[1]) + (x1[2] * x1[2] + x1[3] * x1[3]);
                    asm volatile("" ::: "memory"); __builtin_amdgcn_sched_barrier(0);
                }
                ss = xrow16_sum(ss);
                if (fq == 0) red[wc * 256 + ai * 128 + wr * 64 + m * 16 + fr] = ss;
            }
        WG_BAR();
        if (tid < 256) __hip_atomic_store(ssx + (size_t)u.pn * M + u.pm * 256 + tid, (red[tid] + red[256 + tid]) + (red[512 + tid] + red[768 + tid]), __ATOMIC_RELAXED, __HIP_MEMORY_SCOPE_AGENT);
        asm volatile("s_waitcnt vmcnt(0)" ::: "memory");
        WG_BAR();
        if (tid == 0) {
            unsigned* c = cnt + 64 * u.pm;
            __hip_atomic_fetch_add(c, 1u, __ATOMIC_RELAXED, __HIP_MEMORY_SCOPE_AGENT);
            unsigned spins = 0;
            while (__hip_atomic_load(c, __ATOMIC_RELAXED, __HIP_MEMORY_SCOPE_AGENT) < 4u) { __builtin_amdgcn_s_sleep(2); if (++spins > (1u << 22)) break; }
            __builtin_amdgcn_fence(__ATOMIC_ACQUIRE, "agent");
            asm volatile("s_waitcnt vmcnt(0)" ::: "memory");
        }
        WG_BAR();
        if (tid < 256) {
            const float* p = ssx + u.pm * 256 + tid;
            const float sq = (__hip_atomic_load(p, __ATOMIC_RELAXED, __HIP_MEMORY_SCOPE_AGENT) + __hip_atomic_load(p + M, __ATOMIC_RELAXED, __HIP_MEMORY_SCOPE_AGENT)) +
                             (__hip_atomic_load(p + 2 * M, __ATOMIC_RELAXED, __HIP_MEMORY_SCOPE_AGENT) + __hip_atomic_load(p + 3 * M, __ATOMIC_RELAXED, __HIP_MEMORY_SCOPE_AGENT));
            rsl[tid] = 1.0f / sqrtf(sq * (1.0f / D) + EPS);
        }
        WG_BAR();
#pragma unroll
        for (int ai = 0; ai < 2; ++ai)
#pragma unroll
            for (int m = 0; m < 4; ++m) {
                const int rl = ai * 128 + wr * 64 + m * 16 + fr; const float rs = rsl[rl]; const int row = u.pm * 256 + rl;
#pragma unroll
                for (int bj = 0; bj < 2; ++bj) {
                    const int col = u.pn * 256 + 128 * bj + 32 * wc + 8 * fq; const size_t off = (size_t)row * D + col;
                    *(f32x4*)(x + off) = acc[ai][bj][m][0] * rs * *(const f32x4*)(gain + col); *(f32x4*)(x + off + 4) = acc[ai][bj][m][1] * rs * *(const f32x4*)(gain + col + 4);
                }
                asm volatile("" ::: "memory"); __builtin_amdgcn_sched_barrier(0);
            }
    }
};

struct EpiUp {
    const float* ssp; const float* cw; const float* cb; bf16_t* act; float* HB; float* FB;
    __device__ __forceinline__ void operator()(Acc& acc, const Unit& u, int wr, int wc, int fr, int fq, LAS unsigned char* ldsx, int tid) const {
        LAS float* Hl = (LAS float*)ldsx;
        LAS float* rsl = (LAS float*)(ldsx + 10240);
        const int lane = tid & 63;
        if (tid < 256) { const int row = u.pm * 256 + tid; const float sq = (ssp[row] + ssp[M + row]) + (ssp[2 * M + row] + ssp[3 * M + row]); rsl[tid] = 1.0f / sqrtf(sq * (1.0f / D) + EPS); }
        WG_BAR();
#pragma unroll
        for (int ai = 0; ai < 2; ++ai)
#pragma unroll
            for (int m = 0; m < 4; ++m) {
                const float rs = rsl[ai * 128 + wr * 64 + m * 16 + fr];
#pragma unroll
                for (int bj = 0; bj < 2; ++bj) { acc[ai][bj][m][0] *= rs; acc[ai][bj][m][1] *= rs; }
                asm volatile("" ::: "memory"); __builtin_amdgcn_sched_barrier(0);
            }
        if (tid < 128) *(LAS f32x4*)(Hl + tid * 4) = (f32x4){0.f, 0.f, 0.f, 0.f};
#pragma unroll
        for (int ai = 0; ai < 2; ++ai) {
            const int k = 2 * ai + wr;
#pragma unroll
            for (int bj = 0; bj < 2; ++bj)
#pragma unroll
                for (int n = 0; n < 2; ++n) {
                    const int tc = 128 * bj + 32 * wc + 8 * fq + 4 * n; const int uc = bj * FF + u.pn * 128 + 32 * wc + 8 * fq + 4 * n;
                    if (fr >= 14) { *(LAS f32x4*)(Hl + ((k + 1) * 2 + (fr - 14)) * 256 + tc) = acc[ai][bj][3][n]; if (k == 3) *(f32x4*)(HB + ((size_t)u.pm * 2 + (fr - 14)) * UP + uc) = acc[ai][bj][3][n]; }
                    if (k == 0 && fr < 2) *(f32x4*)(FB + ((size_t)u.pm * 2 + fr) * UP + uc) = acc[0][bj][0][n];
                }
        }
        WG_BAR();
#pragma unroll
        for (int ai = 0; ai < 2; ++ai) {
            const int k = 2 * ai + wr;
            u32x2 pk[4];
#pragma unroll
            for (int n = 0; n < 2; ++n) {
                const int tc = 32 * wc + 8 * fq + 4 * n; const int ucg = u.pn * 128 + tc;
                f32x4 cg[4];
#pragma unroll
                for (int bj = 0; bj < 2; ++bj) {
                    const int uc = bj * FF + ucg;
                    const f32x4 w0 = *(const f32x4*)(cw + uc), w1 = *(const f32x4*)(cw + UP + uc), w2 = *(const f32x4*)(cw + 2 * UP + uc), bb = *(const f32x4*)(cb + uc);
                    const f32x4 h0 = *(const LAS f32x4*)(Hl + (k * 2 + 0) * 256 + 128 * bj + tc), h1 = *(const LAS f32x4*)(Hl + (k * 2 + 1) * 256 + 128 * bj + tc);
#pragma unroll
                    for (int m = 0; m < 4; ++m) {
                        const f32x4 V = acc[ai][bj][m][n]; f32x4 p1, p2;
#pragma unroll
                        for (int e = 0; e < 4; ++e) {
                            const float r1 = dppf<0x121>(V[e]), r2 = dppf<0x122>(V[e]); float x1, x2;
                            if (m > 0) { x1 = dppf<0x121>(acc[ai][bj][m > 0 ? m - 1 : 0][n][e]); x2 = dppf<0x122>(acc[ai][bj][m > 0 ? m - 1 : 0][n][e]); }
                            else { x1 = h1[e]; x2 = (fr == 0) ? h0[e] : h1[e]; }
                            p1[e] = (fr == 0) ? x1 : r1; p2[e] = (fr < 2) ? x2 : r2;
                        }
                        const f32x4 cv = bb + w0 * p2 + w1 * p1 + w2 * V;
                        __builtin_amdgcn_sched_barrier(0);
                        if (bj == 0) cg[m] = cv;
                        else {
                            const int row = u.pm * 256 + ai * 128 + wr * 64 + m * 16 + fr;
                            float o[4];
#pragma unroll
                            for (int e = 0; e < 4; ++e) { const float gt = cg[m][e]; o[e] = gt * sigmoidf_(gt) * cv[e]; }
                            u32x2 w; w.x = cvt_pk_bf16(o[0], o[1]); w.y = cvt_pk_bf16(o[2], o[3]);
                            if (n == 0) pk[m] = w;
                            else { u32x4 w4; w4.x = pk[m].x; w4.y = pk[m].y; w4.z = w.x; w4.w = w.y; *(u32x4*)(act + (size_t)row * FF + ucg - 4) = w4; }
                        }
                    }
                    asm volatile("" ::: "memory"); __builtin_amdgcn_sched_barrier(0);
                }
            }
        }
        WG_BAR();
    }
};

namespace att {
constexpr int SLOT_B = 16384, NSLOT = 6;
constexpr int OFF_K = 0, OFF_IMP = NSLOT * SLOT_B, IMPW = 132, OFF_SEL = OFF_IMP + 64 * IMPW * 4, OFF_UNI = OFF_SEL + 1024, OFF_LIST = OFF_UNI + 64, OFF_N = OFF_LIST + 132 * 4, OFF_CODE = OFF_N + 48, CODEW = 144;
static_assert(OFF_CODE + 8 * CODEW <= LDS_BYTES - 16 && 8 * SLOT_B <= OFF_SEL, "attention LDS map");
struct Ctx {
    const bf16_t *Q, *KCC, *VCT, *KS, *VST, *KW, *VWT; const float* gates; bf16_t* O;
};
__device__ __forceinline__ bf16x8 mk8(s16x4 a, s16x4 b) { return (bf16x8){a[0], a[1], a[2], a[3], b[0], b[1], b[2], b[3]}; }

template <int MODE>
__device__ __forceinline__ void branch(LAS unsigned char* lds, const bf16_t* Kg, const bf16_t* Vg, int ktile_elems, int nt, int c, int w, int lane, int tid,
                                       const bf16x8 (&qf)[4][2], float (&mrow)[4], float (&lrow)[4], f32x4 (&O)[4][4]) {
    const int fr = lane & 15, fq = lane >> 4;
    const LAS int* list = (const LAS int*)(lds + OFF_LIST);
    LAS float* impL = (LAS float*)(lds + OFF_IMP);
    const LAS unsigned char* codeL = (const LAS unsigned char*)(lds + OFF_CODE) + w * CODEW;
    constexpr int TPS = (MODE >= 2) ? 4 : 3;
#define ATT_DMA(ti, slot) do { const int ti_ = (ti); const int s_ = list[ti_]; LAS unsigned char* d_ = lds + OFF_K + (slot) * SLOT_B + w * 1024; \
        int t2_ = tid; asm volatile("" : "+v"(t2_)); const int lr = t2_ >> 3, lq = t2_ & 7; const int goff = lr * 64 + ((lq ^ ((lr >> 1) & 7)) * 8); \
        __builtin_amdgcn_global_load_lds((const unsigned*)(Kg + (size_t)s_ * ktile_elems + goff), (LAS unsigned*)d_, 16, 0, 0); \
        if (MODE != 0) __builtin_amdgcn_global_load_lds((const unsigned*)(Vg + (size_t)s_ * 4096 + goff), (LAS unsigned*)(d_ + 8192), 16, 0, 0); } while (0)
    asm volatile("s_waitcnt vmcnt(0)" ::: "memory");
#pragma unroll
    for (int ti = 0; ti < TPS; ++ti) if (ti < nt) ATT_DMA(ti, ti);
    const int nst = (nt + TPS - 1) / TPS;
    for (int j = 0; j < nst; ++j) {
        asm volatile("s_waitcnt vmcnt(0)" ::: "memory");
        WG_BAR();
#pragma unroll
        for (int hh = 0; hh < TPS; ++hh) if (TPS * (j + 1) + hh < nt) ATT_DMA(TPS * (j + 1) + hh, ((j + 1) & 1) * TPS + hh);
        int sl0 = 0, sl1 = 0, sl2 = 0, sl3 = 0; unsigned codes4 = 0xffffffffu;
        if (TPS == 4) {
            const u32x4 l4 = *(const LAS u32x4*)(list + TPS * j);
            sl0 = __builtin_amdgcn_readfirstlane((int)l4.x); sl1 = __builtin_amdgcn_readfirstlane((int)l4.y); sl2 = __builtin_amdgcn_readfirstlane((int)l4.z); sl3 = __builtin_amdgcn_readfirstlane((int)l4.w);
            if (MODE == 2) codes4 = (unsigned)__builtin_amdgcn_readfirstlane((int)*(const LAS unsigned*)(codeL + TPS * j));
        }
#pragma unroll 1
        for (int h = 0; h < TPS; ++h) {
        const int i = TPS * j + h; if (i >= nt) break;
        const int s = (TPS == 4) ? (h == 0 ? sl0 : h == 1 ? sl1 : h == 2 ? sl2 : sl3) : list[i];
        unsigned code = 0xffu; if (MODE == 2) code = (codes4 >> (8 * h)) & 0xffu;
        const LAS unsigned char* Kb = lds + OFF_K + ((j & 1) * TPS + h) * SLOT_B;
        const LAS unsigned char* Vb = Kb;
        int l2_ = lane; asm volatile("" : "+v"(l2_)); const int fr2 = l2_ & 15, fq2 = l2_ >> 4, swz = (fr2 >> 1) & 7;
        const int kb0 = fr2 * 128 + ((fq2 ^ swz) * 16), kb1 = kb0 ^ 64;
        if (MODE != 2) {
            f32x4 sa[4][4];
#pragma unroll
            for (int p = 0; p < 4; ++p) {
                const float cinit = (MODE == 1) ? lrow[p] : -((mrow[p] < -1e29f) ? 0.f : mrow[p]);
#pragma unroll
                for (int mt = 0; mt < 4; ++mt) sa[p][mt] = (f32x4){cinit, cinit, cinit, cinit};
            }
            bf16x8 vd0[4];
            {
                bf16x8 kf[8];
#pragma unroll
                for (int i8 = 0; i8 < 8; ++i8) kf[i8] = *(const LAS bf16x8*)(Kb + ((i8 & 1) ? kb1 : kb0) + (i8 >> 1) * 2048);
                __builtin_amdgcn_sched_barrier(0);
#pragma unroll
                for (int i8 = 0; i8 < 8; ++i8)
#pragma unroll
                    for (int p = 0; p < 4; ++p) sa[p][i8 >> 1] = __builtin_amdgcn_mfma_f32_16x16x32_bf16(kf[i8], qf[p][i8 & 1], sa[p][i8 >> 1], 0, 0, 0);
            }
            bf16x8 pf[4][2];
#pragma unroll
            for (int p = 0; p < 4; ++p) {
                const int ttA = 8 * w + 2 * p, tt = ttA + (fr >> 3);
                bool needmask;
                if (MODE <= 1) needmask = (((64 * c + ttA - 31) >> 4) - 64 * s) < 63;
                else needmask = (s == c) || (c >= 8 && s == c - 8);
                if (needmask) {
                    int hi, lov = -1;
                    if (MODE <= 1) { const int t = 64 * c + tt; hi = ((t - 31) >> 4) - 64 * s; }
                    else { hi = (s == c) ? tt : 63; lov = (c >= 8 && s == c - 8) ? tt : -1; }
#pragma unroll
                    for (int mt = 0; mt < 4; ++mt)
#pragma unroll
                        for (int j = 0; j < 4; ++j) { const int kk = 16 * mt + 4 * fq + j; sa[p][mt][j] = (kk <= hi && kk > lov) ? sa[p][mt][j] : -1e30f; }
                }
                if (MODE != 1) {
                    float mx = fmaxf(fmaxf(sa[p][0][0], sa[p][0][1]), sa[p][0][2]);
                    mx = fmaxf(fmaxf(mx, sa[p][0][3]), sa[p][1][0]); mx = fmaxf(fmaxf(mx, sa[p][1][1]), sa[p][1][2]); mx = fmaxf(fmaxf(mx, sa[p][1][3]), sa[p][2][0]);
                    mx = fmaxf(fmaxf(mx, sa[p][2][1]), sa[p][2][2]); mx = fmaxf(fmaxf(mx, sa[p][2][3]), sa[p][3][0]); mx = fmaxf(fmaxf(mx, sa[p][3][1]), sa[p][3][2]); mx = fmaxf(mx, sa[p][3][3]);
                    mx = xrow16_max(mx);
                    const bool uninit = mrow[p] < -1e29f;
                    const bool resc = (mx > 8.0f) || (uninit && mx > -1e29f);
                    if (__any(resc)) {
                        const float delta = resc ? mx : 0.f;
                        const float alpha = (resc && !uninit) ? ex2(-delta) : 1.0f;
#pragma unroll
                        for (int mt = 0; mt < 4; ++mt) sa[p][mt] = sa[p][mt] - delta;
                        lrow[p] *= alpha;
                        if (MODE >= 2) {
#pragma unroll
                            for (int d = 0; d < 4; ++d) O[p][d] *= alpha;
                        }
                        if (resc) mrow[p] = (uninit ? 0.f : mrow[p]) + delta;
                    }
                }
#pragma unroll
                for (int mt = 0; mt < 4; ++mt)
#pragma unroll
                    for (int j = 0; j < 4; ++j) sa[p][mt][j] = ex2(sa[p][mt][j]);
                if (MODE != 1) { const f32x4 t4 = (sa[p][0] + sa[p][1]) + (sa[p][2] + sa[p][3]); lrow[p] += (t4[0] + t4[1]) + (t4[2] + t4[3]); }
                if (MODE >= 1) {
#pragma unroll
                    for (int k2 = 0; k2 < 2; ++k2) {
                        u32x4 wv; wv.x = cvt_pk_bf16(sa[p][2 * k2][0], sa[p][2 * k2][1]); wv.y = cvt_pk_bf16(sa[p][2 * k2][2], sa[p][2 * k2][3]); wv.z = cvt_pk_bf16(sa[p][2 * k2 + 1][0], sa[p][2 * k2 + 1][1]); wv.w = cvt_pk_bf16(sa[p][2 * k2 + 1][2], sa[p][2 * k2 + 1][3]);
                        pf[p][k2] = __builtin_bit_cast(bf16x8, wv);
                    }
                }
                if (MODE == 1) {
#pragma unroll
                    for (int mt = 0; mt < 4; ++mt) {
                        float a = sa[p][mt][0] + sa[p][mt][1] + sa[p][mt][2] + 0.5f * sa[p][mt][3], bn = 0.5f * sa[p][mt][3];
                        a = sum8(a); bn = sum8(bn);
                        const int sb = 16 * s + 4 * mt + fq;
                        if ((fr & 7) == 0) { (void)__hip_atomic_fetch_add(impL + tt * IMPW + sb, a, __ATOMIC_RELAXED, __HIP_MEMORY_SCOPE_WORKGROUP); (void)__hip_atomic_fetch_add(impL + tt * IMPW + sb + 1, bn, __ATOMIC_RELAXED, __HIP_MEMORY_SCOPE_WORKGROUP); }
                    }
                }
            }
            if (MODE >= 1) {
                bf16x8 vd1[4];
#pragma unroll
                for (int i4 = 0; i4 < 4; ++i4) vd0[i4] = *(const LAS bf16x8*)(Vb + 8192 + ((i4 & 1) ? kb1 : kb0) + (i4 >> 1) * 2048);
#pragma unroll
                for (int i4 = 0; i4 < 4; ++i4) vd1[i4] = *(const LAS bf16x8*)(Vb + 8192 + ((i4 & 1) ? kb1 : kb0) + (2 + (i4 >> 1)) * 2048);
                __builtin_amdgcn_sched_barrier(0);
#pragma unroll
                for (int i4 = 0; i4 < 4; ++i4)
#pragma unroll
                    for (int p = 0; p < 4; ++p) O[p][i4 >> 1] = __builtin_amdgcn_mfma_f32_16x16x32_bf16(vd0[i4], pf[p][i4 & 1], O[p][i4 >> 1], 0, 0, 0);
#pragma unroll
                for (int i4 = 0; i4 < 4; ++i4)
#pragma unroll
                    for (int p = 0; p < 4; ++p) O[p][2 + (i4 >> 1)] = __builtin_amdgcn_mfma_f32_16x16x32_bf16(vd1[i4], pf[p][i4 & 1], O[p][2 + (i4 >> 1)], 0, 0, 0);
            }
            __builtin_amdgcn_sched_barrier(0);
        } else {
#pragma unroll
        for (int p = 0; p < 4; ++p) {
            const int ttA = 8 * w + 2 * p;
            const unsigned mA = (code >> (2 * p)) & 1u, mB = (code >> (2 * p + 1)) & 1u;
            if ((mA | mB) != 0u) {
            const int tt = ttA + (fr >> 3);
            float cinit;
            if (MODE == 1) cinit = lrow[p];
            else { const float mref = (mrow[p] < -1e29f) ? 0.f : mrow[p]; const bool colact = (MODE != 2) || (((fr >> 3) ? mB : mA) != 0u); cinit = colact ? -mref : -1e30f; }
            f32x4 sa[4];
#pragma unroll
            for (int mt = 0; mt < 4; ++mt) sa[mt] = (f32x4){cinit, cinit, cinit, cinit};
            bf16x8 vf0[4];
            {
                bf16x8 kf[8];
#pragma unroll
                for (int i8 = 0; i8 < 8; ++i8) kf[i8] = *(const LAS bf16x8*)(Kb + ((i8 & 1) ? kb1 : kb0) + (i8 >> 1) * 2048);
                if (MODE >= 1) {
#pragma unroll
                    for (int i4 = 0; i4 < 4; ++i4) vf0[i4] = *(const LAS bf16x8*)(Vb + 8192 + ((i4 & 1) ? kb1 : kb0) + (i4 >> 1) * 2048);
                }
                __builtin_amdgcn_sched_barrier(0);
#pragma unroll
                for (int i8 = 0; i8 < 8; ++i8) sa[i8 >> 1] = __builtin_amdgcn_mfma_f32_16x16x32_bf16(kf[i8], qf[p][i8 & 1], sa[i8 >> 1], 0, 0, 0);
            }
            bool needmask;
            if (MODE <= 1) needmask = (((64 * c + ttA - 31) >> 4) - 64 * s) < 63;
            else if (MODE == 2) needmask = (s == c);
            else needmask = (s == c) || (c >= 8 && s == c - 8);
            if (needmask) {
                int hi, lov = -1;
                if (MODE <= 1) { const int t = 64 * c + tt; hi = ((t - 31) >> 4) - 64 * s; }
                else if (MODE == 2) hi = tt;
                else { hi = (s == c) ? tt : 63; lov = (c >= 8 && s == c - 8) ? tt : -1; }
#pragma unroll
                for (int mt = 0; mt < 4; ++mt)
#pragma unroll
                    for (int j = 0; j < 4; ++j) { const int kk = 16 * mt + 4 * fq + j; sa[mt][j] = (kk <= hi && kk > lov) ? sa[mt][j] : -1e30f; }
            }
            if (MODE != 1) {
                float mx = fmaxf(fmaxf(sa[0][0], sa[0][1]), sa[0][2]);
                mx = fmaxf(fmaxf(mx, sa[0][3]), sa[1][0]); mx = fmaxf(fmaxf(mx, sa[1][1]), sa[1][2]); mx = fmaxf(fmaxf(mx, sa[1][3]), sa[2][0]);
                mx = fmaxf(fmaxf(mx, sa[2][1]), sa[2][2]); mx = fmaxf(fmaxf(mx, sa[2][3]), sa[3][0]); mx = fmaxf(fmaxf(mx, sa[3][1]), sa[3][2]); mx = fmaxf(mx, sa[3][3]);
                mx = xrow16_max(mx);
                const bool uninit = mrow[p] < -1e29f;
                const bool resc = (mx > 8.0f) || (uninit && mx > -1e29f);
                if (__any(resc)) {
                    const float delta = resc ? mx : 0.f;
                    const float alpha = (resc && !uninit) ? ex2(-delta) : 1.0f;
#pragma unroll
                    for (int mt = 0; mt < 4; ++mt) sa[mt] = sa[mt] - delta;
                    lrow[p] *= alpha;
                    if (MODE >= 2) {
#pragma unroll
                        for (int d = 0; d < 4; ++d) O[p][d] *= alpha;
                    }
                    if (resc) mrow[p] = (uninit ? 0.f : mrow[p]) + delta;
                }
            }
            f32x4 pv[4];
#pragma unroll
            for (int mt = 0; mt < 4; ++mt)
#pragma unroll
                for (int j = 0; j < 4; ++j) pv[mt][j] = ex2(sa[mt][j]);
            if (MODE != 1) { const f32x4 t4 = (pv[0] + pv[1]) + (pv[2] + pv[3]); lrow[p] += (t4[0] + t4[1]) + (t4[2] + t4[3]); }
            if (MODE >= 1) {
                bf16x8 pf[2];
#pragma unroll
                for (int k2 = 0; k2 < 2; ++k2) {
                    u32x4 wv; wv.x = cvt_pk_bf16(pv[2 * k2][0], pv[2 * k2][1]); wv.y = cvt_pk_bf16(pv[2 * k2][2], pv[2 * k2][3]); wv.z = cvt_pk_bf16(pv[2 * k2 + 1][0], pv[2 * k2 + 1][1]); wv.w = cvt_pk_bf16(pv[2 * k2 + 1][2], pv[2 * k2 + 1][3]);
                    pf[k2] = __builtin_bit_cast(bf16x8, wv);
                }
                {
                    bf16x8 vf1[4];
#pragma unroll
                    for (int i4 = 0; i4 < 4; ++i4) vf1[i4] = *(const LAS bf16x8*)(Vb + 8192 + ((i4 & 1) ? kb1 : kb0) + (2 + (i4 >> 1)) * 2048);
                    __builtin_amdgcn_sched_barrier(0);
#pragma unroll
                    for (int i4 = 0; i4 < 4; ++i4) O[p][i4 >> 1] = __builtin_amdgcn_mfma_f32_16x16x32_bf16(vf0[i4], pf[i4 & 1], O[p][i4 >> 1], 0, 0, 0);
#pragma unroll
                    for (int i4 = 0; i4 < 4; ++i4) O[p][2 + (i4 >> 1)] = __builtin_amdgcn_mfma_f32_16x16x32_bf16(vf1[i4], pf[i4 & 1], O[p][2 + (i4 >> 1)], 0, 0, 0);
                }
            }
            if (MODE == 1) {
#pragma unroll
                for (int mt = 0; mt < 4; ++mt) {
                    float a = pv[mt][0] + pv[mt][1] + pv[mt][2] + 0.5f * pv[mt][3], bn = 0.5f * pv[mt][3];
                    a = sum8(a); bn = sum8(bn);
                    const int sb = 16 * s + 4 * mt + fq;
                    if ((fr & 7) == 0) { (void)__hip_atomic_fetch_add(impL + tt * IMPW + sb, a, __ATOMIC_RELAXED, __HIP_MEMORY_SCOPE_WORKGROUP); (void)__hip_atomic_fetch_add(impL + tt * IMPW + sb + 1, bn, __ATOMIC_RELAXED, __HIP_MEMORY_SCOPE_WORKGROUP); }
                }
            }
            }
            __builtin_amdgcn_sched_barrier(0);
        }
        }
        }
    }
    WG_BAR();
#undef ATT_DMA
}

__device__ __forceinline__ void unit(LAS unsigned char* lds, const Ctx& X, int b, int g, int c, int tid_in) {
    int tid = tid_in; asm volatile("" : "+v"(tid));
    const int lane = tid & 63, w = __builtin_amdgcn_readfirstlane(tid >> 6), fr = lane & 15, fq = lane >> 4;
    LAS int* list = (LAS int*)(lds + OFF_LIST);
    LAS unsigned* selm = (LAS unsigned*)(lds + OFF_SEL);
    LAS unsigned* uni = (LAS unsigned*)(lds + OFF_UNI);
    LAS float* impL = (LAS float*)(lds + OFF_IMP);
    LAS int* nl = (LAS int*)(lds + OFF_N);
    const int bg = b * 2 + g; const size_t rowbase = (size_t)b * T + 64 * c;
    bf16x8 qf[4][2];
#pragma unroll
    for (int p = 0; p < 4; ++p) { const bf16_t* qp = X.Q + (rowbase + 8 * w + 2 * p + (fr >> 3)) * 1024 + (8 * g + (fr & 7)) * 64 + 8 * fq;
#pragma unroll
        for (int ks = 0; ks < 2; ++ks) qf[p][ks] = *(const bf16x8*)(qp + 32 * ks); }
    for (int i = lane; i < 8 * IMPW; i += 64) impL[(8 * w) * IMPW + i] = 0.f;
    const int ncmp = (4 * c + 3 + 63) >> 6;
    if (tid < 8) list[tid] = tid;
    float mrow[4], lrow[4]; f32x4 O[4][4];
#pragma unroll
    for (int p = 0; p < 4; ++p) { mrow[p] = -1e30f; lrow[p] = 0.f;
#pragma unroll
        for (int d = 0; d < 4; ++d) { O[p][d] = (f32x4){0.f, 0.f, 0.f, 0.f}; } }
    WG_BAR();
    const bf16_t* kcc = X.KCC + (size_t)bg * 512 * 64; const bf16_t* vct = X.VCT + (size_t)bg * 8 * 4096;
    branch<0>(lds, kcc, vct, 4096, ncmp, c, w, lane, tid, qf, mrow, lrow, O);
#pragma unroll
    for (int p = 0; p < 4; ++p) { float l = xrow16_sum(lrow[p]); lrow[p] = (l > 0.f) ? (-mrow[p] - __builtin_amdgcn_logf(l)) : -1e30f; }
    branch<1>(lds, kcc, vct, 4096, ncmp, c, w, lane, tid, qf, mrow, lrow, O);
#define ATT_GATE(br, scale_expr) do { _Pragma("unroll") for (int p = 0; p < 4; ++p) { \
        const size_t grow = rowbase + 8 * w + 2 * p + (fr >> 3); \
        const float gt = X.gates[grow * 48 + (8 * g + (fr & 7)) * 3 + (br)]; const float sc = gt * (scale_expr); \
        _Pragma("unroll") for (int d = 0; d < 4; ++d) { \
            u32x2* optr = (u32x2*)(X.O + grow * 1024 + (8 * g + (fr & 7)) * 64 + 4 * fq + 16 * d); u32x2 ot = (u32x2){0u, 0u}; if ((br) > 0) ot = *optr; \
            float o0 = __uint_as_float(ot.x << 16), o1 = __uint_as_float(ot.x & 0xffff0000u), o2 = __uint_as_float(ot.y << 16), o3 = __uint_as_float(ot.y & 0xffff0000u); \
            o0 += sc * O[p][d][0]; o1 += sc * O[p][d][1]; o2 += sc * O[p][d][2]; o3 += sc * O[p][d][3]; \
            ot.x = cvt_pk_bf16(o0, o1); ot.y = cvt_pk_bf16(o2, o3); O[p][d] = (f32x4){0.f, 0.f, 0.f, 0.f}; \
            *optr = ot; } \
        mrow[p] = -1e30f; lrow[p] = 0.f; } } while (0)
    ATT_GATE(0, 1.0f);
    LDS_WAIT();
    for (int q8 = 0; q8 < 8; ++q8) {
        const int tt = 8 * w + q8;
        unsigned long long blo, bhi;
        if (c + 1 <= 16) { blo = (1ull << (c + 1)) - 1ull; bhi = 0ull; }
        else {
            const int s1 = lane, s2 = lane + 64;
            const bool c1 = (s1 >= 1 && s1 <= c - 2), c2 = (s2 >= 1 && s2 <= c - 2);
            const float v1 = c1 ? impL[tt * IMPW + s1] : -1.f, v2 = c2 ? impL[tt * IMPW + s2] : -1.f;
            int r1 = 0, r2 = 0;
            const int nq = (c - 2) / 4 + 1;
#pragma unroll 2
            for (int q = 0; q < nq; ++q) {
                const f32x4 x4 = *(const LAS f32x4*)(impL + tt * IMPW + 4 * q);
#pragma unroll
                for (int e = 0; e < 4; ++e) { const int sp = 4 * q + e; const float x = (sp >= 1 && sp <= c - 2) ? x4[e] : -2.f;
                    r1 += (x > v1 || (x == v1 && sp < s1)) ? 1 : 0; r2 += (x > v2 || (x == v2 && sp < s2)) ? 1 : 0; }
            }
            const bool f1 = (s1 == 0 || s1 == c || s1 == c - 1), f2 = (s2 == c || s2 == c - 1);
            blo = __ballot((c1 && r1 < 13) || f1); bhi = __ballot((c2 && r2 < 13) || f2);
        }
        if (lane == 0) { selm[tt * 4 + 0] = (unsigned)blo; selm[tt * 4 + 1] = (unsigned)(blo >> 32); selm[tt * 4 + 2] = (unsigned)bhi; selm[tt * 4 + 3] = (unsigned)(bhi >> 32); }
    }
    WG_BAR();
    if (tid < 4) { unsigned o = 0; for (int i = 0; i < 64; ++i) o |= selm[i * 4 + tid]; uni[tid] = o; }
    WG_BAR();
    if (tid == 0) { int n = 0; for (int s = 0; s <= c; ++s) if ((uni[s >> 5] >> (s & 31)) & 1u) list[n++] = s; nl[0] = n; }
    WG_BAR();
    const int nsel = nl[0];
    { LAS unsigned char* cw_ = (LAS unsigned char*)(lds + OFF_CODE) + w * CODEW;
      for (int i = lane; i < nsel; i += 64) { const int s_ = list[i]; unsigned cd = 0;
#pragma unroll
          for (int q8 = 0; q8 < 8; ++q8) cd |= ((selm[(8 * w + q8) * 4 + (s_ >> 5)] >> (s_ & 31)) & 1u) << q8;
          cw_[i] = (unsigned char)cd; }
      LDS_WAIT(); }
    branch<2>(lds, X.KS + (size_t)bg * T * 64, X.VST + (size_t)bg * 128 * 4096, 4096, nsel, c, w, lane, tid, qf, mrow, lrow, O);
#pragma unroll
    for (int p = 0; p < 4; ++p) { float l = xrow16_sum(lrow[p]); lrow[p] = (l > 0.f) ? 1.0f / l : 0.f; }
    { float rl[4] = {lrow[0], lrow[1], lrow[2], lrow[3]}; ATT_GATE(1, rl[p]); }
    const int w0 = (c >= 8) ? c - 8 : 0, nwin = c - w0 + 1;
    if (tid < nwin) list[tid] = w0 + tid;
    WG_BAR();
    branch<3>(lds, X.KW + (size_t)bg * T * 64, X.VWT + (size_t)bg * 128 * 4096, 4096, nwin, c, w, lane, tid, qf, mrow, lrow, O);
#pragma unroll
    for (int p = 0; p < 4; ++p) { float l = xrow16_sum(lrow[p]); lrow[p] = (l > 0.f) ? 1.0f / l : 0.f; }
    { float rl[4] = {lrow[0], lrow[1], lrow[2], lrow[3]}; ATT_GATE(2, rl[p]); }
#undef ATT_GATE
    WG_BAR();
}
}

__device__ __forceinline__ unsigned f2bf(float f) { unsigned u = __builtin_bit_cast(unsigned, f); return (u + 0x7fffu + ((u >> 16) & 1u)) >> 16; }
__device__ __forceinline__ unsigned pk2(float lo, float hi) { return f2bf(lo) | (f2bf(hi) << 16); }
template <int MAP>
__device__ __forceinline__ int rowmap(int a) {
    if (MAP == 0) return perm8(a);
    if (MAP == 1) return a < 1792 ? ((a & ~63) | swap45(a & 63)) : a;
    if (MAP == 2) { if (a < FF) return 256 * (a >> 7) + perm8(a & 127); const int a2 = a - FF; return 256 * (a2 >> 7) + 128 + perm8(a2 & 127); }
    return swap45(a);
}
template <int MAP>
__device__ __forceinline__ void transpose_item(const float* W, int K, int N, bf16_t* WT, int row_off, const float* gain, LAS float* scr, int item, int lane) {
    const int nblk = (N + 31) / 32, kb = item / nblk, nb = item % nblk, k0 = 64 * kb, n0 = 32 * nb;
#pragma unroll
    for (int i = 0; i < 32; ++i) { const int kk = 2 * i + (lane >> 5); const int col = n0 + (lane & 31); float v = (col < N) ? W[(size_t)(k0 + kk) * N + col] : 0.f; if (gain) v *= gain[k0 + kk]; scr[kk * 33 + (lane & 31)] = v; }
    LDS_WAIT();
    const int cc = lane & 7;
#pragma unroll
    for (int j = 0; j < 4; ++j) { const int n = (lane >> 3) + 8 * j; const LAS float* s = scr + (8 * cc) * 33 + n;
        u32x4 o; o.x = pk2(s[0 * 33], s[1 * 33]); o.y = pk2(s[2 * 33], s[3 * 33]); o.z = pk2(s[4 * 33], s[5 * 33]); o.w = pk2(s[6 * 33], s[7 * 33]);
        if (n0 + n < N) *(u32x4*)(WT + (size_t)(row_off + rowmap<MAP>(n0 + n)) * K + k0 + 8 * cc) = o; }
    LDS_WAIT();
}

#define XB_TMO      128
#define XB_XCNT(j)  (256  + 64 * (j))
#define XB_XSUB(j)  (1280 + 64 * (j))
#define XB_XGEN(j)  (2304 + 64 * (j))
#define XB_TOP      3328
#define XB_TOPGEN   3392
#define XCD_BAR_WORDS 3456
#define XB_SPIN_CAP (1u << 18)
__device__ __forceinline__ unsigned xb_ld(unsigned* p)              { return __hip_atomic_load(p, __ATOMIC_RELAXED, __HIP_MEMORY_SCOPE_AGENT); }
__device__ __forceinline__ unsigned xb_add(unsigned* p, unsigned v) { return __hip_atomic_fetch_add(p, v, __ATOMIC_RELAXED, __HIP_MEMORY_SCOPE_AGENT); }
__device__ __forceinline__ unsigned xb_xcc_id() { return (unsigned)__builtin_amdgcn_s_getreg((3 << 11) | 20) & 0xFu; }
#define XB_SPIN(cond, bar) do { unsigned _sp = 0; while (cond) { __builtin_amdgcn_s_sleep(1); \
    if ((++_sp & 255u) == 0u) { if (xb_ld(&(bar)[XB_TMO])) break; if (_sp > XB_SPIN_CAP) { atomicAdd(&(bar)[XB_TMO], 1u); break; } } } } while (0)
struct XcdBarrier { unsigned* bar; unsigned x; volatile LAS unsigned* st; };
__device__ __forceinline__ XcdBarrier xcd_barrier_post(unsigned* bar, volatile LAS unsigned* st) {
    XcdBarrier b; b.bar = bar; b.x = xb_xcc_id(); b.st = st;
    if (threadIdx.x == 0) (void)xb_add(&bar[XB_XCNT(b.x)], 1u);
    return b;
}
__device__ __forceinline__ void xcd_barrier_complete(unsigned* bar, unsigned x, unsigned& nloc, unsigned& nx) {
    const unsigned G = gridDim.x * gridDim.y * gridDim.z;
    unsigned sum, cnt, mine, sp = 0u;
    for (;;) {
        sum = 0u; cnt = 0u; mine = 0u;
#pragma unroll
        for (unsigned j = 0; j < 16; ++j) { const unsigned c = xb_ld(&bar[XB_XCNT(j)]); sum += c; cnt += (c > 0u) ? 1u : 0u; mine = (j == x) ? c : mine; }
        if (sum == G) break;
        __builtin_amdgcn_s_sleep(1);
        if ((++sp & 255u) == 0u) { if (xb_ld(&bar[XB_TMO])) break; if (sp > XB_SPIN_CAP) { atomicAdd(&bar[XB_TMO], 1u); break; } }
    }
    nloc = mine > 0u ? mine : 1u; nx = cnt > 0u ? cnt : 1u;
}
__device__ __forceinline__ void xcd_barrier(const XcdBarrier& b) {
    asm volatile("s_waitcnt vmcnt(0)" ::: "memory");
    __syncthreads();
    if (threadIdx.x == 0) {
        unsigned* bar = b.bar;
        __builtin_amdgcn_s_waitcnt(0);
        unsigned nloc = b.st[0], nx = b.st[1];
        if (nloc == 0u) { xcd_barrier_complete(bar, b.x, nloc, nx); b.st[0] = nloc; b.st[1] = nx; }
        const unsigned old = xb_add(&bar[XB_XSUB(b.x)], 1u);
        const unsigned gen = old / nloc;
        if (old + 1u == (gen + 1u) * nloc) {
            __builtin_amdgcn_fence(__ATOMIC_RELEASE, "agent");
            asm volatile("s_waitcnt vmcnt(0)" ::: "memory");
            const unsigned og = xb_add(&bar[XB_TOP], 1u);
            const unsigned tg = og / nx;
            if (og + 1u == (tg + 1u) * nx) xb_add(&bar[XB_TOPGEN], 1u);
            else XB_SPIN(xb_ld(&bar[XB_TOPGEN]) == tg, bar);
            __builtin_amdgcn_fence(__ATOMIC_ACQUIRE, "agent");
            xb_add(&bar[XB_XGEN(b.x)], 1u);
            asm volatile("s_waitcnt vmcnt(0)" ::: "memory");
        } else {
            XB_SPIN(xb_ld(&bar[XB_XGEN(b.x)]) == gen, bar);
            __builtin_amdgcn_fence(__ATOMIC_ACQUIRE, "agent");
            asm volatile("s_waitcnt vmcnt(0)" ::: "memory");
        }
    }
    __syncthreads();
}

struct Args { const float* in[29]; float* out; unsigned char* ws; float inv[32]; int ph_lo, ph_hi; };

constexpr int DI_UP = 16 * 176, DI_DN = 44 * 32, DI_PL = 4 * 8, N_DEFER = 2 * DI_UP + 2 * DI_DN + 4 * DI_PL;
__device__ __forceinline__ void ffn_weight_item(const Args& a, unsigned char* ws, LAS float* scr, int r, int lane) {
    if (r < DI_UP) { transpose_item<2>(a.in[15], D, UP, (bf16_t*)(ws + WS_WUP0), 0, a.in[14], scr, r, lane); return; } r -= DI_UP;
    if (r < DI_UP) { transpose_item<2>(a.in[24], D, UP, (bf16_t*)(ws + WS_WUP1), 0, a.in[23], scr, r, lane); return; } r -= DI_UP;
    if (r < DI_DN) { transpose_item<0>(a.in[18], FF, D, (bf16_t*)(ws + WS_WDN0), 0, nullptr, scr, r, lane); return; } r -= DI_DN;
    if (r < DI_DN) { transpose_item<0>(a.in[27], FF, D, (bf16_t*)(ws + WS_WDN1), 0, nullptr, scr, r, lane); return; } r -= DI_DN;
    const int gi = r / DI_PL; transpose_item<0>(a.in[20] + (size_t)gi * 65536, 256, 256, (bf16_t*)(ws + WS_WPOOL), gi * 256, nullptr, scr, r % DI_PL, lane);
}

__global__ void __launch_bounds__(512) mk_fwd(Args a) {
    extern __shared__ __attribute__((aligned(16))) unsigned char lds_raw[];
    LAS unsigned char* lds = (LAS unsigned char*)lds_raw;
    LAS unsigned char* ldsx = lds + LDS_RING;
    cg::grid_group grid = cg::this_grid();
    if (threadIdx.x < 2) ((volatile LAS unsigned*)(lds + LDS_BYTES - 16))[threadIdx.x] = 0u;
    __syncthreads();
    if (a.ph_hi == 0x7fff) grid.sync();
    const XcdBarrier xbar = xcd_barrier_post((unsigned*)a.ws, (volatile LAS unsigned*)(lds + LDS_BYTES - 16));
    const int tid = threadIdx.x, lane = tid & 63, wave = __builtin_amdgcn_readfirstlane(tid >> 6);
    const int G = gridDim.x, bx = blockIdx.x;
    unsigned char* ws = a.ws;
#define cosT ((float*)(ws + WS_ROPE))
#define sinT ((float*)(ws + WS_ROPE) + T * 32)
#define ssp ((float*)(ws + WS_SSP))
#define c1p ((float*)(ws + WS_C1P))
#define rstdv ((float*)(ws + WS_RSTD))
#define HB ((float*)(ws + WS_HB))
#define FB ((float*)(ws + WS_FB))
#define gates ((float*)(ws + WS_GATE))
#define Wt_in ((bf16_t*)(ws + WS_WIN))
#define Wt_out ((bf16_t*)(ws + WS_WOUT))
#define Wt_pool ((bf16_t*)(ws + WS_WPOOL))
#define Wt_c1 (kv ? (bf16_t*)(ws + WS_WC1V) : (bf16_t*)(ws + WS_WC1K))
#define Wt_c2 (kv ? (bf16_t*)(ws + WS_WC2V) : (bf16_t*)(ws + WS_WC2K))
#define XB ((bf16_t*)(ws + WS_XB))
#define Qb ((bf16_t*)(ws + WS_Q))
#define KC ((bf16_t*)(ws + WS_KC))
#define VC ((bf16_t*)(ws + WS_VC))
#define KS ((bf16_t*)(ws + WS_KS))
#define VST ((bf16_t*)(ws + WS_VST))
#define KW ((bf16_t*)(ws + WS_KW))
#define VWT ((bf16_t*)(ws + WS_VWT))
#define KCC ((bf16_t*)(ws + WS_KCC))
#define VCT ((bf16_t*)(ws + WS_VCT))
#define Ob ((bf16_t*)(ws + WS_O))
#define ACT ((bf16_t*)(ws + WS_ACT))
#define POOLED ((bf16_t*)(ws + WS_POOLED))
    float* out = a.out;
    const int lo = a.ph_lo, hi = a.ph_hi;
    const bool defer = (G == 256);
#define IN(k) (lo <= (k) && (k) < hi)
#define SEAM(k) do { if (IN(k) && IN((k) + 1)) xcd_barrier(xbar); } while (0)

    if (IN(0)) {
        LAS float* scr = (LAS float*)(lds + wave * 16384);
        const int gw = bx * 8 + wave, NGW = G * 8;
        constexpr int I_IN = 16 * 58, I_OUT = 16 * 32, I_C1 = 32 * 8, I_C2 = 4 * 2;
        constexpr int NA = I_IN + I_OUT + 2 * I_C1 + 2 * I_C2;
        const int NIT = NA + (defer ? 0 : N_DEFER);
        for (int it = gw; it < NIT; it += NGW) {
            int r = it;
            if (r < I_IN) { transpose_item<1>(a.in[2], D, 1840, Wt_in, 0, a.in[1], scr, r, lane); continue; } r -= I_IN;
            if (r < I_OUT) { transpose_item<0>(a.in[13], D, D, Wt_out, 0, nullptr, scr, r, lane); continue; } r -= I_OUT;
            if (r < I_C1) { transpose_item<0>(a.in[4], 2048, 256, (bf16_t*)(ws + WS_WC1K), 0, nullptr, scr, r, lane); continue; } r -= I_C1;
            if (r < I_C1) { transpose_item<0>(a.in[9], 2048, 256, (bf16_t*)(ws + WS_WC1V), 0, nullptr, scr, r, lane); continue; } r -= I_C1;
            if (r < I_C2) { transpose_item<3>(a.in[6], 256, 64, (bf16_t*)(ws + WS_WC2K), 0, nullptr, scr, r, lane); continue; } r -= I_C2;
            if (r < I_C2) { transpose_item<3>(a.in[11], 256, 64, (bf16_t*)(ws + WS_WC2V), 0, nullptr, scr, r, lane); continue; } r -= I_C2;
            ffn_weight_item(a, ws, scr, r, lane);
        }
        for (int m = gw; m < M; m += 2 * NGW) {
            const int m2 = m + NGW;
            const f32x4* xr = (const f32x4*)(a.in[0] + (size_t)m * D) + lane; const f32x4* xr2 = (const f32x4*)(a.in[0] + (size_t)m2 * D) + lane;
            f32x4 v[4], w[4];
#pragma unroll
            for (int j = 0; j < 4; ++j) { v[j] = xr[64 * j]; w[j] = (m2 < M) ? xr2[64 * j] : (f32x4){0.f, 0.f, 0.f, 0.f}; }
            unsigned long long* o8 = (unsigned long long*)(XB + (size_t)m * D) + lane; unsigned long long* o82 = (unsigned long long*)(XB + (size_t)m2 * D) + lane; float s1 = 0.f, s2 = 0.f;
#pragma unroll
            for (int j = 0; j < 4; ++j) {
                s1 += (v[j][0] * v[j][0] + v[j][1] * v[j][1]) + (v[j][2] * v[j][2] + v[j][3] * v[j][3]); o8[64 * j] = (unsigned long long)pk2(v[j][0], v[j][1]) | ((unsigned long long)pk2(v[j][2], v[j][3]) << 32);
                s2 += (w[j][0] * w[j][0] + w[j][1] * w[j][1]) + (w[j][2] * w[j][2] + w[j][3] * w[j][3]); if (m2 < M) o82[64 * j] = (unsigned long long)pk2(w[j][0], w[j][1]) | ((unsigned long long)pk2(w[j][2], w[j][3]) << 32);
            }
#pragma unroll
            for (int o = 1; o < 64; o <<= 1) { s1 += __shfl_xor(s1, o); s2 += __shfl_xor(s2, o); }
            if (lane == 0) { rstdv[m] = 1.0f / sqrtf(s1 * (1.0f / D) + EPS); if (m2 < M) rstdv[m2] = 1.0f / sqrtf(s2 * (1.0f / D) + EPS); }
        }
        for (int i = bx * 512 + tid; i < T * 32; i += G * 512) {
            const int t = i >> 5, f = i & 31; const float ang = (float)t * a.inv[f];
            double x = (double)ang * 0.15915494309189535; x -= __builtin_rint(x); const float xf = (float)x;
            cosT[i] = __builtin_amdgcn_cosf(xf); sinT[i] = __builtin_amdgcn_sinf(xf);
        }
        for (int it = NGW - 1 - gw; it < 256; it += NGW) {
            const int kv = it >> 7, chunk = (it >> 2) & 31, nb = it & 3; const float* pos = a.in[kv ? 8 : 3]; const float* w1 = a.in[kv ? 9 : 4];
            float s = 0.f;
#pragma unroll 32
            for (int r = 0; r < 64; ++r) { const int rr = chunk * 64 + r; s += pos[rr] * w1[(size_t)rr * 256 + nb * 64 + lane]; }
            c1p[(kv * 32 + chunk) * 256 + nb * 64 + lane] = s;
        }
        asm volatile("s_waitcnt vmcnt(0) lgkmcnt(0)" ::: "memory"); __syncthreads();
    }
    SEAM(0);
    if (IN(1)) {
        pg8::Gemm g{XB, Wt_in, M, NIN, D, D, 0}; pg8::StaticOrder S; S.init(M, NIN, G, bx);
        EpiIn E{rstdv, cosT, sinT, Qb, KC, VC, KS, VST, KW, VWT, gates};
        pg8::gemm_phase(lds, ldsx, g, S, E);
    }
    SEAM(1);
    if (IN(2)) {
        const int tid = threadIdx.x, lane = tid & 63, w = __builtin_amdgcn_readfirstlane(tid >> 6), fr = lane & 15, fq = lane >> 4;
        LAS float* c1s = (LAS float*)lds;
        LAS unsigned char* hidL = lds + 4096;
        for (int i = tid; i < 512; i += 512) { const int kv = i >> 8, n = i & 255; const float* b1 = a.in[kv ? 10 : 5]; float sv = b1[n]; for (int q = 0; q < 32; ++q) sv += c1p[(kv * 32 + q) * 256 + n]; c1s[i] = sv; }
        __syncthreads();
        for (int u = bx; u < 256; u += G) {
            const int kv = u >> 7, r0 = (u & 127) * 16;
            const bf16_t* Ap = (kv ? VC : KC) + (size_t)(r0 + fr) * 1024 + 8 * fq;
            const bf16_t* Bp = Wt_c1 + (size_t)(32 * w + fr) * 2048 + 8 * fq;
            f32x4 h0 = (f32x4){0.f, 0.f, 0.f, 0.f}, h1 = h0;
#pragma unroll 1
            for (int k0 = 0; k0 < 2048; k0 += 256) {
                bf16x8 af[8], b0[8], b1f[8];
#pragma unroll
                for (int q = 0; q < 8; ++q) { af[q] = *(const bf16x8*)(Ap + k0 + 32 * q); b0[q] = *(const bf16x8*)(Bp + k0 + 32 * q); b1f[q] = *(const bf16x8*)(Bp + 16 * 2048 + k0 + 32 * q); }
#pragma unroll
                for (int q = 0; q < 8; ++q) { h0 = __builtin_amdgcn_mfma_f32_16x16x32_bf16(b0[q], af[q], h0, 0, 0, 0); h1 = __builtin_amdgcn_mfma_f32_16x16x32_bf16(b1f[q], af[q], h1, 0, 0, 0); }
            }
            { const int c0 = 32 * w + 8 * fq; float v[8];
#pragma unroll
              for (int e = 0; e < 8; ++e) { const float x = ((e >> 2) ? h1[e & 3] : h0[e & 3]) + c1s[kv * 256 + c0 + e]; const float y = 0.7978845608028654f * (x + 0.044715f * x * x * x); v[e] = x * sigmoidf_(2.0f * y); }
              u32x4 wv; wv.x = cvt_pk_bf16(v[0], v[1]); wv.y = cvt_pk_bf16(v[2], v[3]); wv.z = cvt_pk_bf16(v[4], v[5]); wv.w = cvt_pk_bf16(v[6], v[7]);
              *(LAS u32x4*)(hidL + fr * 528 + c0 * 2) = wv; }
            __syncthreads();
            if (w < 2) {
                const bf16_t* W2 = Wt_c2 + (size_t)(32 * w + fr) * 256 + 8 * fq;
                f32x4 oA = (f32x4){0.f, 0.f, 0.f, 0.f}, oB = oA;
#pragma unroll
                for (int q = 0; q < 8; ++q) {
                    const bf16x8 hf = *(const LAS bf16x8*)(hidL + fr * 528 + (32 * q + 8 * fq) * 2);
                    const bf16x8 wa = *(const bf16x8*)(W2 + 32 * q), wb = *(const bf16x8*)(W2 + 16 * 256 + 32 * q);
                    oA = __builtin_amdgcn_mfma_f32_16x16x32_bf16(wa, hf, oA, 0, 0, 0); oB = __builtin_amdgcn_mfma_f32_16x16x32_bf16(wb, hf, oB, 0, 0, 0);
                }
                const float* b2 = a.in[kv ? 12 : 7]; const int d0 = 16 * w + 4 * fq; const int row = r0 + fr, j = row & 511;
                f32x4 a1 = oA + *(const f32x4*)(b2 + d0), a2 = oB + *(const f32x4*)(b2 + d0 + 32);
                if (j == 511) { a1 = (f32x4){0.f, 0.f, 0.f, 0.f}; a2 = a1; }
                if (!kv) {
                    const int pos = (j == 511) ? 0 : 16 * j + 31;
                    const f32x4 cs = *(const f32x4*)(cosT + pos * 32 + d0), sn = *(const f32x4*)(sinT + pos * 32 + d0);
                    const f32x4 o1 = a1 * cs - a2 * sn, o2 = a1 * sn + a2 * cs;
                    bf16_t* p = KCC + (size_t)row * 64 + d0;
                    u32x2 w1; w1.x = cvt_pk_bf16(o1[0], o1[1]); w1.y = cvt_pk_bf16(o1[2], o1[3]); *(u32x2*)p = w1;
                    u32x2 w2; w2.x = cvt_pk_bf16(o2[0], o2[1]); w2.y = cvt_pk_bf16(o2[2], o2[3]); *(u32x2*)(p + 32) = w2;
                } else {
                    bf16_t* p = VCT + (size_t)(row >> 6) * 4096 + vperm(row & 63);
#pragma unroll
                    for (int e = 0; e < 4; ++e) { p[(d0 + e) * 64] = (bf16_t)(cvt_pk_bf16(a1[e], 0.f) & 0xffff); p[(d0 + 32 + e) * 64] = (bf16_t)(cvt_pk_bf16(a2[e], 0.f) & 0xffff); }
                }
            }
            __syncthreads();
        }
    }
    if (IN(2) && IN(4)) xcd_barrier(xbar);
    if (IN(4)) {
        att::Ctx X{Qb, KCC, VCT, KS, VST, KW, VWT, gates, Ob};
        for (int k = bx; k < 256; k += G) {
            for (int rep = 0; rep < 2; ++rep) { const int uu = rep ? 511 - k : k; const int c = 127 - (uu >> 2), bgi = uu & 3; att::unit(lds, X, bgi >> 1, bgi & 1, c, tid); }
        }
        if (defer) {
            int td = threadIdx.x; asm volatile("" : "+v"(td)); const int dl = td & 63, dw = __builtin_amdgcn_readfirstlane(td >> 6);
            LAS float* scr = (LAS float*)(lds + dw * 16384);
            for (int it = bx * 8 + dw; it < N_DEFER; it += 2048) ffn_weight_item(a, ws, scr, it, dl);
        }
    }
    SEAM(4);
    if (IN(5)) {
        pg8::Gemm g{Ob, Wt_out, M, D, D, D, 0}; pg8::StaticOrder S; S.init(M, D, G, bx);
        EpiRes E{a.in[0], out, XB, ssp, nullptr, nullptr, XB};
        pg8::gemm_phase(lds, ldsx, g, S, E);
    }
    SEAM(5);
#pragma unroll
    for (int L = 0; L < 2; ++L) {
        const int pb = 6 + 5 * L;
        const float* cw = a.in[L ? 25 : 16]; const float* cb = a.in[L ? 26 : 17];
        if (IN(pb)) {
            pg8::Gemm g{(const bf16_t*)(ws + (L ? WS_XB2 : WS_XB)), (const bf16_t*)(ws + (L ? WS_WUP1 : WS_WUP0)), M, UP, D, D, 0}; pg8::StaticOrder S; S.init(M, UP, G, bx);
            EpiUp E{L ? ssp + 4 * M : ssp, cw, cb, ACT, HB, FB};
            pg8::gemm_phase(lds, ldsx, g, S, E);
        }
        SEAM(pb);
        if (IN(pb + 1)) {
            for (int i = bx * 512 + tid; i < 64 * FF; i += G * 512) {
                const int pm = i / FF, cidx = i % FF;
                float hg0 = 0.f, hg1 = 0.f, hv0 = 0.f, hv1 = 0.f;
                if (pm & 31) { const float* h = HB + (size_t)(pm - 1) * 2 * UP; hg0 = h[cidx]; hg1 = h[UP + cidx]; hv0 = h[FF + cidx]; hv1 = h[UP + FF + cidx]; }
                const float* f = FB + (size_t)pm * 2 * UP; const float fg0 = f[cidx], fg1 = f[UP + cidx], fv0 = f[FF + cidx], fv1 = f[UP + FF + cidx];
                const float g0 = cb[cidx] + cw[cidx] * hg0 + cw[UP + cidx] * hg1 + cw[2 * UP + cidx] * fg0;
                const float g1 = cb[cidx] + cw[cidx] * hg1 + cw[UP + cidx] * fg0 + cw[2 * UP + cidx] * fg1;
                const float v0 = cb[FF + cidx] + cw[FF + cidx] * hv0 + cw[UP + FF + cidx] * hv1 + cw[2 * UP + FF + cidx] * fv0;
                const float v1 = cb[FF + cidx] + cw[FF + cidx] * hv1 + cw[UP + FF + cidx] * fv0 + cw[2 * UP + FF + cidx] * fv1;
                ACT[(size_t)(pm * 256) * FF + cidx] = (bf16_t)f2bf(g0 * sigmoidf_(g0) * v0);
                ACT[(size_t)(pm * 256 + 1) * FF + cidx] = (bf16_t)f2bf(g1 * sigmoidf_(g1) * v1);
            }
        }
        SEAM(pb + 1);
        if (IN(pb + 2)) {
            pg8::Gemm g{ACT, (const bf16_t*)(ws + (L ? WS_WDN1 : WS_WDN0)), M, D, FF, FF, 0}; pg8::StaticOrder S; S.init(M, D, G, bx);
            bf16_t* XBL = (bf16_t*)(ws + (L ? WS_XB2 : WS_XB));
            if (L == 1 && G == 256) { EpiFinal E{out, a.in[28], (float*)(ws + WS_SSP + 512 * 1024), (unsigned*)(ws + 16384), XBL}; pg8::gemm_phase(lds, ldsx, g, S, E); }
            else { EpiRes E{out, out, XBL, ssp, nullptr, nullptr, XBL}; pg8::gemm_phase(lds, ldsx, g, S, E); }
        }
        if (!(L == 1 && G == 256)) { if (IN(pb + 2)) xcd_barrier(xbar); }
        if (L == 0) {
            if (IN(10)) {
                pg8::Gemm g{POOLED, Wt_pool, M, D, 256, D, 512}; pg8::StaticOrder S; S.init(M, D, G, bx);
                {
                    LAS float* rsd = (LAS float*)lds;
                    const float* gn = a.in[19];
                    int tid = threadIdx.x; asm volatile("" : "+v"(tid));
                    pg8::Unit pu;
                    for (int ui = 0; S.next(ui, pu); ++ui) {
                        const int r0 = pu.pm * 256, tb = r0 & (T - 1), wsz = 2 << pu.pn;
                        const int c8 = pu.pn * 256 + (tid & 31) * 8, t0 = (tid >> 5) * 16;
                        const f32x4 gv0 = *(const f32x4*)(gn + c8), gv1 = *(const f32x4*)(gn + c8 + 4);
                        __syncthreads();
                        if (tid < 272) { const int rr = r0 - 16 + tid; rsd[tid] = (tb - 16 + tid >= 0) ? row_rstd(ssp, 4, rr) : 0.f; }
                        __syncthreads();
                        const bf16_t* xb0 = XB + (size_t)r0 * D + c8;
#define POOL_H(tl, lo, hi) do { unpk8(*(const u32x4*)(xb0 + (ptrdiff_t)(tl) * D), lo, hi); const float rs_ = rsd[16 + (tl)]; lo = lo * rs_; hi = hi * rs_; } while (0)
                        f32x4 s0 = (f32x4){0.f, 0.f, 0.f, 0.f}, s1 = s0;
                        for (int i = 1; i <= wsz; ++i) { const int tl = t0 - i; if (tb + tl >= 0) { f32x4 a0, a1; POOL_H(tl, a0, a1); s0 += a0; s1 += a1; } }
#pragma unroll 4
                        for (int tl = t0; tl < t0 + 16; ++tl) {
                            f32x4 h0, h1; POOL_H(tl, h0, h1); s0 += h0; s1 += h1;
                            const int td = tl - wsz; if (tb + td >= 0) { f32x4 d0, d1; POOL_H(td, d0, d1); s0 -= d0; s1 -= d1; }
                            const int t = tb + tl; const int cnt = (t + 1 < wsz) ? t + 1 : wsz; const float ic = 1.0f / (float)cnt;
                            const f32x4 p0 = (s0 * ic - h0) * gv0, p1 = (s1 * ic - h1) * gv1;
                            u32x4 wv; wv.x = cvt_pk_bf16(p0[0], p0[1]); wv.y = cvt_pk_bf16(p0[2], p0[3]); wv.z = cvt_pk_bf16(p1[0], p1[1]); wv.w = cvt_pk_bf16(p1[2], p1[3]);
                            *(u32x4*)(POOLED + (size_t)(r0 + tl) * D + c8) = wv;
                        }
#undef POOL_H
                    }
                    asm volatile("s_waitcnt vmcnt(0)" ::: "memory"); __syncthreads();
                }
                EpiRes E{out, out, XB, ssp + 4 * M, a.in[21], a.in[22], (bf16_t*)(ws + WS_XB2)};
                pg8::gemm_phase(lds, ldsx, g, S, E);
            }
            SEAM(10);
        }
    }
    if (IN(14) && G != 256) {
        int t14 = threadIdx.x; asm volatile("" : "+v"(t14)); const int lane = t14 & 63, wave = __builtin_amdgcn_readfirstlane(t14 >> 6);
        const int gw = bx * 8 + wave, NGW = G * 8; const float* gn = a.in[28];
        for (int m = gw; m < M; m += NGW) {
            const float rs = row_rstd(ssp, 4, m); f32x4* xr = (f32x4*)(out + (size_t)m * D) + lane; const f32x4* gr = (const f32x4*)gn + lane;
            const u32x2* xbr = (const u32x2*)(ws + WS_XB2) + (size_t)m * (D / 4) + lane;
#pragma unroll
            for (int j = 0; j < 4; ++j) { const u32x2 v = xbr[64 * j]; const f32x4 xv = (f32x4){__uint_as_float(v.x << 16), __uint_as_float(v.x & 0xffff0000u), __uint_as_float(v.y << 16), __uint_as_float(v.y & 0xffff0000u)}; xr[64 * j] = xv * rs * gr[64 * j]; }
        }
    }
#undef IN
#undef SEAM
#undef cosT
#undef sinT
#undef ssp
#undef c1p
#undef rstdv
#undef HB
#undef FB
#undef gates
#undef Wt_in
#undef Wt_out
#undef Wt_pool
#undef Wt_c1
#undef Wt_c2
#undef XB
#undef Qb
#undef KC
#undef VC
#undef KS
#undef VST
#undef KW
#undef VWT
#undef KCC
#undef VCT
#undef Ob
#undef ACT
#undef POOLED
}

extern "C" void kernel_launch(void* const* d_in, const int* in_sizes, int n_in, void* d_out, int out_size, void* d_ws, size_t ws_size, hipStream_t stream) {
    static int grid = 0;
    if (grid == 0) {
        int dev = 0, cus = 0, per_cu = 0;
        hipGetDevice(&dev); hipDeviceGetAttribute(&cus, hipDeviceAttributeMultiprocessorCount, dev);
        hipFuncSetAttribute((const void*)mk_fwd, hipFuncAttributeMaxDynamicSharedMemorySize, LDS_BYTES);
        hipOccupancyMaxActiveBlocksPerMultiprocessor(&per_cu, (const void*)mk_fwd, 512, LDS_BYTES);
        if (per_cu < 1) per_cu = 1;
        grid = cus * per_cu; if (grid > 256) grid = 256;
        (void)hipGetLastError();
    }
    Args a{};
    for (int i = 0; i < 29; ++i) a.in[i] = (const float*)d_in[i];
    a.out = (float*)d_out; a.ws = (unsigned char*)d_ws;
    for (int i = 0; i < 32; ++i) a.inv[i] = 1.0f / powf(10000.0f, (float)(2 * i) / 64.0f);
    a.ph_lo = 0; a.ph_hi = 15;
    hipMemsetAsync(d_ws, 0, 65536, stream);
    void* args[] = {&a};
    hipError_t e = hipLaunchCooperativeKernel((const void*)mk_fwd, dim3(grid), dim3(512), args, LDS_BYTES, stream);
    if (e != hipSuccess) fprintf(stderr, "cooperative launch failed: %s (grid %d)\n", hipGetErrorString(e), grid);
}
```

```cpp
#include <hip/hip_runtime.h>
#include <hip/hip_cooperative_groups.h>
#include <cstdio>
#include <cstdint>
namespace cg = cooperative_groups;

#define LAS __attribute__((address_space(3)))
typedef unsigned short bf16_t;
typedef short bf16x8 __attribute__((ext_vector_type(8)));
typedef short s16x4 __attribute__((ext_vector_type(4)));
typedef float f32x4 __attribute__((ext_vector_type(4)));
typedef unsigned u32x4 __attribute__((ext_vector_type(4)));
typedef unsigned u32x2 __attribute__((ext_vector_type(2)));

constexpr int T = 8192, D = 1024, M = 16384, FF = 2816, UP = 5632, NIN = 2048;
constexpr float EPS = 1e-6f;
constexpr float QSCALE = 0.125f * 1.4426950408889634f;
constexpr size_t MiB = 1u << 20;
constexpr size_t WS_ROPE = 1 * MiB;
constexpr size_t WS_SSP = 3 * MiB;
constexpr size_t WS_C1P = 4 * MiB;
constexpr size_t WS_RSTD = 4 * MiB + 256 * 1024;
constexpr size_t WS_HB = 5 * MiB;
constexpr size_t WS_FB = 8 * MiB;
constexpr size_t WS_GATE = 11 * MiB;
constexpr size_t WS_WIN = 16 * MiB, WS_WOUT = 20 * MiB, WS_WUP0 = 22 * MiB, WS_WUP1 = 33 * MiB, WS_WDN0 = 44 * MiB, WS_WDN1 = 50 * MiB;
constexpr size_t WS_WPOOL = 56 * MiB, WS_WC1K = 57 * MiB, WS_WC1V = 58 * MiB, WS_WC2K = 59 * MiB, WS_WC2V = 59 * MiB + 512 * 1024;
constexpr size_t WS_XB = 64 * MiB;
constexpr size_t WS_Q = 96 * MiB;
constexpr size_t WS_KC = 128 * MiB, WS_VC = 132 * MiB, WS_KS = 136 * MiB, WS_VST = 140 * MiB, WS_KW = 144 * MiB, WS_VWT = 148 * MiB;
constexpr size_t WS_KCC = 152 * MiB, WS_VCT = 153 * MiB, WS_HIDK = 154 * MiB, WS_HIDV = 155 * MiB;
constexpr size_t WS_O = 160 * MiB;
constexpr size_t WS_ACT = 96 * MiB;
constexpr size_t WS_POOLED = 192 * MiB;
constexpr size_t WS_XB2 = 224 * MiB;
constexpr int LDS_RING = 131072, LDS_BYTES = 155648;

__device__ __forceinline__ unsigned cvt_pk_bf16(float lo, float hi) { unsigned r; asm volatile("v_cvt_pk_bf16_f32 %0, %1, %2" : "=v"(r) : "v"(lo), "v"(hi)); return r; }
__device__ __forceinline__ float bf2f(unsigned short b) { return __uint_as_float((unsigned)b << 16); }
__device__ __forceinline__ float ex2(float x) { return __builtin_amdgcn_exp2f(x); }
__device__ __forceinline__ float rcp(float x) { return __builtin_amdgcn_rcpf(x); }
__device__ __forceinline__ float sigmoidf_(float x) { return rcp(1.0f + ex2(-1.4426950408889634f * x)); }
__device__ __forceinline__ void unpk8(const u32x4 v, f32x4& lo, f32x4& hi) { lo = (f32x4){__uint_as_float(v.x << 16), __uint_as_float(v.x & 0xffff0000u), __uint_as_float(v.y << 16), __uint_as_float(v.y & 0xffff0000u)}; hi = (f32x4){__uint_as_float(v.z << 16), __uint_as_float(v.z & 0xffff0000u), __uint_as_float(v.w << 16), __uint_as_float(v.w & 0xffff0000u)}; }
__device__ __forceinline__ int perm8(int a) { return (a & ~31) | (16 * ((a >> 2) & 1) + 4 * ((a >> 3) & 3) + (a & 3)); }
__device__ __forceinline__ int vperm(int kk) { return (kk & 32) | (((kk >> 2) & 3) << 3) | (((kk >> 4) & 1) << 2) | (kk & 3); }
__device__ __forceinline__ int swap45(int a) { return (a & ~48) | (((a >> 4) & 1) << 5) | (((a >> 5) & 1) << 4); }
template <int CTRL> __device__ __forceinline__ float dppf(float x) { return __builtin_bit_cast(float, __builtin_amdgcn_mov_dpp(__builtin_bit_cast(int, x), CTRL, 0xf, 0xf, true)); }
__device__ __forceinline__ float xrow16_max(float x) {
    auto s = __builtin_amdgcn_permlane16_swap(__float_as_uint(x), __float_as_uint(x), false, false); x = fmaxf(__uint_as_float(s[0]), __uint_as_float(s[1]));
    auto t = __builtin_amdgcn_permlane32_swap(__float_as_uint(x), __float_as_uint(x), false, false); return fmaxf(__uint_as_float(t[0]), __uint_as_float(t[1])); }
__device__ __forceinline__ float xrow16_sum(float x) {
    auto s = __builtin_amdgcn_permlane16_swap(__float_as_uint(x), __float_as_uint(x), false, false); x = __uint_as_float(s[0]) + __uint_as_float(s[1]);
    auto t = __builtin_amdgcn_permlane32_swap(__float_as_uint(x), __float_as_uint(x), false, false); return __uint_as_float(t[0]) + __uint_as_float(t[1]); }
__device__ __forceinline__ float sum8(float x) { x += dppf<0xB1>(x); x += dppf<0x4E>(x); x += dppf<0x141>(x); return x; }
#define LDS_WAIT() asm volatile("s_waitcnt lgkmcnt(0)" ::: "memory")
#define WG_BAR() do { asm volatile("s_waitcnt lgkmcnt(0)" ::: "memory"); __builtin_amdgcn_s_barrier(); asm volatile("" ::: "memory"); } while (0)

namespace pg8 {
constexpr int BM = 256, BK = 64, HALF = 128, HTB = HALF * BK * 2, NXCD = 8, WGM = 8;
__host__ __device__ __forceinline__ int lds_byte(int r, int c) { const int st = (r >> 4) * 2 + (c >> 5), rr = r & 15, cc = c & 31, ob = rr * 64 + cc * 2; return st * 1024 + (ob ^ (((ob >> 9) & 1) << 5)); }
__host__ __device__ __forceinline__ void stage_rc(int b, int& R, int& C) { const int st = b / 1024, sb = b % 1024, swz = sb ^ (((sb >> 9) & 1) << 5); R = (st >> 1) * 16 + swz / 64; C = (st & 1) * 32 + (swz % 64) / 2; }
struct Unit { int pm, pn; };
struct Gemm { const bf16_t* A; const bf16_t* Bt; int M, N, K, lda, apn; };
struct StaticOrder {
    int nM, nN, nwg, G, c;
    __device__ __forceinline__ void init(int M_, int N_, int G_, int c_) { nM = M_ / BM; nN = N_ / BM; nwg = nM * nN; G = G_; c = c_; }
    __device__ __forceinline__ bool next(int i, Unit& u) const {
        const long L = (long)i * G + c; if (L >= nwg) return false;
        int wgid = (int)L; { const int q = nwg / NXCD, r = nwg % NXCD, xcd = wgid % NXCD, off = wgid / NXCD; wgid = (xcd < r ? xcd * (q + 1) : r * (q + 1) + (xcd - r) * q) + off; }
        const int nig = WGM * nN, gid = wgid / nig, fm = gid * WGM, gsz = (nM - fm) < WGM ? (nM - fm) : WGM;
        u.pm = fm + ((wgid % nig) % gsz); u.pn = (wgid % nig) / gsz; return true;
    }
};
template <class Epi>
__device__ __forceinline__ void gemm_phase(LAS unsigned char* lds, LAS unsigned char* ldsx, const Gemm g, const StaticOrder& S, const Epi& E) {
    int tid = threadIdx.x; asm volatile("" : "+v"(tid));
    const int wid = __builtin_amdgcn_readfirstlane(tid >> 6), lane = tid & 63, wr = wid >> 2, wc = wid & 3, fr = lane & 15, fq = lane >> 4;
    const int K = g.K, nt = K / BK;
    unsigned voffA[2], voffB[2];
#pragma unroll
    for (int i = 0; i < 2; ++i) { int R, C; stage_rc(tid * 16 + i * 8192, R, C); voffA[i] = (unsigned)(R * g.lda + C) * 2u; voffB[i] = (unsigned)(R * K + C) * 2u; }
    const size_t kstep = (size_t)(BK * 2);
    const size_t hstepA = (size_t)HALF * g.lda * 2, tstepA = 2 * hstepA, hstepB = (size_t)HALF * K * 2, tstepB = 2 * hstepB;
    const unsigned ldsw = (unsigned)wid * 1024u;
    const int aoff = lds_byte(wr * 64 + fr, fq * 8), boff = lds_byte(wc * 32 + fr, fq * 8);
#define PG8_SA(b, h) (((b) * 2 + (h)) * HTB)
#define PG8_SB(b, h) ((4 + (b) * 2 + (h)) * HTB)
#define PG8_STAGE(bufoff, gbase, voff) do { _Pragma("unroll") for (int _i = 0; _i < 2; ++_i) \
        __builtin_amdgcn_global_load_lds((const unsigned*)((const char*)(gbase) + (voff)[_i]), (LAS unsigned*)(lds + (bufoff) + ldsw + _i * 8192), 16, 0, 0); } while (0)
#define PG8_LDA(dst, b, h) do { _Pragma("unroll") for (int m = 0; m < 4; ++m) _Pragma("unroll") for (int k = 0; k < 2; ++k) dst[m][k] = *(const LAS bf16x8*)(lds + PG8_SA(b, h) + aoff + m * 2048 + k * 1024); } while (0)
#define PG8_LDB(dst, b, h) do { _Pragma("unroll") for (int n = 0; n < 2; ++n) _Pragma("unroll") for (int k = 0; k < 2; ++k) dst[n][k] = *(const LAS bf16x8*)(lds + PG8_SB(b, h) + boff + n * 2048 + k * 1024); } while (0)
#define PG8_MMA(ai, bj, At, Bt) do { __builtin_amdgcn_s_setprio(1); _Pragma("unroll") for (int m = 0; m < 4; ++m) _Pragma("unroll") for (int n = 0; n < 2; ++n) _Pragma("unroll") for (int k = 0; k < 2; ++k) \
        acc[ai][bj][m][n] = __builtin_amdgcn_mfma_f32_16x16x32_bf16(Bt[n][k], At[m][k], acc[ai][bj][m][n], 0, 0, 0); __builtin_amdgcn_s_setprio(0); } while (0)
#define PG8_WAIT_V(n) asm volatile("s_waitcnt vmcnt(" #n ")" ::: "memory")
#define PG8_WAIT_L(n) asm volatile("s_waitcnt lgkmcnt(" #n ")" ::: "memory")
#define PG8_BAR __builtin_amdgcn_s_barrier()
#define PG8_SCHED __builtin_amdgcn_sched_barrier(0)
    Unit cur, nxt; int ui = 0;
    if (!S.next(0, cur)) return;
    f32x4 acc[2][2][4][2];
#pragma unroll
    for (int a = 0; a < 2; ++a)
#pragma unroll
        for (int b = 0; b < 2; ++b)
#pragma unroll
            for (int m = 0; m < 4; ++m)
#pragma unroll
                for (int n = 0; n < 2; ++n) acc[a][b][m][n] = (f32x4){0.f, 0.f, 0.f, 0.f};
    bf16x8 At[4][2], B0[2][2], B1[2][2];
    const char* cA = (const char*)g.A + (size_t)cur.pm * tstepA + (size_t)cur.pn * g.apn; const char* cB = (const char*)g.Bt + (size_t)cur.pn * tstepB;
    PG8_STAGE(PG8_SB(0, 0), cB, voffB); PG8_STAGE(PG8_SB(0, 1), cB + hstepB, voffB); PG8_STAGE(PG8_SA(0, 0), cA, voffA); PG8_STAGE(PG8_SA(0, 1), cA + hstepA, voffA);
    if (wr == 1) PG8_BAR;
    PG8_WAIT_V(2); PG8_BAR;
    PG8_STAGE(PG8_SB(1, 0), cB + kstep, voffB); PG8_STAGE(PG8_SA(1, 0), cA + kstep, voffA); PG8_STAGE(PG8_SB(1, 1), cB + hstepB + kstep, voffB);
    PG8_WAIT_V(6); PG8_BAR;
    for (;;) {
        const bool has_next = S.next(ui + 1, nxt);
        const char* nA = has_next ? (const char*)g.A + (size_t)nxt.pm * tstepA + (size_t)nxt.pn * g.apn : cA; const char* nB = has_next ? (const char*)g.Bt + (size_t)nxt.pn * tstepB : cB;
        for (int t = 0; t < nt; t += 2) {
            const bool last = (t == nt - 2);
            const char* a1 = cA + (size_t)(t + 1) * kstep;
            const char* a2 = last ? nA : cA + (size_t)(t + 2) * kstep; const char* b2 = last ? nB : cB + (size_t)(t + 2) * kstep;
            const char* a3 = a2 + kstep; const char* b3 = b2 + kstep;
            PG8_LDB(B0, 0, 0); PG8_LDB(B1, 0, 1); PG8_SCHED; PG8_LDA(At, 0, 0); PG8_STAGE(PG8_SA(1, 1), a1 + hstepA, voffA);
            PG8_WAIT_V(8); PG8_WAIT_L(0); PG8_BAR; PG8_MMA(0, 0, At, B0); PG8_MMA(0, 1, At, B1); PG8_BAR; PG8_SCHED;
            PG8_LDA(At, 0, 1); PG8_STAGE(PG8_SB(0, 0), b2, voffB); PG8_STAGE(PG8_SB(0, 1), b2 + hstepB, voffB); PG8_STAGE(PG8_SA(0, 0), a2, voffA);
            PG8_WAIT_V(8); PG8_WAIT_L(0); PG8_BAR; PG8_MMA(1, 0, At, B0); PG8_MMA(1, 1, At, B1); PG8_BAR; PG8_SCHED;
            PG8_LDB(B0, 1, 0); PG8_LDB(B1, 1, 1); PG8_SCHED; PG8_LDA(At, 1, 0); PG8_STAGE(PG8_SA(0, 1), a2 + hstepA, voffA);
            PG8_WAIT_V(8); PG8_WAIT_L(0); PG8_BAR; PG8_MMA(0, 0, At, B0); PG8_MMA(0, 1, At, B1); PG8_BAR; PG8_SCHED;
            PG8_LDA(At, 1, 1); PG8_STAGE(PG8_SB(1, 0), b3, voffB); PG8_STAGE(PG8_SB(1, 1), b3 + hstepB, voffB); PG8_STAGE(PG8_SA(1, 0), a3, voffA);
            PG8_WAIT_V(8); PG8_WAIT_L(0); PG8_BAR; PG8_MMA(1, 0, At, B0); PG8_MMA(1, 1, At, B1); PG8_BAR; PG8_SCHED;
        }
        if (wr == 0) PG8_BAR;
        { int t2 = threadIdx.x; asm volatile("" : "+v"(t2));
          E(acc, cur, wr, wc, t2 & 15, (t2 & 63) >> 4, ldsx, t2); }
        if (!has_next) break;
#pragma unroll
        for (int a = 0; a < 2; ++a)
#pragma unroll
            for (int b = 0; b < 2; ++b)
#pragma unroll
                for (int m = 0; m < 4; ++m)
#pragma unroll
                    for (int n = 0; n < 2; ++n) acc[a][b][m][n] = (f32x4){0.f, 0.f, 0.f, 0.f};
        cur = nxt; cA = nA; cB = nB; ++ui;
        if (wr == 1) PG8_BAR;
    }
    PG8_WAIT_V(0);
    PG8_BAR;
#undef PG8_SA
#undef PG8_SB
#undef PG8_STAGE
#undef PG8_LDA
#undef PG8_LDB
#undef PG8_MMA
#undef PG8_WAIT_V
#undef PG8_WAIT_L
#undef PG8_BAR
#undef PG8_SCHED
}
}
using pg8::Unit;
typedef f32x4 Acc[2][2][4][2];

__device__ __forceinline__ float row_rstd(const float* ssp, int np, int row) {
    float s = 0.f; for (int i = 0; i < np; ++i) s += ssp[(size_t)i * M + row];
    return 1.0f / sqrtf(s * (1.0f / D) + EPS);
}

struct EpiIn {
    const float* rstdv; const float* cosT; const float* sinT;
    bf16_t *Q, *KC, *VC, *KS, *VST, *KW, *VWT; float* gates;
    __device__ __forceinline__ void operator()(Acc& acc, const Unit& u, int wr, int wc, int fr, int fq, LAS unsigned char*, int) const {
#pragma unroll
        for (int ai = 0; ai < 2; ++ai)
#pragma unroll
            for (int m = 0; m < 4; ++m) {
                const int row = u.pm * 256 + ai * 128 + wr * 64 + m * 16 + fr; const float rs = rstdv[row];
                const int t = row & (T - 1), b = row >> 13;
                const int d0 = 16 * (wc & 1) + 4 * fq;
                const f32x4 cs = *(const f32x4*)(cosT + t * 32 + d0), sn = *(const f32x4*)(sinT + t * 32 + d0);
#pragma unroll
                for (int bj = 0; bj < 2; ++bj) {
                    f32x4 a1 = acc[ai][bj][m][0] * rs, a2 = acc[ai][bj][m][1] * rs;
                    if (u.pn == 7) {
                        if (bj == 0) {
#pragma unroll
                            for (int n = 0; n < 2; ++n) { const int c0 = 32 * wc + 16 * n + 4 * fq; if (c0 < 48) { const f32x4 v = n ? a2 : a1; f32x4 o; o[0] = sigmoidf_(v[0]); o[1] = sigmoidf_(v[1]); o[2] = sigmoidf_(v[2]); o[3] = sigmoidf_(v[3]); *(f32x4*)(gates + (size_t)row * 48 + c0) = o; } }
                        }
                        continue;
                    }
                    const int hh = 2 * bj + (wc >> 1);
                    bool rope; if (u.pn < 4) rope = true; else rope = (u.pn >= 5) && (hh < 2);
                    f32x4 o1 = a1, o2 = a2;
                    if (rope) { o1 = a1 * cs - a2 * sn; o2 = a1 * sn + a2 * cs; }
                    if (u.pn < 4) {
                        o1 = o1 * QSCALE; o2 = o2 * QSCALE;
                        bf16_t* p = Q + (size_t)row * 1024 + (u.pn * 4 + hh) * 64 + d0;
                        u32x2 w1; w1.x = cvt_pk_bf16(o1[0], o1[1]); w1.y = cvt_pk_bf16(o1[2], o1[3]); *(u32x2*)p = w1;
                        u32x2 w2; w2.x = cvt_pk_bf16(o2[0], o2[1]); w2.y = cvt_pk_bf16(o2[2], o2[3]); *(u32x2*)(p + 32) = w2;
                    } else {
                        const int gg = hh & 1; const bool isv = hh >= 2;
                        if (!isv) {
                            bf16_t* base = (u.pn == 4) ? KC : (u.pn == 5) ? KS : KW;
                            bf16_t* p = base + ((size_t)(b * 2 + gg) * T + t) * 64 + d0;
                            u32x2 w1; w1.x = cvt_pk_bf16(o1[0], o1[1]); w1.y = cvt_pk_bf16(o1[2], o1[3]); *(u32x2*)p = w1;
                            u32x2 w2; w2.x = cvt_pk_bf16(o2[0], o2[1]); w2.y = cvt_pk_bf16(o2[2], o2[3]); *(u32x2*)(p + 32) = w2;
                        } else if (u.pn == 4) {
                            bf16_t* p = VC + ((size_t)(b * 2 + gg) * T + t) * 64 + d0;
                            u32x2 w1; w1.x = cvt_pk_bf16(o1[0], o1[1]); w1.y = cvt_pk_bf16(o1[2], o1[3]); *(u32x2*)p = w1;
                            u32x2 w2; w2.x = cvt_pk_bf16(o2[0], o2[1]); w2.y = cvt_pk_bf16(o2[2], o2[3]); *(u32x2*)(p + 32) = w2;
                        } else {
                            bf16_t* base = (u.pn == 5) ? VST : VWT;
                            bf16_t* p = base + ((size_t)(b * 2 + gg) * 128 + (t >> 6)) * 4096 + vperm(t & 63);
#pragma unroll
                            for (int j = 0; j < 4; ++j) { p[(d0 + j) * 64] = (bf16_t)(cvt_pk_bf16(o1[j], 0.f) & 0xffff); p[(d0 + 32 + j) * 64] = (bf16_t)(cvt_pk_bf16(o2[j], 0.f) & 0xffff); }
                        }
                    }
                }
                asm volatile("" ::: "memory"); __builtin_amdgcn_sched_barrier(0);
            }
    }
};

struct EpiC1 {
    bf16_t* hid;
    __device__ __forceinline__ void operator()(Acc& acc, const Unit& u, int wr, int wc, int fr, int fq, LAS unsigned char* ldsx, int) const {
        const LAS float* c1 = (const LAS float*)ldsx;
#pragma unroll
        for (int bj = 0; bj < 2; ++bj) {
            const int c0 = 128 * bj + 32 * wc + 8 * fq;
            const f32x4 bA = *(const LAS f32x4*)(c1 + c0), bB = *(const LAS f32x4*)(c1 + c0 + 4);
#pragma unroll
            for (int ai = 0; ai < 2; ++ai)
#pragma unroll
                for (int m = 0; m < 4; ++m) {
                    const int row = u.pm * 256 + ai * 128 + wr * 64 + m * 16 + fr;
                    float v[8];
#pragma unroll
                    for (int e = 0; e < 8; ++e) { const float x = acc[ai][bj][m][e >> 2][e & 3] + ((e >> 2) ? bB[e & 3] : bA[e & 3]); const float y = 0.7978845608028654f * (x + 0.044715f * x * x * x); v[e] = x * sigmoidf_(2.0f * y); }
                    u32x4 w; w.x = cvt_pk_bf16(v[0], v[1]); w.y = cvt_pk_bf16(v[2], v[3]); w.z = cvt_pk_bf16(v[4], v[5]); w.w = cvt_pk_bf16(v[6], v[7]);
                    *(u32x4*)(hid + (size_t)row * 256 + c0) = w;
                    asm volatile("" ::: "memory"); __builtin_amdgcn_sched_barrier(0);
                }
        }
    }
};
struct EpiC2 {
    const float* b2; const float* cosT; const float* sinT; bf16_t* out; int isv;
    __device__ __forceinline__ void operator()(Acc& acc, const Unit& u, int wr, int wc, int fr, int fq, LAS unsigned char*, int) const {
        if (wc >= 2) return;
        const int d0 = 16 * (wc & 1) + 4 * fq;
        const f32x4 bA = *(const f32x4*)(b2 + d0), bB = *(const f32x4*)(b2 + d0 + 32);
#pragma unroll
        for (int ai = 0; ai < 2; ++ai)
#pragma unroll
            for (int m = 0; m < 4; ++m) {
                const int row = u.pm * 256 + ai * 128 + wr * 64 + m * 16 + fr; const int j = row & 511;
                f32x4 a1 = acc[ai][0][m][0] + bA, a2 = acc[ai][0][m][1] + bB;
                if (j == 511) { a1 = (f32x4){0.f, 0.f, 0.f, 0.f}; a2 = a1; }
                if (!isv) {
                    const int pos = (j == 511) ? 0 : 16 * j + 31;
                    const f32x4 cs = *(const f32x4*)(cosT + pos * 32 + d0), sn = *(const f32x4*)(sinT + pos * 32 + d0);
                    const f32x4 o1 = a1 * cs - a2 * sn, o2 = a1 * sn + a2 * cs;
                    bf16_t* p = out + (size_t)row * 64 + d0;
                    u32x2 w1; w1.x = cvt_pk_bf16(o1[0], o1[1]); w1.y = cvt_pk_bf16(o1[2], o1[3]); *(u32x2*)p = w1;
                    u32x2 w2; w2.x = cvt_pk_bf16(o2[0], o2[1]); w2.y = cvt_pk_bf16(o2[2], o2[3]); *(u32x2*)(p + 32) = w2;
                } else {
                    bf16_t* p = out + (size_t)(row >> 6) * 4096 + vperm(row & 63);
#pragma unroll
                    for (int e = 0; e < 4; ++e) { p[(d0 + e) * 64] = (bf16_t)(cvt_pk_bf16(a1[e], 0.f) & 0xffff); p[(d0 + 32 + e) * 64] = (bf16_t)(cvt_pk_bf16(a2[e], 0.f) & 0xffff); }
                }
                asm volatile("" ::: "memory"); __builtin_amdgcn_sched_barrier(0);
            }
    }
};

struct EpiRes {
    const float* xold; float* xnew; const bf16_t* xb; float* ssp; const float* pb; const float* ps; bf16_t* xbo;
    __device__ __forceinline__ void operator()(Acc& acc, const Unit& u, int wr, int wc, int fr, int fq, LAS unsigned char* ldsx, int tid) const {
#pragma unroll
        for (int ai = 0; ai < 2; ++ai)
#pragma unroll
            for (int m = 0; m < 4; ++m) {
                const int row = u.pm * 256 + ai * 128 + wr * 64 + m * 16 + fr; float ss = 0.f;
#pragma unroll
                for (int bj = 0; bj < 2; ++bj) {
                    const int col = u.pn * 256 + 128 * bj + 32 * wc + 8 * fq; const size_t off = (size_t)row * D + col;
                    f32x4 a0 = acc[ai][bj][m][0], a1 = acc[ai][bj][m][1];
                    if (pb) { a0 = (a0 + *(const f32x4*)(pb + col)) * *(const f32x4*)(ps + col); a1 = (a1 + *(const f32x4*)(pb + col + 4)) * *(const f32x4*)(ps + col + 4); }
                    f32x4 r0, r1; unpk8(*(const u32x4*)(xb + off), r0, r1);
                    const f32x4 x0 = r0 + a0, x1 = r1 + a1;
                    u32x4 w; w.x = cvt_pk_bf16(x0[0], x0[1]); w.y = cvt_pk_bf16(x0[2], x0[3]); w.z = cvt_pk_bf16(x1[0], x1[1]); w.w = cvt_pk_bf16(x1[2], x1[3]);
                    *(u32x4*)(xbo + off) = w;
                    ss += (x0[0] * x0[0] + x0[1] * x0[1]) + (x0[2] * x0[2] + x0[3] * x0[3]) + (x1[0] * x1[0] + x1[1] * x1[1]) + (x1[2] * x1[2] + x1[3] * x1[3]);
                    asm volatile("" ::: "memory"); __builtin_amdgcn_sched_barrier(0);
                }
                ss = xrow16_sum(ss);
                if (fq == 0) ((LAS float*)ldsx)[wc * 256 + ai * 128 + wr * 64 + m * 16 + fr] = ss;
            }
        WG_BAR();
        if (tid < 256) { const LAS float* rd = (const LAS float*)ldsx; ssp[(size_t)u.pn * M + u.pm * 256 + tid] = (rd[tid] + rd[256 + tid]) + (rd[512 + tid] + rd[768 + tid]); }
        WG_BAR();
    }
};

struct EpiFinal {
    float* x; const float* gain; float* ssx; unsigned* cnt; const bf16_t* xb;
    __device__ __forceinline__ void operator()(Acc& acc, const Unit& u, int wr, int wc, int fr, int fq, LAS unsigned char* ldsx, int tid) const {
        LAS float* red = (LAS float*)ldsx; LAS float* rsl = (LAS float*)(ldsx + 4096);
#pragma unroll
        for (int ai = 0; ai < 2; ++ai)
#pragma unroll
            for (int m = 0; m < 4; ++m) {
                const int row = u.pm * 256 + ai * 128 + wr * 64 + m * 16 + fr; float ss = 0.f;
#pragma unroll
                for (int bj = 0; bj < 2; ++bj) {
                    const int col = u.pn * 256 + 128 * bj + 32 * wc + 8 * fq; const size_t off = (size_t)row * D + col;
                    f32x4 r0, r1; unpk8(*(const u32x4*)(xb + off), r0, r1);
                    const f32x4 x0 = r0 + acc[ai][bj][m][0], x1 = r1 + acc[ai][bj][m][1];
                    acc[ai][bj][m][0] = x0; acc[ai][bj][m][1] = x1;
                    ss += (x0[0] * x0[0] + x0[1] * x0[1]) + (x0[2] * x0[2] + x0[3] * x0[3]) + (x1[0] * x1[0] + x1[1] * x1[1]) + (x1[2] * x1[2] + x1[3] * x1[3]);
                    asm volatile("" ::: "memory"); __builtin_amdgcn_sched_barrier(0);
                }
                ss = xrow16_sum(ss);
                if (fq == 0) red[wc * 256 + ai * 128 + wr * 64 + m * 16 + fr] = ss;
            }
        WG_BAR();
        if (tid < 256) __hip_atomic_store(ssx + (size_t)u.pn * M + u.pm * 256 + tid, (red[tid] + red[256 + tid]) + (red[512 + tid] + red[768 + tid]), __ATOMIC_RELAXED, __HIP_MEMORY_SCOPE_AGENT);
        asm volatile("s_waitcnt vmcnt(0)" ::: "memory");
        WG_BAR();
        if (tid == 0) {
            unsigned* c = cnt + 64 * u.pm;
            __hip_atomic_fetch_add(c, 1u, __ATOMIC_RELAXED, __HIP_MEMORY_SCOPE_AGENT);
            unsigned spins = 0;
            while (__hip_atomic_load(c, __ATOMIC_RELAXED, __HIP_MEMORY_SCOPE_AGENT) < 4u) { __builtin_amdgcn_s_sleep(2); if (++spins > (1u << 22)) break; }
            __builtin_amdgcn_fence(__ATOMIC_ACQUIRE, "agent");
            asm volatile("s_waitcnt vmcnt(0)" ::: "memory");
        }
        WG_BAR();
        if (tid < 256) {
            const float* p = ssx + u.pm * 256 + tid;
            const float sq = (__hip_atomic_load(p, __ATOMIC_RELAXED, __HIP_MEMORY_SCOPE_AGENT) + __hip_atomic_load(p + M, __ATOMIC_RELAXED, __HIP_MEMORY_SCOPE_AGENT)) +
                             (__hip_atomic_load(p + 2 * M, __ATOMIC_RELAXED, __HIP_MEMORY_SCOPE_AGENT) + __hip_atomic_load(p + 3 * M, __ATOMIC_RELAXED, __HIP_MEMORY_SCOPE_AGENT));
            rsl[tid] = 1.0f / sqrtf(sq * (1.0f / D) + EPS);
        }
        WG_BAR();
#pragma unroll
        for (int ai = 0; ai < 2; ++ai)
#pragma unroll
            for (int m = 0; m < 4; ++m) {
                const int rl = ai * 128 + wr * 64 + m * 16 + fr; const float rs = rsl[rl]; const int row = u.pm * 256 + rl;
#pragma unroll
                for (int bj = 0; bj < 2; ++bj) {
                    const int col = u.pn * 256 + 128 * bj + 32 * wc + 8 * fq; const size_t off = (size_t)row * D + col;
                    *(f32x4*)(x + off) = acc[ai][bj][m][0] * rs * *(const f32x4*)(gain + col); *(f32x4*)(x + off + 4) = acc[ai][bj][m][1] * rs * *(const f32x4*)(gain + col + 4);
                }
                asm volatile("" ::: "memory"); __builtin_amdgcn_sched_barrier(0);
            }
    }
};

struct EpiUp {
    const float* ssp; const float* cw; const float* cb; bf16_t* act; float* HB; float* FB;
    __device__ __forceinline__ void operator()(Acc& acc, const Unit& u, int wr, int wc, int fr, int fq, LAS unsigned char* ldsx, int tid) const {
        LAS float* Hl = (LAS float*)ldsx;
        LAS float* rsl = (LAS float*)(ldsx + 10240);
        const int lane = tid & 63;
        if (tid < 256) { const int row = u.pm * 256 + tid; const float sq = (ssp[row] + ssp[M + row]) + (ssp[2 * M + row] + ssp[3 * M + row]); rsl[tid] = 1.0f / sqrtf(sq * (1.0f / D) + EPS); }
        WG_BAR();
#pragma unroll
        for (int ai = 0; ai < 2; ++ai)
#pragma unroll
            for (int m = 0; m < 4; ++m) {
                const float rs = rsl[ai * 128 + wr * 64 + m * 16 + fr];
#pragma unroll
                for (int bj = 0; bj < 2; ++bj) { acc[ai][bj][m][0] *= rs; acc[ai][bj][m][1] *= rs; }
                asm volatile("" ::: "memory"); __builtin_amdgcn_sched_barrier(0);
            }
        if (tid < 128) *(LAS f32x4*)(Hl + tid * 4) = (f32x4){0.f, 0.f, 0.f, 0.f};
#pragma unroll
        for (int ai = 0; ai < 2; ++ai) {
            const int k = 2 * ai + wr;
#pragma unroll
            for (int bj = 0; bj < 2; ++bj)
#pragma unroll
                for (int n = 0; n < 2; ++n) {
                    const int tc = 128 * bj + 32 * wc + 8 * fq + 4 * n; const int uc = bj * FF + u.pn * 128 + 32 * wc + 8 * fq + 4 * n;
                    if (fr >= 14) { *(LAS f32x4*)(Hl + ((k + 1) * 2 + (fr - 14)) * 256 + tc) = acc[ai][bj][3][n]; if (k == 3) *(f32x4*)(HB + ((size_t)u.pm * 2 + (fr - 14)) * UP + uc) = acc[ai][bj][3][n]; }
                    if (k == 0 && fr < 2) *(f32x4*)(FB + ((size_t)u.pm * 2 + fr) * UP + uc) = acc[0][bj][0][n];
                }
        }
        WG_BAR();
#define UP_CONV(dst, ai_, bj_, W0, W1, W2, BB, H0, H1) do { _Pragma("unroll") for (int m = 0; m < 4; ++m) { \
            const f32x4 V = acc[ai_][bj_][m][n]; f32x4 p1, p2; \
            _Pragma("unroll") for (int e = 0; e < 4; ++e) { \
                const float r1 = dppf<0x121>(V[e]), r2 = dppf<0x122>(V[e]); float x1, x2; \
                if (m > 0) { x1 = dppf<0x121>(acc[ai_][bj_][m > 0 ? m - 1 : 0][n][e]); x2 = dppf<0x122>(acc[ai_][bj_][m > 0 ? m - 1 : 0][n][e]); } \
                else { x1 = H1[e]; x2 = (fr == 0) ? H0[e] : H1[e]; } \
                p1[e] = (fr == 0) ? x1 : r1; p2[e] = (fr < 2) ? x2 : r2; } \
            dst[m] = BB + W0 * p2 + W1 * p1 + W2 * V; } } while (0)
        u32x2 pk[2][4];
#pragma unroll
        for (int n = 0; n < 2; ++n) {
            const int tc = 32 * wc + 8 * fq + 4 * n; const int ucg = u.pn * 128 + tc;
            const f32x4 gw0 = *(const f32x4*)(cw + ucg), gw1 = *(const f32x4*)(cw + UP + ucg), gw2 = *(const f32x4*)(cw + 2 * UP + ucg), gbb = *(const f32x4*)(cb + ucg);
            const f32x4 vw0 = *(const f32x4*)(cw + FF + ucg), vw1 = *(const f32x4*)(cw + UP + FF + ucg), vw2 = *(const f32x4*)(cw + 2 * UP + FF + ucg), vbb = *(const f32x4*)(cb + FF + ucg);
            f32x4 cg[2][4];
#pragma unroll
            for (int ai = 0; ai < 2; ++ai) {
                const int k = 2 * ai + wr;
                const f32x4 h0 = *(const LAS f32x4*)(Hl + (k * 2 + 0) * 256 + tc), h1 = *(const LAS f32x4*)(Hl + (k * 2 + 1) * 256 + tc);
                UP_CONV(cg[ai], ai, 0, gw0, gw1, gw2, gbb, h0, h1);
                __builtin_amdgcn_sched_barrier(0);
            }
#pragma unroll
            for (int ai = 0; ai < 2; ++ai) {
                const int k = 2 * ai + wr;
                const f32x4 h0 = *(const LAS f32x4*)(Hl + (k * 2 + 0) * 256 + 128 + tc), h1 = *(const LAS f32x4*)(Hl + (k * 2 + 1) * 256 + 128 + tc);
                f32x4 cv[4];
                UP_CONV(cv, ai, 1, vw0, vw1, vw2, vbb, h0, h1);
#pragma unroll
                for (int m = 0; m < 4; ++m) {
                    const int row = u.pm * 256 + ai * 128 + wr * 64 + m * 16 + fr;
                    float o[4];
#pragma unroll
                    for (int e = 0; e < 4; ++e) { const float gt = cg[ai][m][e]; o[e] = gt * sigmoidf_(gt) * cv[m][e]; }
                    u32x2 w; w.x = cvt_pk_bf16(o[0], o[1]); w.y = cvt_pk_bf16(o[2], o[3]);
                    if (n == 0) pk[ai][m] = w;
                    else { u32x4 w4; w4.x = pk[ai][m].x; w4.y = pk[ai][m].y; w4.z = w.x; w4.w = w.y; *(u32x4*)(act + (size_t)row * FF + ucg - 4) = w4; }
                }
                asm volatile("" ::: "memory"); __builtin_amdgcn_sched_barrier(0);
            }
        }
#undef UP_CONV
        WG_BAR();
    }
};

namespace att {
constexpr int SLOT_B = 16384, NSLOT = 6;
constexpr int OFF_K = 0, OFF_IMP = NSLOT * SLOT_B, IMPW = 132, OFF_SEL = OFF_IMP + 64 * IMPW * 4, OFF_UNI = OFF_SEL + 1024, OFF_LIST = OFF_UNI + 64, OFF_N = OFF_LIST + 132 * 4, OFF_CODE = OFF_N + 48, CODEW = 144;
static_assert(OFF_CODE + 8 * CODEW <= LDS_BYTES - 16 && 8 * SLOT_B <= OFF_SEL, "attention LDS map");
struct Ctx {
    const bf16_t *Q, *KCC, *VCT, *KS, *VST, *KW, *VWT; const float* gates; bf16_t* O;
};
__device__ __forceinline__ bf16x8 mk8(s16x4 a, s16x4 b) { return (bf16x8){a[0], a[1], a[2], a[3], b[0], b[1], b[2], b[3]}; }

template <int MODE>
__device__ __forceinline__ void branch(LAS unsigned char* lds, const bf16_t* Kg, const bf16_t* Vg, int ktile_elems, int nt, int c, int w, int lane, int tid,
                                       const bf16x8 (&qf)[4][2], float (&mrow)[4], float (&lrow)[4], f32x4 (&O)[4][4]) {
    const int fr = lane & 15, fq = lane >> 4;
    const LAS int* list = (const LAS int*)(lds + OFF_LIST);
    LAS float* impL = (LAS float*)(lds + OFF_IMP);
    const LAS unsigned char* codeL = (const LAS unsigned char*)(lds + OFF_CODE) + w * CODEW;
    constexpr int TPS = (MODE >= 2) ? 4 : 3;
#define ATT_DMA(ti, slot) do { const int ti_ = (ti); const int s_ = list[ti_]; LAS unsigned char* d_ = lds + OFF_K + (slot) * SLOT_B + w * 1024; \
        int t2_ = tid; asm volatile("" : "+v"(t2_)); const int lr = t2_ >> 3, lq = t2_ & 7; const int goff = lr * 64 + ((lq ^ ((lr >> 1) & 7)) * 8); \
        __builtin_amdgcn_global_load_lds((const unsigned*)(Kg + (size_t)s_ * ktile_elems + goff), (LAS unsigned*)d_, 16, 0, 0); \
        if (MODE != 0) __builtin_amdgcn_global_load_lds((const unsigned*)(Vg + (size_t)s_ * 4096 + goff), (LAS unsigned*)(d_ + 8192), 16, 0, 0); } while (0)
    asm volatile("s_waitcnt vmcnt(0)" ::: "memory");
#pragma unroll
    for (int ti = 0; ti < TPS; ++ti) if (ti < nt) ATT_DMA(ti, ti);
    const int nst = (nt + TPS - 1) / TPS;
    for (int j = 0; j < nst; ++j) {
        asm volatile("s_waitcnt vmcnt(0)" ::: "memory");
        WG_BAR();
#pragma unroll
        for (int hh = 0; hh < TPS; ++hh) if (TPS * (j + 1) + hh < nt) ATT_DMA(TPS * (j + 1) + hh, ((j + 1) & 1) * TPS + hh);
        int sl0 = 0, sl1 = 0, sl2 = 0, sl3 = 0; unsigned codes4 = 0xffffffffu;
        if (TPS == 4) {
            const u32x4 l4 = *(const LAS u32x4*)(list + TPS * j);
            sl0 = __builtin_amdgcn_readfirstlane((int)l4.x); sl1 = __builtin_amdgcn_readfirstlane((int)l4.y); sl2 = __builtin_amdgcn_readfirstlane((int)l4.z); sl3 = __builtin_amdgcn_readfirstlane((int)l4.w);
            if (MODE == 2) codes4 = (unsigned)__builtin_amdgcn_readfirstlane((int)*(const LAS unsigned*)(codeL + TPS * j));
        }
#pragma unroll 1
        for (int h = 0; h < TPS; ++h) {
        const int i = TPS * j + h; if (i >= nt) break;
        const int s = (TPS == 4) ? (h == 0 ? sl0 : h == 1 ? sl1 : h == 2 ? sl2 : sl3) : list[i];
        unsigned code = 0xffu; if (MODE == 2) code = (codes4 >> (8 * h)) & 0xffu;
        const LAS unsigned char* Kb = lds + OFF_K + ((j & 1) * TPS + h) * SLOT_B;
        const LAS unsigned char* Vb = Kb;
        int l2_ = lane; asm volatile("" : "+v"(l2_)); const int fr2 = l2_ & 15, fq2 = l2_ >> 4, swz = (fr2 >> 1) & 7;
        const int kb0 = fr2 * 128 + ((fq2 ^ swz) * 16), kb1 = kb0 ^ 64;
        if (MODE != 2) {
            f32x4 sa[4][4];
#pragma unroll
            for (int p = 0; p < 4; ++p) {
                const float cinit = (MODE == 1) ? lrow[p] : -((mrow[p] < -1e29f) ? 0.f : mrow[p]);
#pragma unroll
                for (int mt = 0; mt < 4; ++mt) sa[p][mt] = (f32x4){cinit, cinit, cinit, cinit};
            }
            bf16x8 vd0[4];
            {
                bf16x8 kf[8];
#pragma unroll
                for (int i8 = 0; i8 < 8; ++i8) kf[i8] = *(const LAS bf16x8*)(Kb + ((i8 & 1) ? kb1 : kb0) + (i8 >> 1) * 2048);
                __builtin_amdgcn_sched_barrier(0);
#pragma unroll
                for (int i8 = 0; i8 < 8; ++i8)
#pragma unroll
                    for (int p = 0; p < 4; ++p) sa[p][i8 >> 1] = __builtin_amdgcn_mfma_f32_16x16x32_bf16(kf[i8], qf[p][i8 & 1], sa[p][i8 >> 1], 0, 0, 0);
            }
            bf16x8 pf[4][2];
#pragma unroll
            for (int p = 0; p < 4; ++p) {
                const int ttA = 8 * w + 2 * p, tt = ttA + (fr >> 3);
                bool needmask;
                if (MODE <= 1) needmask = (((64 * c + ttA - 31) >> 4) - 64 * s) < 63;
                else needmask = (s == c) || (c >= 8 && s == c - 8);
                if (needmask) {
                    int hi, lov = -1;
                    if (MODE <= 1) { const int t = 64 * c + tt; hi = ((t - 31) >> 4) - 64 * s; }
                    else { hi = (s == c) ? tt : 63; lov = (c >= 8 && s == c - 8) ? tt : -1; }
#pragma unroll
                    for (int mt = 0; mt < 4; ++mt)
#pragma unroll
                        for (int j = 0; j < 4; ++j) { const int kk = 16 * mt + 4 * fq + j; sa[p][mt][j] = (kk <= hi && kk > lov) ? sa[p][mt][j] : -1e30f; }
                }
                if (MODE != 1) {
                    float mx = fmaxf(fmaxf(sa[p][0][0], sa[p][0][1]), sa[p][0][2]);
                    mx = fmaxf(fmaxf(mx, sa[p][0][3]), sa[p][1][0]); mx = fmaxf(fmaxf(mx, sa[p][1][1]), sa[p][1][2]); mx = fmaxf(fmaxf(mx, sa[p][1][3]), sa[p][2][0]);
                    mx = fmaxf(fmaxf(mx, sa[p][2][1]), sa[p][2][2]); mx = fmaxf(fmaxf(mx, sa[p][2][3]), sa[p][3][0]); mx = fmaxf(fmaxf(mx, sa[p][3][1]), sa[p][3][2]); mx = fmaxf(mx, sa[p][3][3]);
                    mx = xrow16_max(mx);
                    const bool uninit = mrow[p] < -1e29f;
                    const bool resc = (mx > 8.0f) || (uninit && mx > -1e29f);
                    if (__any(resc)) {
                        const float delta = resc ? mx : 0.f;
                        const float alpha = (resc && !uninit) ? ex2(-delta) : 1.0f;
#pragma unroll
                        for (int mt = 0; mt < 4; ++mt) sa[p][mt] = sa[p][mt] - delta;
                        lrow[p] *= alpha;
                        if (MODE >= 2) {
#pragma unroll
                            for (int d = 0; d < 4; ++d) O[p][d] *= alpha;
                        }
                        if (resc) mrow[p] = (uninit ? 0.f : mrow[p]) + delta;
                    }
                }
#pragma unroll
                for (int mt = 0; mt < 4; ++mt)
#pragma unroll
                    for (int j = 0; j < 4; ++j) sa[p][mt][j] = ex2(sa[p][mt][j]);
                if (MODE != 1) { const f32x4 t4 = (sa[p][0] + sa[p][1]) + (sa[p][2] + sa[p][3]); lrow[p] += (t4[0] + t4[1]) + (t4[2] + t4[3]); }
                if (MODE >= 1) {
#pragma unroll
                    for (int k2 = 0; k2 < 2; ++k2) {
                        u32x4 wv; wv.x = cvt_pk_bf16(sa[p][2 * k2][0], sa[p][2 * k2][1]); wv.y = cvt_pk_bf16(sa[p][2 * k2][2], sa[p][2 * k2][3]); wv.z = cvt_pk_bf16(sa[p][2 * k2 + 1][0], sa[p][2 * k2 + 1][1]); wv.w = cvt_pk_bf16(sa[p][2 * k2 + 1][2], sa[p][2 * k2 + 1][3]);
                        pf[p][k2] = __builtin_bit_cast(bf16x8, wv);
                    }
                }
                if (MODE == 1) {
#pragma unroll
                    for (int mt = 0; mt < 4; ++mt) {
                        float a = sa[p][mt][0] + sa[p][mt][1] + sa[p][mt][2] + 0.5f * sa[p][mt][3], bn = 0.5f * sa[p][mt][3];
                        a = sum8(a); bn = sum8(bn);
                        const int sb = 16 * s + 4 * mt + fq;
                        if ((fr & 7) == 0) { (void)__hip_atomic_fetch_add(impL + tt * IMPW + sb, a, __ATOMIC_RELAXED, __HIP_MEMORY_SCOPE_WORKGROUP); (void)__hip_atomic_fetch_add(impL + tt * IMPW + sb + 1, bn, __ATOMIC_RELAXED, __HIP_MEMORY_SCOPE_WORKGROUP); }
                    }
                }
            }
            if (MODE >= 1) {
                bf16x8 vd1[4];
#pragma unroll
                for (int i4 = 0; i4 < 4; ++i4) vd0[i4] = *(const LAS bf16x8*)(Vb + 8192 + ((i4 & 1) ? kb1 : kb0) + (i4 >> 1) * 2048);
#pragma unroll
                for (int i4 = 0; i4 < 4; ++i4) vd1[i4] = *(const LAS bf16x8*)(Vb + 8192 + ((i4 & 1) ? kb1 : kb0) + (2 + (i4 >> 1)) * 2048);
                __builtin_amdgcn_sched_barrier(0);
#pragma unroll
                for (int i4 = 0; i4 < 4; ++i4)
#pragma unroll
                    for (int p = 0; p < 4; ++p) O[p][i4 >> 1] = __builtin_amdgcn_mfma_f32_16x16x32_bf16(vd0[i4], pf[p][i4 & 1], O[p][i4 >> 1], 0, 0, 0);
#pragma unroll
                for (int i4 = 0; i4 < 4; ++i4)
#pragma unroll
                    for (int p = 0; p < 4; ++p) O[p][2 + (i4 >> 1)] = __builtin_amdgcn_mfma_f32_16x16x32_bf16(vd1[i4], pf[p][i4 & 1], O[p][2 + (i4 >> 1)], 0, 0, 0);
            }
            __builtin_amdgcn_sched_barrier(0);
        } else {
#pragma unroll
        for (int p = 0; p < 4; ++p) {
            const int ttA = 8 * w + 2 * p;
            const unsigned mA = (code >> (2 * p)) & 1u, mB = (code >> (2 * p + 1)) & 1u;
            if ((mA | mB) != 0u) {
            const int tt = ttA + (fr >> 3);
            float cinit;
            if (MODE == 1) cinit = lrow[p];
            else { const float mref = (mrow[p] < -1e29f) ? 0.f : mrow[p]; const bool colact = (MODE != 2) || (((fr >> 3) ? mB : mA) != 0u); cinit = colact ? -mref : -1e30f; }
            f32x4 sa[4];
#pragma unroll
            for (int mt = 0; mt < 4; ++mt) sa[mt] = (f32x4){cinit, cinit, cinit, cinit};
            bf16x8 vf0[4];
            {
                bf16x8 kf[8];
#pragma unroll
                for (int i8 = 0; i8 < 8; ++i8) kf[i8] = *(const LAS bf16x8*)(Kb + ((i8 & 1) ? kb1 : kb0) + (i8 >> 1) * 2048);
                if (MODE >= 1) {
#pragma unroll
                    for (int i4 = 0; i4 < 4; ++i4) vf0[i4] = *(const LAS bf16x8*)(Vb + 8192 + ((i4 & 1) ? kb1 : kb0) + (i4 >> 1) * 2048);
                }
                __builtin_amdgcn_sched_barrier(0);
#pragma unroll
                for (int i8 = 0; i8 < 8; ++i8) sa[i8 >> 1] = __builtin_amdgcn_mfma_f32_16x16x32_bf16(kf[i8], qf[p][i8 & 1], sa[i8 >> 1], 0, 0, 0);
            }
            bool needmask;
            if (MODE <= 1) needmask = (((64 * c + ttA - 31) >> 4) - 64 * s) < 63;
            else if (MODE == 2) needmask = (s == c);
            else needmask = (s == c) || (c >= 8 && s == c - 8);
            if (needmask) {
                int hi, lov = -1;
                if (MODE <= 1) { const int t = 64 * c + tt; hi = ((t - 31) >> 4) - 64 * s; }
                else if (MODE == 2) hi = tt;
                else { hi = (s == c) ? tt : 63; lov = (c >= 8 && s == c - 8) ? tt : -1; }
#pragma unroll
                for (int mt = 0; mt < 4; ++mt)
#pragma unroll
                    for (int j = 0; j < 4; ++j) { const int kk = 16 * mt + 4 * fq + j; sa[mt][j] = (kk <= hi && kk > lov) ? sa[mt][j] : -1e30f; }
            }
            if (MODE != 1) {
                float mx = fmaxf(fmaxf(sa[0][0], sa[0][1]), sa[0][2]);
                mx = fmaxf(fmaxf(mx, sa[0][3]), sa[1][0]); mx = fmaxf(fmaxf(mx, sa[1][1]), sa[1][2]); mx = fmaxf(fmaxf(mx, sa[1][3]), sa[2][0]);
                mx = fmaxf(fmaxf(mx, sa[2][1]), sa[2][2]); mx = fmaxf(fmaxf(mx, sa[2][3]), sa[3][0]); mx = fmaxf(fmaxf(mx, sa[3][1]), sa[3][2]); mx = fmaxf(mx, sa[3][3]);
                mx = xrow16_max(mx);
                const bool uninit = mrow[p] < -1e29f;
                const bool resc = (mx > 8.0f) || (uninit && mx > -1e29f);
                if (__any(resc)) {
                    const float delta = resc ? mx : 0.f;
                    const float alpha = (resc && !uninit) ? ex2(-delta) : 1.0f;
#pragma unroll
                    for (int mt = 0; mt < 4; ++mt) sa[mt] = sa[mt] - delta;
                    lrow[p] *= alpha;
                    if (MODE >= 2) {
#pragma unroll
                        for (int d = 0; d < 4; ++d) O[p][d] *= alpha;
                    }
                    if (resc) mrow[p] = (uninit ? 0.f : mrow[p]) + delta;
                }
            }
            f32x4 pv[4];
#pragma unroll
            for (int mt = 0; mt < 4; ++mt)
#pragma unroll
                for (int j = 0; j < 4; ++j) pv[mt][j] = ex2(sa[mt][j]);
            if (MODE != 1) { const f32x4 t4 = (pv[0] + pv[1]) + (pv[2] + pv[3]); lrow[p] += (t4[0] + t4[1]) + (t4[2] + t4[3]); }
            if (MODE >= 1) {
                bf16x8 pf[2];
#pragma unroll
                for (int k2 = 0; k2 < 2; ++k2) {
                    u32x4 wv; wv.x = cvt_pk_bf16(pv[2 * k2][0], pv[2 * k2][1]); wv.y = cvt_pk_bf16(pv[2 * k2][2], pv[2 * k2][3]); wv.z = cvt_pk_bf16(pv[2 * k2 + 1][0], pv[2 * k2 + 1][1]); wv.w = cvt_pk_bf16(pv[2 * k2 + 1][2], pv[2 * k2 + 1][3]);
                    pf[k2] = __builtin_bit_cast(bf16x8, wv);
                }
                {
                    bf16x8 vf1[4];
#pragma unroll
                    for (int i4 = 0; i4 < 4; ++i4) vf1[i4] = *(const LAS bf16x8*)(Vb + 8192 + ((i4 & 1) ? kb1 : kb0) + (2 + (i4 >> 1)) * 2048);
                    __builtin_amdgcn_sched_barrier(0);
#pragma unroll
                    for (int i4 = 0; i4 < 4; ++i4) O[p][i4 >> 1] = __builtin_amdgcn_mfma_f32_16x16x32_bf16(vf0[i4], pf[i4 & 1], O[p][i4 >> 1], 0, 0, 0);
#pragma unroll
                    for (int i4 = 0; i4 < 4; ++i4) O[p][2 + (i4 >> 1)] = __builtin_amdgcn_mfma_f32_16x16x32_bf16(vf1[i4], pf[i4 & 1], O[p][2 + (i4 >> 1)], 0, 0, 0);
                }
            }
            if (MODE == 1) {
#pragma unroll
                for (int mt = 0; mt < 4; ++mt) {
                    float a = pv[mt][0] + pv[mt][1] + pv[mt][2] + 0.5f * pv[mt][3], bn = 0.5f * pv[mt][3];
                    a = sum8(a); bn = sum8(bn);
                    const int sb = 16 * s + 4 * mt + fq;
                    if ((fr & 7) == 0) { (void)__hip_atomic_fetch_add(impL + tt * IMPW + sb, a, __ATOMIC_RELAXED, __HIP_MEMORY_SCOPE_WORKGROUP); (void)__hip_atomic_fetch_add(impL + tt * IMPW + sb + 1, bn, __ATOMIC_RELAXED, __HIP_MEMORY_SCOPE_WORKGROUP); }
                }
            }
            }
            __builtin_amdgcn_sched_barrier(0);
        }
        }
        }
    }
    WG_BAR();
#undef ATT_DMA
}

__device__ __forceinline__ void unit(LAS unsigned char* lds, const Ctx& X, int b, int g, int c, int tid_in) {
    int tid = tid_in; asm volatile("" : "+v"(tid));
    const int lane = tid & 63, w = __builtin_amdgcn_readfirstlane(tid >> 6), fr = lane & 15, fq = lane >> 4;
    LAS int* list = (LAS int*)(lds + OFF_LIST);
    LAS unsigned* selm = (LAS unsigned*)(lds + OFF_SEL);
    LAS unsigned* uni = (LAS unsigned*)(lds + OFF_UNI);
    LAS float* impL = (LAS float*)(lds + OFF_IMP);
    LAS int* nl = (LAS int*)(lds + OFF_N);
    const int bg = b * 2 + g; const size_t rowbase = (size_t)b * T + 64 * c;
    bf16x8 qf[4][2];
#pragma unroll
    for (int p = 0; p < 4; ++p) { const bf16_t* qp = X.Q + (rowbase + 8 * w + 2 * p + (fr >> 3)) * 1024 + (8 * g + (fr & 7)) * 64 + 8 * fq;
#pragma unroll
        for (int ks = 0; ks < 2; ++ks) qf[p][ks] = *(const bf16x8*)(qp + 32 * ks); }
    for (int i = lane; i < 8 * IMPW; i += 64) impL[(8 * w) * IMPW + i] = 0.f;
    const int ncmp = (4 * c + 3 + 63) >> 6;
    if (tid < 8) list[tid] = tid;
    float mrow[4], lrow[4]; f32x4 O[4][4];
#pragma unroll
    for (int p = 0; p < 4; ++p) { mrow[p] = -1e30f; lrow[p] = 0.f;
#pragma unroll
        for (int d = 0; d < 4; ++d) { O[p][d] = (f32x4){0.f, 0.f, 0.f, 0.f}; } }
    WG_BAR();
    const bf16_t* kcc = X.KCC + (size_t)bg * 512 * 64; const bf16_t* vct = X.VCT + (size_t)bg * 8 * 4096;
    branch<0>(lds, kcc, vct, 4096, ncmp, c, w, lane, tid, qf, mrow, lrow, O);
#pragma unroll
    for (int p = 0; p < 4; ++p) { float l = xrow16_sum(lrow[p]); lrow[p] = (l > 0.f) ? (-mrow[p] - __builtin_amdgcn_logf(l)) : -1e30f; }
    branch<1>(lds, kcc, vct, 4096, ncmp, c, w, lane, tid, qf, mrow, lrow, O);
#define ATT_GATE(br, scale_expr) do { _Pragma("unroll") for (int p = 0; p < 4; ++p) { \
        const size_t grow = rowbase + 8 * w + 2 * p + (fr >> 3); \
        const float gt = X.gates[grow * 48 + (8 * g + (fr & 7)) * 3 + (br)]; const float sc = gt * (scale_expr); \
        _Pragma("unroll") for (int d = 0; d < 4; ++d) { \
            u32x2* optr = (u32x2*)(X.O + grow * 1024 + (8 * g + (fr & 7)) * 64 + 4 * fq + 16 * d); u32x2 ot = (u32x2){0u, 0u}; if ((br) > 0) ot = *optr; \
            float o0 = __uint_as_float(ot.x << 16), o1 = __uint_as_float(ot.x & 0xffff0000u), o2 = __uint_as_float(ot.y << 16), o3 = __uint_as_float(ot.y & 0xffff0000u); \
            o0 += sc * O[p][d][0]; o1 += sc * O[p][d][1]; o2 += sc * O[p][d][2]; o3 += sc * O[p][d][3]; \
            ot.x = cvt_pk_bf16(o0, o1); ot.y = cvt_pk_bf16(o2, o3); O[p][d] = (f32x4){0.f, 0.f, 0.f, 0.f}; \
            *optr = ot; } \
        mrow[p] = -1e30f; lrow[p] = 0.f; } } while (0)
    ATT_GATE(0, 1.0f);
    LDS_WAIT();
    for (int q8 = 0; q8 < 8; ++q8) {
        const int tt = 8 * w + q8;
        unsigned long long blo, bhi;
        if (c + 1 <= 16) { blo = (1ull << (c + 1)) - 1ull; bhi = 0ull; }
        else {
            const int s1 = lane, s2 = lane + 64;
            const bool c1 = (s1 >= 1 && s1 <= c - 2), c2 = (s2 >= 1 && s2 <= c - 2);
            const float v1 = c1 ? impL[tt * IMPW + s1] : -1.f, v2 = c2 ? impL[tt * IMPW + s2] : -1.f;
            int r1 = 0, r2 = 0;
            const int nq = (c - 2) / 4 + 1;
#pragma unroll 2
            for (int q = 0; q < nq; ++q) {
                const f32x4 x4 = *(const LAS f32x4*)(impL + tt * IMPW + 4 * q);
#pragma unroll
                for (int e = 0; e < 4; ++e) { const int sp = 4 * q + e; const float x = (sp >= 1 && sp <= c - 2) ? x4[e] : -2.f;
                    r1 += (x > v1 || (x == v1 && sp < s1)) ? 1 : 0; r2 += (x > v2 || (x == v2 && sp < s2)) ? 1 : 0; }
            }
            const bool f1 = (s1 == 0 || s1 == c || s1 == c - 1), f2 = (s2 == c || s2 == c - 1);
            blo = __ballot((c1 && r1 < 13) || f1); bhi = __ballot((c2 && r2 < 13) || f2);
        }
        if (lane == 0) { selm[tt * 4 + 0] = (unsigned)blo; selm[tt * 4 + 1] = (unsigned)(blo >> 32); selm[tt * 4 + 2] = (unsigned)bhi; selm[tt * 4 + 3] = (unsigned)(bhi >> 32); }
    }
    WG_BAR();
    if (tid < 4) { unsigned o = 0; for (int i = 0; i < 64; ++i) o |= selm[i * 4 + tid]; uni[tid] = o; }
    WG_BAR();
    if (tid == 0) { int n = 0; for (int s = 0; s <= c; ++s) if ((uni[s >> 5] >> (s & 31)) & 1u) list[n++] = s; nl[0] = n; }
    WG_BAR();
    const int nsel = nl[0];
    { LAS unsigned char* cw_ = (LAS unsigned char*)(lds + OFF_CODE) + w * CODEW;
      for (int i = lane; i < nsel; i += 64) { const int s_ = list[i]; unsigned cd = 0;
#pragma unroll
          for (int q8 = 0; q8 < 8; ++q8) cd |= ((selm[(8 * w + q8) * 4 + (s_ >> 5)] >> (s_ & 31)) & 1u) << q8;
          cw_[i] = (unsigned char)cd; }
      LDS_WAIT(); }
    branch<2>(lds, X.KS + (size_t)bg * T * 64, X.VST + (size_t)bg * 128 * 4096, 4096, nsel, c, w, lane, tid, qf, mrow, lrow, O);
#pragma unroll
    for (int p = 0; p < 4; ++p) { float l = xrow16_sum(lrow[p]); lrow[p] = (l > 0.f) ? 1.0f / l : 0.f; }
    { float rl[4] = {lrow[0], lrow[1], lrow[2], lrow[3]}; ATT_GATE(1, rl[p]); }
    const int w0 = (c >= 8) ? c - 8 : 0, nwin = c - w0 + 1;
    if (tid < nwin) list[tid] = w0 + tid;
    WG_BAR();
    branch<3>(lds, X.KW + (size_t)bg * T * 64, X.VWT + (size_t)bg * 128 * 4096, 4096, nwin, c, w, lane, tid, qf, mrow, lrow, O);
#pragma unroll
    for (int p = 0; p < 4; ++p) { float l = xrow16_sum(lrow[p]); lrow[p] = (l > 0.f) ? 1.0f / l : 0.f; }
    { float rl[4] = {lrow[0], lrow[1], lrow[2], lrow[3]}; ATT_GATE(2, rl[p]); }
#undef ATT_GATE
    WG_BAR();
}
}

__device__ __forceinline__ unsigned f2bf(float f) { unsigned u = __builtin_bit_cast(unsigned, f); return (u + 0x7fffu + ((u >> 16) & 1u)) >> 16; }
__device__ __forceinline__ unsigned pk2(float lo, float hi) { return f2bf(lo) | (f2bf(hi) << 16); }
template <int MAP>
__device__ __forceinline__ int rowmap(int a) {
    if (MAP == 0) return perm8(a);
    if (MAP == 1) return a < 1792 ? ((a & ~63) | swap45(a & 63)) : a;
    if (MAP == 2) { if (a < FF) return 256 * (a >> 7) + perm8(a & 127); const int a2 = a - FF; return 256 * (a2 >> 7) + 128 + perm8(a2 & 127); }
    return swap45(a);
}
template <int MAP>
__device__ __forceinline__ void transpose_item(const float* W, int K, int N, bf16_t* WT, int row_off, const float* gain, LAS float* scr, int item, int lane) {
    const int nblk = (N + 31) / 32, kb = item / nblk, nb = item % nblk, k0 = 64 * kb, n0 = 32 * nb;
#pragma unroll
    for (int i = 0; i < 32; ++i) { const int kk = 2 * i + (lane >> 5); const int col = n0 + (lane & 31); float v = (col < N) ? W[(size_t)(k0 + kk) * N + col] : 0.f; if (gain) v *= gain[k0 + kk]; scr[kk * 33 + (lane & 31)] = v; }
    LDS_WAIT();
    const int cc = lane & 7;
#pragma unroll
    for (int j = 0; j < 4; ++j) { const int n = (lane >> 3) + 8 * j; const LAS float* s = scr + (8 * cc) * 33 + n;
        u32x4 o; o.x = pk2(s[0 * 33], s[1 * 33]); o.y = pk2(s[2 * 33], s[3 * 33]); o.z = pk2(s[4 * 33], s[5 * 33]); o.w = pk2(s[6 * 33], s[7 * 33]);
        if (n0 + n < N) *(u32x4*)(WT + (size_t)(row_off + rowmap<MAP>(n0 + n)) * K + k0 + 8 * cc) = o; }
    LDS_WAIT();
}

#define XB_TMO      128
#define XB_XCNT(j)  (256  + 64 * (j))
#define XB_XSUB(j)  (1280 + 64 * (j))
#define XB_XGEN(j)  (2304 + 64 * (j))
#define XB_TOP      3328
#define XB_TOPGEN   3392
#define XCD_BAR_WORDS 3456
#define XB_SPIN_CAP (1u << 18)
__device__ __forceinline__ unsigned xb_ld(unsigned* p)              { return __hip_atomic_load(p, __ATOMIC_RELAXED, __HIP_MEMORY_SCOPE_AGENT); }
__device__ __forceinline__ unsigned xb_add(unsigned* p, unsigned v) { return __hip_atomic_fetch_add(p, v, __ATOMIC_RELAXED, __HIP_MEMORY_SCOPE_AGENT); }
__device__ __forceinline__ unsigned xb_xcc_id() { return (unsigned)__builtin_amdgcn_s_getreg((3 << 11) | 20) & 0xFu; }
#define XB_SPIN(cond, bar) do { unsigned _sp = 0; while (cond) { __builtin_amdgcn_s_sleep(1); \
    if ((++_sp & 255u) == 0u) { if (xb_ld(&(bar)[XB_TMO])) break; if (_sp > XB_SPIN_CAP) { atomicAdd(&(bar)[XB_TMO], 1u); break; } } } } while (0)
struct XcdBarrier { unsigned* bar; unsigned x; volatile LAS unsigned* st; };
__device__ __forceinline__ XcdBarrier xcd_barrier_post(unsigned* bar, volatile LAS unsigned* st) {
    XcdBarrier b; b.bar = bar; b.x = xb_xcc_id(); b.st = st;
    if (threadIdx.x == 0) (void)xb_add(&bar[XB_XCNT(b.x)], 1u);
    return b;
}
__device__ __forceinline__ void xcd_barrier_complete(unsigned* bar, unsigned x, unsigned& nloc, unsigned& nx) {
    const unsigned G = gridDim.x * gridDim.y * gridDim.z;
    unsigned sum, cnt, mine, sp = 0u;
    for (;;) {
        sum = 0u; cnt = 0u; mine = 0u;
#pragma unroll
        for (unsigned j = 0; j < 16; ++j) { const unsigned c = xb_ld(&bar[XB_XCNT(j)]); sum += c; cnt += (c > 0u) ? 1u : 0u; mine = (j == x) ? c : mine; }
        if (sum == G) break;
        __builtin_amdgcn_s_sleep(1);
        if ((++sp & 255u) == 0u) { if (xb_ld(&bar[XB_TMO])) break; if (sp > XB_SPIN_CAP) { atomicAdd(&bar[XB_TMO], 1u); break; } }
    }
    nloc = mine > 0u ? mine : 1u; nx = cnt > 0u ? cnt : 1u;
}
__device__ __forceinline__ void xcd_barrier(const XcdBarrier& b) {
    asm volatile("s_waitcnt vmcnt(0)" ::: "memory");
    __syncthreads();
    if (threadIdx.x == 0) {
        unsigned* bar = b.bar;
        __builtin_amdgcn_s_waitcnt(0);
        unsigned nloc = b.st[0], nx = b.st[1];
        if (nloc == 0u) { xcd_barrier_complete(bar, b.x, nloc, nx); b.st[0] = nloc; b.st[1] = nx; }
        const unsigned old = xb_add(&bar[XB_XSUB(b.x)], 1u);
        const unsigned gen = old / nloc;
        if (old + 1u == (gen + 1u) * nloc) {
            __builtin_amdgcn_fence(__ATOMIC_RELEASE, "agent");
            asm volatile("s_waitcnt vmcnt(0)" ::: "memory");
            const unsigned og = xb_add(&bar[XB_TOP], 1u);
            const unsigned tg = og / nx;
            if (og + 1u == (tg + 1u) * nx) xb_add(&bar[XB_TOPGEN], 1u);
            else XB_SPIN(xb_ld(&bar[XB_TOPGEN]) == tg, bar);
            __builtin_amdgcn_fence(__ATOMIC_ACQUIRE, "agent");
            xb_add(&bar[XB_XGEN(b.x)], 1u);
            asm volatile("s_waitcnt vmcnt(0)" ::: "memory");
        } else {
            XB_SPIN(xb_ld(&bar[XB_XGEN(b.x)]) == gen, bar);
            __builtin_amdgcn_fence(__ATOMIC_ACQUIRE, "agent");
            asm volatile("s_waitcnt vmcnt(0)" ::: "memory");
        }
    }
    __syncthreads();
}

struct Args { const float* in[29]; float* out; unsigned char* ws; float inv[32]; int ph_lo, ph_hi; };

constexpr int DI_UP = 16 * 176, DI_DN = 44 * 32, DI_PL = 4 * 8, N_DEFER = 2 * DI_UP + 2 * DI_DN + 4 * DI_PL;
__device__ __forceinline__ void ffn_weight_item(const Args& a, unsigned char* ws, LAS float* scr, int r, int lane) {
    if (r < DI_UP) { transpose_item<2>(a.in[15], D, UP, (bf16_t*)(ws + WS_WUP0), 0, a.in[14], scr, r, lane); return; } r -= DI_UP;
    if (r < DI_UP) { transpose_item<2>(a.in[24], D, UP, (bf16_t*)(ws + WS_WUP1), 0, a.in[23], scr, r, lane); return; } r -= DI_UP;
    if (r < DI_DN) { transpose_item<0>(a.in[18], FF, D, (bf16_t*)(ws + WS_WDN0), 0, nullptr, scr, r, lane); return; } r -= DI_DN;
    if (r < DI_DN) { transpose_item<0>(a.in[27], FF, D, (bf16_t*)(ws + WS_WDN1), 0, nullptr, scr, r, lane); return; } r -= DI_DN;
    const int gi = r / DI_PL; transpose_item<0>(a.in[20] + (size_t)gi * 65536, 256, 256, (bf16_t*)(ws + WS_WPOOL), gi * 256, nullptr, scr, r % DI_PL, lane);
}

__global__ void __launch_bounds__(512) mk_fwd(Args a) {
    extern __shared__ __attribute__((aligned(16))) unsigned char lds_raw[];
    LAS unsigned char* lds = (LAS unsigned char*)lds_raw;
    LAS unsigned char* ldsx = lds + LDS_RING;
    cg::grid_group grid = cg::this_grid();
    if (threadIdx.x < 2) ((volatile LAS unsigned*)(lds + LDS_BYTES - 16))[threadIdx.x] = 0u;
    __syncthreads();
    if (a.ph_hi == 0x7fff) grid.sync();
    const XcdBarrier xbar = xcd_barrier_post((unsigned*)a.ws, (volatile LAS unsigned*)(lds + LDS_BYTES - 16));
    const int tid = threadIdx.x, lane = tid & 63, wave = __builtin_amdgcn_readfirstlane(tid >> 6);
    const int G = gridDim.x, bx = blockIdx.x;
    unsigned char* ws = a.ws;
#define cosT ((float*)(ws + WS_ROPE))
#define sinT ((float*)(ws + WS_ROPE) + T * 32)
#define ssp ((float*)(ws + WS_SSP))
#define c1p ((float*)(ws + WS_C1P))
#define rstdv ((float*)(ws + WS_RSTD))
#define HB ((float*)(ws + WS_HB))
#define FB ((float*)(ws + WS_FB))
#define gates ((float*)(ws + WS_GATE))
#define Wt_in ((bf16_t*)(ws + WS_WIN))
#define Wt_out ((bf16_t*)(ws + WS_WOUT))
#define Wt_pool ((bf16_t*)(ws + WS_WPOOL))
#define Wt_c1 (kv ? (bf16_t*)(ws + WS_WC1V) : (bf16_t*)(ws + WS_WC1K))
#define Wt_c2 (kv ? (bf16_t*)(ws + WS_WC2V) : (bf16_t*)(ws + WS_WC2K))
#define XB ((bf16_t*)(ws + WS_XB))
#define Qb ((bf16_t*)(ws + WS_Q))
#define KC ((bf16_t*)(ws + WS_KC))
#define VC ((bf16_t*)(ws + WS_VC))
#define KS ((bf16_t*)(ws + WS_KS))
#define VST ((bf16_t*)(ws + WS_VST))
#define KW ((bf16_t*)(ws + WS_KW))
#define VWT ((bf16_t*)(ws + WS_VWT))
#define KCC ((bf16_t*)(ws + WS_KCC))
#define VCT ((bf16_t*)(ws + WS_VCT))
#define Ob ((bf16_t*)(ws + WS_O))
#define ACT ((bf16_t*)(ws + WS_ACT))
#define POOLED ((bf16_t*)(ws + WS_POOLED))
    float* out = a.out;
    const int lo = a.ph_lo, hi = a.ph_hi;
    const bool defer = (G == 256);
#define IN(k) (lo <= (k) && (k) < hi)
#define SEAM(k) do { if (IN(k) && IN((k) + 1)) xcd_barrier(xbar); } while (0)

    if (IN(0)) {
        LAS float* scr = (LAS float*)(lds + wave * 16384);
        const int gw = bx * 8 + wave, NGW = G * 8;
        constexpr int I_IN = 16 * 58, I_OUT = 16 * 32, I_C1 = 32 * 8, I_C2 = 4 * 2;
        constexpr int NA = I_IN + I_OUT + 2 * I_C1 + 2 * I_C2;
        const int NIT = NA + (defer ? 0 : N_DEFER);
        for (int it = gw; it < NIT; it += NGW) {
            int r = it;
            if (r < I_IN) { transpose_item<1>(a.in[2], D, 1840, Wt_in, 0, a.in[1], scr, r, lane); continue; } r -= I_IN;
            if (r < I_OUT) { transpose_item<0>(a.in[13], D, D, Wt_out, 0, nullptr, scr, r, lane); continue; } r -= I_OUT;
            if (r < I_C1) { transpose_item<0>(a.in[4], 2048, 256, (bf16_t*)(ws + WS_WC1K), 0, nullptr, scr, r, lane); continue; } r -= I_C1;
            if (r < I_C1) { transpose_item<0>(a.in[9], 2048, 256, (bf16_t*)(ws + WS_WC1V), 0, nullptr, scr, r, lane); continue; } r -= I_C1;
            if (r < I_C2) { transpose_item<3>(a.in[6], 256, 64, (bf16_t*)(ws + WS_WC2K), 0, nullptr, scr, r, lane); continue; } r -= I_C2;
            if (r < I_C2) { transpose_item<3>(a.in[11], 256, 64, (bf16_t*)(ws + WS_WC2V), 0, nullptr, scr, r, lane); continue; } r -= I_C2;
            ffn_weight_item(a, ws, scr, r, lane);
        }
        for (int m = gw; m < M; m += 2 * NGW) {
            const int m2 = m + NGW;
            const f32x4* xr = (const f32x4*)(a.in[0] + (size_t)m * D) + lane; const f32x4* xr2 = (const f32x4*)(a.in[0] + (size_t)m2 * D) + lane;
            f32x4 v[4], w[4];
#pragma unroll
            for (int j = 0; j < 4; ++j) { v[j] = xr[64 * j]; w[j] = (m2 < M) ? xr2[64 * j] : (f32x4){0.f, 0.f, 0.f, 0.f}; }
            unsigned long long* o8 = (unsigned long long*)(XB + (size_t)m * D) + lane; unsigned long long* o82 = (unsigned long long*)(XB + (size_t)m2 * D) + lane; float s1 = 0.f, s2 = 0.f;
#pragma unroll
            for (int j = 0; j < 4; ++j) {
                s1 += (v[j][0] * v[j][0] + v[j][1] * v[j][1]) + (v[j][2] * v[j][2] + v[j][3] * v[j][3]); o8[64 * j] = (unsigned long long)pk2(v[j][0], v[j][1]) | ((unsigned long long)pk2(v[j][2], v[j][3]) << 32);
                s2 += (w[j][0] * w[j][0] + w[j][1] * w[j][1]) + (w[j][2] * w[j][2] + w[j][3] * w[j][3]); if (m2 < M) o82[64 * j] = (unsigned long long)pk2(w[j][0], w[j][1]) | ((unsigned long long)pk2(w[j][2], w[j][3]) << 32);
            }
#pragma unroll
            for (int o = 1; o < 64; o <<= 1) { s1 += __shfl_xor(s1, o); s2 += __shfl_xor(s2, o); }
            if (lane == 0) { rstdv[m] = 1.0f / sqrtf(s1 * (1.0f / D) + EPS); if (m2 < M) rstdv[m2] = 1.0f / sqrtf(s2 * (1.0f / D) + EPS); }
        }
        for (int i = bx * 512 + tid; i < T * 32; i += G * 512) {
            const int t = i >> 5, f = i & 31; const float ang = (float)t * a.inv[f];
            double x = (double)ang * 0.15915494309189535; x -= __builtin_rint(x); const float xf = (float)x;
            cosT[i] = __builtin_amdgcn_cosf(xf); sinT[i] = __builtin_amdgcn_sinf(xf);
        }
        for (int it = NGW - 1 - gw; it < 256; it += NGW) {
            const int kv = it >> 7, chunk = (it >> 2) & 31, nb = it & 3; const float* pos = a.in[kv ? 8 : 3]; const float* w1 = a.in[kv ? 9 : 4];
            float s = 0.f;
#pragma unroll 32
            for (int r = 0; r < 64; ++r) { const int rr = chunk * 64 + r; s += pos[rr] * w1[(size_t)rr * 256 + nb * 64 + lane]; }
            c1p[(kv * 32 + chunk) * 256 + nb * 64 + lane] = s;
        }
        asm volatile("s_waitcnt vmcnt(0) lgkmcnt(0)" ::: "memory"); __syncthreads();
    }
    SEAM(0);
    if (IN(1)) {
        pg8::Gemm g{XB, Wt_in, M, NIN, D, D, 0}; pg8::StaticOrder S; S.init(M, NIN, G, bx);
        EpiIn E{rstdv, cosT, sinT, Qb, KC, VC, KS, VST, KW, VWT, gates};
        pg8::gemm_phase(lds, ldsx, g, S, E);
    }
    SEAM(1);
    if (IN(2)) {
        const int tid = threadIdx.x, lane = tid & 63, w = __builtin_amdgcn_readfirstlane(tid >> 6), fr = lane & 15, fq = lane >> 4;
        LAS float* c1s = (LAS float*)lds;
        LAS unsigned char* hidL = lds + 4096;
        for (int i = tid; i < 512; i += 512) { const int kv = i >> 8, n = i & 255; const float* b1 = a.in[kv ? 10 : 5]; float sv = b1[n]; for (int q = 0; q < 32; ++q) sv += c1p[(kv * 32 + q) * 256 + n]; c1s[i] = sv; }
        __syncthreads();
        for (int u = bx; u < 256; u += G) {
            const int kv = u >> 7, r0 = (u & 127) * 16;
            const bf16_t* Ap = (kv ? VC : KC) + (size_t)(r0 + fr) * 1024 + 8 * fq;
            const bf16_t* Bp = Wt_c1 + (size_t)(32 * w + fr) * 2048 + 8 * fq;
            f32x4 h0 = (f32x4){0.f, 0.f, 0.f, 0.f}, h1 = h0;
#pragma unroll 1
            for (int k0 = 0; k0 < 2048; k0 += 256) {
                bf16x8 af[8], b0[8], b1f[8];
#pragma unroll
                for (int q = 0; q < 8; ++q) { af[q] = *(const bf16x8*)(Ap + k0 + 32 * q); b0[q] = *(const bf16x8*)(Bp + k0 + 32 * q); b1f[q] = *(const bf16x8*)(Bp + 16 * 2048 + k0 + 32 * q); }
#pragma unroll
                for (int q = 0; q < 8; ++q) { h0 = __builtin_amdgcn_mfma_f32_16x16x32_bf16(b0[q], af[q], h0, 0, 0, 0); h1 = __builtin_amdgcn_mfma_f32_16x16x32_bf16(b1f[q], af[q], h1, 0, 0, 0); }
            }
            { const int c0 = 32 * w + 8 * fq; float v[8];
#pragma unroll
              for (int e = 0; e < 8; ++e) { const float x = ((e >> 2) ? h1[e & 3] : h0[e & 3]) + c1s[kv * 256 + c0 + e]; const float y = 0.7978845608028654f * (x + 0.044715f * x * x * x); v[e] = x * sigmoidf_(2.0f * y); }
              u32x4 wv; wv.x = cvt_pk_bf16(v[0], v[1]); wv.y = cvt_pk_bf16(v[2], v[3]); wv.z = cvt_pk_bf16(v[4], v[5]); wv.w = cvt_pk_bf16(v[6], v[7]);
              *(LAS u32x4*)(hidL + fr * 528 + c0 * 2) = wv; }
            __syncthreads();
            if (w < 2) {
                const bf16_t* W2 = Wt_c2 + (size_t)(32 * w + fr) * 256 + 8 * fq;
                f32x4 oA = (f32x4){0.f, 0.f, 0.f, 0.f}, oB = oA;
#pragma unroll
                for (int q = 0; q < 8; ++q) {
                    const bf16x8 hf = *(const LAS bf16x8*)(hidL + fr * 528 + (32 * q + 8 * fq) * 2);
                    const bf16x8 wa = *(const bf16x8*)(W2 + 32 * q), wb = *(const bf16x8*)(W2 + 16 * 256 + 32 * q);
                    oA = __builtin_amdgcn_mfma_f32_16x16x32_bf16(wa, hf, oA, 0, 0, 0); oB = __builtin_amdgcn_mfma_f32_16x16x32_bf16(wb, hf, oB, 0, 0, 0);
                }
                const float* b2 = a.in[kv ? 12 : 7]; const int d0 = 16 * w + 4 * fq; const int row = r0 + fr, j = row & 511;
                f32x4 a1 = oA + *(const f32x4*)(b2 + d0), a2 = oB + *(const f32x4*)(b2 + d0 + 32);
                if (j == 511) { a1 = (f32x4){0.f, 0.f, 0.f, 0.f}; a2 = a1; }
                if (!kv) {
                    const int pos = (j == 511) ? 0 : 16 * j + 31;
                    const f32x4 cs = *(const f32x4*)(cosT + pos * 32 + d0), sn = *(const f32x4*)(sinT + pos * 32 + d0);
                    const f32x4 o1 = a1 * cs - a2 * sn, o2 = a1 * sn + a2 * cs;
                    bf16_t* p = KCC + (size_t)row * 64 + d0;
                    u32x2 w1; w1.x = cvt_pk_bf16(o1[0], o1[1]); w1.y = cvt_pk_bf16(o1[2], o1[3]); *(u32x2*)p = w1;
                    u32x2 w2; w2.x = cvt_pk_bf16(o2[0], o2[1]); w2.y = cvt_pk_bf16(o2[2], o2[3]); *(u32x2*)(p + 32) = w2;
                } else {
                    bf16_t* p = VCT + (size_t)(row >> 6) * 4096 + vperm(row & 63);
#pragma unroll
                    for (int e = 0; e < 4; ++e) { p[(d0 + e) * 64] = (bf16_t)(cvt_pk_bf16(a1[e], 0.f) & 0xffff); p[(d0 + 32 + e) * 64] = (bf16_t)(cvt_pk_bf16(a2[e], 0.f) & 0xffff); }
                }
            }
            __syncthreads();
        }
    }
    if (IN(2) && IN(4)) xcd_barrier(xbar);
    if (IN(4)) {
        att::Ctx X{Qb, KCC, VCT, KS, VST, KW, VWT, gates, Ob};
        for (int k = bx; k < 256; k += G) {
            for (int rep = 0; rep < 2; ++rep) { const int uu = rep ? 511 - k : k; const int c = 127 - (uu >> 2), bgi = uu & 3; att::unit(lds, X, bgi >> 1, bgi & 1, c, tid); }
        }
        if (defer) {
            int td = threadIdx.x; asm volatile("" : "+v"(td)); const int dl = td & 63, dw = __builtin_amdgcn_readfirstlane(td >> 6);
            LAS float* scr = (LAS float*)(lds + dw * 16384);
            for (int it = bx * 8 + dw; it < N_DEFER; it += 2048) ffn_weight_item(a, ws, scr, it, dl);
        }
    }
    SEAM(4);
    if (IN(5)) {
        pg8::Gemm g{Ob, Wt_out, M, D, D, D, 0}; pg8::StaticOrder S; S.init(M, D, G, bx);
        EpiRes E{a.in[0], out, XB, ssp, nullptr, nullptr, XB};
        pg8::gemm_phase(lds, ldsx, g, S, E);
    }
    SEAM(5);
#pragma unroll
    for (int L = 0; L < 2; ++L) {
        const int pb = 6 + 5 * L;
        const float* cw = a.in[L ? 25 : 16]; const float* cb = a.in[L ? 26 : 17];
        if (IN(pb)) {
            pg8::Gemm g{(const bf16_t*)(ws + (L ? WS_XB2 : WS_XB)), (const bf16_t*)(ws + (L ? WS_WUP1 : WS_WUP0)), M, UP, D, D, 0}; pg8::StaticOrder S; S.init(M, UP, G, bx);
            EpiUp E{L ? ssp + 4 * M : ssp, cw, cb, ACT, HB, FB};
            pg8::gemm_phase(lds, ldsx, g, S, E);
        }
        SEAM(pb);
        if (IN(pb + 1)) {
            for (int i = bx * 512 + tid; i < 64 * FF; i += G * 512) {
                const int pm = i / FF, cidx = i % FF;
                float hg0 = 0.f, hg1 = 0.f, hv0 = 0.f, hv1 = 0.f;
                if (pm & 31) { const float* h = HB + (size_t)(pm - 1) * 2 * UP; hg0 = h[cidx]; hg1 = h[UP + cidx]; hv0 = h[FF + cidx]; hv1 = h[UP + FF + cidx]; }
                const float* f = FB + (size_t)pm * 2 * UP; const float fg0 = f[cidx], fg1 = f[UP + cidx], fv0 = f[FF + cidx], fv1 = f[UP + FF + cidx];
                const float g0 = cb[cidx] + cw[cidx] * hg0 + cw[UP + cidx] * hg1 + cw[2 * UP + cidx] * fg0;
                const float g1 = cb[cidx] + cw[cidx] * hg1 + cw[UP + cidx] * fg0 + cw[2 * UP + cidx] * fg1;
                const float v0 = cb[FF + cidx] + cw[FF + cidx] * hv0 + cw[UP + FF + cidx] * hv1 + cw[2 * UP + FF + cidx] * fv0;
                const float v1 = cb[FF + cidx] + cw[FF + cidx] * hv1 + cw[UP + FF + cidx] * fv0 + cw[2 * UP + FF + cidx] * fv1;
                ACT[(size_t)(pm * 256) * FF + cidx] = (bf16_t)f2bf(g0 * sigmoidf_(g0) * v0);
                ACT[(size_t)(pm * 256 + 1) * FF + cidx] = (bf16_t)f2bf(g1 * sigmoidf_(g1) * v1);
            }
        }
        SEAM(pb + 1);
        if (IN(pb + 2)) {
            pg8::Gemm g{ACT, (const bf16_t*)(ws + (L ? WS_WDN1 : WS_WDN0)), M, D, FF, FF, 0}; pg8::StaticOrder S; S.init(M, D, G, bx);
            bf16_t* XBL = (bf16_t*)(ws + (L ? WS_XB2 : WS_XB));
            if (L == 1 && G == 256) { EpiFinal E{out, a.in[28], (float*)(ws + WS_SSP + 512 * 1024), (unsigned*)(ws + 16384), XBL}; pg8::gemm_phase(lds, ldsx, g, S, E); }
            else { EpiRes E{out, out, XBL, ssp, nullptr, nullptr, XBL}; pg8::gemm_phase(lds, ldsx, g, S, E); }
        }
        if (!(L == 1 && G == 256)) { if (IN(pb + 2)) xcd_barrier(xbar); }
        if (L == 0) {
            if (IN(10)) {
                pg8::Gemm g{POOLED, Wt_pool, M, D, 256, D, 512}; pg8::StaticOrder S; S.init(M, D, G, bx);
                {
                    LAS float* rsd = (LAS float*)lds;
                    const float* gn = a.in[19];
                    int tid = threadIdx.x; asm volatile("" : "+v"(tid));
                    pg8::Unit pu;
                    for (int ui = 0; S.next(ui, pu); ++ui) {
                        const int r0 = pu.pm * 256, tb = r0 & (T - 1), wsz = 2 << pu.pn;
                        const int c8 = pu.pn * 256 + (tid & 31) * 8, t0 = (tid >> 5) * 16;
                        const f32x4 gv0 = *(const f32x4*)(gn + c8), gv1 = *(const f32x4*)(gn + c8 + 4);
                        __syncthreads();
                        if (tid < 272) { const int rr = r0 - 16 + tid; rsd[tid] = (tb - 16 + tid >= 0) ? row_rstd(ssp, 4, rr) : 0.f; }
                        __syncthreads();
                        const bf16_t* xb0 = XB + (size_t)r0 * D + c8;
#define POOL_H(tl, lo, hi) do { unpk8(*(const u32x4*)(xb0 + (ptrdiff_t)(tl) * D), lo, hi); const float rs_ = rsd[16 + (tl)]; lo = lo * rs_; hi = hi * rs_; } while (0)
                        f32x4 s0 = (f32x4){0.f, 0.f, 0.f, 0.f}, s1 = s0;
                        for (int i = 1; i <= wsz; ++i) { const int tl = t0 - i; if (tb + tl >= 0) { f32x4 a0, a1; POOL_H(tl, a0, a1); s0 += a0; s1 += a1; } }
#pragma unroll 4
                        for (int tl = t0; tl < t0 + 16; ++tl) {
                            f32x4 h0, h1; POOL_H(tl, h0, h1); s0 += h0; s1 += h1;
                            const int td = tl - wsz; if (tb + td >= 0) { f32x4 d0, d1; POOL_H(td, d0, d1); s0 -= d0; s1 -= d1; }
                            const int t = tb + tl; const int cnt = (t + 1 < wsz) ? t + 1 : wsz; const float ic = 1.0f / (float)cnt;
                            const f32x4 p0 = (s0 * ic - h0) * gv0, p1 = (s1 * ic - h1) * gv1;
                            u32x4 wv; wv.x = cvt_pk_bf16(p0[0], p0[1]); wv.y = cvt_pk_bf16(p0[2], p0[3]); wv.z = cvt_pk_bf16(p1[0], p1[1]); wv.w = cvt_pk_bf16(p1[2], p1[3]);
                            *(u32x4*)(POOLED + (size_t)(r0 + tl) * D + c8) = wv;
                        }
#undef POOL_H
                    }
                    asm volatile("s_waitcnt vmcnt(0)" ::: "memory"); __syncthreads();
                }
                EpiRes E{out, out, XB, ssp + 4 * M, a.in[21], a.in[22], (bf16_t*)(ws + WS_XB2)};
                pg8::gemm_phase(lds, ldsx, g, S, E);
            }
            SEAM(10);
        }
    }
    if (IN(14) && G != 256) {
        int t14 = threadIdx.x; asm volatile("" : "+v"(t14)); const int lane = t14 & 63, wave = __builtin_amdgcn_readfirstlane(t14 >> 6);
        const int gw = bx * 8 + wave, NGW = G * 8; const float* gn = a.in[28];
        for (int m = gw; m < M; m += NGW) {
            const float rs = row_rstd(ssp, 4, m); f32x4* xr = (f32x4*)(out + (size_t)m * D) + lane; const f32x4* gr = (const f32x4*)gn + lane;
            const u32x2* xbr = (const u32x2*)(ws + WS_XB2) + (size_t)m * (D / 4) + lane;
#pragma unroll
            for (int j = 0; j < 4; ++j) { const u32x2 v = xbr[64 * j]; const f32x4 xv = (f32x4){__uint_as_float(v.x << 16), __uint_as_float(v.x & 0xffff0000u), __uint_as_float(v.y << 16), __uint_as_float(v.y & 0xffff0000u)}; xr[64 * j] = xv * rs * gr[64 * j]; }
        }
    }
#undef IN
#undef SEAM
#undef cosT
#undef sinT
#undef ssp
#undef c1p
#undef rstdv
#undef HB
#undef FB
#undef gates
#undef Wt_in
#undef Wt_out
#undef Wt_pool
#undef Wt_c1
#undef Wt_c2
#undef XB
#undef Qb
#undef KC
#undef VC
#undef KS
#undef VST
#undef KW
#undef VWT
#undef KCC
#undef VCT
#undef Ob
#undef ACT
#undef POOLED
}

extern "C" void kernel_launch(void* const* d_in, const int* in_sizes, int n_in, void* d_out, int out_size, void* d_ws, size_t ws_size, hipStream_t stream) {
    static int grid = 0;
    if (grid == 0) {
        int dev = 0, cus = 0, per_cu = 0;
        hipGetDevice(&dev); hipDeviceGetAttribute(&cus, hipDeviceAttributeMultiprocessorCount, dev);
        hipFuncSetAttribute((const void*)mk_fwd, hipFuncAttributeMaxDynamicSharedMemorySize, LDS_BYTES);
        hipOccupancyMaxActiveBlocksPerMultiprocessor(&per_cu, (const void*)mk_fwd, 512, LDS_BYTES);
        if (per_cu < 1) per_cu = 1;
        grid = cus * per_cu; if (grid > 256) grid = 256;
        (void)hipGetLastError();
    }
    Args a{};
    for (int i = 0; i < 29; ++i) a.in[i] = (const float*)d_in[i];
    a.out = (float*)d_out; a.ws = (unsigned char*)d_ws;
    for (int i = 0; i < 32; ++i) a.inv[i] = 1.0f / powf(10000.0f, (float)(2 * i) / 64.0f);
    a.ph_lo = 0; a.ph_hi = 15;
    hipMemsetAsync(d_ws, 0, 65536, stream);
    void* args[] = {&a};
    hipError_t e = hipLaunchCooperativeKernel((const void*)mk_fwd, dim3(grid), dim3(512), args, LDS_BYTES, stream);
    if (e != hipSuccess) fprintf(stderr, "cooperative launch failed: %s (grid %d)\n", hipGetErrorString(e), grid);
}
```

```cpp
#include <hip/hip_runtime.h>
#include <hip/hip_cooperative_groups.h>
#include <cstdio>
#include <cstdint>
namespace cg = cooperative_groups;

#define LAS __attribute__((address_space(3)))
typedef unsigned short bf16_t;
typedef short bf16x8 __attribute__((ext_vector_type(8)));
typedef short s16x4 __attribute__((ext_vector_type(4)));
typedef float f32x4 __attribute__((ext_vector_type(4)));
typedef unsigned u32x4 __attribute__((ext_vector_type(4)));
typedef unsigned u32x2 __attribute__((ext_vector_type(2)));

constexpr int T = 8192, D = 1024, M = 16384, FF = 2816, UP = 5632, NIN = 2048;
constexpr float EPS = 1e-6f;
constexpr float QSCALE = 0.125f * 1.4426950408889634f;
constexpr size_t MiB = 1u << 20;
constexpr size_t WS_ROPE = 1 * MiB;
constexpr size_t WS_SSP = 3 * MiB;
constexpr size_t WS_C1P = 4 * MiB;
constexpr size_t WS_RSTD = 4 * MiB + 256 * 1024;
constexpr size_t WS_HB = 5 * MiB;
constexpr size_t WS_FB = 8 * MiB;
constexpr size_t WS_GATE = 11 * MiB;
constexpr size_t WS_WIN = 16 * MiB, WS_WOUT = 20 * MiB, WS_WUP0 = 22 * MiB, WS_WUP1 = 33 * MiB, WS_WDN0 = 44 * MiB, WS_WDN1 = 50 * MiB;
constexpr size_t WS_WPOOL = 56 * MiB, WS_WC1K = 57 * MiB, WS_WC1V = 58 * MiB, WS_WC2K = 59 * MiB, WS_WC2V = 59 * MiB + 512 * 1024;
constexpr size_t WS_XB = 64 * MiB;
constexpr size_t WS_Q = 96 * MiB;
constexpr size_t WS_KC = 128 * MiB, WS_VC = 132 * MiB, WS_KS = 136 * MiB, WS_VST = 140 * MiB, WS_KW = 144 * MiB, WS_VWT = 148 * MiB;
constexpr size_t WS_KCC = 152 * MiB, WS_VCT = 153 * MiB, WS_HIDK = 154 * MiB, WS_HIDV = 155 * MiB;
constexpr size_t WS_O = 160 * MiB;
constexpr size_t WS_ACT = 96 * MiB;
constexpr size_t WS_POOLED = 192 * MiB;
constexpr size_t WS_XB2 = 224 * MiB;
constexpr int LDS_RING = 131072, LDS_BYTES = 155648;

__device__ __forceinline__ unsigned cvt_pk_bf16(float lo, float hi) { unsigned r; asm volatile("v_cvt_pk_bf16_f32 %0, %1, %2" : "=v"(r) : "v"(lo), "v"(hi)); return r; }
__device__ __forceinline__ float bf2f(unsigned short b) { return __uint_as_float((unsigned)b << 16); }
__device__ __forceinline__ float ex2(float x) { return __builtin_amdgcn_exp2f(x); }
__device__ __forceinline__ float rcp(float x) { return __builtin_amdgcn_rcpf(x); }
__device__ __forceinline__ float sigmoidf_(float x) { return rcp(1.0f + ex2(-1.4426950408889634f * x)); }
__device__ __forceinline__ void unpk8(const u32x4 v, f32x4& lo, f32x4& hi) { lo = (f32x4){__uint_as_float(v.x << 16), __uint_as_float(v.x & 0xffff0000u), __uint_as_float(v.y << 16), __uint_as_float(v.y & 0xffff0000u)}; hi = (f32x4){__uint_as_float(v.z << 16), __uint_as_float(v.z & 0xffff0000u), __uint_as_float(v.w << 16), __uint_as_float(v.w & 0xffff0000u)}; }
__device__ __forceinline__ int perm8(int a) { return (a & ~31) | (16 * ((a >> 2) & 1) + 4 * ((a >> 3) & 3) + (a & 3)); }
__device__ __forceinline__ int vperm(int kk) { return (kk & 32) | (((kk >> 2) & 3) << 3) | (((kk >> 4) & 1) << 2) | (kk & 3); }
__device__ __forceinline__ int swap45(int a) { return (a & ~48) | (((a >> 4) & 1) << 5) | (((a >> 5) & 1) << 4); }
template <int CTRL> __device__ __forceinline__ float dppf(float x) { return __builtin_bit_cast(float, __builtin_amdgcn_mov_dpp(__builtin_bit_cast(int, x), CTRL, 0xf, 0xf, true)); }
__device__ __forceinline__ float xrow16_max(float x) {
    auto s = __builtin_amdgcn_permlane16_swap(__float_as_uint(x), __float_as_uint(x), false, false); x = fmaxf(__uint_as_float(s[0]), __uint_as_float(s[1]));
    auto t = __builtin_amdgcn_permlane32_swap(__float_as_uint(x), __float_as_uint(x), false, false); return fmaxf(__uint_as_float(t[0]), __uint_as_float(t[1])); }
__device__ __forceinline__ float xrow16_sum(float x) {
    auto s = __builtin_amdgcn_permlane16_swap(__float_as_uint(x), __float_as_uint(x), false, false); x = __uint_as_float(s[0]) + __uint_as_float(s[1]);
    auto t = __builtin_amdgcn_permlane32_swap(__float_as_uint(x), __float_as_uint(x), false, false); return __uint_as_float(t[0]) + __uint_as_float(t[1]); }
__device__ __forceinline__ float sum8(float x) { x += dppf<0xB1>(x); x += dppf<0x4E>(x); x += dppf<0x141>(x); return x; }
#define LDS_WAIT() asm volatile("s_waitcnt lgkmcnt(0)" ::: "memory")
#define WG_BAR() do { asm volatile("s_waitcnt lgkmcnt(0)" ::: "memory"); __builtin_amdgcn_s_barrier(); asm volatile("" ::: "memory"); } while (0)

namespace pg8 {
constexpr int BM = 256, BK = 64, HALF = 128, HTB = HALF * BK * 2, NXCD = 8, WGM = 8;
__host__ __device__ __forceinline__ int lds_byte(int r, int c) { const int st = (r >> 4) * 2 + (c >> 5), rr = r & 15, cc = c & 31, ob = rr * 64 + cc * 2; return st * 1024 + (ob ^ (((ob >> 9) & 1) << 5)); }
__host__ __device__ __forceinline__ void stage_rc(int b, int& R, int& C) { const int st = b / 1024, sb = b % 1024, swz = sb ^ (((sb >> 9) & 1) << 5); R = (st >> 1) * 16 + swz / 64; C = (st & 1) * 32 + (swz % 64) / 2; }
struct Unit { int pm, pn; };
struct Gemm { const bf16_t* A; const bf16_t* Bt; int M, N, K, lda, apn; };
struct StaticOrder {
    int nM, nN, nwg, G, c;
    __device__ __forceinline__ void init(int M_, int N_, int G_, int c_) { nM = M_ / BM; nN = N_ / BM; nwg = nM * nN; G = G_; c = c_; }
    __device__ __forceinline__ bool next(int i, Unit& u) const {
        const long L = (long)i * G + c; if (L >= nwg) return false;
        int wgid = (int)L; { const int q = nwg / NXCD, r = nwg % NXCD, xcd = wgid % NXCD, off = wgid / NXCD; wgid = (xcd < r ? xcd * (q + 1) : r * (q + 1) + (xcd - r) * q) + off; }
        const int nig = WGM * nN, gid = wgid / nig, fm = gid * WGM, gsz = (nM - fm) < WGM ? (nM - fm) : WGM;
        u.pm = fm + ((wgid % nig) % gsz); u.pn = (wgid % nig) / gsz; return true;
    }
};
template <class Epi>
__device__ __forceinline__ void gemm_phase(LAS unsigned char* lds, LAS unsigned char* ldsx, const Gemm g, const StaticOrder& S, const Epi& E) {
    int tid = threadIdx.x; asm volatile("" : "+v"(tid));
    const int wid = __builtin_amdgcn_readfirstlane(tid >> 6), lane = tid & 63, wr = wid >> 2, wc = wid & 3, fr = lane & 15, fq = lane >> 4;
    const int K = g.K, nt = K / BK;
    unsigned voffA[2], voffB[2];
#pragma unroll
    for (int i = 0; i < 2; ++i) { int R, C; stage_rc(tid * 16 + i * 8192, R, C); voffA[i] = (unsigned)(R * g.lda + C) * 2u; voffB[i] = (unsigned)(R * K + C) * 2u; }
    const size_t kstep = (size_t)(BK * 2);
    const size_t hstepA = (size_t)HALF * g.lda * 2, tstepA = 2 * hstepA, hstepB = (size_t)HALF * K * 2, tstepB = 2 * hstepB;
    const unsigned ldsw = (unsigned)wid * 1024u;
    const int aoff = lds_byte(wr * 64 + fr, fq * 8), boff = lds_byte(wc * 32 + fr, fq * 8);
#define PG8_SA(b, h) (((b) * 2 + (h)) * HTB)
#define PG8_SB(b, h) ((4 + (b) * 2 + (h)) * HTB)
#define PG8_STAGE(bufoff, gbase, voff) do { _Pragma("unroll") for (int _i = 0; _i < 2; ++_i) \
        __builtin_amdgcn_global_load_lds((const unsigned*)((const char*)(gbase) + (voff)[_i]), (LAS unsigned*)(lds + (bufoff) + ldsw + _i * 8192), 16, 0, 0); } while (0)
#define PG8_LDA(dst, b, h) do { _Pragma("unroll") for (int m = 0; m < 4; ++m) _Pragma("unroll") for (int k = 0; k < 2; ++k) dst[m][k] = *(const LAS bf16x8*)(lds + PG8_SA(b, h) + aoff + m * 2048 + k * 1024); } while (0)
#define PG8_LDB(dst, b, h) do { _Pragma("unroll") for (int n = 0; n < 2; ++n) _Pragma("unroll") for (int k = 0; k < 2; ++k) dst[n][k] = *(const LAS bf16x8*)(lds + PG8_SB(b, h) + boff + n * 2048 + k * 1024); } while (0)
#define PG8_MMA(ai, bj, At, Bt) do { __builtin_amdgcn_s_setprio(1); _Pragma("unroll") for (int m = 0; m < 4; ++m) _Pragma("unroll") for (int n = 0; n < 2; ++n) _Pragma("unroll") for (int k = 0; k < 2; ++k) \
        acc[ai][bj][m][n] = __builtin_amdgcn_mfma_f32_16x16x32_bf16(Bt[n][k], At[m][k], acc[ai][bj][m][n], 0, 0, 0); __builtin_amdgcn_s_setprio(0); } while (0)
#define PG8_WAIT_V(n) asm volatile("s_waitcnt vmcnt(" #n ")" ::: "memory")
#define PG8_WAIT_L(n) asm volatile("s_waitcnt lgkmcnt(" #n ")" ::: "memory")
#define PG8_BAR __builtin_amdgcn_s_barrier()
#define PG8_SCHED __builtin_amdgcn_sched_barrier(0)
    Unit cur, nxt; int ui = 0;
    if (!S.next(0, cur)) return;
    f32x4 acc[2][2][4][2];
#pragma unroll
    for (int a = 0; a < 2; ++a)
#pragma unroll
        for (int b = 0; b < 2; ++b)
#pragma unroll
            for (int m = 0; m < 4; ++m)
#pragma unroll
                for (int n = 0; n < 2; ++n) acc[a][b][m][n] = (f32x4){0.f, 0.f, 0.f, 0.f};
    bf16x8 At[4][2], B0[2][2], B1[2][2];
    const char* cA = (const char*)g.A + (size_t)cur.pm * tstepA + (size_t)cur.pn * g.apn; const char* cB = (const char*)g.Bt + (size_t)cur.pn * tstepB;
    PG8_STAGE(PG8_SB(0, 0), cB, voffB); PG8_STAGE(PG8_SB(0, 1), cB + hstepB, voffB); PG8_STAGE(PG8_SA(0, 0), cA, voffA); PG8_STAGE(PG8_SA(0, 1), cA + hstepA, voffA);
    if (wr == 1) PG8_BAR;
    PG8_WAIT_V(2); PG8_BAR;
    PG8_STAGE(PG8_SB(1, 0), cB + kstep, voffB); PG8_STAGE(PG8_SA(1, 0), cA + kstep, voffA); PG8_STAGE(PG8_SB(1, 1), cB + hstepB + kstep, voffB);
    PG8_WAIT_V(6); PG8_BAR;
    for (;;) {
        const bool has_next = S.next(ui + 1, nxt);
        const char* nA = has_next ? (const char*)g.A + (size_t)nxt.pm * tstepA + (size_t)nxt.pn * g.apn : cA; const char* nB = has_next ? (const char*)g.Bt + (size_t)nxt.pn * tstepB : cB;
        for (int t = 0; t < nt; t += 2) {
            const bool last = (t == nt - 2);
            const char* a1 = cA + (size_t)(t + 1) * kstep;
            const char* a2 = last ? nA : cA + (size_t)(t + 2) * kstep; const char* b2 = last ? nB : cB + (size_t)(t + 2) * kstep;
            const char* a3 = a2 + kstep; const char* b3 = b2 + kstep;
            PG8_LDB(B0, 0, 0); PG8_LDB(B1, 0, 1); PG8_SCHED; PG8_LDA(At, 0, 0); PG8_STAGE(PG8_SA(1, 1), a1 + hstepA, voffA);
            PG8_WAIT_V(8); PG8_WAIT_L(0); PG8_BAR; PG8_MMA(0, 0, At, B0); PG8_MMA(0, 1, At, B1); PG8_BAR; PG8_SCHED;
            PG8_LDA(At, 0, 1); PG8_STAGE(PG8_SB(0, 0), b2, voffB); PG8_STAGE(PG8_SB(0, 1), b2 + hstepB, voffB); PG8_STAGE(PG8_SA(0, 0), a2, voffA);
            PG8_WAIT_V(8); PG8_WAIT_L(0); PG8_BAR; PG8_MMA(1, 0, At, B0); PG8_MMA(1, 1, At, B1); PG8_BAR; PG8_SCHED;
            PG8_LDB(B0, 1, 0); PG8_LDB(B1, 1, 1); PG8_SCHED; PG8_LDA(At, 1, 0); PG8_STAGE(PG8_SA(0, 1), a2 + hstepA, voffA);
            PG8_WAIT_V(8); PG8_WAIT_L(0); PG8_BAR; PG8_MMA(0, 0, At, B0); PG8_MMA(0, 1, At, B1); PG8_BAR; PG8_SCHED;
            PG8_LDA(At, 1, 1); PG8_STAGE(PG8_SB(1, 0), b3, voffB); PG8_STAGE(PG8_SB(1, 1), b3 + hstepB, voffB); PG8_STAGE(PG8_SA(1, 0), a3, voffA);
            PG8_WAIT_V(8); PG8_WAIT_L(0); PG8_BAR; PG8_MMA(1, 0, At, B0); PG8_MMA(1, 1, At, B1); PG8_BAR; PG8_SCHED;
        }
        if (wr == 0) PG8_BAR;
        { int t2 = threadIdx.x; asm volatile("" : "+v"(t2));
          E(acc, cur, wr, wc, t2 & 15, (t2 & 63) >> 4, ldsx, t2); }
        if (!has_next) break;
#pragma unroll
        for (int a = 0; a < 2; ++a)
#pragma unroll
            for (int b = 0; b < 2; ++b)
#pragma unroll
                for (int m = 0; m < 4; ++m)
#pragma unroll
                    for (int n = 0; n < 2; ++n) acc[a][b][m][n] = (f32x4){0.f, 0.f, 0.f, 0.f};
        cur = nxt; cA = nA; cB = nB; ++ui;
        if (wr == 1) PG8_BAR;
    }
    PG8_WAIT_V(0);
    PG8_BAR;
#undef PG8_SA
#undef PG8_SB
#undef PG8_STAGE
#undef PG8_LDA
#undef PG8_LDB
#undef PG8_MMA
#undef PG8_WAIT_V
#undef PG8_WAIT_L
#undef PG8_BAR
#undef PG8_SCHED
}
}
using pg8::Unit;
typedef f32x4 Acc[2][2][4][2];

__device__ __forceinline__ float row_rstd(const float* ssp, int np, int row) {
    float s = 0.f; for (int i = 0; i < np; ++i) s += ssp[(size_t)i * M + row];
    return 1.0f / sqrtf(s * (1.0f / D) + EPS);
}

struct EpiIn {
    const float* rstdv; const float* cosT; const float* sinT;
    bf16_t *Q, *KC, *VC, *KS, *VST, *KW, *VWT; float* gates;
    __device__ __forceinline__ void operator()(Acc& acc, const Unit& u, int wr, int wc, int fr, int fq, LAS unsigned char*, int) const {
#pragma unroll
        for (int ai = 0; ai < 2; ++ai)
#pragma unroll
            for (int m = 0; m < 4; ++m) {
                const int row = u.pm * 256 + ai * 128 + wr * 64 + m * 16 + fr; const float rs = rstdv[row];
                const int t = row & (T - 1), b = row >> 13;
                const int d0 = 16 * (wc & 1) + 4 * fq;
                const f32x4 cs = *(const f32x4*)(cosT + t * 32 + d0), sn = *(const f32x4*)(sinT + t * 32 + d0);
#pragma unroll
                for (int bj = 0; bj < 2; ++bj) {
                    f32x4 a1 = acc[ai][bj][m][0] * rs, a2 = acc[ai][bj][m][1] * rs;
                    if (u.pn == 7) {
                        if (bj == 0) {
#pragma unroll
                            for (int n = 0; n < 2; ++n) { const int c0 = 32 * wc + 16 * n + 4 * fq; if (c0 < 48) { const f32x4 v = n ? a2 : a1; f32x4 o; o[0] = sigmoidf_(v[0]); o[1] = sigmoidf_(v[1]); o[2] = sigmoidf_(v[2]); o[3] = sigmoidf_(v[3]); *(f32x4*)(gates + (size_t)row * 48 + c0) = o; } }
                        }
                        continue;
                    }
                    const int hh = 2 * bj + (wc >> 1);
                    bool rope; if (u.pn < 4) rope = true; else rope = (u.pn >= 5) && (hh < 2);
                    f32x4 o1 = a1, o2 = a2;
                    if (rope) { o1 = a1 * cs - a2 * sn; o2 = a1 * sn + a2 * cs; }
                    if (u.pn < 4) {
                        o1 = o1 * QSCALE; o2 = o2 * QSCALE;
                        bf16_t* p = Q + (size_t)row * 1024 + (u.pn * 4 + hh) * 64 + d0;
                        u32x2 w1; w1.x = cvt_pk_bf16(o1[0], o1[1]); w1.y = cvt_pk_bf16(o1[2], o1[3]); *(u32x2*)p = w1;
                        u32x2 w2; w2.x = cvt_pk_bf16(o2[0], o2[1]); w2.y = cvt_pk_bf16(o2[2], o2[3]); *(u32x2*)(p + 32) = w2;
                    } else {
                        const int gg = hh & 1; const bool isv = hh >= 2;
                        if (!isv) {
                            bf16_t* base = (u.pn == 4) ? KC : (u.pn == 5) ? KS : KW;
                            bf16_t* p = base + ((size_t)(b * 2 + gg) * T + t) * 64 + d0;
                            u32x2 w1; w1.x = cvt_pk_bf16(o1[0], o1[1]); w1.y = cvt_pk_bf16(o1[2], o1[3]); *(u32x2*)p = w1;
                            u32x2 w2; w2.x = cvt_pk_bf16(o2[0], o2[1]); w2.y = cvt_pk_bf16(o2[2], o2[3]); *(u32x2*)(p + 32) = w2;
                        } else if (u.pn == 4) {
                            bf16_t* p = VC + ((size_t)(b * 2 + gg) * T + t) * 64 + d0;
                            u32x2 w1; w1.x = cvt_pk_bf16(o1[0], o1[1]); w1.y = cvt_pk_bf16(o1[2], o1[3]); *(u32x2*)p = w1;
                            u32x2 w2; w2.x = cvt_pk_bf16(o2[0], o2[1]); w2.y = cvt_pk_bf16(o2[2], o2[3]); *(u32x2*)(p + 32) = w2;
                        } else {
                            bf16_t* base = (u.pn == 5) ? VST : VWT;
                            bf16_t* p = base + ((size_t)(b * 2 + gg) * 128 + (t >> 6)) * 4096 + vperm(t & 63);
#pragma unroll
                            for (int j = 0; j < 4; ++j) { p[(d0 + j) * 64] = (bf16_t)(cvt_pk_bf16(o1[j], 0.f) & 0xffff); p[(d0 + 32 + j) * 64] = (bf16_t)(cvt_pk_bf16(o2[j], 0.f) & 0xffff); }
                        }
                    }
                }
                asm volatile("" ::: "memory"); __builtin_amdgcn_sched_barrier(0);
            }
    }
};

struct EpiC1 {
    bf16_t* hid;
    __device__ __forceinline__ void operator()(Acc& acc, const Unit& u, int wr, int wc, int fr, int fq, LAS unsigned char* ldsx, int) const {
        const LAS float* c1 = (const LAS float*)ldsx;
#pragma unroll
        for (int bj = 0; bj < 2; ++bj) {
            const int c0 = 128 * bj + 32 * wc + 8 * fq;
            const f32x4 bA = *(const LAS f32x4*)(c1 + c0), bB = *(const LAS f32x4*)(c1 + c0 + 4);
#pragma unroll
            for (int ai = 0; ai < 2; ++ai)
#pragma unroll
                for (int m = 0; m < 4; ++m) {
                    const int row = u.pm * 256 + ai * 128 + wr * 64 + m * 16 + fr;
                    float v[8];
#pragma unroll
                    for (int e = 0; e < 8; ++e) { const float x = acc[ai][bj][m][e >> 2][e & 3] + ((e >> 2) ? bB[e & 3] : bA[e & 3]); const float y = 0.7978845608028654f * (x + 0.044715f * x * x * x); v[e] = x * sigmoidf_(2.0f * y); }
                    u32x4 w; w.x = cvt_pk_bf16(v[0], v[1]); w.y = cvt_pk_bf16(v[2], v[3]); w.z = cvt_pk_bf16(v[4], v[5]); w.w = cvt_pk_bf16(v[6], v[7]);
                    *(u32x4*)(hid + (size_t)row * 256 + c0) = w;
                    asm volatile("" ::: "memory"); __builtin_amdgcn_sched_barrier(0);
                }
        }
    }
};
struct EpiC2 {
    const float* b2; const float* cosT; const float* sinT; bf16_t* out; int isv;
    __device__ __forceinline__ void operator()(Acc& acc, const Unit& u, int wr, int wc, int fr, int fq, LAS unsigned char*, int) const {
        if (wc >= 2) return;
        const int d0 = 16 * (wc & 1) + 4 * fq;
        const f32x4 bA = *(const f32x4*)(b2 + d0), bB = *(const f32x4*)(b2 + d0 + 32);
#pragma unroll
        for (int ai = 0; ai < 2; ++ai)
#pragma unroll
            for (int m = 0; m < 4; ++m) {
                const int row = u.pm * 256 + ai * 128 + wr * 64 + m * 16 + fr; const int j = row & 511;
                f32x4 a1 = acc[ai][0][m][0] + bA, a2 = acc[ai][0][m][1] + bB;
                if (j == 511) { a1 = (f32x4){0.f, 0.f, 0.f, 0.f}; a2 = a1; }
                if (!isv) {
                    const int pos = (j == 511) ? 0 : 16 * j + 31;
                    const f32x4 cs = *(const f32x4*)(cosT + pos * 32 + d0), sn = *(const f32x4*)(sinT + pos * 32 + d0);
                    const f32x4 o1 = a1 * cs - a2 * sn, o2 = a1 * sn + a2 * cs;
                    bf16_t* p = out + (size_t)row * 64 + d0;
                    u32x2 w1; w1.x = cvt_pk_bf16(o1[0], o1[1]); w1.y = cvt_pk_bf16(o1[2], o1[3]); *(u32x2*)p = w1;
                    u32x2 w2; w2.x = cvt_pk_bf16(o2[0], o2[1]); w2.y = cvt_pk_bf16(o2[2], o2[3]); *(u32x2*)(p + 32) = w2;
                } else {
                    bf16_t* p = out + (size_t)(row >> 6) * 4096 + vperm(row & 63);
#pragma unroll
                    for (int e = 0; e < 4; ++e) { p[(d0 + e) * 64] = (bf16_t)(cvt_pk_bf16(a1[e], 0.f) & 0xffff); p[(d0 + 32 + e) * 64] = (bf16_t)(cvt_pk_bf16(a2[e], 0.f) & 0xffff); }
                }
                asm volatile("" ::: "memory"); __builtin_amdgcn_sched_barrier(0);
            }
    }
};

struct EpiRes {
    const float* xold; float* xnew; const bf16_t* xb; float* ssp; const float* pb; const float* ps; bf16_t* xbo;
    __device__ __forceinline__ void operator()(Acc& acc, const Unit& u, int wr, int wc, int fr, int fq, LAS unsigned char* ldsx, int tid) const {
#pragma unroll
        for (int ai = 0; ai < 2; ++ai) {
            u32x4 xo[4][2];
#pragma unroll
            for (int m = 0; m < 4; ++m)
#pragma unroll
                for (int bj = 0; bj < 2; ++bj) xo[m][bj] = *(const u32x4*)(xb + (size_t)(u.pm * 256 + ai * 128 + wr * 64 + m * 16 + fr) * D + u.pn * 256 + 128 * bj + 32 * wc + 8 * fq);
            __builtin_amdgcn_sched_barrier(0);
#pragma unroll
            for (int m = 0; m < 4; ++m) {
                const int row = u.pm * 256 + ai * 128 + wr * 64 + m * 16 + fr; float ss = 0.f;
#pragma unroll
                for (int bj = 0; bj < 2; ++bj) {
                    const int col = u.pn * 256 + 128 * bj + 32 * wc + 8 * fq; const size_t off = (size_t)row * D + col;
                    f32x4 a0 = acc[ai][bj][m][0], a1 = acc[ai][bj][m][1];
                    if (pb) { a0 = (a0 + *(const f32x4*)(pb + col)) * *(const f32x4*)(ps + col); a1 = (a1 + *(const f32x4*)(pb + col + 4)) * *(const f32x4*)(ps + col + 4); }
                    f32x4 r0, r1; unpk8(xo[m][bj], r0, r1);
                    const f32x4 x0 = r0 + a0, x1 = r1 + a1;
                    u32x4 w; w.x = cvt_pk_bf16(x0[0], x0[1]); w.y = cvt_pk_bf16(x0[2], x0[3]); w.z = cvt_pk_bf16(x1[0], x1[1]); w.w = cvt_pk_bf16(x1[2], x1[3]);
                    *(u32x4*)(xbo + off) = w;
                    ss += (x0[0] * x0[0] + x0[1] * x0[1]) + (x0[2] * x0[2] + x0[3] * x0[3]) + (x1[0] * x1[0] + x1[1] * x1[1]) + (x1[2] * x1[2] + x1[3] * x1[3]);
                    asm volatile("" ::: "memory"); __builtin_amdgcn_sched_barrier(0);
                }
                ss = xrow16_sum(ss);
                if (fq == 0) ((LAS float*)ldsx)[wc * 256 + ai * 128 + wr * 64 + m * 16 + fr] = ss;
            }
        }
        WG_BAR();
        if (tid < 256) { const LAS float* rd = (const LAS float*)ldsx; ssp[(size_t)u.pn * M + u.pm * 256 + tid] = (rd[tid] + rd[256 + tid]) + (rd[512 + tid] + rd[768 + tid]); }
        WG_BAR();
    }
};

struct EpiFinal {
    float* x; const float* gain; float* ssx; unsigned* cnt; const bf16_t* xb;
    __device__ __forceinline__ void operator()(Acc& acc, const Unit& u, int wr, int wc, int fr, int fq, LAS unsigned char* ldsx, int tid) const {
        LAS float* red = (LAS float*)ldsx; LAS float* rsl = (LAS float*)(ldsx + 4096);
#pragma unroll
        for (int ai = 0; ai < 2; ++ai) {
            u32x4 xo[4][2];
#pragma unroll
            for (int m = 0; m < 4; ++m)
#pragma unroll
                for (int bj = 0; bj < 2; ++bj) xo[m][bj] = *(const u32x4*)(xb + (size_t)(u.pm * 256 + ai * 128 + wr * 64 + m * 16 + fr) * D + u.pn * 256 + 128 * bj + 32 * wc + 8 * fq);
            __builtin_amdgcn_sched_barrier(0);
#pragma unroll
            for (int m = 0; m < 4; ++m) {
                const int row = u.pm * 256 + ai * 128 + wr * 64 + m * 16 + fr; float ss = 0.f;
#pragma unroll
                for (int bj = 0; bj < 2; ++bj) {
                    const int col = u.pn * 256 + 128 * bj + 32 * wc + 8 * fq; const size_t off = (size_t)row * D + col; (void)off;
                    f32x4 r0, r1; unpk8(xo[m][bj], r0, r1);
                    const f32x4 x0 = r0 + acc[ai][bj][m][0], x1 = r1 + acc[ai][bj][m][1];
                    acc[ai][bj][m][0] = x0; acc[ai][bj][m][1] = x1;
                    ss += (x0[0] * x0[0] + x0[1] * x0[1]) + (x0[2] * x0[2] + x0[3] * x0[3]) + (x1[0] * x1[0] + x1[1] * x1[1]) + (x1[2] * x1[2] + x1[3] * x1[3]);
                    asm volatile("" ::: "memory"); __builtin_amdgcn_sched_barrier(0);
                }
                ss = xrow16_sum(ss);
                if (fq == 0) red[wc * 256 + ai * 128 + wr * 64 + m * 16 + fr] = ss;
            }
        }
        WG_BAR();
        if (tid < 256) __hip_atomic_store(ssx + (size_t)u.pn * M + u.pm * 256 + tid, (red[tid] + red[256 + tid]) + (red[512 + tid] + red[768 + tid]), __ATOMIC_RELAXED, __HIP_MEMORY_SCOPE_AGENT);
        asm volatile("s_waitcnt vmcnt(0)" ::: "memory");
        WG_BAR();
        if (tid == 0) {
            unsigned* c = cnt + 64 * u.pm;
            __hip_atomic_fetch_add(c, 1u, __ATOMIC_RELAXED, __HIP_MEMORY_SCOPE_AGENT);
            unsigned spins = 0;
            while (__hip_atomic_load(c, __ATOMIC_RELAXED, __HIP_MEMORY_SCOPE_AGENT) < 4u) { __builtin_amdgcn_s_sleep(2); if (++spins > (1u << 22)) break; }
            __builtin_amdgcn_fence(__ATOMIC_ACQUIRE, "agent");
            asm volatile("s_waitcnt vmcnt(0)" ::: "memory");
        }
        WG_BAR();
        if (tid < 256) {
            const float* p = ssx + u.pm * 256 + tid;
            const float sq = (__hip_atomic_load(p, __ATOMIC_RELAXED, __HIP_MEMORY_SCOPE_AGENT) + __hip_atomic_load(p + M, __ATOMIC_RELAXED, __HIP_MEMORY_SCOPE_AGENT)) +
                             (__hip_atomic_load(p + 2 * M, __ATOMIC_RELAXED, __HIP_MEMORY_SCOPE_AGENT) + __hip_atomic_load(p + 3 * M, __ATOMIC_RELAXED, __HIP_MEMORY_SCOPE_AGENT));
            rsl[tid] = 1.0f / sqrtf(sq * (1.0f / D) + EPS);
        }
        WG_BAR();
#pragma unroll
        for (int ai = 0; ai < 2; ++ai)
#pragma unroll
            for (int m = 0; m < 4; ++m) {
                const int rl = ai * 128 + wr * 64 + m * 16 + fr; const float rs = rsl[rl]; const int row = u.pm * 256 + rl;
#pragma unroll
                for (int bj = 0; bj < 2; ++bj) {
                    const int col = u.pn * 256 + 128 * bj + 32 * wc + 8 * fq; const size_t off = (size_t)row * D + col;
                    *(f32x4*)(x + off) = acc[ai][bj][m][0] * rs * *(const f32x4*)(gain + col); *(f32x4*)(x + off + 4) = acc[ai][bj][m][1] * rs * *(const f32x4*)(gain + col + 4);
                }
                asm volatile("" ::: "memory"); __builtin_amdgcn_sched_barrier(0);
            }
    }
};

struct EpiUp {
    const float* ssp; const float* cw; const float* cb; bf16_t* act; float* HB; float* FB;
    __device__ __forceinline__ void operator()(Acc& acc, const Unit& u, int wr, int wc, int fr, int fq, LAS unsigned char* ldsx, int tid) const {
        LAS float* Hl = (LAS float*)ldsx;
        LAS float* rsl = (LAS float*)(ldsx + 10240);
        const int lane = tid & 63;
        if (tid < 256) { const int row = u.pm * 256 + tid; const float sq = (ssp[row] + ssp[M + row]) + (ssp[2 * M + row] + ssp[3 * M + row]); rsl[tid] = 1.0f / sqrtf(sq * (1.0f / D) + EPS); }
        WG_BAR();
#pragma unroll
        for (int ai = 0; ai < 2; ++ai)
#pragma unroll
            for (int m = 0; m < 4; ++m) {
                const float rs = rsl[ai * 128 + wr * 64 + m * 16 + fr];
#pragma unroll
                for (int bj = 0; bj < 2; ++bj) { acc[ai][bj][m][0] *= rs; acc[ai][bj][m][1] *= rs; }
                asm volatile("" ::: "memory"); __builtin_amdgcn_sched_barrier(0);
            }
        if (tid < 128) *(LAS f32x4*)(Hl + tid * 4) = (f32x4){0.f, 0.f, 0.f, 0.f};
#pragma unroll
        for (int ai = 0; ai < 2; ++ai) {
            const int k = 2 * ai + wr;
#pragma unroll
            for (int bj = 0; bj < 2; ++bj)
#pragma unroll
                for (int n = 0; n < 2; ++n) {
                    const int tc = 128 * bj + 32 * wc + 8 * fq + 4 * n; const int uc = bj * FF + u.pn * 128 + 32 * wc + 8 * fq + 4 * n;
                    if (fr >= 14) { *(LAS f32x4*)(Hl + ((k + 1) * 2 + (fr - 14)) * 256 + tc) = acc[ai][bj][3][n]; if (k == 3) *(f32x4*)(HB + ((size_t)u.pm * 2 + (fr - 14)) * UP + uc) = acc[ai][bj][3][n]; }
                    if (k == 0 && fr < 2) *(f32x4*)(FB + ((size_t)u.pm * 2 + fr) * UP + uc) = acc[0][bj][0][n];
                }
        }
        WG_BAR();
#define UP_CONV(dst, ai_, bj_, W0, W1, W2, BB, H0, H1) do { _Pragma("unroll") for (int m = 0; m < 4; ++m) { \
            const f32x4 V = acc[ai_][bj_][m][n]; f32x4 p1, p2; \
            _Pragma("unroll") for (int e = 0; e < 4; ++e) { \
                const float r1 = dppf<0x121>(V[e]), r2 = dppf<0x122>(V[e]); float x1, x2; \
                if (m > 0) { x1 = dppf<0x121>(acc[ai_][bj_][m > 0 ? m - 1 : 0][n][e]); x2 = dppf<0x122>(acc[ai_][bj_][m > 0 ? m - 1 : 0][n][e]); } \
                else { x1 = H1[e]; x2 = (fr == 0) ? H0[e] : H1[e]; } \
                p1[e] = (fr == 0) ? x1 : r1; p2[e] = (fr < 2) ? x2 : r2; } \
            dst[m] = BB + W0 * p2 + W1 * p1 + W2 * V; } } while (0)
        u32x2 pk[2][4];
#pragma unroll
        for (int n = 0; n < 2; ++n) {
            const int tc = 32 * wc + 8 * fq + 4 * n; const int ucg = u.pn * 128 + tc;
            const f32x4 gw0 = *(const f32x4*)(cw + ucg), gw1 = *(const f32x4*)(cw + UP + ucg), gw2 = *(const f32x4*)(cw + 2 * UP + ucg), gbb = *(const f32x4*)(cb + ucg);
            const f32x4 vw0 = *(const f32x4*)(cw + FF + ucg), vw1 = *(const f32x4*)(cw + UP + FF + ucg), vw2 = *(const f32x4*)(cw + 2 * UP + FF + ucg), vbb = *(const f32x4*)(cb + FF + ucg);
            f32x4 cg[2][4];
#pragma unroll
            for (int ai = 0; ai < 2; ++ai) {
                const int k = 2 * ai + wr;
                const f32x4 h0 = *(const LAS f32x4*)(Hl + (k * 2 + 0) * 256 + tc), h1 = *(const LAS f32x4*)(Hl + (k * 2 + 1) * 256 + tc);
                UP_CONV(cg[ai], ai, 0, gw0, gw1, gw2, gbb, h0, h1);
                __builtin_amdgcn_sched_barrier(0);
            }
#pragma unroll
            for (int ai = 0; ai < 2; ++ai) {
                const int k = 2 * ai + wr;
                const f32x4 h0 = *(const LAS f32x4*)(Hl + (k * 2 + 0) * 256 + 128 + tc), h1 = *(const LAS f32x4*)(Hl + (k * 2 + 1) * 256 + 128 + tc);
                f32x4 cv[4];
                UP_CONV(cv, ai, 1, vw0, vw1, vw2, vbb, h0, h1);
#pragma unroll
                for (int m = 0; m < 4; ++m) {
                    const int row = u.pm * 256 + ai * 128 + wr * 64 + m * 16 + fr;
                    float o[4];
#pragma unroll
                    for (int e = 0; e < 4; ++e) { const float gt = cg[ai][m][e]; o[e] = gt * sigmoidf_(gt) * cv[m][e]; }
                    u32x2 w; w.x = cvt_pk_bf16(o[0], o[1]); w.y = cvt_pk_bf16(o[2], o[3]);
                    if (n == 0) pk[ai][m] = w;
                    else { u32x4 w4; w4.x = pk[ai][m].x; w4.y = pk[ai][m].y; w4.z = w.x; w4.w = w.y; *(u32x4*)(act + (size_t)row * FF + ucg - 4) = w4; }
                }
                asm volatile("" ::: "memory"); __builtin_amdgcn_sched_barrier(0);
            }
        }
#undef UP_CONV
        WG_BAR();
    }
};

namespace att {
constexpr int SLOT_B = 16384, NSLOT = 6;
constexpr int OFF_K = 0, OFF_IMP = NSLOT * SLOT_B, IMPW = 132, OFF_SEL = OFF_IMP + 64 * IMPW * 4, OFF_UNI = OFF_SEL + 1024, OFF_LIST = OFF_UNI + 64, OFF_N = OFF_LIST + 132 * 4, OFF_CODE = OFF_N + 48, CODEW = 144;
static_assert(OFF_CODE + 8 * CODEW <= LDS_BYTES - 16 && 8 * SLOT_B <= OFF_SEL, "attention LDS map");
struct Ctx {
    const bf16_t *Q, *KCC, *VCT, *KS, *VST, *KW, *VWT; const float* gates; bf16_t* O;
};
__device__ __forceinline__ bf16x8 mk8(s16x4 a, s16x4 b) { return (bf16x8){a[0], a[1], a[2], a[3], b[0], b[1], b[2], b[3]}; }

template <int MODE>
__device__ __forceinline__ void branch(LAS unsigned char* lds, const bf16_t* Kg, const bf16_t* Vg, int ktile_elems, int nt, int c, int w, int lane, int tid,
                                       const bf16x8 (&qf)[4][2], float (&mrow)[4], float (&lrow)[4], f32x4 (&O)[4][4]) {
    const int fr = lane & 15, fq = lane >> 4;
    const LAS int* list = (const LAS int*)(lds + OFF_LIST);
    LAS float* impL = (LAS float*)(lds + OFF_IMP);
    const LAS unsigned char* codeL = (const LAS unsigned char*)(lds + OFF_CODE) + w * CODEW;
    constexpr int TPS = (MODE >= 2) ? 4 : 3;
#define ATT_DMA(ti, slot) do { const int ti_ = (ti); const int s_ = list[ti_]; LAS unsigned char* d_ = lds + OFF_K + (slot) * SLOT_B + w * 1024; \
        int t2_ = tid; asm volatile("" : "+v"(t2_)); const int lr = t2_ >> 3, lq = t2_ & 7; const int goff = lr * 64 + ((lq ^ ((lr >> 1) & 7)) * 8); \
        __builtin_amdgcn_global_load_lds((const unsigned*)(Kg + (size_t)s_ * ktile_elems + goff), (LAS unsigned*)d_, 16, 0, 0); \
        if (MODE != 0) __builtin_amdgcn_global_load_lds((const unsigned*)(Vg + (size_t)s_ * 4096 + goff), (LAS unsigned*)(d_ + 8192), 16, 0, 0); } while (0)
    asm volatile("s_waitcnt vmcnt(0)" ::: "memory");
#pragma unroll
    for (int ti = 0; ti < TPS; ++ti) if (ti < nt) ATT_DMA(ti, ti);
    const int nst = (nt + TPS - 1) / TPS;
    for (int j = 0; j < nst; ++j) {
        asm volatile("s_waitcnt vmcnt(0)" ::: "memory");
        WG_BAR();
#pragma unroll
        for (int hh = 0; hh < TPS; ++hh) if (TPS * (j + 1) + hh < nt) ATT_DMA(TPS * (j + 1) + hh, ((j + 1) & 1) * TPS + hh);
        int sl0 = 0, sl1 = 0, sl2 = 0, sl3 = 0; unsigned codes4 = 0xffffffffu;
        if (TPS == 4) {
            const u32x4 l4 = *(const LAS u32x4*)(list + TPS * j);
            sl0 = __builtin_amdgcn_readfirstlane((int)l4.x); sl1 = __builtin_amdgcn_readfirstlane((int)l4.y); sl2 = __builtin_amdgcn_readfirstlane((int)l4.z); sl3 = __builtin_amdgcn_readfirstlane((int)l4.w);
            if (MODE == 2) codes4 = (unsigned)__builtin_amdgcn_readfirstlane((int)*(const LAS unsigned*)(codeL + TPS * j));
        }
#pragma unroll 1
        for (int h = 0; h < TPS; ++h) {
        const int i = TPS * j + h; if (i >= nt) break;
        const int s = (TPS == 4) ? (h == 0 ? sl0 : h == 1 ? sl1 : h == 2 ? sl2 : sl3) : list[i];
        unsigned code = 0xffu; if (MODE == 2) code = (codes4 >> (8 * h)) & 0xffu;
        const LAS unsigned char* Kb = lds + OFF_K + ((j & 1) * TPS + h) * SLOT_B;
        const LAS unsigned char* Vb = Kb;
        int l2_ = lane; asm volatile("" : "+v"(l2_)); const int fr2 = l2_ & 15, fq2 = l2_ >> 4, swz = (fr2 >> 1) & 7;
        const int kb0 = fr2 * 128 + ((fq2 ^ swz) * 16), kb1 = kb0 ^ 64;
        if (MODE != 2) {
            f32x4 sa[4][4];
#pragma unroll
            for (int p = 0; p < 4; ++p) {
                const float cinit = (MODE == 1) ? lrow[p] : -((mrow[p] < -1e29f) ? 0.f : mrow[p]);
#pragma unroll
                for (int mt = 0; mt < 4; ++mt) sa[p][mt] = (f32x4){cinit, cinit, cinit, cinit};
            }
            bf16x8 vd0[4];
            {
                bf16x8 kf[8];
#pragma unroll
                for (int i8 = 0; i8 < 8; ++i8) kf[i8] = *(const LAS bf16x8*)(Kb + ((i8 & 1) ? kb1 : kb0) + (i8 >> 1) * 2048);
                __builtin_amdgcn_sched_barrier(0);
#pragma unroll
                for (int i8 = 0; i8 < 8; ++i8)
#pragma unroll
                    for (int p = 0; p < 4; ++p) sa[p][i8 >> 1] = __builtin_amdgcn_mfma_f32_16x16x32_bf16(kf[i8], qf[p][i8 & 1], sa[p][i8 >> 1], 0, 0, 0);
            }
            bf16x8 pf[4][2];
#pragma unroll
            for (int p = 0; p < 4; ++p) {
                const int ttA = 8 * w + 2 * p, tt = ttA + (fr >> 3);
                bool needmask;
                if (MODE <= 1) needmask = (((64 * c + ttA - 31) >> 4) - 64 * s) < 63;
                else needmask = (s == c) || (c >= 8 && s == c - 8);
                if (needmask) {
                    int hi, lov = -1;
                    if (MODE <= 1) { const int t = 64 * c + tt; hi = ((t - 31) >> 4) - 64 * s; }
                    else { hi = (s == c) ? tt : 63; lov = (c >= 8 && s == c - 8) ? tt : -1; }
#pragma unroll
                    for (int mt = 0; mt < 4; ++mt)
#pragma unroll
                        for (int j = 0; j < 4; ++j) { const int kk = 16 * mt + 4 * fq + j; sa[p][mt][j] = (kk <= hi && kk > lov) ? sa[p][mt][j] : -1e30f; }
                }
                if (MODE != 1) {
                    float mx = fmaxf(fmaxf(sa[p][0][0], sa[p][0][1]), sa[p][0][2]);
                    mx = fmaxf(fmaxf(mx, sa[p][0][3]), sa[p][1][0]); mx = fmaxf(fmaxf(mx, sa[p][1][1]), sa[p][1][2]); mx = fmaxf(fmaxf(mx, sa[p][1][3]), sa[p][2][0]);
                    mx = fmaxf(fmaxf(mx, sa[p][2][1]), sa[p][2][2]); mx = fmaxf(fmaxf(mx, sa[p][2][3]), sa[p][3][0]); mx = fmaxf(fmaxf(mx, sa[p][3][1]), sa[p][3][2]); mx = fmaxf(mx, sa[p][3][3]);
                    mx = xrow16_max(mx);
                    const bool uninit = mrow[p] < -1e29f;
                    const bool resc = (mx > 8.0f) || (uninit && mx > -1e29f);
                    if (__any(resc)) {
                        const float delta = resc ? mx : 0.f;
                        const float alpha = (resc && !uninit) ? ex2(-delta) : 1.0f;
#pragma unroll
                        for (int mt = 0; mt < 4; ++mt) sa[p][mt] = sa[p][mt] - delta;
                        lrow[p] *= alpha;
                        if (MODE >= 2) {
#pragma unroll
                            for (int d = 0; d < 4; ++d) O[p][d] *= alpha;
                        }
                        if (resc) mrow[p] = (uninit ? 0.f : mrow[p]) + delta;
                    }
                }
#pragma unroll
                for (int mt = 0; mt < 4; ++mt)
#pragma unroll
                    for (int j = 0; j < 4; ++j) sa[p][mt][j] = ex2(sa[p][mt][j]);
                if (MODE != 1) { const f32x4 t4 = (sa[p][0] + sa[p][1]) + (sa[p][2] + sa[p][3]); lrow[p] += (t4[0] + t4[1]) + (t4[2] + t4[3]); }
                if (MODE >= 1) {
#pragma unroll
                    for (int k2 = 0; k2 < 2; ++k2) {
                        u32x4 wv; wv.x = cvt_pk_bf16(sa[p][2 * k2][0], sa[p][2 * k2][1]); wv.y = cvt_pk_bf16(sa[p][2 * k2][2], sa[p][2 * k2][3]); wv.z = cvt_pk_bf16(sa[p][2 * k2 + 1][0], sa[p][2 * k2 + 1][1]); wv.w = cvt_pk_bf16(sa[p][2 * k2 + 1][2], sa[p][2 * k2 + 1][3]);
                        pf[p][k2] = __builtin_bit_cast(bf16x8, wv);
                    }
                }
                if (MODE == 1) {
#pragma unroll
                    for (int mt = 0; mt < 4; ++mt) {
                        float a = sa[p][mt][0] + sa[p][mt][1] + sa[p][mt][2] + 0.5f * sa[p][mt][3], bn = 0.5f * sa[p][mt][3];
                        a = sum8(a); bn = sum8(bn);
                        const int sb = 16 * s + 4 * mt + fq;
                        if ((fr & 7) == 0) { (void)__hip_atomic_fetch_add(impL + tt * IMPW + sb, a, __ATOMIC_RELAXED, __HIP_MEMORY_SCOPE_WORKGROUP); (void)__hip_atomic_fetch_add(impL + tt * IMPW + sb + 1, bn, __ATOMIC_RELAXED, __HIP_MEMORY_SCOPE_WORKGROUP); }
                    }
                }
            }
            if (MODE >= 1) {
                bf16x8 vd1[4];
#pragma unroll
                for (int i4 = 0; i4 < 4; ++i4) vd0[i4] = *(const LAS bf16x8*)(Vb + 8192 + ((i4 & 1) ? kb1 : kb0) + (i4 >> 1) * 2048);
#pragma unroll
                for (int i4 = 0; i4 < 4; ++i4) vd1[i4] = *(const LAS bf16x8*)(Vb + 8192 + ((i4 & 1) ? kb1 : kb0) + (2 + (i4 >> 1)) * 2048);
                __builtin_amdgcn_sched_barrier(0);
#pragma unroll
                for (int i4 = 0; i4 < 4; ++i4)
#pragma unroll
                    for (int p = 0; p < 4; ++p) O[p][i4 >> 1] = __builtin_amdgcn_mfma_f32_16x16x32_bf16(vd0[i4], pf[p][i4 & 1], O[p][i4 >> 1], 0, 0, 0);
#pragma unroll
                for (int i4 = 0; i4 < 4; ++i4)
#pragma unroll
                    for (int p = 0; p < 4; ++p) O[p][2 + (i4 >> 1)] = __builtin_amdgcn_mfma_f32_16x16x32_bf16(vd1[i4], pf[p][i4 & 1], O[p][2 + (i4 >> 1)], 0, 0, 0);
            }
            __builtin_amdgcn_sched_barrier(0);
        } else {
#pragma unroll
        for (int p = 0; p < 4; ++p) {
            const int ttA = 8 * w + 2 * p;
            const unsigned mA = (code >> (2 * p)) & 1u, mB = (code >> (2 * p + 1)) & 1u;
            if ((mA | mB) != 0u) {
            const int tt = ttA + (fr >> 3);
            float cinit;
            if (MODE == 1) cinit = lrow[p];
            else { const float mref = (mrow[p] < -1e29f) ? 0.f : mrow[p]; const bool colact = (MODE != 2) || (((fr >> 3) ? mB : mA) != 0u); cinit = colact ? -mref : -1e30f; }
            f32x4 sa[4];
#pragma unroll
            for (int mt = 0; mt < 4; ++mt) sa[mt] = (f32x4){cinit, cinit, cinit, cinit};
            bf16x8 vf0[4];
            {
                bf16x8 kf[8];
#pragma unroll
                for (int i8 = 0; i8 < 8; ++i8) kf[i8] = *(const LAS bf16x8*)(Kb + ((i8 & 1) ? kb1 : kb0) + (i8 >> 1) * 2048);
                if (MODE >= 1) {
#pragma unroll
                    for (int i4 = 0; i4 < 4; ++i4) vf0[i4] = *(const LAS bf16x8*)(Vb + 8192 + ((i4 & 1) ? kb1 : kb0) + (i4 >> 1) * 2048);
                }
                __builtin_amdgcn_sched_barrier(0);
#pragma unroll
                for (int i8 = 0; i8 < 8; ++i8) sa[i8 >> 1] = __builtin_amdgcn_mfma_f32_16x16x32_bf16(kf[i8], qf[p][i8 & 1], sa[i8 >> 1], 0, 0, 0);
            }
            bool needmask;
            if (MODE <= 1) needmask = (((64 * c + ttA - 31) >> 4) - 64 * s) < 63;
            else if (MODE == 2) needmask = (s == c);
            else needmask = (s == c) || (c >= 8 && s == c - 8);
            if (needmask) {
                int hi, lov = -1;
                if (MODE <= 1) { const int t = 64 * c + tt; hi = ((t - 31) >> 4) - 64 * s; }
                else if (MODE == 2) hi = tt;
                else { hi = (s == c) ? tt : 63; lov = (c >= 8 && s == c - 8) ? tt : -1; }
#pragma unroll
                for (int mt = 0; mt < 4; ++mt)
#pragma unroll
                    for (int j = 0; j < 4; ++j) { const int kk = 16 * mt + 4 * fq + j; sa[mt][j] = (kk <= hi && kk > lov) ? sa[mt][j] : -1e30f; }
            }
            if (MODE != 1) {
                float mx = fmaxf(fmaxf(sa[0][0], sa[0][1]), sa[0][2]);
                mx = fmaxf(fmaxf(mx, sa[0][3]), sa[1][0]); mx = fmaxf(fmaxf(mx, sa[1][1]), sa[1][2]); mx = fmaxf(fmaxf(mx, sa[1][3]), sa[2][0]);
                mx = fmaxf(fmaxf(mx, sa[2][1]), sa[2][2]); mx = fmaxf(fmaxf(mx, sa[2][3]), sa[3][0]); mx = fmaxf(fmaxf(mx, sa[3][1]), sa[3][2]); mx = fmaxf(mx, sa[3][3]);
                mx = xrow16_max(mx);
                const bool uninit = mrow[p] < -1e29f;
                const bool resc = (mx > 8.0f) || (uninit && mx > -1e29f);
                if (__any(resc)) {
                    const float delta = resc ? mx : 0.f;
                    const float alpha = (resc && !uninit) ? ex2(-delta) : 1.0f;
#pragma unroll
                    for (int mt = 0; mt < 4; ++mt) sa[mt] = sa[mt] - delta;
                    lrow[p] *= alpha;
                    if (MODE >= 2) {
#pragma unroll
                        for (int d = 0; d < 4; ++d) O[p][d] *= alpha;
                    }
                    if (resc) mrow[p] = (uninit ? 0.f : mrow[p]) + delta;
                }
            }
            f32x4 pv[4];
#pragma unroll
            for (int mt = 0; mt < 4; ++mt)
#pragma unroll
                for (int j = 0; j < 4; ++j) pv[mt][j] = ex2(sa[mt][j]);
            if (MODE != 1) { const f32x4 t4 = (pv[0] + pv[1]) + (pv[2] + pv[3]); lrow[p] += (t4[0] + t4[1]) + (t4[2] + t4[3]); }
            if (MODE >= 1) {
                bf16x8 pf[2];
#pragma unroll
                for (int k2 = 0; k2 < 2; ++k2) {
                    u32x4 wv; wv.x = cvt_pk_bf16(pv[2 * k2][0], pv[2 * k2][1]); wv.y = cvt_pk_bf16(pv[2 * k2][2], pv[2 * k2][3]); wv.z = cvt_pk_bf16(pv[2 * k2 + 1][0], pv[2 * k2 + 1][1]); wv.w = cvt_pk_bf16(pv[2 * k2 + 1][2], pv[2 * k2 + 1][3]);
                    pf[k2] = __builtin_bit_cast(bf16x8, wv);
                }
                {
                    bf16x8 vf1[4];
#pragma unroll
                    for (int i4 = 0; i4 < 4; ++i4) vf1[i4] = *(const LAS bf16x8*)(Vb + 8192 + ((i4 & 1) ? kb1 : kb0) + (2 + (i4 >> 1)) * 2048);
                    __builtin_amdgcn_sched_barrier(0);
#pragma unroll
                    for (int i4 = 0; i4 < 4; ++i4) O[p][i4 >> 1] = __builtin_amdgcn_mfma_f32_16x16x32_bf16(vf0[i4], pf[i4 & 1], O[p][i4 >> 1], 0, 0, 0);
#pragma unroll
                    for (int i4 = 0; i4 < 4; ++i4) O[p][2 + (i4 >> 1)] = __builtin_amdgcn_mfma_f32_16x16x32_bf16(vf1[i4], pf[i4 & 1], O[p][2 + (i4 >> 1)], 0, 0, 0);
                }
            }
            if (MODE == 1) {
#pragma unroll
                for (int mt = 0; mt < 4; ++mt) {
                    float a = pv[mt][0] + pv[mt][1] + pv[mt][2] + 0.5f * pv[mt][3], bn = 0.5f * pv[mt][3];
                    a = sum8(a); bn = sum8(bn);
                    const int sb = 16 * s + 4 * mt + fq;
                    if ((fr & 7) == 0) { (void)__hip_atomic_fetch_add(impL + tt * IMPW + sb, a, __ATOMIC_RELAXED, __HIP_MEMORY_SCOPE_WORKGROUP); (void)__hip_atomic_fetch_add(impL + tt * IMPW + sb + 1, bn, __ATOMIC_RELAXED, __HIP_MEMORY_SCOPE_WORKGROUP); }
                }
            }
            }
            __builtin_amdgcn_sched_barrier(0);
        }
        }
        }
    }
    WG_BAR();
#undef ATT_DMA
}

__device__ __forceinline__ void unit(LAS unsigned char* lds, const Ctx& X, int b, int g, int c, int tid_in) {
    int tid = tid_in; asm volatile("" : "+v"(tid));
    const int lane = tid & 63, w = __builtin_amdgcn_readfirstlane(tid >> 6), fr = lane & 15, fq = lane >> 4;
    LAS int* list = (LAS int*)(lds + OFF_LIST);
    LAS unsigned* selm = (LAS unsigned*)(lds + OFF_SEL);
    LAS unsigned* uni = (LAS unsigned*)(lds + OFF_UNI);
    LAS float* impL = (LAS float*)(lds + OFF_IMP);
    LAS int* nl = (LAS int*)(lds + OFF_N);
    const int bg = b * 2 + g; const size_t rowbase = (size_t)b * T + 64 * c;
    bf16x8 qf[4][2];
#pragma unroll
    for (int p = 0; p < 4; ++p) { const bf16_t* qp = X.Q + (rowbase + 8 * w + 2 * p + (fr >> 3)) * 1024 + (8 * g + (fr & 7)) * 64 + 8 * fq;
#pragma unroll
        for (int ks = 0; ks < 2; ++ks) qf[p][ks] = *(const bf16x8*)(qp + 32 * ks); }
    for (int i = lane; i < 8 * IMPW; i += 64) impL[(8 * w) * IMPW + i] = 0.f;
    const int ncmp = (4 * c + 3 + 63) >> 6;
    if (tid < 8) list[tid] = tid;
    float mrow[4], lrow[4]; f32x4 O[4][4];
#pragma unroll
    for (int p = 0; p < 4; ++p) { mrow[p] = -1e30f; lrow[p] = 0.f;
#pragma unroll
        for (int d = 0; d < 4; ++d) { O[p][d] = (f32x4){0.f, 0.f, 0.f, 0.f}; } }
    WG_BAR();
    const bf16_t* kcc = X.KCC + (size_t)bg * 512 * 64; const bf16_t* vct = X.VCT + (size_t)bg * 8 * 4096;
    branch<0>(lds, kcc, vct, 4096, ncmp, c, w, lane, tid, qf, mrow, lrow, O);
#pragma unroll
    for (int p = 0; p < 4; ++p) { float l = xrow16_sum(lrow[p]); lrow[p] = (l > 0.f) ? (-mrow[p] - __builtin_amdgcn_logf(l)) : -1e30f; }
    branch<1>(lds, kcc, vct, 4096, ncmp, c, w, lane, tid, qf, mrow, lrow, O);
#define ATT_GATE(br, scale_expr) do { _Pragma("unroll") for (int p = 0; p < 4; ++p) { \
        const size_t grow = rowbase + 8 * w + 2 * p + (fr >> 3); \
        const float gt = X.gates[grow * 48 + (8 * g + (fr & 7)) * 3 + (br)]; const float sc = gt * (scale_expr); \
        _Pragma("unroll") for (int d = 0; d < 4; ++d) { \
            u32x2* optr = (u32x2*)(X.O + grow * 1024 + (8 * g + (fr & 7)) * 64 + 4 * fq + 16 * d); u32x2 ot = (u32x2){0u, 0u}; if ((br) > 0) ot = *optr; \
            float o0 = __uint_as_float(ot.x << 16), o1 = __uint_as_float(ot.x & 0xffff0000u), o2 = __uint_as_float(ot.y << 16), o3 = __uint_as_float(ot.y & 0xffff0000u); \
            o0 += sc * O[p][d][0]; o1 += sc * O[p][d][1]; o2 += sc * O[p][d][2]; o3 += sc * O[p][d][3]; \
            ot.x = cvt_pk_bf16(o0, o1); ot.y = cvt_pk_bf16(o2, o3); O[p][d] = (f32x4){0.f, 0.f, 0.f, 0.f}; \
            *optr = ot; } \
        mrow[p] = -1e30f; lrow[p] = 0.f; } } while (0)
    ATT_GATE(0, 1.0f);
    LDS_WAIT();
    for (int q8 = 0; q8 < 8; ++q8) {
        const int tt = 8 * w + q8;
        unsigned long long blo, bhi;
        if (c + 1 <= 16) { blo = (1ull << (c + 1)) - 1ull; bhi = 0ull; }
        else {
            const int s1 = lane, s2 = lane + 64;
            const bool c1 = (s1 >= 1 && s1 <= c - 2), c2 = (s2 >= 1 && s2 <= c - 2);
            const float v1 = c1 ? impL[tt * IMPW + s1] : -1.f, v2 = c2 ? impL[tt * IMPW + s2] : -1.f;
            int r1 = 0, r2 = 0;
            const int nq = (c - 2) / 4 + 1;
#pragma unroll 2
            for (int q = 0; q < nq; ++q) {
                const f32x4 x4 = *(const LAS f32x4*)(impL + tt * IMPW + 4 * q);
#pragma unroll
                for (int e = 0; e < 4; ++e) { const int sp = 4 * q + e; const float x = (sp >= 1 && sp <= c - 2) ? x4[e] : -2.f;
                    r1 += (x > v1 || (x == v1 && sp < s1)) ? 1 : 0; r2 += (x > v2 || (x == v2 && sp < s2)) ? 1 : 0; }
            }
            const bool f1 = (s1 == 0 || s1 == c || s1 == c - 1), f2 = (s2 == c || s2 == c - 1);
            blo = __ballot((c1 && r1 < 13) || f1); bhi = __ballot((c2 && r2 < 13) || f2);
        }
        if (lane == 0) { selm[tt * 4 + 0] = (unsigned)blo; selm[tt * 4 + 1] = (unsigned)(blo >> 32); selm[tt * 4 + 2] = (unsigned)bhi; selm[tt * 4 + 3] = (unsigned)(bhi >> 32); }
    }
    WG_BAR();
    if (tid < 4) { unsigned o = 0; for (int i = 0; i < 64; ++i) o |= selm[i * 4 + tid]; uni[tid] = o; }
    WG_BAR();
    if (tid == 0) { int n = 0; for (int s = 0; s <= c; ++s) if ((uni[s >> 5] >> (s & 31)) & 1u) list[n++] = s; nl[0] = n; }
    WG_BAR();
    const int nsel = nl[0];
    { LAS unsigned char* cw_ = (LAS unsigned char*)(lds + OFF_CODE) + w * CODEW;
      for (int i = lane; i < nsel; i += 64) { const int s_ = list[i]; unsigned cd = 0;
#pragma unroll
          for (int q8 = 0; q8 < 8; ++q8) cd |= ((selm[(8 * w + q8) * 4 + (s_ >> 5)] >> (s_ & 31)) & 1u) << q8;
          cw_[i] = (unsigned char)cd; }
      LDS_WAIT(); }
    branch<2>(lds, X.KS + (size_t)bg * T * 64, X.VST + (size_t)bg * 128 * 4096, 4096, nsel, c, w, lane, tid, qf, mrow, lrow, O);
#pragma unroll
    for (int p = 0; p < 4; ++p) { float l = xrow16_sum(lrow[p]); lrow[p] = (l > 0.f) ? 1.0f / l : 0.f; }
    { float rl[4] = {lrow[0], lrow[1], lrow[2], lrow[3]}; ATT_GATE(1, rl[p]); }
    const int w0 = (c >= 8) ? c - 8 : 0, nwin = c - w0 + 1;
    if (tid < nwin) list[tid] = w0 + tid;
    WG_BAR();
    branch<3>(lds, X.KW + (size_t)bg * T * 64, X.VWT + (size_t)bg * 128 * 4096, 4096, nwin, c, w, lane, tid, qf, mrow, lrow, O);
#pragma unroll
    for (int p = 0; p < 4; ++p) { float l = xrow16_sum(lrow[p]); lrow[p] = (l > 0.f) ? 1.0f / l : 0.f; }
    { float rl[4] = {lrow[0], lrow[1], lrow[2], lrow[3]}; ATT_GATE(2, rl[p]); }
#undef ATT_GATE
    WG_BAR();
}
}

__device__ __forceinline__ unsigned f2bf(float f) { unsigned u = __builtin_bit_cast(unsigned, f); return (u + 0x7fffu + ((u >> 16) & 1u)) >> 16; }
__device__ __forceinline__ unsigned pk2(float lo, float hi) { return f2bf(lo) | (f2bf(hi) << 16); }
template <int MAP>
__device__ __forceinline__ int rowmap(int a) {
    if (MAP == 0) return perm8(a);
    if (MAP == 1) return a < 1792 ? ((a & ~63) | swap45(a & 63)) : a;
    if (MAP == 2) { if (a < FF) return 256 * (a >> 7) + perm8(a & 127); const int a2 = a - FF; return 256 * (a2 >> 7) + 128 + perm8(a2 & 127); }
    return swap45(a);
}
template <int MAP>
__device__ __forceinline__ void transpose_item(const float* W, int K, int N, bf16_t* WT, int row_off, const float* gain, LAS float* scr, int item, int lane) {
    const int nblk = (N + 31) / 32, kb = item / nblk, nb = item % nblk, k0 = 64 * kb, n0 = 32 * nb;
#pragma unroll
    for (int i = 0; i < 32; ++i) { const int kk = 2 * i + (lane >> 5); const int col = n0 + (lane & 31); float v = (col < N) ? W[(size_t)(k0 + kk) * N + col] : 0.f; if (gain) v *= gain[k0 + kk]; scr[kk * 33 + (lane & 31)] = v; }
    LDS_WAIT();
    const int cc = lane & 7;
#pragma unroll
    for (int j = 0; j < 4; ++j) { const int n = (lane >> 3) + 8 * j; const LAS float* s = scr + (8 * cc) * 33 + n;
        u32x4 o; o.x = pk2(s[0 * 33], s[1 * 33]); o.y = pk2(s[2 * 33], s[3 * 33]); o.z = pk2(s[4 * 33], s[5 * 33]); o.w = pk2(s[6 * 33], s[7 * 33]);
        if (n0 + n < N) *(u32x4*)(WT + (size_t)(row_off + rowmap<MAP>(n0 + n)) * K + k0 + 8 * cc) = o; }
    LDS_WAIT();
}

#define XB_TMO      128
#define XB_XCNT(j)  (256  + 64 * (j))
#define XB_XSUB(j)  (1280 + 64 * (j))
#define XB_XGEN(j)  (2304 + 64 * (j))
#define XB_TOP      3328
#define XB_TOPGEN   3392
#define XCD_BAR_WORDS 3456
#define XB_SPIN_CAP (1u << 18)
__device__ __forceinline__ unsigned xb_ld(unsigned* p)              { return __hip_atomic_load(p, __ATOMIC_RELAXED, __HIP_MEMORY_SCOPE_AGENT); }
__device__ __forceinline__ unsigned xb_add(unsigned* p, unsigned v) { return __hip_atomic_fetch_add(p, v, __ATOMIC_RELAXED, __HIP_MEMORY_SCOPE_AGENT); }
__device__ __forceinline__ unsigned xb_xcc_id() { return (unsigned)__builtin_amdgcn_s_getreg((3 << 11) | 20) & 0xFu; }
#define XB_SPIN(cond, bar) do { unsigned _sp = 0; while (cond) { __builtin_amdgcn_s_sleep(1); \
    if ((++_sp & 255u) == 0u) { if (xb_ld(&(bar)[XB_TMO])) break; if (_sp > XB_SPIN_CAP) { atomicAdd(&(bar)[XB_TMO], 1u); break; } } } } while (0)
struct XcdBarrier { unsigned* bar; unsigned x; volatile LAS unsigned* st; };
__device__ __forceinline__ XcdBarrier xcd_barrier_post(unsigned* bar, volatile LAS unsigned* st) {
    XcdBarrier b; b.bar = bar; b.x = xb_xcc_id(); b.st = st;
    if (threadIdx.x == 0) (void)xb_add(&bar[XB_XCNT(b.x)], 1u);
    return b;
}
__device__ __forceinline__ void xcd_barrier_complete(unsigned* bar, unsigned x, unsigned& nloc, unsigned& nx) {
    const unsigned G = gridDim.x * gridDim.y * gridDim.z;
    unsigned sum, cnt, mine, sp = 0u;
    for (;;) {
        sum = 0u; cnt = 0u; mine = 0u;
#pragma unroll
        for (unsigned j = 0; j < 16; ++j) { const unsigned c = xb_ld(&bar[XB_XCNT(j)]); sum += c; cnt += (c > 0u) ? 1u : 0u; mine = (j == x) ? c : mine; }
        if (sum == G) break;
        __builtin_amdgcn_s_sleep(1);
        if ((++sp & 255u) == 0u) { if (xb_ld(&bar[XB_TMO])) break; if (sp > XB_SPIN_CAP) { atomicAdd(&bar[XB_TMO], 1u); break; } }
    }
    nloc = mine > 0u ? mine : 1u; nx = cnt > 0u ? cnt : 1u;
}
__device__ __forceinline__ void xcd_barrier(const XcdBarrier& b) {
    asm volatile("s_waitcnt vmcnt(0)" ::: "memory");
    __syncthreads();
    if (threadIdx.x == 0) {
        unsigned* bar = b.bar;
        __builtin_amdgcn_s_waitcnt(0);
        unsigned nloc = b.st[0], nx = b.st[1];
        if (nloc == 0u) { xcd_barrier_complete(bar, b.x, nloc, nx); b.st[0] = nloc; b.st[1] = nx; }
        const unsigned old = xb_add(&bar[XB_XSUB(b.x)], 1u);
        const unsigned gen = old / nloc;
        if (old + 1u == (gen + 1u) * nloc) {
            __builtin_amdgcn_fence(__ATOMIC_RELEASE, "agent");
            asm volatile("s_waitcnt vmcnt(0)" ::: "memory");
            const unsigned og = xb_add(&bar[XB_TOP], 1u);
            const unsigned tg = og / nx;
            if (og + 1u == (tg + 1u) * nx) xb_add(&bar[XB_TOPGEN], 1u);
            else XB_SPIN(xb_ld(&bar[XB_TOPGEN]) == tg, bar);
            __builtin_amdgcn_fence(__ATOMIC_ACQUIRE, "agent");
            xb_add(&bar[XB_XGEN(b.x)], 1u);
            asm volatile("s_waitcnt vmcnt(0)" ::: "memory");
        } else {
            XB_SPIN(xb_ld(&bar[XB_XGEN(b.x)]) == gen, bar);
            __builtin_amdgcn_fence(__ATOMIC_ACQUIRE, "agent");
            asm volatile("s_waitcnt vmcnt(0)" ::: "memory");
        }
    }
    __syncthreads();
}

struct Args { const float* in[29]; float* out; unsigned char* ws; float inv[32]; int ph_lo, ph_hi; };

constexpr int DI_UP = 16 * 176, DI_DN = 44 * 32, DI_PL = 4 * 8, N_DEFER = 2 * DI_UP + 2 * DI_DN + 4 * DI_PL;
__device__ __forceinline__ void ffn_weight_item(const Args& a, unsigned char* ws, LAS float* scr, int r, int lane) {
    if (r < DI_UP) { transpose_item<2>(a.in[15], D, UP, (bf16_t*)(ws + WS_WUP0), 0, a.in[14], scr, r, lane); return; } r -= DI_UP;
    if (r < DI_UP) { transpose_item<2>(a.in[24], D, UP, (bf16_t*)(ws + WS_WUP1), 0, a.in[23], scr, r, lane); return; } r -= DI_UP;
    if (r < DI_DN) { transpose_item<0>(a.in[18], FF, D, (bf16_t*)(ws + WS_WDN0), 0, nullptr, scr, r, lane); return; } r -= DI_DN;
    if (r < DI_DN) { transpose_item<0>(a.in[27], FF, D, (bf16_t*)(ws + WS_WDN1), 0, nullptr, scr, r, lane); return; } r -= DI_DN;
    const int gi = r / DI_PL; transpose_item<0>(a.in[20] + (size_t)gi * 65536, 256, 256, (bf16_t*)(ws + WS_WPOOL), gi * 256, nullptr, scr, r % DI_PL, lane);
}

__global__ void __launch_bounds__(512) mk_fwd(Args a) {
    extern __shared__ __attribute__((aligned(16))) unsigned char lds_raw[];
    LAS unsigned char* lds = (LAS unsigned char*)lds_raw;
    LAS unsigned char* ldsx = lds + LDS_RING;
    cg::grid_group grid = cg::this_grid();
    if (threadIdx.x < 2) ((volatile LAS unsigned*)(lds + LDS_BYTES - 16))[threadIdx.x] = 0u;
    __syncthreads();
    if (a.ph_hi == 0x7fff) grid.sync();
    const XcdBarrier xbar = xcd_barrier_post((unsigned*)a.ws, (volatile LAS unsigned*)(lds + LDS_BYTES - 16));
    const int tid = threadIdx.x, lane = tid & 63, wave = __builtin_amdgcn_readfirstlane(tid >> 6);
    const int G = gridDim.x, bx = blockIdx.x;
    unsigned char* ws = a.ws;
#define cosT ((float*)(ws + WS_ROPE))
#define sinT ((float*)(ws + WS_ROPE) + T * 32)
#define ssp ((float*)(ws + WS_SSP))
#define c1p ((float*)(ws + WS_C1P))
#define rstdv ((float*)(ws + WS_RSTD))
#define HB ((float*)(ws + WS_HB))
#define FB ((float*)(ws + WS_FB))
#define gates ((float*)(ws + WS_GATE))
#define Wt_in ((bf16_t*)(ws + WS_WIN))
#define Wt_out ((bf16_t*)(ws + WS_WOUT))
#define Wt_pool ((bf16_t*)(ws + WS_WPOOL))
#define Wt_c1 (kv ? (bf16_t*)(ws + WS_WC1V) : (bf16_t*)(ws + WS_WC1K))
#define Wt_c2 (kv ? (bf16_t*)(ws + WS_WC2V) : (bf16_t*)(ws + WS_WC2K))
#define XB ((bf16_t*)(ws + WS_XB))
#define Qb ((bf16_t*)(ws + WS_Q))
#define KC ((bf16_t*)(ws + WS_KC))
#define VC ((bf16_t*)(ws + WS_VC))
#define KS ((bf16_t*)(ws + WS_KS))
#define VST ((bf16_t*)(ws + WS_VST))
#define KW ((bf16_t*)(ws + WS_KW))
#define VWT ((bf16_t*)(ws + WS_VWT))
#define KCC ((bf16_t*)(ws + WS_KCC))
#define VCT ((bf16_t*)(ws + WS_VCT))
#define Ob ((bf16_t*)(ws + WS_O))
#define ACT ((bf16_t*)(ws + WS_ACT))
#define POOLED ((bf16_t*)(ws + WS_POOLED))
    float* out = a.out;
    const int lo = a.ph_lo, hi = a.ph_hi;
    const bool defer = (G == 256);
#define IN(k) (lo <= (k) && (k) < hi)
#define SEAM(k) do { if (IN(k) && IN((k) + 1)) xcd_barrier(xbar); } while (0)

    if (IN(0)) {
        LAS float* scr = (LAS float*)(lds + wave * 16384);
        const int gw = bx * 8 + wave, NGW = G * 8;
        constexpr int I_IN = 16 * 58, I_OUT = 16 * 32, I_C1 = 32 * 8, I_C2 = 4 * 2;
        constexpr int NA = I_IN + I_OUT + 2 * I_C1 + 2 * I_C2;
        const int NIT = NA + (defer ? 0 : N_DEFER);
        for (int it = gw; it < NIT; it += NGW) {
            int r = it;
            if (r < I_IN) { transpose_item<1>(a.in[2], D, 1840, Wt_in, 0, a.in[1], scr, r, lane); continue; } r -= I_IN;
            if (r < I_OUT) { transpose_item<0>(a.in[13], D, D, Wt_out, 0, nullptr, scr, r, lane); continue; } r -= I_OUT;
            if (r < I_C1) { transpose_item<0>(a.in[4], 2048, 256, (bf16_t*)(ws + WS_WC1K), 0, nullptr, scr, r, lane); continue; } r -= I_C1;
            if (r < I_C1) { transpose_item<0>(a.in[9], 2048, 256, (bf16_t*)(ws + WS_WC1V), 0, nullptr, scr, r, lane); continue; } r -= I_C1;
            if (r < I_C2) { transpose_item<3>(a.in[6], 256, 64, (bf16_t*)(ws + WS_WC2K), 0, nullptr, scr, r, lane); continue; } r -= I_C2;
            if (r < I_C2) { transpose_item<3>(a.in[11], 256, 64, (bf16_t*)(ws + WS_WC2V), 0, nullptr, scr, r, lane); continue; } r -= I_C2;
            ffn_weight_item(a, ws, scr, r, lane);
        }
        for (int m = gw; m < M; m += 2 * NGW) {
            const int m2 = m + NGW;
            const f32x4* xr = (const f32x4*)(a.in[0] + (size_t)m * D) + lane; const f32x4* xr2 = (const f32x4*)(a.in[0] + (size_t)m2 * D) + lane;
            f32x4 v[4], w[4];
#pragma unroll
            for (int j = 0; j < 4; ++j) { v[j] = xr[64 * j]; w[j] = (m2 < M) ? xr2[64 * j] : (f32x4){0.f, 0.f, 0.f, 0.f}; }
            unsigned long long* o8 = (unsigned long long*)(XB + (size_t)m * D) + lane; unsigned long long* o82 = (unsigned long long*)(XB + (size_t)m2 * D) + lane; float s1 = 0.f, s2 = 0.f;
#pragma unroll
            for (int j = 0; j < 4; ++j) {
                s1 += (v[j][0] * v[j][0] + v[j][1] * v[j][1]) + (v[j][2] * v[j][2] + v[j][3] * v[j][3]); o8[64 * j] = (unsigned long long)pk2(v[j][0], v[j][1]) | ((unsigned long long)pk2(v[j][2], v[j][3]) << 32);
                s2 += (w[j][0] * w[j][0] + w[j][1] * w[j][1]) + (w[j][2] * w[j][2] + w[j][3] * w[j][3]); if (m2 < M) o82[64 * j] = (unsigned long long)pk2(w[j][0], w[j][1]) | ((unsigned long long)pk2(w[j][2], w[j][3]) << 32);
            }
#pragma unroll
            for (int o = 1; o < 64; o <<= 1) { s1 += __shfl_xor(s1, o); s2 += __shfl_xor(s2, o); }
            if (lane == 0) { rstdv[m] = 1.0f / sqrtf(s1 * (1.0f / D) + EPS); if (m2 < M) rstdv[m2] = 1.0f / sqrtf(s2 * (1.0f / D) + EPS); }
        }
        for (int i = bx * 512 + tid; i < T * 32; i += G * 512) {
            const int t = i >> 5, f = i & 31; const float ang = (float)t * a.inv[f];
            double x = (double)ang * 0.15915494309189535; x -= __builtin_rint(x); const float xf = (float)x;
            cosT[i] = __builtin_amdgcn_cosf(xf); sinT[i] = __builtin_amdgcn_sinf(xf);
        }
        for (int it = NGW - 1 - gw; it < 256; it += NGW) {
            const int kv = it >> 7, chunk = (it >> 2) & 31, nb = it & 3; const float* pos = a.in[kv ? 8 : 3]; const float* w1 = a.in[kv ? 9 : 4];
            float s = 0.f;
#pragma unroll 32
            for (int r = 0; r < 64; ++r) { const int rr = chunk * 64 + r; s += pos[rr] * w1[(size_t)rr * 256 + nb * 64 + lane]; }
            c1p[(kv * 32 + chunk) * 256 + nb * 64 + lane] = s;
        }
        asm volatile("s_waitcnt vmcnt(0) lgkmcnt(0)" ::: "memory"); __syncthreads();
    }
    SEAM(0);
    if (IN(1)) {
        pg8::Gemm g{XB, Wt_in, M, NIN, D, D, 0}; pg8::StaticOrder S; S.init(M, NIN, G, bx);
        EpiIn E{rstdv, cosT, sinT, Qb, KC, VC, KS, VST, KW, VWT, gates};
        pg8::gemm_phase(lds, ldsx, g, S, E);
    }
    SEAM(1);
    if (IN(2)) {
        const int tid = threadIdx.x, lane = tid & 63, w = __builtin_amdgcn_readfirstlane(tid >> 6), fr = lane & 15, fq = lane >> 4;
        LAS float* c1s = (LAS float*)lds;
        LAS unsigned char* hidL = lds + 4096;
        for (int i = tid; i < 512; i += 512) { const int kv = i >> 8, n = i & 255; const float* b1 = a.in[kv ? 10 : 5]; float sv = b1[n]; for (int q = 0; q < 32; ++q) sv += c1p[(kv * 32 + q) * 256 + n]; c1s[i] = sv; }
        __syncthreads();
        for (int u = bx; u < 256; u += G) {
            const int kv = u >> 7, r0 = (u & 127) * 16;
            const bf16_t* Ap = (kv ? VC : KC) + (size_t)(r0 + fr) * 1024 + 8 * fq;
            const bf16_t* Bp = Wt_c1 + (size_t)(32 * w + fr) * 2048 + 8 * fq;
            f32x4 h0 = (f32x4){0.f, 0.f, 0.f, 0.f}, h1 = h0;
#pragma unroll 1
            for (int k0 = 0; k0 < 2048; k0 += 256) {
                bf16x8 af[8], b0[8], b1f[8];
#pragma unroll
                for (int q = 0; q < 8; ++q) { af[q] = *(const bf16x8*)(Ap + k0 + 32 * q); b0[q] = *(const bf16x8*)(Bp + k0 + 32 * q); b1f[q] = *(const bf16x8*)(Bp + 16 * 2048 + k0 + 32 * q); }
#pragma unroll
                for (int q = 0; q < 8; ++q) { h0 = __builtin_amdgcn_mfma_f32_16x16x32_bf16(b0[q], af[q], h0, 0, 0, 0); h1 = __builtin_amdgcn_mfma_f32_16x16x32_bf16(b1f[q], af[q], h1, 0, 0, 0); }
            }
            { const int c0 = 32 * w + 8 * fq; float v[8];
#pragma unroll
              for (int e = 0; e < 8; ++e) { const float x = ((e >> 2) ? h1[e & 3] : h0[e & 3]) + c1s[kv * 256 + c0 + e]; const float y = 0.7978845608028654f * (x + 0.044715f * x * x * x); v[e] = x * sigmoidf_(2.0f * y); }
              u32x4 wv; wv.x = cvt_pk_bf16(v[0], v[1]); wv.y = cvt_pk_bf16(v[2], v[3]); wv.z = cvt_pk_bf16(v[4], v[5]); wv.w = cvt_pk_bf16(v[6], v[7]);
              *(LAS u32x4*)(hidL + fr * 528 + c0 * 2) = wv; }
            __syncthreads();
            if (w < 2) {
                const bf16_t* W2 = Wt_c2 + (size_t)(32 * w + fr) * 256 + 8 * fq;
                f32x4 oA = (f32x4){0.f, 0.f, 0.f, 0.f}, oB = oA;
#pragma unroll
                for (int q = 0; q < 8; ++q) {
                    const bf16x8 hf = *(const LAS bf16x8*)(hidL + fr * 528 + (32 * q + 8 * fq) * 2);
                    const bf16x8 wa = *(const bf16x8*)(W2 + 32 * q), wb = *(const bf16x8*)(W2 + 16 * 256 + 32 * q);
                    oA = __builtin_amdgcn_mfma_f32_16x16x32_bf16(wa, hf, oA, 0, 0, 0); oB = __builtin_amdgcn_mfma_f32_16x16x32_bf16(wb, hf, oB, 0, 0, 0);
                }
                const float* b2 = a.in[kv ? 12 : 7]; const int d0 = 16 * w + 4 * fq; const int row = r0 + fr, j = row & 511;
                f32x4 a1 = oA + *(const f32x4*)(b2 + d0), a2 = oB + *(const f32x4*)(b2 + d0 + 32);
                if (j == 511) { a1 = (f32x4){0.f, 0.f, 0.f, 0.f}; a2 = a1; }
                if (!kv) {
                    const int pos = (j == 511) ? 0 : 16 * j + 31;
                    const f32x4 cs = *(const f32x4*)(cosT + pos * 32 + d0), sn = *(const f32x4*)(sinT + pos * 32 + d0);
                    const f32x4 o1 = a1 * cs - a2 * sn, o2 = a1 * sn + a2 * cs;
                    bf16_t* p = KCC + (size_t)row * 64 + d0;
                    u32x2 w1; w1.x = cvt_pk_bf16(o1[0], o1[1]); w1.y = cvt_pk_bf16(o1[2], o1[3]); *(u32x2*)p = w1;
                    u32x2 w2; w2.x = cvt_pk_bf16(o2[0], o2[1]); w2.y = cvt_pk_bf16(o2[2], o2[3]); *(u32x2*)(p + 32) = w2;
                } else {
                    bf16_t* p = VCT + (size_t)(row >> 6) * 4096 + vperm(row & 63);
#pragma unroll
                    for (int e = 0; e < 4; ++e) { p[(d0 + e) * 64] = (bf16_t)(cvt_pk_bf16(a1[e], 0.f) & 0xffff); p[(d0 + 32 + e) * 64] = (bf16_t)(cvt_pk_bf16(a2[e], 0.f) & 0xffff); }
                }
            }
            __syncthreads();
        }
    }
    if (IN(2) && IN(4)) xcd_barrier(xbar);
    if (IN(4)) {
        att::Ctx X{Qb, KCC, VCT, KS, VST, KW, VWT, gates, Ob};
        for (int k = bx; k < 256; k += G) {
            for (int rep = 0; rep < 2; ++rep) { const int uu = rep ? 511 - k : k; const int c = 127 - (uu >> 2), bgi = uu & 3; att::unit(lds, X, bgi >> 1, bgi & 1, c, tid); }
        }
        if (defer) {
            int td = threadIdx.x; asm volatile("" : "+v"(td)); const int dl = td & 63, dw = __builtin_amdgcn_readfirstlane(td >> 6);
            LAS float* scr = (LAS float*)(lds + dw * 16384);
            for (int it = bx * 8 + dw; it < N_DEFER; it += 2048) ffn_weight_item(a, ws, scr, it, dl);
        }
    }
    SEAM(4);
    if (IN(5)) {
        pg8::Gemm g{Ob, Wt_out, M, D, D, D, 0}; pg8::StaticOrder S; S.init(M, D, G, bx);
        EpiRes E{a.in[0], out, XB, ssp, nullptr, nullptr, XB};
        pg8::gemm_phase(lds, ldsx, g, S, E);
    }
    SEAM(5);
#pragma unroll
    for (int L = 0; L < 2; ++L) {
        const int pb = 6 + 5 * L;
        const float* cw = a.in[L ? 25 : 16]; const float* cb = a.in[L ? 26 : 17];
        if (IN(pb)) {
            pg8::Gemm g{(const bf16_t*)(ws + (L ? WS_XB2 : WS_XB)), (const bf16_t*)(ws + (L ? WS_WUP1 : WS_WUP0)), M, UP, D, D, 0}; pg8::StaticOrder S; S.init(M, UP, G, bx);
            EpiUp E{L ? ssp + 4 * M : ssp, cw, cb, ACT, HB, FB};
            pg8::gemm_phase(lds, ldsx, g, S, E);
        }
        SEAM(pb);
        if (IN(pb + 1)) {
            for (int i = bx * 512 + tid; i < 64 * FF; i += G * 512) {
                const int pm = i / FF, cidx = i % FF;
                float hg0 = 0.f, hg1 = 0.f, hv0 = 0.f, hv1 = 0.f;
                if (pm & 31) { const float* h = HB + (size_t)(pm - 1) * 2 * UP; hg0 = h[cidx]; hg1 = h[UP + cidx]; hv0 = h[FF + cidx]; hv1 = h[UP + FF + cidx]; }
                const float* f = FB + (size_t)pm * 2 * UP; const float fg0 = f[cidx], fg1 = f[UP + cidx], fv0 = f[FF + cidx], fv1 = f[UP + FF + cidx];
                const float g0 = cb[cidx] + cw[cidx] * hg0 + cw[UP + cidx] * hg1 + cw[2 * UP + cidx] * fg0;
                const float g1 = cb[cidx] + cw[cidx] * hg1 + cw[UP + cidx] * fg0 + cw[2 * UP + cidx] * fg1;
                const float v0 = cb[FF + cidx] + cw[FF + cidx] * hv0 + cw[UP + FF + cidx] * hv1 + cw[2 * UP + FF + cidx] * fv0;
                const float v1 = cb[FF + cidx] + cw[FF + cidx] * hv1 + cw[UP + FF + cidx] * fv0 + cw[2 * UP + FF + cidx] * fv1;
                ACT[(size_t)(pm * 256) * FF + cidx] = (bf16_t)f2bf(g0 * sigmoidf_(g0) * v0);
                ACT[(size_t)(pm * 256 + 1) * FF + cidx] = (bf16_t)f2bf(g1 * sigmoidf_(g1) * v1);
            }
        }
        SEAM(pb + 1);
        if (IN(pb + 2)) {
            pg8::Gemm g{ACT, (const bf16_t*)(ws + (L ? WS_WDN1 : WS_WDN0)), M, D, FF, FF, 0}; pg8::StaticOrder S; S.init(M, D, G, bx);
            bf16_t* XBL = (bf16_t*)(ws + (L ? WS_XB2 : WS_XB));
            if (L == 1 && G == 256) { EpiFinal E{out, a.in[28], (float*)(ws + WS_SSP + 512 * 1024), (unsigned*)(ws + 16384), XBL}; pg8::gemm_phase(lds, ldsx, g, S, E); }
            else { EpiRes E{out, out, XBL, ssp, nullptr, nullptr, XBL}; pg8::gemm_phase(lds, ldsx, g, S, E); }
        }
        if (!(L == 1 && G == 256)) { if (IN(pb + 2)) xcd_barrier(xbar); }
        if (L == 0) {
            if (IN(10)) {
                pg8::Gemm g{POOLED, Wt_pool, M, D, 256, D, 512}; pg8::StaticOrder S; S.init(M, D, G, bx);
                {
                    LAS float* rsd = (LAS float*)lds;
                    const float* gn = a.in[19];
                    int tid = threadIdx.x; asm volatile("" : "+v"(tid));
                    pg8::Unit pu;
                    for (int ui = 0; S.next(ui, pu); ++ui) {
                        const int r0 = pu.pm * 256, tb = r0 & (T - 1), wsz = 2 << pu.pn;
                        const int c8 = pu.pn * 256 + (tid & 31) * 8, t0 = (tid >> 5) * 16;
                        const f32x4 gv0 = *(const f32x4*)(gn + c8), gv1 = *(const f32x4*)(gn + c8 + 4);
                        __syncthreads();
                        if (tid < 272) { const int rr = r0 - 16 + tid; rsd[tid] = (tb - 16 + tid >= 0) ? row_rstd(ssp, 4, rr) : 0.f; }
                        __syncthreads();
                        const bf16_t* xb0 = XB + (size_t)r0 * D + c8;
#define POOL_H(tl, lo, hi) do { unpk8(*(const u32x4*)(xb0 + (ptrdiff_t)(tl) * D), lo, hi); const float rs_ = rsd[16 + (tl)]; lo = lo * rs_; hi = hi * rs_; } while (0)
                        f32x4 s0 = (f32x4){0.f, 0.f, 0.f, 0.f}, s1 = s0;
                        for (int i = 1; i <= wsz; ++i) { const int tl = t0 - i; if (tb + tl >= 0) { f32x4 a0, a1; POOL_H(tl, a0, a1); s0 += a0; s1 += a1; } }
#pragma unroll 4
                        for (int tl = t0; tl < t0 + 16; ++tl) {
                            f32x4 h0, h1; POOL_H(tl, h0, h1); s0 += h0; s1 += h1;
                            const int td = tl - wsz; if (tb + td >= 0) { f32x4 d0, d1; POOL_H(td, d0, d1); s0 -= d0; s1 -= d1; }
                            const int t = tb + tl; const int cnt = (t + 1 < wsz) ? t + 1 : wsz; const float ic = 1.0f / (float)cnt;
                            const f32x4 p0 = (s0 * ic - h0) * gv0, p1 = (s1 * ic - h1) * gv1;
                            u32x4 wv; wv.x = cvt_pk_bf16(p0[0], p0[1]); wv.y = cvt_pk_bf16(p0[2], p0[3]); wv.z = cvt_pk_bf16(p1[0], p1[1]); wv.w = cvt_pk_bf16(p1[2], p1[3]);
                            *(u32x4*)(POOLED + (size_t)(r0 + tl) * D + c8) = wv;
                        }
#undef POOL_H
                    }
                    asm volatile("s_waitcnt vmcnt(0)" ::: "memory"); __syncthreads();
                }
                EpiRes E{out, out, XB, ssp + 4 * M, a.in[21], a.in[22], (bf16_t*)(ws + WS_XB2)};
                pg8::gemm_phase(lds, ldsx, g, S, E);
            }
            SEAM(10);
        }
    }
    if (IN(14) && G != 256) {
        int t14 = threadIdx.x; asm volatile("" : "+v"(t14)); const int lane = t14 & 63, wave = __builtin_amdgcn_readfirstlane(t14 >> 6);
        const int gw = bx * 8 + wave, NGW = G * 8; const float* gn = a.in[28];
        for (int m = gw; m < M; m += NGW) {
            const float rs = row_rstd(ssp, 4, m); f32x4* xr = (f32x4*)(out + (size_t)m * D) + lane; const f32x4* gr = (const f32x4*)gn + lane;
            const u32x2* xbr = (const u32x2*)(ws + WS_XB2) + (size_t)m * (D / 4) + lane;
#pragma unroll
            for (int j = 0; j < 4; ++j) { const u32x2 v = xbr[64 * j]; const f32x4 xv = (f32x4){__uint_as_float(v.x << 16), __uint_as_float(v.x & 0xffff0000u), __uint_as_float(v.y << 16), __uint_as_float(v.y & 0xffff0000u)}; xr[64 * j] = xv * rs * gr[64 * j]; }
        }
    }
#undef IN
#undef SEAM
#undef cosT
#undef sinT
#undef ssp
#undef c1p
#undef rstdv
#undef HB
#undef FB
#undef gates
#undef Wt_in
#undef Wt_out
#undef Wt_pool
#undef Wt_c1
#undef Wt_c2
#undef XB
#undef Qb
#undef KC
#undef VC
#undef KS
#undef VST
#undef KW
#undef VWT
#undef KCC
#undef VCT
#undef Ob
#undef ACT
#undef POOLED
}

extern "C" void kernel_launch(void* const* d_in, const int* in_sizes, int n_in, void* d_out, int out_size, void* d_ws, size_t ws_size, hipStream_t stream) {
    static int grid = 0;
    if (grid == 0) {
        int dev = 0, cus = 0, per_cu = 0;
        hipGetDevice(&dev); hipDeviceGetAttribute(&cus, hipDeviceAttributeMultiprocessorCount, dev);
        hipFuncSetAttribute((const void*)mk_fwd, hipFuncAttributeMaxDynamicSharedMemorySize, LDS_BYTES);
        hipOccupancyMaxActiveBlocksPerMultiprocessor(&per_cu, (const void*)mk_fwd, 512, LDS_BYTES);
        if (per_cu < 1) per_cu = 1;
        grid = cus * per_cu; if (grid > 256) grid = 256;
        (void)hipGetLastError();
    }
    Args a{};
    for (int i = 0; i < 29; ++i) a.in[i] = (const float*)d_in[i];
    a.out = (float*)d_out; a.ws = (unsigned char*)d_ws;
    for (int i = 0; i < 32; ++i) a.inv[i] = 1.0f / powf(10000.0f, (float)(2 * i) / 64.0f);
    a.ph_lo = 0; a.ph_hi = 15;
    hipMemsetAsync(d_ws, 0, 65536, stream);
    void* args[] = {&a};
    hipError_t e = hipLaunchCooperativeKernel((const void*)mk_fwd, dim3(grid), dim3(512), args, LDS_BYTES, stream);
    if (e != hipSuccess) fprintf(stderr, "cooperative launch failed: %s (grid %d)\n", hipGetErrorString(e), grid);
}
```
